# Optimizing an MI355X kernel written in HIP

```python
import math
import jax
import jax.numpy as jnp
from jax import lax
import numpy as np

D_MODEL = 1024
BATCH = 2
SEQ = 8192
DEPTH = 2

GRID_W = 64
CTX_LEN = 256
HEAD_DIM = 64
ROPE_THETA = 10000.0
NORM_EPS = 1e-6
Q_BLOCK = 128
N_DIRS = 2

SSD_HEADS = 4
SSD_HEAD_DIM = 64
SSD_GROUPS = 2
SSD_STATE = 128
SSD_CONV = 3
SSD_CHUNK = 128
D_SSD = SSD_HEADS * SSD_HEAD_DIM
SSD_XBC = D_SSD + 2 * SSD_GROUPS * SSD_STATE

GA_HEADS = 4
GA_KV_HEADS = 2
D_GA = GA_HEADS * HEAD_DIM

WA_HEADS = 4
WA_KV_HEADS = 2
WINDOW = 128
D_WA = WA_HEADS * HEAD_DIM

S5_GROUPS = 16
S5_GROUP_CH = 16
S5_STATE = 64
S5_MAX_RE = -1e-4
D_S5 = S5_GROUPS * S5_GROUP_CH

D_MIX = D_SSD + D_GA + D_WA + D_S5

D_FF = 2816
FFN_CONV = 3

IN_SIZES = (D_SSD, SSD_XBC, N_DIRS * SSD_HEADS,
            D_GA, GA_KV_HEADS * HEAD_DIM, GA_KV_HEADS * HEAD_DIM,
            D_WA, WA_KV_HEADS * HEAD_DIM, WA_KV_HEADS * HEAD_DIM,
            D_S5)
IN_OFFSETS = tuple(sum(IN_SIZES[:j + 1]) for j in range(len(IN_SIZES) - 1))
D_IN = sum(IN_SIZES)

kernel_name = 'hybrid_parallel_heads_prefix_dit'


def rms_norm(x, g):
    xf = x.astype(jnp.float32)
    y = xf * lax.rsqrt(jnp.mean(xf * xf, axis=-1, keepdims=True) + NORM_EPS)
    return (y * g.astype(jnp.float32)).astype(x.dtype)


def modulate(x, g, shift, scale):
    return rms_norm(x, g) * (1 + scale) + shift


def dwconv(u, w, b):
    k = w.shape[0]
    y = lax.conv_general_dilated(u, w[:, None, :].astype(u.dtype), (1,), [(k // 2, k // 2)],
                                 dimension_numbers=('NWC', 'WIO', 'NWC'),
                                 feature_group_count=u.shape[-1])
    return y + b


def heads(u, n):
    return u.reshape(u.shape[:-1] + (n, HEAD_DIM))


def axial_rope(seq):
    rows = seq // GRID_W
    row = jnp.broadcast_to(jnp.arange(rows, dtype=jnp.float32)[:, None], (rows, GRID_W)).reshape(-1)
    col = jnp.broadcast_to(jnp.arange(GRID_W, dtype=jnp.float32)[None, :], (rows, GRID_W)).reshape(-1)
    n_freq = HEAD_DIM // 4
    inv = ROPE_THETA ** (-jnp.arange(n_freq, dtype=jnp.float32) / n_freq)
    ang = jnp.concatenate([row[:, None] * inv, col[:, None] * inv], axis=-1)
    return jnp.cos(ang), jnp.sin(ang)


def apply_rope(x, cos, sin):
    half = HEAD_DIM // 2
    xf = x.astype(jnp.float32)
    x1, x2 = xf[..., :half], xf[..., half:]
    cos, sin = cos[None, :, None, :], sin[None, :, None, :]
    return jnp.concatenate([x1 * cos - x2 * sin, x2 * cos + x1 * sin], axis=-1).astype(x.dtype)


def global_attention(q, k, v, kc, vc):
    b, s, hq, dh = q.shape
    n_kv = k.shape[2]
    g = hq // n_kv
    nb = s // Q_BLOCK
    k_all = jnp.concatenate([kc, k], axis=1)
    v_all = jnp.concatenate([vc, v], axis=1)
    qb = jnp.moveaxis(q.reshape(b, nb, Q_BLOCK, n_kv, g, dh), 1, 0)

    def block(qi):
        sc = jnp.einsum('bqhgd,bkhd->bhgqk', qi, k_all, preferred_element_type=jnp.float32)
        p = jax.nn.softmax(sc, axis=-1).astype(v_all.dtype)
        return jnp.einsum('bhgqk,bkhd->bqhgd', p, v_all)

    o = lax.map(block, qb)
    return jnp.moveaxis(o, 0, 1).reshape(b, s, hq * dh)


def window_attention(q, k, v, kc, vc, sink):
    b, s, hq, dh = q.shape
    n_kv = k.shape[2]
    g = hq // n_kv
    nb = s // Q_BLOCK
    nw = 3 * Q_BLOCK
    n_ctx = kc.shape[1]

    def bands(u):
        up = jnp.pad(u, ((0, 0), (Q_BLOCK, Q_BLOCK), (0, 0), (0, 0))).reshape(b, nb + 2, Q_BLOCK, n_kv, dh)
        return jnp.concatenate([up[:, :-2], up[:, 1:-1], up[:, 2:]], axis=2)

    kw, vw = bands(k), bands(v)
    qb = q.reshape(b, nb, Q_BLOCK, n_kv, g, dh)
    s_loc = jnp.einsum('bnqhgd,bnkhd->bnhgqk', qb, kw, preferred_element_type=jnp.float32)
    qi = jnp.arange(Q_BLOCK)[:, None]
    kj = jnp.arange(nw)[None, :]
    band = (kj >= qi + Q_BLOCK - WINDOW) & (kj <= qi + Q_BLOCK + WINDOW)
    kpos = (jnp.arange(nb)[:, None] - 1) * Q_BLOCK + jnp.arange(nw)[None, :]
    valid = (kpos >= 0) & (kpos < s)
    mask = band[None] & valid[:, None, :]
    s_loc = jnp.where(mask[None, :, None, None], s_loc, -jnp.inf)
    s_ctx = jnp.einsum('bnqhgd,bkhd->bnhgqk', qb, kc, preferred_element_type=jnp.float32)
    s_sink = jnp.broadcast_to(sink.astype(jnp.float32).reshape(n_kv, g)[None, None, :, :, None, None],
                              s_ctx.shape[:-1] + (1,))
    p = jax.nn.softmax(jnp.concatenate([s_loc, s_ctx, s_sink], axis=-1), axis=-1)
    o = (jnp.einsum('bnhgqk,bnkhd->bnqhgd', p[..., :nw].astype(vw.dtype), vw)
         + jnp.einsum('bnhgqk,bkhd->bnqhgd', p[..., nw:nw + n_ctx].astype(vc.dtype), vc))
    return o.reshape(b, s, hq * dh)


def context_attention(qc, kc, vc, sink=None):
    b, l, hq, dh = qc.shape
    n_kv = kc.shape[2]
    g = hq // n_kv
    sc = jnp.einsum('bqhgd,bkhd->bhgqk', qc.reshape(b, l, n_kv, g, dh), kc,
                    preferred_element_type=jnp.float32)
    if sink is not None:
        s_sink = jnp.broadcast_to(sink.astype(jnp.float32).reshape(1, n_kv, g, 1, 1), sc.shape[:-1] + (1,))
        sc = jnp.concatenate([sc, s_sink], axis=-1)
    p = jax.nn.softmax(sc, axis=-1)[..., :l]
    o = jnp.einsum('bhgqk,bkhd->bqhgd', p.astype(vc.dtype), vc)
    return o.reshape(b, l, hq * dh)


def ssd_chunked(xh, dt, a, bm, cm, h0, want_y):
    b, t, g, e, p = xh.shape
    n = bm.shape[-1]
    nc = t // SSD_CHUNK
    f32 = jnp.float32
    shp = (b, nc, SSD_CHUNK)
    xdt = (xh.astype(f32) * dt[..., None]).reshape(shp + (g, e, p))
    a_cs = jnp.cumsum((dt * a).reshape(shp + (g, e)), axis=2)
    bm = bm.astype(f32).reshape(shp + (g, n))
    cm = cm.astype(f32).reshape(shp + (g, n))
    a_end = a_cs[:, :, -1]
    chunk_states = jnp.einsum('bclgn,bclgep->bcgepn', bm,
                              xdt * jnp.exp(a_end[:, :, None] - a_cs)[..., None])

    def carry(h, inp):
        dec, st = inp
        return h * dec[..., None, None] + st, h

    h_final, h_in = lax.scan(carry, h0, (jnp.moveaxis(jnp.exp(a_end), 1, 0),
                                         jnp.moveaxis(chunk_states, 1, 0)))
    if not want_y:
        return None, h_final
    h_in = jnp.moveaxis(h_in, 0, 1)
    a_l = jnp.moveaxis(a_cs, 2, -1)
    causal = jnp.tril(jnp.ones((SSD_CHUNK, SSD_CHUNK), dtype=bool))
    decay = jnp.exp(jnp.where(causal, a_l[..., :, None] - a_l[..., None, :], -jnp.inf))
    cb = jnp.einsum('bclgn,bcsgn->bcgls', cm, bm)
    y_diag = jnp.einsum('bcgels,bcsgep->bclgep', cb[:, :, :, None] * decay, xdt)
    y_off = jnp.einsum('bclgn,bcgepn->bclgep', cm, h_in) * jnp.exp(a_cs)[..., None]
    return (y_diag + y_off).reshape(b, t, g, e, p).astype(xh.dtype), h_final


def ssd_mixer(lat, ctx, conv_w, conv_b, a_log, dt_bias, d_skip, norm_g, need_ctx):
    hpg = SSD_HEADS // SSD_GROUPS
    f32 = jnp.float32

    def prep(z, xbc, dt_raw):
        b, t, _ = xbc.shape
        xbc = jax.nn.silu(dwconv(xbc, conv_w, conv_b))
        xs, bm, cm = jnp.split(xbc, [D_SSD, D_SSD + SSD_GROUPS * SSD_STATE], axis=-1)
        return (z, xs.reshape(b, t, SSD_GROUPS, hpg, SSD_HEAD_DIM),
                bm.reshape(b, t, SSD_GROUPS, SSD_STATE), cm.reshape(b, t, SSD_GROUPS, SSD_STATE),
                dt_raw.reshape(b, t, N_DIRS, SSD_GROUPS, hpg))

    zl, xl, bl, cl, dl = prep(*lat)
    zc, xc, bc, cc, dc = prep(*ctx)
    dsk = d_skip.reshape(SSD_GROUPS, hpg, 1)
    y_lat = dsk * xl
    y_ctx = dsk * xc if need_ctx else None
    for d in range(N_DIRS):
        a = -jnp.exp(a_log[d].astype(f32)).reshape(SSD_GROUPS, hpg)
        bias = dt_bias[d].astype(f32).reshape(SSD_GROUPS, hpg)

        def rev(u):
            return jnp.flip(u, axis=1) if d == 1 else u

        def run(xs, bm, cm, dtr, h0, want_y):
            dt = jax.nn.softplus(dtr[:, :, d].astype(f32) + bias)
            y, hf = ssd_chunked(rev(xs), rev(dt), a, rev(bm), rev(cm), h0, want_y)
            return (rev(y) if want_y else None), hf

        h0 = jnp.zeros((xc.shape[0], SSD_GROUPS, hpg, SSD_HEAD_DIM, SSD_STATE), f32)
        yc, hc = run(xc, bc, cc, dc, h0, need_ctx)
        yl, _ = run(xl, bl, cl, dl, hc, True)
        y_lat = y_lat + yl
        if need_ctx:
            y_ctx = y_ctx + yc

    def out(y, z):
        return rms_norm(y.reshape(z.shape) * jax.nn.silu(z), norm_g)

    return out(y_lat, zl), (out(y_ctx, zc) if need_ctx else None)


def _linear_recurrence(e1, e2):
    a1, b1 = e1
    a2, b2 = e2
    return a1 * a2, a2 * b1 + b2


def s5_mixer(u_lat, u_ctx, lam_re, lam_im, log_step, b_re, b_im, c_re, c_im, d_skip, w_glu, b_glu, need_ctx):
    f32 = jnp.float32

    def grouped(u):
        return u.astype(f32).reshape(u.shape[0], u.shape[1], S5_GROUPS, S5_GROUP_CH)

    ul, uc = grouped(u_lat), grouped(u_ctx)
    dsk = d_skip.astype(f32).reshape(S5_GROUPS, S5_GROUP_CH)
    y_lat = dsk * ul
    y_ctx = dsk * uc if need_ctx else None
    for d in range(N_DIRS):
        lam = lax.complex(jnp.minimum(lam_re[d].astype(f32), S5_MAX_RE), lam_im[d].astype(f32))
        lam_bar = jnp.exp(lam * jnp.exp(log_step[d].astype(f32))[:, None])
        b_bar = ((lam_bar - 1.0) / lam)[..., None] * lax.complex(b_re[d].astype(f32), b_im[d].astype(f32))
        c_mat = lax.complex(c_re[d].astype(f32), c_im[d].astype(f32))

        def rev(u):
            return jnp.flip(u, axis=1) if d == 1 else u

        def run(u, h0, want_y):
            bu = jnp.einsum('gnk,btgk->btgn', b_bar, rev(u).astype(jnp.complex64))
            bu = bu.at[:, 0].add(lam_bar * h0)
            _, h = lax.associative_scan(_linear_recurrence, (jnp.broadcast_to(lam_bar, bu.shape), bu), axis=1)
            y = rev(jnp.real(jnp.einsum('gkn,btgn->btgk', c_mat, h))) if want_y else None
            return y, h[:, -1]

        h0 = jnp.zeros((uc.shape[0], S5_GROUPS, S5_STATE), jnp.complex64)
        yc, hc = run(uc, h0, need_ctx)
        yl, _ = run(ul, hc, True)
        y_lat = y_lat + yl
        if need_ctx:
            y_ctx = y_ctx + yc

    def glu(y, like):
        y = jax.nn.gelu(y).reshape(like.shape).astype(like.dtype)
        a, g = jnp.split(y @ w_glu + b_glu, 2, axis=-1)
        return a * jax.nn.sigmoid(g)

    return glu(y_lat, u_lat), (glu(y_ctx, u_ctx) if need_ctx else None)


def conv_ffn(h, w_gate, w_up, conv_w, conv_b, w_down):
    gate = dwconv(h @ w_gate, conv_w, conv_b)
    return (jax.nn.silu(gate) * (h @ w_up)) @ w_down


def setup_inputs(seed: int = 0) -> dict:
    key = jax.random.key(seed)
    ks = iter(jax.random.split(key, 40))
    f32 = jnp.float32
    L = DEPTH

    def nrm(shape, scale):
        return scale * jax.random.normal(next(ks), shape, f32)

    def gain(shape):
        return 1.0 + nrm(shape, 0.02)

    def unif(shape, lo, hi):
        return jax.random.uniform(next(ks), shape, f32, lo, hi)

    inp = {}
    inp['x'] = nrm((BATCH, SEQ, D_MODEL), 1.0)
    inp['c'] = nrm((BATCH, D_MODEL), 1.0)
    inp['ctx'] = nrm((BATCH, CTX_LEN, D_MODEL), 1.0)
    inp['c_ctx'] = nrm((D_MODEL,), 1.0)
    inp['w_mod'] = nrm((L, D_MODEL, 6 * D_MODEL), 0.5 * D_MODEL ** -0.5)
    inp['b_mod'] = nrm((L, 6 * D_MODEL), 0.02)
    inp['g_mix'] = gain((L, D_MODEL))
    inp['w_in'] = nrm((L, D_MODEL, D_IN), D_MODEL ** -0.5)
    inp['ssd_conv_w'] = nrm((L, SSD_CONV, SSD_XBC), SSD_CONV ** -0.5)
    inp['ssd_conv_b'] = nrm((L, SSD_XBC), 0.02)
    inp['ssd_a_log'] = jnp.log(unif((L, N_DIRS, SSD_HEADS), 1.0, 16.0))
    dt0 = jnp.exp(unif((L, N_DIRS, SSD_HEADS), math.log(1e-3), math.log(1e-1)))
    inp['ssd_dt_bias'] = dt0 + jnp.log(-jnp.expm1(-dt0))
    inp['ssd_d'] = gain((L, SSD_HEADS))
    inp['ssd_norm_g'] = gain((L, D_SSD))
    inp['ga_q_norm'] = gain((L, HEAD_DIM))
    inp['ga_k_norm'] = gain((L, HEAD_DIM))
    inp['wa_sink'] = nrm((L, WA_HEADS), 0.5)
    inp['s5_lambda_re'] = -0.5 + nrm((L, N_DIRS, S5_GROUPS, S5_STATE), 0.01)
    inp['s5_lambda_im'] = jnp.pi * jnp.arange(S5_STATE, dtype=f32) + nrm((L, N_DIRS, S5_GROUPS, S5_STATE), 0.01)
    inp['s5_log_step'] = unif((L, N_DIRS, S5_GROUPS), math.log(1e-3), math.log(1e-1))
    inp['s5_b_re'] = nrm((L, N_DIRS, S5_GROUPS, S5_STATE, S5_GROUP_CH), (2 * S5_GROUP_CH) ** -0.5)
    inp['s5_b_im'] = nrm((L, N_DIRS, S5_GROUPS, S5_STATE, S5_GROUP_CH), (2 * S5_GROUP_CH) ** -0.5)
    inp['s5_c_re'] = nrm((L, N_DIRS, S5_GROUPS, S5_GROUP_CH, S5_STATE), S5_STATE ** -0.5)
    inp['s5_c_im'] = nrm((L, N_DIRS, S5_GROUPS, S5_GROUP_CH, S5_STATE), S5_STATE ** -0.5)
    inp['s5_d'] = nrm((L, D_S5), 1.0)
    inp['s5_w_glu'] = nrm((L, D_S5, 2 * D_S5), D_S5 ** -0.5)
    inp['s5_b_glu'] = nrm((L, 2 * D_S5), 0.02)
    inp['w_out'] = nrm((L, D_MIX, D_MODEL), D_MIX ** -0.5)
    inp['g_ffn'] = gain((L, D_MODEL))
    inp['w_gate'] = nrm((L, D_MODEL, D_FF), D_MODEL ** -0.5)
    inp['w_up'] = nrm((L, D_MODEL, D_FF), D_MODEL ** -0.5)
    inp['ffn_conv_w'] = nrm((L, FFN_CONV, D_FF), FFN_CONV ** -0.5)
    inp['ffn_conv_b'] = nrm((L, D_FF), 0.02)
    inp['w_down'] = nrm((L, D_FF, D_MODEL), D_FF ** -0.5)
    inp['g_final'] = gain((D_MODEL,))
    return inp


def reference(x, c, ctx, c_ctx, w_mod, b_mod, g_mix, w_in, ssd_conv_w, ssd_conv_b, ssd_a_log,
              ssd_dt_bias, ssd_d, ssd_norm_g, ga_q_norm, ga_k_norm, wa_sink, s5_lambda_re,
              s5_lambda_im, s5_log_step, s5_b_re, s5_b_im, s5_c_re, s5_c_im, s5_d, s5_w_glu,
              s5_b_glu, w_out, g_ffn, w_gate, w_up, ffn_conv_w, ffn_conv_b, w_down, g_final):
    seq = x.shape[1]
    cos, sin = axial_rope(seq)
    q_scale = HEAD_DIM ** -0.5
    xc = ctx
    for i in range(DEPTH):
        need_ctx = i < DEPTH - 1
        mod = jax.nn.silu(c) @ w_mod[i] + b_mod[i]
        modc = jax.nn.silu(c_ctx) @ w_mod[i] + b_mod[i]
        sh_a, sc_a, gt_a, sh_f, sc_f, gt_f = jnp.split(mod[:, None, :], 6, axis=-1)
        shc_a, scc_a, gtc_a, shc_f, scc_f, gtc_f = jnp.split(modc, 6)

        pl = jnp.split(modulate(x, g_mix[i], sh_a, sc_a) @ w_in[i], IN_OFFSETS, axis=-1)
        pc = jnp.split(modulate(xc, g_mix[i], shc_a, scc_a) @ w_in[i], IN_OFFSETS, axis=-1)

        y_ssd, yc_ssd = ssd_mixer(pl[0:3], pc[0:3], ssd_conv_w[i], ssd_conv_b[i], ssd_a_log[i],
                                  ssd_dt_bias[i], ssd_d[i], ssd_norm_g[i], need_ctx)

        kc_ga = rms_norm(heads(pc[4], GA_KV_HEADS), ga_k_norm[i])
        vc_ga = heads(pc[5], GA_KV_HEADS)
        q = apply_rope(rms_norm(heads(pl[3], GA_HEADS), ga_q_norm[i]), cos, sin) * q_scale
        k = apply_rope(rms_norm(heads(pl[4], GA_KV_HEADS), ga_k_norm[i]), cos, sin)
        y_ga = global_attention(q, k, heads(pl[5], GA_KV_HEADS), kc_ga, vc_ga)

        kc_wa = heads(pc[7], WA_KV_HEADS)
        vc_wa = heads(pc[8], WA_KV_HEADS)
        q = apply_rope(heads(pl[6], WA_HEADS), cos, sin) * q_scale
        k = apply_rope(heads(pl[7], WA_KV_HEADS), cos, sin)
        y_wa = window_attention(q, k, heads(pl[8], WA_KV_HEADS), kc_wa, vc_wa, wa_sink[i])

        y_s5, yc_s5 = s5_mixer(pl[9], pc[9], s5_lambda_re[i], s5_lambda_im[i], s5_log_step[i],
                               s5_b_re[i], s5_b_im[i], s5_c_re[i], s5_c_im[i], s5_d[i],
                               s5_w_glu[i], s5_b_glu[i], need_ctx)

        y = jnp.concatenate([y_ssd, y_ga, y_wa, y_s5], axis=-1) @ w_out[i]
        x = x + gt_a * y
        x = x + gt_f * conv_ffn(modulate(x, g_ffn[i], sh_f, sc_f), w_gate[i], w_up[i],
                                ffn_conv_w[i], ffn_conv_b[i], w_down[i])

        if need_ctx:
            yc_ga = context_attention(rms_norm(heads(pc[3], GA_HEADS), ga_q_norm[i]) * q_scale, kc_ga, vc_ga)
            yc_wa = context_attention(heads(pc[6], WA_HEADS) * q_scale, kc_wa, vc_wa, wa_sink[i])
            yc = jnp.concatenate([yc_ssd, yc_ga, yc_wa, yc_s5], axis=-1) @ w_out[i]
            xc = xc + gtc_a * yc
            xc = xc + gtc_f * conv_ffn(modulate(xc, g_ffn[i], shc_f, scc_f), w_gate[i], w_up[i],
                                       ffn_conv_w[i], ffn_conv_b[i], w_down[i])
    return rms_norm(x, g_final)
```

```cpp
#ifndef CPU_TEST
#include <hip/hip_runtime.h>
#include <cstdio>
#include <cstdint>
#define HD __device__ __forceinline__
#define HDM __device__ __forceinline__
#else
#include <cmath>
#include <cstdio>
#include <cstdint>
#include <cstring>
#define HD static inline
#define HDM inline
#endif

#ifndef D_MODEL
#define D_MODEL 1024
#endif
#ifndef SEQ
#define SEQ 8192
#endif
#ifndef CTX_LEN
#define CTX_LEN 256
#endif
#ifndef D_FF
#define D_FF 2816
#endif
#define BATCH 2
#define DEPTH 2
#define GRID_W 64
#define HEAD_DIM 64
#define NORM_EPS 1e-6f
#define D_SSD 256
#define SSD_XBC 768
#define D_S5 256
#define D_MIX 1024
#define D_IN 2312
constexpr int ML = BATCH * SEQ, MC = BATCH * CTX_LEN, MT = ML + MC;
constexpr int NCH = MT / 128;
constexpr int NSC = MT / 16;
constexpr int PLD = 2560;
constexpr int Z_OFF = 0, XBC_OFF = 256, DT_OFF = 1024, GAQ = 1032, GAK = 1288, GAV = 1416, WAQ = 1544, WAK = 1800, WAV = 1928, S5U = 2056;
constexpr int YSSD_OFF = 256, YS5_OFF = 512;

#ifdef CPU_TEST
typedef float act_t;
HD float ldf(const act_t* p) { return *p; }
HD void stf(act_t* p, float v) { *p = v; }
#else
typedef unsigned short act_t;
HD float ldf(const act_t* p) { return __uint_as_float(((unsigned)*p) << 16); }
HD void stf(act_t* p, float v) { unsigned u = __float_as_uint(v); u = (u + 0x7fffu + ((u >> 16) & 1u)) >> 16; *p = (act_t)u; }
#endif

constexpr size_t al256(size_t x) { return (x + 255) & ~(size_t)255; }
constexpr size_t WS_CTL = 0, CTL_BYTES = 1u << 20;
constexpr size_t WS_MOD = WS_CTL + CTL_BYTES;
constexpr size_t WS_ROPE = WS_MOD + al256((size_t)DEPTH * (BATCH + 1) * 6 * D_MODEL * 4);
constexpr size_t WS_LAMP = WS_ROPE + al256((size_t)SEQ * 64 * 4);
constexpr size_t WS_BBAR = WS_LAMP + al256((size_t)DEPTH * 2 * 16 * 64 * 17 * 2 * 4);
constexpr size_t WS_KT = WS_BBAR + al256((size_t)DEPTH * 2 * 16 * 64 * 16 * 2 * 4);
constexpr size_t WS_XC = WS_KT + al256((size_t)DEPTH * 2 * 16 * 16 * 256 * 4);
constexpr size_t WS_SS = WS_XC + al256((size_t)MC * D_MODEL * 4);
constexpr size_t WS_DT = WS_SS + al256((size_t)MT * 4);
constexpr size_t WS_CS = WS_DT + al256((size_t)MT * 8 * 4);
constexpr size_t WS_ARENA = WS_CS + al256((size_t)MT * 8 * 4);
constexpr size_t WS_XN = WS_ARENA;
constexpr size_t WS_YMIX = WS_XN;
constexpr size_t WS_P = WS_XN + al256((size_t)MT * (D_MODEL > D_MIX ? D_MODEL : D_MIX) * sizeof(act_t));
constexpr size_t WS_XBC = WS_P + al256((size_t)MT * PLD * sizeof(act_t));
constexpr size_t WS_SST = WS_XBC + al256((size_t)MT * 768 * sizeof(act_t));
constexpr size_t WS_CB = WS_SST + al256((size_t)NCH * 2 * 4 * 64 * 128 * 4);
constexpr size_t WS_S5E = WS_CB + al256((size_t)NCH * 2 * 128 * 128 * 4);
constexpr size_t WS_MIX_END = WS_S5E + al256((size_t)NSC * 2 * 16 * 64 * 2 * 4);
constexpr size_t WS_GT = WS_P;
constexpr size_t WS_ACT = WS_GT + al256((size_t)MT * D_FF * sizeof(act_t));
constexpr size_t WS_FFN_END = WS_ACT + al256((size_t)MT * D_FF * sizeof(act_t));
constexpr size_t WS_END = WS_MIX_END > WS_FFN_END ? WS_MIX_END : WS_FFN_END;
#ifndef CPU_TEST
static_assert(WS_END <= ((size_t)256 << 20), "workspace map exceeds 256 MiB");
#endif

struct Prm { const float* in[35]; float* out; unsigned char* ws; };
enum { I_X = 0, I_C, I_CTX, I_CCTX, I_WMOD, I_BMOD, I_GMIX, I_WIN, I_SCW, I_SCB, I_SALOG, I_SDTB, I_SD, I_SNG, I_GAQN, I_GAKN, I_SINK,
       I_LRE, I_LIM, I_LSTEP, I_BRE, I_BIM, I_CRE, I_CIM, I_S5D, I_WGLU, I_BGLU, I_WOUT, I_GFFN, I_WGATE, I_WUP, I_FCW, I_FCB, I_WDOWN, I_GFIN };

HD float sigmoidf_(float x) { return 1.f / (1.f + expf(-x)); }
HD float siluf_(float x) { return x * sigmoidf_(x); }
HD float softplusf_(float x) { return x > 20.f ? x : log1pf(expf(x)); }
HD float geluf_(float x) { return 0.5f * x * (1.f + tanhf(0.7978845608028654f * (x + 0.044715f * x * x * x))); }
struct RowInfo { int isctx, b, t, T, modrow; };
HD RowInfo rowinfo(int r) { RowInfo q; if (r < ML) { q.isctx = 0; q.b = r / SEQ; q.t = r % SEQ; q.T = SEQ; q.modrow = q.b; } else { const int rr = r - ML; q.isctx = 1; q.b = rr / CTX_LEN; q.t = rr % CTX_LEN; q.T = CTX_LEN; q.modrow = BATCH; } return q; }
HD float* xrow(const Prm& p, int r) { return r < ML ? p.out + (size_t)r * D_MODEL : (float*)(p.ws + WS_XC) + (size_t)(r - ML) * D_MODEL; }
HD const float* modp(const Prm& p, int layer, int modrow, int which) { return (const float*)(p.ws + WS_MOD) + ((size_t)(layer * (BATCH + 1) + modrow) * 6 + which) * D_MODEL; }
#define WSP(T, off) ((T*)(p.ws + (off)))

HD void st_mod(const Prm& p, long g0, long gs) {
    float* mod = WSP(float, WS_MOD);
    for (long i = g0; i < (long)DEPTH * (BATCH + 1) * 6 * D_MODEL; i += gs) {
        const int j = (int)(i % (6 * D_MODEL)); const int m = (int)((i / (6 * D_MODEL)) % (BATCH + 1)); const int l = (int)(i / ((long)6 * D_MODEL * (BATCH + 1)));
        const float* cv = m < BATCH ? p.in[I_C] + (size_t)m * D_MODEL : p.in[I_CCTX];
        const float* w = p.in[I_WMOD] + (size_t)l * D_MODEL * 6 * D_MODEL + j;
        float acc = 0.f;
        for (int k = 0; k < D_MODEL; ++k) acc += siluf_(cv[k]) * w[(size_t)k * 6 * D_MODEL];
        mod[i] = acc + p.in[I_BMOD][(size_t)l * 6 * D_MODEL + j];
    }
}
HD void st_init(const Prm& p, long g0, long gs) {
    for (long i = g0; i < (long)ML * D_MODEL; i += gs) p.out[i] = p.in[I_X][i];
    float* xc = WSP(float, WS_XC);
    for (long i = g0; i < (long)MC * D_MODEL; i += gs) xc[i] = p.in[I_CTX][i];
    float* rc = WSP(float, WS_ROPE); float* rs = rc + (size_t)SEQ * 32;
    for (long i = g0; i < (long)SEQ * 32; i += gs) {
        const int t = (int)(i / 32), f = (int)(i % 32); const int pos = f < 16 ? t / GRID_W : t % GRID_W; const int fi = f & 15;
        const double inv = pow(10000.0, -(double)fi / 16.0); const double ang = (double)pos * inv;
        rc[i] = (float)cos(ang); rs[i] = (float)sin(ang);
    }
}
HD void st_s5tab1(const Prm& p, long g0, long gs) {
    float* lamp = WSP(float, WS_LAMP); float* bbar = WSP(float, WS_BBAR);
    for (long i = g0; i < (long)DEPTH * 2 * 16 * 64; i += gs) {
        const int g = (int)((i / 64) % 16); const long ldg = i / 64;
        (void)g;
        const double lre = fmin((double)p.in[I_LRE][i], -1e-4), lim = (double)p.in[I_LIM][i];
        const double step = exp((double)p.in[I_LSTEP][ldg]);
        for (int tau = 0; tau <= 16; ++tau) {
            const double mag = exp(lre * step * tau), ang = lim * step * tau;
            lamp[(i * 17 + tau) * 2 + 0] = (float)(mag * cos(ang)); lamp[(i * 17 + tau) * 2 + 1] = (float)(mag * sin(ang));
        }
        const double mag = exp(lre * step), ang = lim * step;
        const double nr = mag * cos(ang) - 1.0, ni = mag * sin(ang);
        const double den = lre * lre + lim * lim;
        const double fr = (nr * lre + ni * lim) / den, fi = (ni * lre - nr * lim) / den;
        for (int k = 0; k < 16; ++k) {
            const double br = p.in[I_BRE][i * 16 + k], bi = p.in[I_BIM][i * 16 + k];
            bbar[(i * 16 + k) * 2 + 0] = (float)(fr * br - fi * bi); bbar[(i * 16 + k) * 2 + 1] = (float)(fr * bi + fi * br);
        }
    }
}
HD void st_s5tab2(const Prm& p, long g0, long gs) {
    const float* lamp = WSP(float, WS_LAMP); const float* bbar = WSP(float, WS_BBAR); float* kt = WSP(float, WS_KT);
    for (long i = g0; i < (long)DEPTH * 2 * 16 * 16 * 256; i += gs) {
        const int kp = (int)(i % 16), k = (int)((i / 16) % 16), tau = (int)((i / 256) % 16); const long ldg = i / 4096;
        float acc = 0.f;
        for (int n = 0; n < 64; ++n) {
            const float cr = p.in[I_CRE][(ldg * 16 + k) * 64 + n], ci = p.in[I_CIM][(ldg * 16 + k) * 64 + n];
            const float lr = lamp[((ldg * 64 + n) * 17 + tau) * 2], li = lamp[((ldg * 64 + n) * 17 + tau) * 2 + 1];
            const float br = bbar[((ldg * 64 + n) * 16 + kp) * 2], bi = bbar[((ldg * 64 + n) * 16 + kp) * 2 + 1];
            const float tr = lr * br - li * bi, ti = lr * bi + li * br;
            acc += cr * tr - ci * ti;
        }
        kt[i] = acc;
    }
}

HD void st_rowss(const Prm& p, int nrows, long g0, long gs) {
    float* ss = WSP(float, WS_SS);
    for (long r = g0; r < nrows; r += gs) { const float* x = xrow(p, (int)r); float s = 0.f; for (int k = 0; k < D_MODEL; ++k) s += x[k] * x[k]; ss[r] = s; }
}
HD void st_normmod(const Prm& p, int layer, int which  , int nrows, long g0, long gs) {
    const float* ss = WSP(float, WS_SS); act_t* xn = WSP(act_t, WS_XN);
    const float* gw = p.in[which ? I_GFFN : I_GMIX] + (size_t)layer * D_MODEL;
    for (long i = g0; i < (long)nrows * D_MODEL; i += gs) {
        const int r = (int)(i / D_MODEL), k = (int)(i % D_MODEL); const RowInfo q = rowinfo(r);
        const float rs = 1.0f / sqrtf(ss[r] * (1.0f / D_MODEL) + NORM_EPS);
        const float sh = modp(p, layer, q.modrow, which ? 3 : 0)[k], sc = modp(p, layer, q.modrow, which ? 4 : 1)[k];
        stf(xn + i, xrow(p, r)[k] * rs * gw[k] * (1.f + sc) + sh);
    }
}
HD void st_final(const Prm& p, long g0, long gs) {
    const float* ss = WSP(float, WS_SS);
    for (long i = g0; i < (long)ML * D_MODEL; i += gs) { const int r = (int)(i / D_MODEL), k = (int)(i % D_MODEL);
        p.out[i] = p.out[i] * (1.0f / sqrtf(ss[r] * (1.0f / D_MODEL) + NORM_EPS)) * p.in[I_GFIN][k]; }
}

template <class Epi> HD void naive_gemm(const act_t* A, int lda, const float* W, int ldw, int M, int N, int K, const Epi& epi, long g0, long gs) {
    const long n4 = N / 4, total = (long)(M / 4) * n4;
    for (long i = g0; i < total; i += gs) {
        const int r0 = (int)(i / n4) * 4, c0 = (int)(i % n4) * 4;
        float acc[4][4];
#pragma unroll
        for (int a = 0; a < 4; ++a)
#pragma unroll
            for (int b = 0; b < 4; ++b) acc[a][b] = 0.f;
        for (int k = 0; k < K; ++k) {
            float av[4], wv[4];
#pragma unroll
            for (int a = 0; a < 4; ++a) av[a] = ldf(A + (size_t)(r0 + a) * lda + k);
#pragma unroll
            for (int b = 0; b < 4; ++b) wv[b] = W[(size_t)k * ldw + c0 + b];
#pragma unroll
            for (int a = 0; a < 4; ++a)
#pragma unroll
                for (int b = 0; b < 4; ++b) acc[a][b] += av[a] * wv[b];
        }
#pragma unroll
        for (int a = 0; a < 4; ++a)
#pragma unroll
            for (int b = 0; b < 4; ++b) epi(r0 + a, c0 + b, acc[a][b]);
    }
}
struct EpiStore { act_t* O; int ldo; HDM void operator()(int r, int c, float v) const { stf(O + (size_t)r * ldo + c, v); } };
struct EpiResid { const Prm* p; int layer, which; HDM void operator()(int r, int c, float v) const { const RowInfo q = rowinfo(r); xrow(*p, r)[c] += modp(*p, layer, q.modrow, which)[c] * v; } };
struct EpiUp { const Prm* p; int layer; HDM void operator()(int r, int c, float v) const {
    const RowInfo q = rowinfo(r); const act_t* gt = (const act_t*)(p->ws + WS_GT); const float* cw = p->in[I_FCW] + (size_t)layer * 3 * D_FF; const float* cb = p->in[I_FCB] + (size_t)layer * D_FF;
    float g = cb[c] + cw[D_FF + c] * ldf(gt + (size_t)r * D_FF + c);
    if (q.t > 0) g += cw[c] * ldf(gt + (size_t)(r - 1) * D_FF + c);
    if (q.t < q.T - 1) g += cw[2 * D_FF + c] * ldf(gt + (size_t)(r + 1) * D_FF + c);
    stf((act_t*)(p->ws + WS_ACT) + (size_t)r * D_FF + c, siluf_(g) * v); } };

HD void st_ssd_conv(const Prm& p, int layer, long g0, long gs) {
    const act_t* P = WSP(act_t, WS_P); act_t* xbc = WSP(act_t, WS_XBC);
    const float* cw = p.in[I_SCW] + (size_t)layer * 3 * SSD_XBC; const float* cb = p.in[I_SCB] + (size_t)layer * SSD_XBC;
    for (long i = g0; i < (long)MT * SSD_XBC; i += gs) {
        const int r = (int)(i / SSD_XBC), c = (int)(i % SSD_XBC); const RowInfo q = rowinfo(r);
        float v = cb[c] + cw[SSD_XBC + c] * ldf(P + (size_t)r * PLD + XBC_OFF + c);
        if (q.t > 0) v += cw[c] * ldf(P + (size_t)(r - 1) * PLD + XBC_OFF + c);
        if (q.t < q.T - 1) v += cw[2 * SSD_XBC + c] * ldf(P + (size_t)(r + 1) * PLD + XBC_OFF + c);
        stf(xbc + i, siluf_(v));
    }
}
HD void st_ssd_cs(const Prm& p, int layer, long g0, long gs) {
    const act_t* P = WSP(act_t, WS_P); float* DT = WSP(float, WS_DT); float* CS = WSP(float, WS_CS);
    for (long i = g0; i < (long)NCH * 8; i += gs) {
        const int dh = (int)(i % 8), c = (int)(i / 8), d = dh >> 2;
        const float a = -expf(p.in[I_SALOG][layer * 8 + dh]), bias = p.in[I_SDTB][layer * 8 + dh];
        float run = 0.f;
        for (int j = 0; j < 128; ++j) { const int l = d ? 127 - j : j; const size_t r = (size_t)c * 128 + l;
            const float dt = softplusf_(ldf(P + r * PLD + DT_OFF + dh) + bias); run += dt * a; DT[r * 8 + dh] = dt; CS[r * 8 + dh] = run; }
    }
}
HD void st_qk_prep(const Prm& p, int layer, long g0, long gs) {
    act_t* P = WSP(act_t, WS_P); const float* rc = WSP(float, WS_ROPE); const float* rs = rc + (size_t)SEQ * 32;
    for (long i = g0; i < (long)MT * 12; i += gs) {
        const int r = (int)(i / 12), s = (int)(i % 12); const RowInfo q = rowinfo(r);
        int off; const float* gn = nullptr; float scale = 1.f;
        if (s < 4) { off = GAQ + s * 64; gn = p.in[I_GAQN] + layer * 64; scale = 0.125f; }
        else if (s < 6) { off = GAK + (s - 4) * 64; gn = p.in[I_GAKN] + layer * 64; }
        else if (s < 10) { off = WAQ + (s - 6) * 64; scale = 0.125f; }
        else off = WAK + (s - 10) * 64;
        act_t* v = P + (size_t)r * PLD + off;
        float rn = 1.f;
        if (gn) { float ssq = 0.f; for (int e = 0; e < 64; ++e) { const float x = ldf(v + e); ssq += x * x; } rn = 1.0f / sqrtf(ssq * (1.f / 64.f) + NORM_EPS); }
        for (int e = 0; e < 32; ++e) {
            float x1 = ldf(v + e) * rn, x2 = ldf(v + e + 32) * rn;
            if (gn) { x1 *= gn[e]; x2 *= gn[e + 32]; }
            float o1 = x1, o2 = x2;
            if (!q.isctx) { const float c = rc[(size_t)q.t * 32 + e], sn = rs[(size_t)q.t * 32 + e]; o1 = x1 * c - x2 * sn; o2 = x2 * c + x1 * sn; }
            stf(v + e, o1 * scale); stf(v + e + 32, o2 * scale);
        }
    }
}

HD void st_ssd_state(const Prm& p, long g0, long gs) {
    const act_t* xbc = WSP(act_t, WS_XBC); const float* DT = WSP(float, WS_DT); const float* CS = WSP(float, WS_CS); float* sst = WSP(float, WS_SST);
    for (long i = g0; i < (long)NCH * 2 * 4 * 64 * 128; i += gs) {
        const int n = (int)(i % 128), pp = (int)((i / 128) % 64), h = (int)((i / 8192) % 4), d = (int)((i / 32768) % 2), c = (int)(i / 65536);
        const int dh = d * 4 + h, g = h >> 1; const size_t r0 = (size_t)c * 128;
        const float aend = CS[(r0 + (d ? 0 : 127)) * 8 + dh];
        float acc = 0.f;
        for (int l = 0; l < 128; ++l) { const size_t r = r0 + l;
            acc += ldf(xbc + r * 768 + 256 + g * 128 + n) * ldf(xbc + r * 768 + h * 64 + pp) * DT[r * 8 + dh] * expf(aend - CS[r * 8 + dh]); }
        sst[i] = acc;
    }
}
HD void st_ssd_cb(const Prm& p, long g0, long gs) {
    const act_t* xbc = WSP(act_t, WS_XBC); float* cb = WSP(float, WS_CB);
    for (long i = g0; i < (long)NCH * 2 * 128 * 128; i += gs) {
        const int s = (int)(i % 128), l = (int)((i / 128) % 128), g = (int)((i / 16384) % 2), c = (int)(i / 32768); const size_t r0 = (size_t)c * 128;
        float acc = 0.f;
        for (int n = 0; n < 128; ++n) acc += ldf(xbc + (r0 + l) * 768 + 512 + g * 128 + n) * ldf(xbc + (r0 + s) * 768 + 256 + g * 128 + n);
        cb[i] = acc;
    }
}
HD int ssd_chunk_of(int b, int d, int j) {
    constexpr int CC = CTX_LEN / 128, LC = SEQ / 128;
    if (j < CC) return ML / 128 + b * CC + (d ? CC - 1 - j : j);
    const int jj = j - CC; return b * LC + (d ? LC - 1 - jj : jj);
}
HD void st_ssd_carry(const Prm& p, long g0, long gs) {
    float* sst = WSP(float, WS_SST); const float* CS = WSP(float, WS_CS);
    for (long i = g0; i < (long)BATCH * 2 * 4 * 64 * 128; i += gs) {
        const int e = (int)(i % 8192), h = (int)((i / 8192) % 4), d = (int)((i / 32768) % 2), b = (int)(i / 65536); const int dh = d * 4 + h;
        float hst = 0.f;
        for (int j = 0; j < (CTX_LEN + SEQ) / 128; ++j) { const int c = ssd_chunk_of(b, d, j);
            const float dec = expf(CS[((size_t)c * 128 + (d ? 0 : 127)) * 8 + dh]); float* sp = sst + ((size_t)(c * 2 + d) * 4 + h) * 8192 + e;
            const float tmp = *sp; *sp = hst; hst = hst * dec + tmp; }
    }
}
HD void st_ssd_y(const Prm& p, int layer, int nrows, long g0, long gs) {
    const act_t* xbc = WSP(act_t, WS_XBC); const float* DT = WSP(float, WS_DT); const float* CS = WSP(float, WS_CS); const float* sst = WSP(float, WS_SST); const float* cb = WSP(float, WS_CB);
    act_t* P = WSP(act_t, WS_P);
    for (long i = g0; i < (long)nrows * 256; i += gs) {
        const int r = (int)(i / 256), hp = (int)(i % 256), h = hp >> 6, pp = hp & 63, g = h >> 1; const int c = r >> 7, l = r & 127; const size_t r0 = (size_t)c * 128;
        float y = p.in[I_SD][layer * 4 + h] * ldf(xbc + (size_t)r * 768 + hp);
        for (int d = 0; d < 2; ++d) { const int dh = d * 4 + h; const float csl = CS[(size_t)r * 8 + dh];
            const int s0 = d ? l : 0, s1 = d ? 127 : l; float acc = 0.f;
            for (int s = s0; s <= s1; ++s) { const size_t rs_ = r0 + s;
                acc += cb[((size_t)(c * 2 + g) * 128 + l) * 128 + s] * expf(csl - CS[rs_ * 8 + dh]) * ldf(xbc + rs_ * 768 + hp) * DT[rs_ * 8 + dh]; }
            float off = 0.f; const float* hin = sst + ((size_t)(c * 2 + d) * 4 + h) * 8192 + (size_t)pp * 128;
            for (int n = 0; n < 128; ++n) off += ldf(xbc + (size_t)r * 768 + 512 + g * 128 + n) * hin[n];
            y += acc + off * expf(csl); }
        stf(P + (size_t)r * PLD + YSSD_OFF + hp, y);
    }
}
HD void st_ssd_out(const Prm& p, int layer, int nrows, long g0, long gs) {
    const act_t* P = WSP(act_t, WS_P); act_t* ym = WSP(act_t, WS_YMIX); const float* ng = p.in[I_SNG] + layer * 256;
    for (long r = g0; r < nrows; r += gs) { float ssq = 0.f;
        for (int c = 0; c < 256; ++c) { const float v = ldf(P + (size_t)r * PLD + YSSD_OFF + c) * siluf_(ldf(P + (size_t)r * PLD + Z_OFF + c)); ssq += v * v; }
        const float rn = 1.0f / sqrtf(ssq * (1.f / 256.f) + NORM_EPS);
        for (int c = 0; c < 256; ++c) { const float v = ldf(P + (size_t)r * PLD + YSSD_OFF + c) * siluf_(ldf(P + (size_t)r * PLD + Z_OFF + c)); stf(ym + (size_t)r * D_MIX + c, v * rn * ng[c]); } }
}

HD void st_s5_E(const Prm& p, int layer, long g0, long gs) {
    const act_t* P = WSP(act_t, WS_P); const float* lamp = WSP(float, WS_LAMP) + (size_t)layer * 2 * 16 * 64 * 17 * 2; const float* bbar = WSP(float, WS_BBAR) + (size_t)layer * 2 * 16 * 64 * 16 * 2; float* E = WSP(float, WS_S5E);
    for (long i = g0; i < (long)NSC * 2 * 16 * 64; i += gs) {
        const int n = (int)(i % 64), g = (int)((i / 64) % 16), d = (int)((i / 1024) % 2), sc = (int)(i / 2048); const size_t dgn = (size_t)(d * 16 + g) * 64 + n;
        float er = 0.f, ei = 0.f;
        for (int j = 0; j < 16; ++j) { const size_t r = (size_t)sc * 16 + j; float br = 0.f, bi = 0.f;
            for (int k = 0; k < 16; ++k) { const float u = ldf(P + r * PLD + S5U + g * 16 + k); br += bbar[(dgn * 16 + k) * 2] * u; bi += bbar[(dgn * 16 + k) * 2 + 1] * u; }
            const int tau = d ? j : 15 - j; const float lr = lamp[(dgn * 17 + tau) * 2], li = lamp[(dgn * 17 + tau) * 2 + 1];
            er += lr * br - li * bi; ei += lr * bi + li * br; }
        E[i * 2] = er; E[i * 2 + 1] = ei;
    }
}
HD int s5_sc_of(int b, int d, int j) {
    constexpr int CC = CTX_LEN / 16, LC = SEQ / 16;
    if (j < CC) return ML / 16 + b * CC + (d ? CC - 1 - j : j);
    const int jj = j - CC; return b * LC + (d ? LC - 1 - jj : jj);
}
HD void st_s5_carry(const Prm& p, int layer, long g0, long gs) {
    const float* lamp = WSP(float, WS_LAMP) + (size_t)layer * 2 * 16 * 64 * 17 * 2; float* E = WSP(float, WS_S5E);
    for (long i = g0; i < (long)BATCH * 2 * 16 * 64; i += gs) {
        const int gn = (int)(i % 1024), d = (int)((i / 1024) % 2), b = (int)(i / 2048); const size_t dgn = (size_t)d * 1024 + gn;
        const float lr = lamp[(dgn * 17 + 16) * 2], li = lamp[(dgn * 17 + 16) * 2 + 1];
        float hr = 0.f, hi = 0.f;
        for (int j = 0; j < (CTX_LEN + SEQ) / 16; ++j) { const int sc = s5_sc_of(b, d, j); float* e = E + ((size_t)(sc * 2 + d) * 1024 + gn) * 2;
            const float tr = e[0], ti = e[1]; e[0] = hr; e[1] = hi; const float nr = lr * hr - li * hi + tr, ni = lr * hi + li * hr + ti; hr = nr; hi = ni; }
    }
}
HD void st_s5_y(const Prm& p, int layer, int nrows, long g0, long gs) {
    act_t* P = WSP(act_t, WS_P); const float* lamp = WSP(float, WS_LAMP) + (size_t)layer * 2 * 16 * 64 * 17 * 2; const float* kt = WSP(float, WS_KT) + (size_t)layer * 2 * 16 * 16 * 256; const float* E = WSP(float, WS_S5E);
    for (long i = g0; i < (long)nrows * 256; i += gs) {
        const int r = (int)(i / 256), gk = (int)(i % 256), g = gk >> 4, k = gk & 15; const int sc = r >> 4, ii = r & 15; const size_t r0 = (size_t)sc * 16;
        float y = p.in[I_S5D][layer * 256 + gk] * ldf(P + (size_t)r * PLD + S5U + gk);
        for (int d = 0; d < 2; ++d) {
            const int j0 = d ? ii : 0, j1 = d ? 15 : ii;
            for (int j = j0; j <= j1; ++j) { const int tau = d ? j - ii : ii - j; const float* kk = kt + (((size_t)(d * 16 + g) * 16 + tau) * 16 + k) * 16;
                for (int kp = 0; kp < 16; ++kp) y += kk[kp] * ldf(P + (r0 + j) * PLD + S5U + g * 16 + kp); }
            const int pw = d ? 16 - ii : ii + 1; const size_t dg = (size_t)(layer * 2 + d) * 16 + g;
            for (int n = 0; n < 64; ++n) { const float cr = p.in[I_CRE][(dg * 16 + k) * 64 + n], ci = p.in[I_CIM][(dg * 16 + k) * 64 + n];
                const size_t dgn = (size_t)(d * 16 + g) * 64 + n; const float lr = lamp[(dgn * 17 + pw) * 2], li = lamp[(dgn * 17 + pw) * 2 + 1];
                const float* e = E + ((size_t)(sc * 2 + d) * 1024 + g * 64 + n) * 2; const float hr = lr * e[0] - li * e[1], hi = lr * e[1] + li * e[0];
                y += cr * hr - ci * hi; }
        }
        stf(P + (size_t)r * PLD + YS5_OFF + gk, geluf_(y));
    }
}
HD void st_glu(const Prm& p, int layer, int nrows, long g0, long gs) {
    const act_t* P = WSP(act_t, WS_P); act_t* ym = WSP(act_t, WS_YMIX); const float* w = p.in[I_WGLU] + (size_t)layer * 256 * 512; const float* bg = p.in[I_BGLU] + layer * 512;
    for (long i = g0; i < (long)nrows * 256; i += gs) { const int r = (int)(i / 256), n = (int)(i % 256); float a = bg[n], g = bg[256 + n];
        for (int k = 0; k < 256; ++k) { const float y = ldf(P + (size_t)r * PLD + YS5_OFF + k); a += y * w[(size_t)k * 512 + n]; g += y * w[(size_t)k * 512 + 256 + n]; }
        stf(ym + (size_t)r * D_MIX + 768 + n, a * sigmoidf_(g)); }
}

struct AttnAcc { float m, l; float o[64]; };
HD void attn_seg(AttnAcc& A, const float* q, const act_t* P, int row0, int cnt, int koff, int voff) {
    for (int j = 0; j < cnt; ++j) { const act_t* kr = P + (size_t)(row0 + j) * PLD;
        float s = 0.f;
#pragma unroll
        for (int e = 0; e < 64; ++e) s += q[e] * ldf(kr + koff + e);
        if (s > A.m) { const float f = expf(A.m - s); A.l *= f;
#pragma unroll
            for (int e = 0; e < 64; ++e) A.o[e] *= f;
            A.m = s; }
        const float pexp = expf(s - A.m); A.l += pexp;
#pragma unroll
        for (int e = 0; e < 64; ++e) A.o[e] += pexp * ldf(kr + voff + e); }
}
HD void st_attn(const Prm& p, int layer, int nrows, long g0, long gs) {
    const act_t* P = WSP(act_t, WS_P); act_t* ym = WSP(act_t, WS_YMIX);
    for (long i = g0; i < (long)nrows * 8; i += gs) {
        const int r = (int)(i / 8), s = (int)(i % 8); const RowInfo qi = rowinfo(r); const int isw = s >= 4, hq = s & 3, kv = hq >> 1;
        const int qoff = (isw ? WAQ : GAQ) + hq * 64, koff = (isw ? WAK : GAK) + kv * 64, voff = (isw ? WAV : GAV) + kv * 64;
        float q[64];
#pragma unroll
        for (int e = 0; e < 64; ++e) q[e] = ldf(P + (size_t)r * PLD + qoff + e);
        AttnAcc A; A.m = -1e30f; A.l = 0.f;
#pragma unroll
        for (int e = 0; e < 64; ++e) A.o[e] = 0.f;
        attn_seg(A, q, P, ML + qi.b * CTX_LEN, CTX_LEN, koff, voff);
        if (!qi.isctx) {
            if (!isw) attn_seg(A, q, P, qi.b * SEQ, SEQ, koff, voff);
            else { const int t0 = qi.t - 128 < 0 ? 0 : qi.t - 128, t1 = qi.t + 128 > SEQ - 1 ? SEQ - 1 : qi.t + 128; attn_seg(A, q, P, qi.b * SEQ + t0, t1 - t0 + 1, koff, voff); }
        }
        if (isw) { const float sk = p.in[I_SINK][layer * 4 + hq]; if (sk > A.m) { const float f = expf(A.m - sk); A.l *= f;
#pragma unroll
                for (int e = 0; e < 64; ++e) A.o[e] *= f;
                A.m = sk; }
            A.l += expf(sk - A.m); }
        const float inv = 1.f / A.l;
#pragma unroll
        for (int e = 0; e < 64; ++e) stf(ym + (size_t)r * D_MIX + 256 + s * 64 + e, A.o[e] * inv);
    }
}

enum { S_SYNC = 0, S_MOD, S_INIT, S_TAB1, S_TAB2, S_ROWSS, S_NORM_MIX, S_GEMM_IN, S_CONV, S_CS, S_QK, S_STATE, S_CB, S_S5E, S_ATTN, S_SSD_CARRY, S_S5_CARRY,
       S_SSD_Y, S_S5_Y, S_SSD_OUT, S_GLU, S_GEMM_OUT, S_NORM_FFN, S_GEMM_GATE, S_GEMM_UP, S_GEMM_DOWN, S_ROWSS_FIN, S_FINAL };
struct Step { int st, layer; };
#define LAYER_STEPS(L) {S_ROWSS, L}, {S_SYNC, 0}, {S_NORM_MIX, L}, {S_SYNC, 0}, {S_GEMM_IN, L}, {S_SYNC, 0}, {S_CONV, L}, {S_CS, L}, {S_QK, L}, {S_SYNC, 0}, \
    {S_STATE, L}, {S_CB, L}, {S_S5E, L}, {S_ATTN, L}, {S_SYNC, 0}, {S_SSD_CARRY, L}, {S_S5_CARRY, L}, {S_SYNC, 0}, {S_SSD_Y, L}, {S_S5_Y, L}, {S_SYNC, 0}, \
    {S_SSD_OUT, L}, {S_GLU, L}, {S_SYNC, 0}, {S_GEMM_OUT, L}, {S_SYNC, 0}, {S_ROWSS, L}, {S_SYNC, 0}, {S_NORM_FFN, L}, {S_SYNC, 0}, {S_GEMM_GATE, L}, {S_SYNC, 0}, \
    {S_GEMM_UP, L}, {S_SYNC, 0}, {S_GEMM_DOWN, L}, {S_SYNC, 0}
#ifdef CPU_TEST
static const Step PROG[] = {
#else
__constant__ Step PROG_D[] = {
#endif
    {S_MOD, 0}, {S_INIT, 0}, {S_TAB1, 0}, {S_SYNC, 0}, {S_TAB2, 0}, {S_SYNC, 0}, LAYER_STEPS(0), LAYER_STEPS(1), {S_ROWSS_FIN, 0}, {S_SYNC, 0}, {S_FINAL, 0} };
#ifndef CPU_TEST
static const Step PROG[] = { {S_MOD, 0}, {S_INIT, 0}, {S_TAB1, 0}, {S_SYNC, 0}, {S_TAB2, 0}, {S_SYNC, 0}, LAYER_STEPS(0), LAYER_STEPS(1), {S_ROWSS_FIN, 0}, {S_SYNC, 0}, {S_FINAL, 0} };
#endif
constexpr int NPROG = 6 + 2 * 36 + 3;

HD void run_step(const Prm& p, int st, int L, long g0, long gs) {
    const int nrows = (L < DEPTH - 1) ? MT : ML;
    switch (st) {
    case S_MOD: st_mod(p, g0, gs); break;
    case S_INIT: st_init(p, g0, gs); break;
    case S_TAB1: st_s5tab1(p, g0, gs); break;
    case S_TAB2: st_s5tab2(p, g0, gs); break;
    case S_ROWSS: st_rowss(p, MT, g0, gs); break;
    case S_NORM_MIX: st_normmod(p, L, 0, MT, g0, gs); break;
    case S_GEMM_IN: { EpiStore e{WSP(act_t, WS_P), PLD}; naive_gemm(WSP(act_t, WS_XN), D_MODEL, p.in[I_WIN] + (size_t)L * D_MODEL * D_IN, D_IN, MT, D_IN, D_MODEL, e, g0, gs); } break;
    case S_CONV: st_ssd_conv(p, L, g0, gs); break;
    case S_CS: st_ssd_cs(p, L, g0, gs); break;
    case S_QK: st_qk_prep(p, L, g0, gs); break;
    case S_STATE: st_ssd_state(p, g0, gs); break;
    case S_CB: st_ssd_cb(p, g0, gs); break;
    case S_S5E: st_s5_E(p, L, g0, gs); break;
    case S_ATTN: st_attn(p, L, nrows, g0, gs); break;
    case S_SSD_CARRY: st_ssd_carry(p, g0, gs); break;
    case S_S5_CARRY: st_s5_carry(p, L, g0, gs); break;
    case S_SSD_Y: st_ssd_y(p, L, nrows, g0, gs); break;
    case S_S5_Y: st_s5_y(p, L, nrows, g0, gs); break;
    case S_SSD_OUT: st_ssd_out(p, L, nrows, g0, gs); break;
    case S_GLU: st_glu(p, L, nrows, g0, gs); break;
    case S_GEMM_OUT: { EpiResid e{&p, L, 2}; naive_gemm(WSP(act_t, WS_YMIX), D_MIX, p.in[I_WOUT] + (size_t)L * D_MIX * D_MODEL, D_MODEL, nrows, D_MODEL, D_MIX, e, g0, gs); } break;
    case S_NORM_FFN: st_normmod(p, L, 1, nrows, g0, gs); break;
    case S_GEMM_GATE: { EpiStore e{WSP(act_t, WS_GT), D_FF}; naive_gemm(WSP(act_t, WS_XN), D_MODEL, p.in[I_WGATE] + (size_t)L * D_MODEL * D_FF, D_FF, nrows, D_FF, D_MODEL, e, g0, gs); } break;
    case S_GEMM_UP: { EpiUp e{&p, L}; naive_gemm(WSP(act_t, WS_XN), D_MODEL, p.in[I_WUP] + (size_t)L * D_MODEL * D_FF, D_FF, nrows, D_FF, D_MODEL, e, g0, gs); } break;
    case S_GEMM_DOWN: { EpiResid e{&p, L, 5}; naive_gemm(WSP(act_t, WS_ACT), D_FF, p.in[I_WDOWN] + (size_t)L * D_FF * D_MODEL, D_MODEL, nrows, D_MODEL, D_FF, e, g0, gs); } break;
    case S_ROWSS_FIN: st_rowss(p, ML, g0, gs); break;
    case S_FINAL: st_final(p, g0, gs); break;
    default: break;
    }
}

#ifndef CPU_TEST
__global__ void __launch_bounds__(256) k_step(Prm p, int st, int L) {
    run_step(p, st, L, (long)blockIdx.x * blockDim.x + threadIdx.x, (long)gridDim.x * blockDim.x);
}
extern "C" void kernel_launch(void* const* d_in, const int* in_sizes, int n_in, void* d_out, int out_size, void* d_ws, size_t ws_size, hipStream_t stream) {
    if (n_in != 35 || out_size != ML * D_MODEL || ws_size < WS_END) { fprintf(stderr, "kernel_launch: unexpected shapes (n_in %d out %d ws %zu need %zu)\n", n_in, out_size, ws_size, (size_t)WS_END); return; }
    Prm p{};
    for (int i = 0; i < 35; ++i) p.in[i] = (const float*)d_in[i];
    p.out = (float*)d_out; p.ws = (unsigned char*)d_ws;
    for (int i = 0; i < NPROG; ++i) { if (PROG[i].st == S_SYNC) continue; hipLaunchKernelGGL(k_step, dim3(2048), dim3(256), 0, stream, p, PROG[i].st, PROG[i].layer); }
}
#endif
```

```cpp
#ifndef CPU_TEST
#include <hip/hip_runtime.h>
#include <cstdio>
#include <cstdint>
#define HD __device__ __forceinline__
#define HDM __device__ __forceinline__
#else
#include <cmath>
#include <cstdio>
#include <cstdint>
#include <cstring>
#define HD static inline
#define HDM inline
#endif

#ifndef D_MODEL
#define D_MODEL 1024
#endif
#ifndef SEQ
#define SEQ 8192
#endif
#ifndef CTX_LEN
#define CTX_LEN 256
#endif
#ifndef D_FF
#define D_FF 2816
#endif
#define BATCH 2
#define DEPTH 2
#define GRID_W 64
#define HEAD_DIM 64
#define NORM_EPS 1e-6f
#define D_SSD 256
#define SSD_XBC 768
#define D_S5 256
#define D_MIX 1024
#define D_IN 2312
constexpr int NTHREADS_ = 512;
constexpr int ML = BATCH * SEQ, MC = BATCH * CTX_LEN, MT = ML + MC;
constexpr int NCH = MT / 128;
constexpr int NSC = MT / 16;
constexpr int PLD = 2048;
constexpr int NIN = 2560;
constexpr int S5R = 1280;
constexpr int Z_OFF = 0, XBC_OFF = 256, GAQ = 1024, GAK = 1280, GAV = 1408, WAQ = 1536, WAK = 1792, WAV = 1920;
constexpr int YSSD_OFF = 256, YS5_OFF = 512;

#ifdef CPU_TEST
typedef float act_t;
HD float ldf(const act_t* p) { return *p; }
HD void stf(act_t* p, float v) { *p = v; }
#else
typedef unsigned short act_t;
HD float ldf(const act_t* p) { return __uint_as_float(((unsigned)*p) << 16); }
HD void stf(act_t* p, float v) { unsigned u = __float_as_uint(v); u = (u + 0x7fffu + ((u >> 16) & 1u)) >> 16; *p = (act_t)u; }
#endif

constexpr size_t al256(size_t x) { return (x + 255) & ~(size_t)255; }
constexpr size_t WS_CTL = 0, CTL_BYTES = 1u << 20;
constexpr size_t WS_MOD = WS_CTL + 65536;
static_assert(65536 + (size_t)DEPTH * (BATCH + 1) * 6 * D_MODEL * 4 <= CTL_BYTES, "mod table inside the zeroed region");
constexpr size_t WS_ROPE = WS_CTL + CTL_BYTES;
constexpr size_t WS_LAMP = WS_ROPE + al256((size_t)SEQ * 64 * 4);
constexpr size_t WS_BBAR = WS_LAMP + al256((size_t)DEPTH * 2 * 16 * 64 * 17 * 2 * 4);
constexpr size_t WS_KT = WS_BBAR + al256((size_t)DEPTH * 2 * 16 * 64 * 16 * 2 * 4);
constexpr size_t WS_XC = WS_KT + al256((size_t)DEPTH * 2 * 16 * 16 * 256 * 4);
constexpr size_t WS_SS = WS_XC + al256((size_t)MC * D_MODEL * 4);
constexpr size_t WS_DT = WS_SS + al256((size_t)MT * 4);
constexpr size_t WS_CS = WS_DT + al256((size_t)MT * 8 * 4);
constexpr size_t WS_DTRAW = WS_CS + al256((size_t)MT * 8 * 4);
constexpr size_t WS_S5BY = WS_DTRAW + al256((size_t)MT * 8 * 4);
constexpr size_t WS_S5BE = WS_S5BY + al256((size_t)16 * 256 * 512 * sizeof(act_t));
constexpr size_t WS_ARENA = WS_S5BE + al256((size_t)16 * 256 * 256 * sizeof(act_t));
constexpr size_t WS_XN = WS_ARENA;
constexpr size_t WS_YMIX = WS_XN;
constexpr size_t WS_P = WS_XN + al256((size_t)MT * (D_MODEL > D_MIX ? D_MODEL : D_MIX) * sizeof(act_t));
constexpr size_t WS_XBC = WS_P + al256((size_t)MT * PLD * sizeof(act_t));
constexpr size_t WS_SST = WS_XBC + al256((size_t)MT * 768 * sizeof(act_t));
constexpr size_t WS_CB = WS_SST + al256((size_t)NCH * 2 * 4 * 64 * 128 * 4);
constexpr size_t WS_SLAB = WS_CB;
constexpr size_t WS_S5E = WS_CB + al256((size_t)NCH * 2 * 128 * 128 * 4);
constexpr size_t WS_S5A = WS_S5E + al256((size_t)16 * NSC * 256 * 4);
constexpr size_t WS_MIX_END = WS_S5A + al256((size_t)16 * S5R * 512 * sizeof(act_t));
constexpr size_t WS_GT = WS_P;
constexpr size_t WS_EG = WS_GT;
constexpr size_t WS_EU = WS_EG + al256((size_t)(MT / 256) * 4 * D_FF * 4);
constexpr size_t WS_ACT = WS_GT + al256((size_t)MT * D_FF * sizeof(act_t));
constexpr size_t WS_FFN_END = WS_ACT + al256((size_t)MT * D_FF * sizeof(act_t));
constexpr size_t WS_END = WS_MIX_END > WS_FFN_END ? WS_MIX_END : WS_FFN_END;
constexpr size_t WS_WIN = WS_END;
constexpr size_t WS_WOUT = WS_WIN + al256((size_t)NIN * D_MODEL * 2);
constexpr size_t WS_WG = WS_WOUT + al256((size_t)D_MODEL * D_MIX * 2);
constexpr size_t WS_WU = WS_WG + al256((size_t)D_FF * D_MODEL * 2);
constexpr size_t WS_WD = WS_WU + al256((size_t)D_FF * D_MODEL * 2);
constexpr size_t WS_WGLU = WS_WD + al256((size_t)D_MODEL * D_FF * 2);
constexpr size_t WS_TOTAL = WS_WGLU + al256((size_t)512 * 256 * 2);
#ifndef CPU_TEST
static_assert(WS_TOTAL <= ((size_t)256 << 20), "workspace map exceeds 256 MiB");
static_assert(WS_WU == WS_WG + (size_t)D_FF * D_MODEL * 2, "gate | up weight copies are one contiguous [2*D_FF][D] matrix");
#endif

struct Prm { const float* in[35]; float* out; unsigned char* ws; };
enum { I_X = 0, I_C, I_CTX, I_CCTX, I_WMOD, I_BMOD, I_GMIX, I_WIN, I_SCW, I_SCB, I_SALOG, I_SDTB, I_SD, I_SNG, I_GAQN, I_GAKN, I_SINK,
       I_LRE, I_LIM, I_LSTEP, I_BRE, I_BIM, I_CRE, I_CIM, I_S5D, I_WGLU, I_BGLU, I_WOUT, I_GFFN, I_WGATE, I_WUP, I_FCW, I_FCB, I_WDOWN, I_GFIN };

HD float sigmoidf_(float x) { return 1.f / (1.f + expf(-x)); }
HD float siluf_(float x) { return x * sigmoidf_(x); }
HD float softplusf_(float x) { return x > 20.f ? x : log1pf(expf(x)); }
HD float geluf_(float x) { return 0.5f * x * (1.f + tanhf(0.7978845608028654f * (x + 0.044715f * x * x * x))); }
struct RowInfo { int isctx, b, t, T, modrow; };
HD RowInfo rowinfo(int r) { RowInfo q; if (r < ML) { q.isctx = 0; q.b = r / SEQ; q.t = r % SEQ; q.T = SEQ; q.modrow = q.b; } else { const int rr = r - ML; q.isctx = 1; q.b = rr / CTX_LEN; q.t = rr % CTX_LEN; q.T = CTX_LEN; q.modrow = BATCH; } return q; }
HD float* xrow(const Prm& p, int r) { return r < ML ? p.out + (size_t)r * D_MODEL : (float*)(p.ws + WS_XC) + (size_t)(r - ML) * D_MODEL; }
HD const float* modp(const Prm& p, int layer, int modrow, int which) { return (const float*)(p.ws + WS_MOD) + ((size_t)(layer * (BATCH + 1) + modrow) * 6 + which) * D_MODEL; }
#define WSP(T, off) ((T*)(p.ws + (off)))
#ifdef CPU_TEST
#define QSCALE 0.125f
#else
#define QSCALE (0.125f * 1.4426950408889634f)
#endif

HD void st_mod(const Prm& p, int g0, int gs) {
    float* mod = WSP(float, WS_MOD);
    for (int i = g0; i < (int)(DEPTH * (BATCH + 1) * 6 * D_MODEL); i += gs) {
        const int j = (int)(i % (6 * D_MODEL)); const int m = (int)((i / (6 * D_MODEL)) % (BATCH + 1)); const int l = (int)(i / (6 * D_MODEL * (BATCH + 1)));
        const float* cv = m < BATCH ? p.in[I_C] + (size_t)m * D_MODEL : p.in[I_CCTX];
        const float* w = p.in[I_WMOD] + (size_t)l * D_MODEL * 6 * D_MODEL + j;
        float acc = 0.f;
        for (int k = 0; k < D_MODEL; ++k) acc += siluf_(cv[k]) * w[(size_t)k * 6 * D_MODEL];
        mod[i] = acc + p.in[I_BMOD][(size_t)l * 6 * D_MODEL + j];
    }
}
HD void st_init(const Prm& p, int g0, int gs) {
    for (int i = g0; i < (int)(ML * D_MODEL); i += gs) p.out[i] = p.in[I_X][i];
    float* xc = WSP(float, WS_XC);
    for (int i = g0; i < (int)(MC * D_MODEL); i += gs) xc[i] = p.in[I_CTX][i];
    float* rc = WSP(float, WS_ROPE); float* rs = rc + (size_t)SEQ * 32;
    for (int i = g0; i < (int)(SEQ * 32); i += gs) {
        const int t = (int)(i / 32), f = (int)(i % 32); const int pos = f < 16 ? t / GRID_W : t % GRID_W; const int fi = f & 15;
        const double inv = exp(-(double)fi * 0.5756462732485115); const double ang = (double)pos * inv;
        rc[i] = (float)cos(ang); rs[i] = (float)sin(ang);
    }
}
HD void st_rope_tab(const Prm& p, int g0, int gs) {
    float* rc = WSP(float, WS_ROPE); float* rs = rc + (size_t)SEQ * 32;
    for (int i = g0; i < (int)(SEQ * 32); i += gs) {
        const int t = (int)(i / 32), f = (int)(i % 32); const int pos = f < 16 ? t / GRID_W : t % GRID_W; const int fi = f & 15;
        const double inv = exp(-(double)fi * 0.5756462732485115); const double ang = (double)pos * inv;
        rc[i] = (float)cos(ang); rs[i] = (float)sin(ang);
    }
}
HD void st_s5tab1(const Prm& p, int g0, int gs) {
    float* lamp = WSP(float, WS_LAMP); float* bbar = WSP(float, WS_BBAR);
    for (int idx = g0; idx < (int)(DEPTH * 2 * 16 * 64 * 17); idx += gs) { const int i = idx / 17, tau = idx % 17, ldg = i / 64;
        const double lre = fmin((double)p.in[I_LRE][i], -1e-4), lim = (double)p.in[I_LIM][i], step = exp((double)p.in[I_LSTEP][ldg]);
        const double mag = exp(lre * step * tau), ang = lim * step * tau;
        lamp[(size_t)idx * 2 + 0] = (float)(mag * cos(ang)); lamp[(size_t)idx * 2 + 1] = (float)(mag * sin(ang)); }
    for (int i = gs - 1 - g0; i < (int)(DEPTH * 2 * 16 * 64); i += gs) { const int ldg = i / 64;
        const double lre = fmin((double)p.in[I_LRE][i], -1e-4), lim = (double)p.in[I_LIM][i], step = exp((double)p.in[I_LSTEP][ldg]);
        const double mag = exp(lre * step), ang = lim * step;
        const double nr = mag * cos(ang) - 1.0, ni = mag * sin(ang);
        const double den = lre * lre + lim * lim;
        const double fr = (nr * lre + ni * lim) / den, fi = (ni * lre - nr * lim) / den;
#pragma unroll
        for (int k = 0; k < 16; ++k) { const double br = p.in[I_BRE][i * 16 + k], bi = p.in[I_BIM][i * 16 + k];
            bbar[((size_t)i * 16 + k) * 2 + 0] = (float)(fr * br - fi * bi); bbar[((size_t)i * 16 + k) * 2 + 1] = (float)(fr * bi + fi * br); } }
}
HD void st_s5tab2(const Prm& p, int g0, int gs) {
    const float* lamp = WSP(float, WS_LAMP); const float* bbar = WSP(float, WS_BBAR); float* kt = WSP(float, WS_KT);
    for (int i = g0; i < (int)(DEPTH * 2 * 16 * 16 * 256); i += gs) {
        const int kp = (int)(i % 16), k = (int)((i / 16) % 16), tau = (int)((i / 256) % 16); const int ldg = i / 4096;
        float acc = 0.f;
        for (int n = 0; n < 64; ++n) {
            const float cr = p.in[I_CRE][(ldg * 16 + k) * 64 + n], ci = p.in[I_CIM][(ldg * 16 + k) * 64 + n];
            const float lr = lamp[((ldg * 64 + n) * 17 + tau) * 2], li = lamp[((ldg * 64 + n) * 17 + tau) * 2 + 1];
            const float br = bbar[((ldg * 64 + n) * 16 + kp) * 2], bi = bbar[((ldg * 64 + n) * 16 + kp) * 2 + 1];
            const float tr = lr * br - li * bi, ti = lr * bi + li * br;
            acc += cr * tr - ci * ti;
        }
        kt[i] = acc;
    }
}

HD void st_rowss(const Prm& p, int nrows, int g0, int gs) {
    float* ss = WSP(float, WS_SS);
    for (int r = g0; r < nrows; r += gs) { const float* x = xrow(p, (int)r); float s = 0.f; for (int k = 0; k < D_MODEL; ++k) s += x[k] * x[k]; ss[r] = s; }
}
HD void st_normmod(const Prm& p, int layer, int which  , int nrows, int g0, int gs) {
    const float* ss = WSP(float, WS_SS); act_t* xn = WSP(act_t, WS_XN);
    const float* gw = p.in[which ? I_GFFN : I_GMIX] + (size_t)layer * D_MODEL;
    for (int i = g0; i < (int)(nrows * D_MODEL); i += gs) {
        const int r = (int)(i / D_MODEL), k = (int)(i % D_MODEL); const RowInfo q = rowinfo(r);
        const float rs = 1.0f / sqrtf(ss[r] * (1.0f / D_MODEL) + NORM_EPS);
        const float sh = modp(p, layer, q.modrow, which ? 3 : 0)[k], sc = modp(p, layer, q.modrow, which ? 4 : 1)[k];
        stf(xn + i, xrow(p, r)[k] * rs * gw[k] * (1.f + sc) + sh);
    }
}
HD void st_final(const Prm& p, int g0, int gs) {
    const float* ss = WSP(float, WS_SS);
    for (int i = g0; i < (int)(ML * D_MODEL); i += gs) { const int r = (int)(i / D_MODEL), k = (int)(i % D_MODEL);
        p.out[i] = p.out[i] * (1.0f / sqrtf(ss[r] * (1.0f / D_MODEL) + NORM_EPS)) * p.in[I_GFIN][k]; }
}

template <class Epi> HD void naive_gemm(const act_t* A, int lda, const float* W, int ldw, int M, int N, int K, const Epi& epi, int g0, int gs) {
    const long n4 = N / 4, total = (long)(M / 4) * n4;
    for (long i = g0; i < total; i += gs) {
        const int r0 = (int)(i / n4) * 4, c0 = (int)(i % n4) * 4;
        float acc[4][4];
#pragma unroll
        for (int a = 0; a < 4; ++a)
#pragma unroll
            for (int b = 0; b < 4; ++b) acc[a][b] = 0.f;
        for (int k = 0; k < K; ++k) {
            float av[4], wv[4];
#pragma unroll
            for (int a = 0; a < 4; ++a) av[a] = ldf(A + (size_t)(r0 + a) * lda + k);
#pragma unroll
            for (int b = 0; b < 4; ++b) wv[b] = W[(size_t)k * ldw + c0 + b];
#pragma unroll
            for (int a = 0; a < 4; ++a)
#pragma unroll
                for (int b = 0; b < 4; ++b) acc[a][b] += av[a] * wv[b];
        }
#pragma unroll
        for (int a = 0; a < 4; ++a)
#pragma unroll
            for (int b = 0; b < 4; ++b) epi(r0 + a, c0 + b, acc[a][b]);
    }
}
HD void in_store(const Prm& p, int r, int c, float v) {
    if (c < 1024) stf((act_t*)(p.ws + WS_P) + (size_t)r * PLD + c, v);
    else if (c < 1032) ((float*)(p.ws + WS_DTRAW))[(size_t)r * 8 + (c - 1024)] = v;
    else if (c < 2056) stf((act_t*)(p.ws + WS_P) + (size_t)r * PLD + (c - 8), v);
    else { const int g = (c - 2056) >> 4, k = (c - 2056) & 15; stf((act_t*)(p.ws + WS_S5A) + ((size_t)g * S5R + (r >> 4)) * 512 + (r & 15) * 16 + k, v); }
}
struct EpiStoreIn { const Prm* p; HDM void operator()(int r, int c, float v) const { in_store(*p, r, c, v); } };
struct EpiStore { act_t* O; int ldo; HDM void operator()(int r, int c, float v) const { stf(O + (size_t)r * ldo + c, v); } };
struct EpiResid { const Prm* p; int layer, which; HDM void operator()(int r, int c, float v) const { const RowInfo q = rowinfo(r); xrow(*p, r)[c] += modp(*p, layer, q.modrow, which)[c] * v; } };
struct EpiUp { const Prm* p; int layer; HDM void operator()(int r, int c, float v) const {
    const RowInfo q = rowinfo(r); const act_t* gt = (const act_t*)(p->ws + WS_GT); const float* cw = p->in[I_FCW] + (size_t)layer * 3 * D_FF; const float* cb = p->in[I_FCB] + (size_t)layer * D_FF;
    float g = cb[c] + cw[D_FF + c] * ldf(gt + (size_t)r * D_FF + c);
    if (q.t > 0) g += cw[c] * ldf(gt + (size_t)(r - 1) * D_FF + c);
    if (q.t < q.T - 1) g += cw[2 * D_FF + c] * ldf(gt + (size_t)(r + 1) * D_FF + c);
    stf((act_t*)(p->ws + WS_ACT) + (size_t)r * D_FF + c, siluf_(g) * v); } };

HD void st_ssd_conv(const Prm& p, int layer, int g0, int gs) {
    const act_t* P = WSP(act_t, WS_P); act_t* xbc = WSP(act_t, WS_XBC);
    const float* cw = p.in[I_SCW] + (size_t)layer * 3 * SSD_XBC; const float* cb = p.in[I_SCB] + (size_t)layer * SSD_XBC;
    for (int i = g0; i < (int)(MT * SSD_XBC); i += gs) {
        const int r = (int)(i / SSD_XBC), c = (int)(i % SSD_XBC); const RowInfo q = rowinfo(r);
        float v = cb[c] + cw[SSD_XBC + c] * ldf(P + (size_t)r * PLD + XBC_OFF + c);
        if (q.t > 0) v += cw[c] * ldf(P + (size_t)(r - 1) * PLD + XBC_OFF + c);
        if (q.t < q.T - 1) v += cw[2 * SSD_XBC + c] * ldf(P + (size_t)(r + 1) * PLD + XBC_OFF + c);
        stf(xbc + i, siluf_(v));
    }
}
HD void st_ssd_cs(const Prm& p, int layer, int g0, int gs) {
    const act_t* P = WSP(act_t, WS_P); float* DT = WSP(float, WS_DT); float* CS = WSP(float, WS_CS);
    for (int i = g0; i < (int)(NCH * 8); i += gs) {
        const int dh = (int)(i % 8), c = (int)(i / 8), d = dh >> 2;
        const float a = -expf(p.in[I_SALOG][layer * 8 + dh]), bias = p.in[I_SDTB][layer * 8 + dh];
        float run = 0.f;
        for (int j = 0; j < 128; ++j) { const int l = d ? 127 - j : j; const size_t r = (size_t)c * 128 + l;
            const float dt = softplusf_(WSP(float, WS_DTRAW)[r * 8 + dh] + bias); run += dt * a; DT[r * 8 + dh] = dt; CS[r * 8 + dh] = run; }
    }
}
HD void st_qk_prep(const Prm& p, int layer, int g0, int gs) {
    act_t* P = WSP(act_t, WS_P); const float* rc = WSP(float, WS_ROPE); const float* rs = rc + (size_t)SEQ * 32;
    for (int i = g0; i < (int)(MT * 12); i += gs) {
        const int r = (int)(i / 12), s = (int)(i % 12); const RowInfo q = rowinfo(r);
        int off; const float* gn = nullptr; float scale = 1.f;
        if (s < 4) { off = GAQ + s * 64; gn = p.in[I_GAQN] + layer * 64; scale = QSCALE; }
        else if (s < 6) { off = GAK + (s - 4) * 64; gn = p.in[I_GAKN] + layer * 64; }
        else if (s < 10) { off = WAQ + (s - 6) * 64; scale = QSCALE; }
        else off = WAK + (s - 10) * 64;
        act_t* v = P + (size_t)r * PLD + off;
        float rn = 1.f;
        if (gn) { float ssq = 0.f; for (int e = 0; e < 64; ++e) { const float x = ldf(v + e); ssq += x * x; } rn = 1.0f / sqrtf(ssq * (1.f / 64.f) + NORM_EPS); }
        for (int e = 0; e < 32; ++e) {
            float x1 = ldf(v + e) * rn, x2 = ldf(v + e + 32) * rn;
            if (gn) { x1 *= gn[e]; x2 *= gn[e + 32]; }
            float o1 = x1, o2 = x2;
            if (!q.isctx) { const float c = rc[(size_t)q.t * 32 + e], sn = rs[(size_t)q.t * 32 + e]; o1 = x1 * c - x2 * sn; o2 = x2 * c + x1 * sn; }
            stf(v + e, o1 * scale); stf(v + e + 32, o2 * scale);
        }
    }
}

HD void st_ssd_state(const Prm& p, int g0, int gs) {
    const act_t* xbc = WSP(act_t, WS_XBC); const float* DT = WSP(float, WS_DT); const float* CS = WSP(float, WS_CS); float* sst = WSP(float, WS_SST);
    for (int i = g0; i < (int)(NCH * 2 * 4 * 64 * 128); i += gs) {
        const int n = (int)(i % 128), pp = (int)((i / 128) % 64), h = (int)((i / 8192) % 4), d = (int)((i / 32768) % 2), c = (int)(i / 65536);
        const int dh = d * 4 + h, g = h >> 1; const size_t r0 = (size_t)c * 128;
        const float aend = CS[(r0 + (d ? 0 : 127)) * 8 + dh];
        float acc = 0.f;
        for (int l = 0; l < 128; ++l) { const size_t r = r0 + l;
            acc += ldf(xbc + r * 768 + 256 + g * 128 + n) * ldf(xbc + r * 768 + h * 64 + pp) * DT[r * 8 + dh] * expf(aend - CS[r * 8 + dh]); }
        sst[i] = acc;
    }
}
HD void st_ssd_cb(const Prm& p, int g0, int gs) {
    const act_t* xbc = WSP(act_t, WS_XBC); float* cb = WSP(float, WS_CB);
    for (int i = g0; i < (int)(NCH * 2 * 128 * 128); i += gs) {
        const int s = (int)(i % 128), l = (int)((i / 128) % 128), g = (int)((i / 16384) % 2), c = (int)(i / 32768); const size_t r0 = (size_t)c * 128;
        float acc = 0.f;
        for (int n = 0; n < 128; ++n) acc += ldf(xbc + (r0 + l) * 768 + 512 + g * 128 + n) * ldf(xbc + (r0 + s) * 768 + 256 + g * 128 + n);
        cb[i] = acc;
    }
}
HD int ssd_chunk_of(int b, int d, int j) {
    constexpr int CC = CTX_LEN / 128, LC = SEQ / 128;
    if (j < CC) return ML / 128 + b * CC + (d ? CC - 1 - j : j);
    const int jj = j - CC; return b * LC + (d ? LC - 1 - jj : jj);
}
HD void st_ssd_carry(const Prm& p, int g0, int gs) {
    float* sst = WSP(float, WS_SST); const float* CS = WSP(float, WS_CS);
    for (int i = g0; i < (int)(BATCH * 2 * 4 * 64 * 128); i += gs) {
        const int e = (int)(i % 8192), h = (int)((i / 8192) % 4), d = (int)((i / 32768) % 2), b = (int)(i / 65536); const int dh = d * 4 + h;
        float hst = 0.f;
        for (int j = 0; j < (CTX_LEN + SEQ) / 128; ++j) { const int c = ssd_chunk_of(b, d, j);
            const float dec = expf(CS[((size_t)c * 128 + (d ? 0 : 127)) * 8 + dh]); float* sp = sst + ((size_t)(c * 2 + d) * 4 + h) * 8192 + e;
            const float tmp = *sp; *sp = hst; hst = hst * dec + tmp; }
    }
}
HD void st_ssd_y(const Prm& p, int layer, int nrows, int g0, int gs) {
    const act_t* xbc = WSP(act_t, WS_XBC); const float* DT = WSP(float, WS_DT); const float* CS = WSP(float, WS_CS); const float* sst = WSP(float, WS_SST); const float* cb = WSP(float, WS_CB);
    act_t* P = WSP(act_t, WS_P);
    for (int i = g0; i < (int)(nrows * 256); i += gs) {
        const int r = (int)(i / 256), hp = (int)(i % 256), h = hp >> 6, pp = hp & 63, g = h >> 1; const int c = r >> 7, l = r & 127; const size_t r0 = (size_t)c * 128;
        float y = p.in[I_SD][layer * 4 + h] * ldf(xbc + (size_t)r * 768 + hp);
        for (int d = 0; d < 2; ++d) { const int dh = d * 4 + h; const float csl = CS[(size_t)r * 8 + dh];
            const int s0 = d ? l : 0, s1 = d ? 127 : l; float acc = 0.f;
            for (int s = s0; s <= s1; ++s) { const size_t rs_ = r0 + s;
                acc += cb[((size_t)(c * 2 + g) * 128 + l) * 128 + s] * expf(csl - CS[rs_ * 8 + dh]) * ldf(xbc + rs_ * 768 + hp) * DT[rs_ * 8 + dh]; }
            float off = 0.f; const float* hin = sst + ((size_t)(c * 2 + d) * 4 + h) * 8192 + (size_t)pp * 128;
            for (int n = 0; n < 128; ++n) off += ldf(xbc + (size_t)r * 768 + 512 + g * 128 + n) * hin[n];
            y += acc + off * expf(csl); }
        stf(P + (size_t)r * PLD + YSSD_OFF + hp, y);
    }
}
HD void st_ssd_out(const Prm& p, int layer, int nrows, int g0, int gs) {
    const act_t* P = WSP(act_t, WS_P); act_t* ym = WSP(act_t, WS_YMIX); const float* ng = p.in[I_SNG] + layer * 256;
    for (int r = g0; r < nrows; r += gs) { float ssq = 0.f;
        for (int c = 0; c < 256; ++c) { const float v = ldf(P + (size_t)r * PLD + YSSD_OFF + c) * siluf_(ldf(P + (size_t)r * PLD + Z_OFF + c)); ssq += v * v; }
        const float rn = 1.0f / sqrtf(ssq * (1.f / 256.f) + NORM_EPS);
        for (int c = 0; c < 256; ++c) { const float v = ldf(P + (size_t)r * PLD + YSSD_OFF + c) * siluf_(ldf(P + (size_t)r * PLD + Z_OFF + c)); stf(ym + (size_t)r * D_MIX + c, v * rn * ng[c]); } }
}

HD void st_s5tabB(const Prm& p, int layer, int g0, int gs) {
    const float* lamp = WSP(float, WS_LAMP) + (size_t)layer * 2 * 16 * 64 * 17 * 2; const float* bbar = WSP(float, WS_BBAR) + (size_t)layer * 2 * 16 * 64 * 16 * 2; const float* kt = WSP(float, WS_KT) + (size_t)layer * 2 * 16 * 16 * 256;
    act_t* BY = WSP(act_t, WS_S5BY); act_t* BE = WSP(act_t, WS_S5BE);
    for (int idx = g0; idx < 16 * 256 * 512; idx += gs) { const int q = idx & 511, ik = (idx >> 9) & 255, g = idx >> 17, i = ik >> 4, k = ik & 15; float v;
        if (q < 256) { const int j = q >> 4, kp = q & 15;
            if (j < i) v = kt[(((size_t)(0 * 16 + g) * 16 + (i - j)) * 16 + k) * 16 + kp];
            else if (j > i) v = kt[(((size_t)(1 * 16 + g) * 16 + (j - i)) * 16 + k) * 16 + kp];
            else v = kt[(((size_t)(0 * 16 + g) * 16) * 16 + k) * 16 + kp] + kt[(((size_t)(1 * 16 + g) * 16) * 16 + k) * 16 + kp] + (k == kp ? p.in[I_S5D][layer * 256 + g * 16 + k] : 0.f); }
        else { const int dd = (q - 256) >> 7, n = ((q - 256) & 127) >> 1, c = q & 1, pw = dd ? 16 - i : i + 1; const size_t dg = (size_t)(layer * 2 + dd) * 16 + g, dgn = (size_t)(dd * 16 + g) * 64 + n;
            const float cr = p.in[I_CRE][(dg * 16 + k) * 64 + n], ci = p.in[I_CIM][(dg * 16 + k) * 64 + n], lr = lamp[(dgn * 17 + pw) * 2], li = lamp[(dgn * 17 + pw) * 2 + 1];
            v = c ? -(cr * li + ci * lr) : (cr * lr - ci * li); }
        stf(BY + idx, v); }
    for (int idx = g0; idx < 16 * 256 * 256; idx += gs) { const int q = idx & 255, rr = (idx >> 8) & 255, g = idx >> 16, dd = rr >> 7, n = (rr & 127) >> 1, c = rr & 1, j = q >> 4, kp = q & 15, pw = dd ? j : 15 - j;
        const size_t dgn = (size_t)(dd * 16 + g) * 64 + n; const float lr = lamp[(dgn * 17 + pw) * 2], li = lamp[(dgn * 17 + pw) * 2 + 1], br = bbar[(dgn * 16 + kp) * 2], bi = bbar[(dgn * 16 + kp) * 2 + 1];
        stf(BE + idx, c ? (lr * bi + li * br) : (lr * br - li * bi)); }
}
HD void st_s5_E_naive(const Prm& p, int g0, int gs) {
    const act_t* A = WSP(act_t, WS_S5A); const act_t* BE = WSP(act_t, WS_S5BE); float* E = WSP(float, WS_S5E);
    for (int idx = g0; idx < 16 * NSC * 256; idx += gs) { const int rr = idx & 255, sc = (idx >> 8) % NSC, g = (idx >> 8) / NSC; float acc = 0.f;
        for (int q = 0; q < 256; ++q) acc += ldf(A + ((size_t)g * S5R + sc) * 512 + q) * ldf(BE + ((size_t)g * 256 + rr) * 256 + q);
        E[idx] = acc; }
}
HD int s5_sc_of(int b, int d, int j) {
    constexpr int CC = CTX_LEN / 16, LC = SEQ / 16;
    if (j < CC) return ML / 16 + b * CC + (d ? CC - 1 - j : j);
    const int jj = j - CC; return b * LC + (d ? LC - 1 - jj : jj);
}
HD void st_s5_carry(const Prm& p, int layer, int g0, int gs) {
    const float* lamp = WSP(float, WS_LAMP) + (size_t)layer * 2 * 16 * 64 * 17 * 2; const float* E = WSP(float, WS_S5E); act_t* A = WSP(act_t, WS_S5A);
    for (int i = g0; i < BATCH * 2 * 16 * 64; i += gs) {
        const int n = i & 63, g = (i >> 6) & 15, d = (i >> 10) & 1, b = i >> 11; const size_t dgn = (size_t)(d * 16 + g) * 64 + n;
        const float lr = lamp[(dgn * 17 + 16) * 2], li = lamp[(dgn * 17 + 16) * 2 + 1];
        float hr = 0.f, hi = 0.f;
        for (int j = 0; j < (CTX_LEN + SEQ) / 16; ++j) { const int sc = s5_sc_of(b, d, j); const float* e = E + ((size_t)g * NSC + sc) * 256 + d * 128 + 2 * n; act_t* a = A + ((size_t)g * S5R + sc) * 512 + 256 + d * 128 + 2 * n;
            const float tr = e[0], ti = e[1]; stf(a, hr); stf(a + 1, hi); const float nr = lr * hr - li * hi + tr, ni = lr * hi + li * hr + ti; hr = nr; hi = ni; }
    }
}
HD void s5y_store(const Prm& p, int g, int sc, int ik, float v) { const int r = sc * 16 + (ik >> 4); stf((act_t*)(p.ws + WS_P) + (size_t)r * PLD + YS5_OFF + g * 16 + (ik & 15), geluf_(v)); }
HD void st_s5_Y_naive(const Prm& p, int nrows, int g0, int gs) {
    const act_t* A = WSP(act_t, WS_S5A); const act_t* BY = WSP(act_t, WS_S5BY);
    for (int idx = g0; idx < 16 * (nrows / 16) * 256; idx += gs) { const int ik = idx & 255, sc = (idx >> 8) % (nrows / 16), g = (idx >> 8) / (nrows / 16); float acc = 0.f;
        for (int q = 0; q < 512; ++q) acc += ldf(A + ((size_t)g * S5R + sc) * 512 + q) * ldf(BY + ((size_t)g * 256 + ik) * 512 + q);
        s5y_store(p, g, sc, ik, acc); }
}
HD void st_glu(const Prm& p, int layer, int nrows, int g0, int gs) {
    const act_t* P = WSP(act_t, WS_P); act_t* ym = WSP(act_t, WS_YMIX); const float* w = p.in[I_WGLU] + (size_t)layer * 256 * 512; const float* bg = p.in[I_BGLU] + layer * 512;
    for (int i = g0; i < (int)(nrows * 256); i += gs) { const int r = (int)(i / 256), n = (int)(i % 256); float a = bg[n], g = bg[256 + n];
        for (int k = 0; k < 256; ++k) { const float y = ldf(P + (size_t)r * PLD + YS5_OFF + k); a += y * w[(size_t)k * 512 + n]; g += y * w[(size_t)k * 512 + 256 + n]; }
        stf(ym + (size_t)r * D_MIX + 768 + n, a * sigmoidf_(g)); }
}

struct AttnAcc { float m, l; float o[32]; };
#ifdef CPU_TEST
HD void ld8(const act_t* p, float* o) { for (int e = 0; e < 8; ++e) o[e] = p[e]; }
#else
typedef unsigned u32x4_t __attribute__((ext_vector_type(4)));
HD void ld8(const act_t* p, float* o) { const u32x4_t v = *(const u32x4_t*)p;
#pragma unroll
    for (int e = 0; e < 4; ++e) { o[2 * e] = __uint_as_float(v[e] << 16); o[2 * e + 1] = __uint_as_float(v[e] & 0xffff0000u); } }
#endif
HD void attn_seg(AttnAcc& A, const act_t* q, const act_t* P, int row0, int cnt, int koff, int voff) {
#pragma clang loop unroll(disable)
    for (int j = 0; j < cnt; ++j) { const act_t* kr = P + (size_t)(row0 + j) * PLD;
        float s = 0.f;
#pragma clang loop unroll(disable)
        for (int c = 0; c < 8; ++c) { float qv[8], kv[8]; ld8(q + c * 8, qv); ld8(kr + koff + c * 8, kv);
#pragma unroll
            for (int e = 0; e < 8; ++e) s += qv[e] * kv[e]; }
        if (s > A.m) { const float f = expf(A.m - s); A.l *= f;
#pragma unroll
            for (int e = 0; e < 32; ++e) A.o[e] *= f;
            A.m = s; }
        const float pexp = expf(s - A.m); A.l += pexp;
#pragma unroll
        for (int c = 0; c < 4; ++c) { float vv[8]; ld8(kr + voff + c * 8, vv);
#pragma unroll
            for (int e = 0; e < 8; ++e) A.o[c * 8 + e] += pexp * vv[e]; } }
}
HD void st_attn(const Prm& p, int layer, int nrows, int g0, int gs) {
    const act_t* P = WSP(act_t, WS_P); act_t* ym = WSP(act_t, WS_YMIX);
    for (int i = g0; i < (int)(nrows * 16); i += gs) {
        const int r = (int)(i / 16), s = (int)((i % 16) >> 1), half = (int)(i & 1); const RowInfo qi = rowinfo(r); const int isw = s >= 4, hq = s & 3, kv = hq >> 1;
        const int qoff = (isw ? WAQ : GAQ) + hq * 64, koff = (isw ? WAK : GAK) + kv * 64, voff = (isw ? WAV : GAV) + kv * 64 + half * 32;
        const act_t* q = P + (size_t)r * PLD + qoff;
        AttnAcc A; A.m = -1e30f; A.l = 0.f;
#pragma unroll
        for (int e = 0; e < 32; ++e) A.o[e] = 0.f;
        attn_seg(A, q, P, ML + qi.b * CTX_LEN, CTX_LEN, koff, voff);
        if (!qi.isctx) {
            if (!isw) attn_seg(A, q, P, qi.b * SEQ, SEQ, koff, voff);
            else { const int t0 = qi.t - 128 < 0 ? 0 : qi.t - 128, t1 = qi.t + 128 > SEQ - 1 ? SEQ - 1 : qi.t + 128; attn_seg(A, q, P, qi.b * SEQ + t0, t1 - t0 + 1, koff, voff); }
        }
        if (isw) { const float sk = p.in[I_SINK][layer * 4 + hq]; if (sk > A.m) { const float f = expf(A.m - sk); A.l *= f;
#pragma unroll
                for (int e = 0; e < 32; ++e) A.o[e] *= f;
                A.m = sk; }
            A.l += expf(sk - A.m); }
        const float inv = 1.f / A.l;
#pragma unroll
        for (int e = 0; e < 32; ++e) stf(ym + (size_t)r * D_MIX + 256 + s * 64 + half * 32 + e, A.o[e] * inv);
    }
}

enum { S_SYNC = 0, S_MOD, S_INIT, S_TAB1, S_TAB2, S_ROWSS, S_NORM_MIX, S_GEMM_IN, S_CONV, S_CS, S_QK, S_STATE, S_CB, S_S5E, S_ATTN, S_SSD_CARRY, S_S5_CARRY,
       S_SSD_Y, S_S5_Y, S_SSD_OUT, S_GLU, S_GEMM_OUT, S_NORM_FFN, S_GEMM_GATE, S_GEMM_UP, S_GEMM_DOWN, S_ROWSS_FIN, S_FINAL, S_WPREP, S_MODR, S_TABB, S_GEMM_GU, S_FIXUP, S_SUBGLU, S_WPREP2, S_ATTNC };
struct Step { int st, layer; };
#define LAYER_STEPS(L) {S_WPREP, L}, {S_TABB, L}, {S_ROWSS, L}, {S_SYNC, 0}, {S_NORM_MIX, L}, {S_SYNC, 0}, {S_GEMM_IN, L}, {S_SYNC, 0}, {S_CONV, L}, {S_CS, L}, {S_QK, L}, {S_SYNC, 0}, \
    {S_STATE, L}, {S_CB, L}, {S_S5E, L}, {S_ATTN, L}, {S_SYNC, 0}, {S_SSD_CARRY, L}, {S_S5_CARRY, L}, {S_SYNC, 0}, {S_SSD_Y, L}, {S_S5_Y, L}, {S_SYNC, 0}, \
    {S_SSD_OUT, L}, {S_GLU, L}, {S_SYNC, 0}, {S_GEMM_OUT, L}, {S_SYNC, 0}, {S_ROWSS, L}, {S_SYNC, 0}, {S_NORM_FFN, L}, {S_SYNC, 0}, {S_GEMM_GATE, L}, {S_SYNC, 0}, \
    {S_GEMM_UP, L}, {S_SYNC, 0}, {S_GEMM_DOWN, L}, {S_SYNC, 0}
#ifdef CPU_TEST
static const Step PROG[] = {
#else
__constant__ Step PROG_D[] = {
#endif
    {S_MOD, 0}, {S_INIT, 0}, {S_TAB1, 0}, {S_SYNC, 0}, {S_TAB2, 0}, {S_SYNC, 0}, LAYER_STEPS(0), LAYER_STEPS(1), {S_ROWSS_FIN, 0}, {S_SYNC, 0}, {S_FINAL, 0} };
#ifndef CPU_TEST
static const Step PROG[] = { {S_MOD, 0}, {S_INIT, 0}, {S_TAB1, 0}, {S_SYNC, 0}, {S_TAB2, 0}, {S_SYNC, 0}, LAYER_STEPS(0), LAYER_STEPS(1), {S_ROWSS_FIN, 0}, {S_SYNC, 0}, {S_FINAL, 0} };
#endif
constexpr int NPROG = 6 + 2 * 38 + 3;

#ifndef CPU_TEST
#define LAS __attribute__((address_space(3)))
__device__ __forceinline__ int BIDX_() { int v = blockIdx.x; asm volatile("" : "+s"(v)); return v; }
__device__ __forceinline__ int GDIM_() { int v = gridDim.x; asm volatile("" : "+s"(v)); return v; }
constexpr int MISC_OFF_ = 131072, WTAB_ = 32;
__device__ __forceinline__ int HWSLOT_() { return (int)(__builtin_amdgcn_s_getreg((5 << 11) | 4) & 0x3f); }
__device__ __forceinline__ int TID_() { extern __shared__ __attribute__((aligned(16))) unsigned char l_dyn_[];
    const int w = __builtin_amdgcn_readfirstlane(((volatile LAS int*)((LAS unsigned char*)l_dyn_ + MISC_OFF_))[WTAB_ + HWSLOT_()]);
    unsigned m_ = ~0u; asm volatile("" : "+s"(m_));
    return w * 64 + (int)__builtin_amdgcn_mbcnt_hi(m_, __builtin_amdgcn_mbcnt_lo(m_, 0u)); }
namespace pg8 {
#define PG8_LAS __attribute__((address_space(3)))
typedef unsigned short bf16_t;
typedef short bf16x8 __attribute__((ext_vector_type(8)));
typedef float f32x4 __attribute__((ext_vector_type(4)));
typedef unsigned u32x4 __attribute__((ext_vector_type(4)));
constexpr int BM = 256, BK = 64, HALF = 128, HTB = HALF * BK * 2  , STAGE_BYTES = 8 * HTB, NXCD = 8, WGM = 8;

__host__ __device__ __forceinline__ int lds_byte(int r, int c) { const int st = (r >> 4) * 2 + (c >> 5), rr = r & 15, cc = c & 31, ob = rr * 64 + cc * 2; return st * 1024 + (ob ^ (((ob >> 9) & 1) << 5)); }
__host__ __device__ __forceinline__ void stage_rc(int b, int& R, int& C) { const int st = b / 1024, sb = b % 1024, swz = sb ^ (((sb >> 9) & 1) << 5); R = (st >> 1) * 16 + swz / 64; C = (st & 1) * 32 + (swz % 64) / 2; }
__host__ __device__ __forceinline__ int perm32(int rho) { const int n = rho >> 4, i = rho & 15; return 8 * (i >> 2) + 4 * n + (i & 3); }

struct Unit { int pm, pn, kb = 0, nt = 0; };
struct Gemm { const bf16_t* A; const bf16_t* Bt; int M, N, K, lda; };

struct StaticOrder {
    int nM, nN, nwg, G, c;
    __host__ __device__ void init(int M, int N, int G_, int c_) { nM = M / BM; nN = N / BM; nwg = nM * nN; G = G_; c = c_; }
    __host__ __device__ bool next(int i, Unit& u) const {
        const long L = (long)i * G + c; if (L >= nwg) return false;
        int wgid = (int)L; { const int q = nwg / NXCD, r = nwg % NXCD, xcd = wgid % NXCD, off = wgid / NXCD; wgid = (xcd < r ? xcd * (q + 1) : r * (q + 1) + (xcd - r) * q) + off; }
        const int nig = WGM * nN, gid = wgid / nig, fm = gid * WGM, gsz = (nM - fm) < WGM ? (nM - fm) : WGM;
        u.pm = fm + ((wgid % nig) % gsz); u.pn = (wgid % nig) / gsz; return true;
    }
    __device__ __forceinline__ void a_ready(const Unit&) const {}
    __device__ __forceinline__ void done(const Unit&) const {}
};

__device__ __forceinline__ unsigned cvt_pk_bf16(float lo, float hi) { unsigned r; asm volatile("v_cvt_pk_bf16_f32 %0, %1, %2" : "=v"(r) : "v"(lo), "v"(hi)); return r; }
typedef float f32x2 __attribute__((ext_vector_type(2)));
__device__ __forceinline__ void st_wt(f32x4* p, f32x4 v) { asm volatile("global_store_dwordx4 %0, %1, off sc1\n\ts_nop 1" :: "v"(p), "v"(v) : "memory"); }
__device__ __forceinline__ void st_wt(u32x4* p, u32x4 v) { asm volatile("global_store_dwordx4 %0, %1, off sc1\n\ts_nop 1" :: "v"(p), "v"(v) : "memory"); }
typedef unsigned u32x2w __attribute__((ext_vector_type(2)));
__device__ __forceinline__ void st_wt(u32x2w* p, u32x2w v) { asm volatile("global_store_dwordx2 %0, %1, off sc1" :: "v"(p), "v"(v) : "memory"); }
__device__ __forceinline__ f32x2 gelu_pk(f32x2 v) {
    const f32x2 av = __builtin_elementwise_abs(v), d = av * 0.2316418882f + 1.0f;
    f32x2 t; t.x = __builtin_amdgcn_rcpf(d.x); t.y = __builtin_amdgcn_rcpf(d.y);
    f32x2 q = t * 0.5307027145f + (-0.7265760135f); q = q * t + 0.7107068705f; q = q * t + (-0.142248368f); q = q * t + 0.127414796f; q = q * t;
    const f32x2 s = (v * v) * (-0.72134752044f);
    f32x2 e; e.x = __builtin_amdgcn_exp2f(s.x); e.y = __builtin_amdgcn_exp2f(s.y);
    const f32x2 m = v * (q * e), r = v - m;
    f32x2 o; o.x = v.x < 0.f ? m.x : r.x; o.y = v.y < 0.f ? m.y : r.y; return o;
}

template <int ACT  > struct EpiBf16 {
    static constexpr bool PERM = true, AFTER_DRAIN = false; static_assert(ACT == 0 || ACT == 1, "EpiBf16: ACT is 0 (none) or 1 (gelu_pk)");
    bf16_t* O; int ldc; const float* bias; int split_cols; size_t split_stride; float scale0;
    __device__ __forceinline__ void operator()(const f32x4 (&acc)[2][2][4][2], const Unit& u, int wr, int wc, int fr, int fq) const {
        const int row0 = u.pm * BM + wr * 64 + fr; int colt = u.pn * BM; bf16_t* base = O;
        float sc = 1.f; if (split_cols) { const int t = colt / split_cols; base += (size_t)t * split_stride; colt -= t * split_cols; if (t == 0) sc = scale0; }
        const int col0 = colt + wc * 32 + 8 * fq, bcol0 = u.pn * BM + wc * 32 + 8 * fq;
        f32x4 bv[2][2];
#pragma unroll
        for (int bj = 0; bj < 2; ++bj)
#pragma unroll
            for (int n = 0; n < 2; ++n) bv[bj][n] = bias ? *(const f32x4*)(bias + bcol0 + bj * HALF + 4 * n) : (f32x4){0.f, 0.f, 0.f, 0.f};
#pragma unroll
        for (int ai = 0; ai < 2; ++ai)
#pragma unroll
            for (int m = 0; m < 4; ++m) { bf16_t* rowp = base + (size_t)(row0 + ai * HALF + m * 16) * ldc + col0;
#pragma unroll
                for (int bj = 0; bj < 2; ++bj) { f32x4 v0 = acc[ai][bj][m][0] + bv[bj][0], v1 = acc[ai][bj][m][1] + bv[bj][1];
                    if (ACT == 1) { f32x2 a = gelu_pk((f32x2){v0[0], v0[1]}), b = gelu_pk((f32x2){v0[2], v0[3]}), c = gelu_pk((f32x2){v1[0], v1[1]}), d = gelu_pk((f32x2){v1[2], v1[3]});
                        v0 = (f32x4){a.x, a.y, b.x, b.y}; v1 = (f32x4){c.x, c.y, d.x, d.y}; }
                    v0 = v0 * sc; v1 = v1 * sc; u32x4 w; w.x = cvt_pk_bf16(v0[0], v0[1]); w.y = cvt_pk_bf16(v0[2], v0[3]); w.z = cvt_pk_bf16(v1[0], v1[1]); w.w = cvt_pk_bf16(v1[2], v1[3]);
                    *(u32x4*)(rowp + bj * HALF) = w; } }
    }
};
template <class Epi, class Sched, bool ALIGN_EPI = false, bool SP2 = false>
__device__ __forceinline__ void gemm_phase(PG8_LAS unsigned char* lds, const Gemm g, const Sched& S, const Epi& E) {
    const int tid = TID_(),
        wid = __builtin_amdgcn_readfirstlane(tid >> 6), lane = tid & 63, wr = wid >> 2, wc = wid & 3, fr = lane & 15, fq = lane >> 4;
    const int K = g.K, nt = K / BK;
    unsigned voffA[2], voffB[2];
#pragma unroll
    for (int i = 0; i < 2; ++i) { int R, C; stage_rc(tid * 16 + i * 8192, R, C); const int Rb = Epi::PERM ? ((R & ~31) + perm32(R & 31)) : R;
        voffA[i] = (unsigned)(R * g.lda + C) * 2u; voffB[i] = (unsigned)(Rb * K + C) * 2u; }
    const size_t kstep = (size_t)(BK * 2);
    const size_t hstepA = (size_t)HALF * g.lda * 2, hstepB = (size_t)HALF * K * 2;
    const size_t tstepA = 2 * hstepA, tstepB = 2 * hstepB;
    const unsigned ldsw = (unsigned)wid * 1024u;
    const int aoff = lds_byte(wr * 64 + fr, fq * 8), boff = lds_byte(wc * 32 + fr, fq * 8);
#define PG8_SA(b, h) (((b) * 2 + (h)) * HTB)
#define PG8_SB(b, h) ((4 + (b) * 2 + (h)) * HTB)
#define PG8_STAGE(bufoff, gbase, voff) do { _Pragma("unroll") for (int _i = 0; _i < 2; ++_i) \
        __builtin_amdgcn_global_load_lds((const unsigned*)((const char*)(gbase) + (voff)[_i]), (PG8_LAS unsigned*)(lds + (bufoff) + ldsw + _i * 8192), 16, 0, 0); } while (0)
#define PG8_LDA(dst, b, h) do { _Pragma("unroll") for (int m = 0; m < 4; ++m) _Pragma("unroll") for (int k = 0; k < 2; ++k) dst[m][k] = *(const PG8_LAS bf16x8*)(lds + PG8_SA(b, h) + aoff + m * 2048 + k * 1024); } while (0)
#define PG8_LDB(dst, b, h) do { _Pragma("unroll") for (int n = 0; n < 2; ++n) _Pragma("unroll") for (int k = 0; k < 2; ++k) dst[n][k] = *(const PG8_LAS bf16x8*)(lds + PG8_SB(b, h) + boff + n * 2048 + k * 1024); } while (0)
#define PG8_MMA(ai, bj, At, Bt) do { __builtin_amdgcn_s_setprio(1); _Pragma("unroll") for (int m = 0; m < 4; ++m) _Pragma("unroll") for (int n = 0; n < 2; ++n) _Pragma("unroll") for (int k = 0; k < 2; ++k) \
        acc[ai][bj][m][n] = __builtin_amdgcn_mfma_f32_16x16x32_bf16(Bt[n][k], At[m][k], acc[ai][bj][m][n], 0, 0, 0); __builtin_amdgcn_s_setprio(0); } while (0)
#define PG8_WAIT_V(n) asm volatile("s_waitcnt vmcnt(" #n ")" ::: "memory")
#define PG8_WAIT_L(n) asm volatile("s_waitcnt lgkmcnt(" #n ")" ::: "memory")
#define PG8_BAR __builtin_amdgcn_s_barrier()
#define PG8_SCHED __builtin_amdgcn_sched_barrier(0)
    Unit cur, nxt; int ui = 0;
    if (!S.next(0, cur)) return;
    f32x4 acc[2][2][4][2];
#pragma unroll
    for (int a = 0; a < 2; ++a)
#pragma unroll
        for (int b = 0; b < 2; ++b)
#pragma unroll
            for (int m = 0; m < 4; ++m)
#pragma unroll
                for (int n = 0; n < 2; ++n) acc[a][b][m][n] = (f32x4){0.f, 0.f, 0.f, 0.f};
    bf16x8 At[4][2], B0[2][2], B1[2][2];
    const char* cA = (const char*)g.A + (size_t)cur.pm * tstepA + cur.kb; const char* cB = (const char*)g.Bt + (size_t)cur.pn * tstepB + cur.kb;
    S.a_ready(cur);
    if constexpr (SP2) {
        PG8_STAGE(PG8_SB(0, 0), cB, voffB); PG8_STAGE(PG8_SB(0, 1), cB + hstepB, voffB); PG8_STAGE(PG8_SA(0, 0), cA, voffA); PG8_STAGE(PG8_SA(0, 1), cA + hstepA, voffA);
        if (wr == 1) PG8_BAR;
        PG8_WAIT_V(2); PG8_BAR;
        PG8_STAGE(PG8_SB(1, 0), cB + kstep, voffB); PG8_STAGE(PG8_SA(1, 0), cA + kstep, voffA); PG8_STAGE(PG8_SB(1, 1), cB + hstepB + kstep, voffB);
        PG8_WAIT_V(6); PG8_BAR;
    } else {
        PG8_STAGE(PG8_SB(0, 0), cB, voffB); PG8_STAGE(PG8_SA(0, 0), cA, voffA); PG8_STAGE(PG8_SB(0, 1), cB + hstepB, voffB); PG8_STAGE(PG8_SA(0, 1), cA + hstepA, voffA);
        if (wr == 1) PG8_BAR;
        PG8_WAIT_V(4); PG8_BAR;
        PG8_STAGE(PG8_SB(1, 0), cB + kstep, voffB); PG8_STAGE(PG8_SA(1, 0), cA + kstep, voffA); PG8_STAGE(PG8_SB(1, 1), cB + hstepB + kstep, voffB);
        PG8_WAIT_V(6); PG8_BAR;
    }
    for (;;) {
        const bool has_next = S.next(ui + 1, nxt);
        const char* nA = has_next ? (const char*)g.A + (size_t)nxt.pm * tstepA + nxt.kb : cA; const char* nB = has_next ? (const char*)g.Bt + (size_t)nxt.pn * tstepB + nxt.kb : cB;
        const int unt = cur.nt ? cur.nt : nt;
        for (int t = 0; t < unt; t += 2) {
            const bool last = (t == unt - 2);
            const char* a1 = cA + (size_t)(t + 1) * kstep;
            const char* a2 = last ? nA : cA + (size_t)(t + 2) * kstep; const char* b2 = last ? nB : cB + (size_t)(t + 2) * kstep;
            const char* a3 = a2 + kstep; const char* b3 = b2 + kstep;
            if (last && has_next) S.a_ready(nxt);
            if constexpr (SP2) {
            PG8_LDB(B0, 0, 0); PG8_LDB(B1, 0, 1); PG8_SCHED; PG8_LDA(At, 0, 0); PG8_STAGE(PG8_SA(1, 1), a1 + hstepA, voffA);
            PG8_WAIT_V(8); PG8_WAIT_L(0); PG8_BAR; PG8_MMA(0, 0, At, B0); PG8_MMA(0, 1, At, B1); PG8_BAR; PG8_SCHED;
            PG8_LDA(At, 0, 1); PG8_STAGE(PG8_SB(0, 0), b2, voffB); PG8_STAGE(PG8_SB(0, 1), b2 + hstepB, voffB); PG8_STAGE(PG8_SA(0, 0), a2, voffA);
            PG8_WAIT_V(8); PG8_WAIT_L(0); PG8_BAR; PG8_MMA(1, 0, At, B0); PG8_MMA(1, 1, At, B1); PG8_BAR; PG8_SCHED;
            PG8_LDB(B0, 1, 0); PG8_LDB(B1, 1, 1); PG8_SCHED; PG8_LDA(At, 1, 0); PG8_STAGE(PG8_SA(0, 1), a2 + hstepA, voffA);
            PG8_WAIT_V(8); PG8_WAIT_L(0); PG8_BAR; PG8_MMA(0, 0, At, B0); PG8_MMA(0, 1, At, B1); PG8_BAR; PG8_SCHED;
            PG8_LDA(At, 1, 1); PG8_STAGE(PG8_SB(1, 0), b3, voffB); PG8_STAGE(PG8_SB(1, 1), b3 + hstepB, voffB); PG8_STAGE(PG8_SA(1, 0), a3, voffA);
            PG8_WAIT_V(8); PG8_WAIT_L(0); PG8_BAR; PG8_MMA(1, 0, At, B0); PG8_MMA(1, 1, At, B1); PG8_BAR; PG8_SCHED;
            } else {
            PG8_LDB(B0, 0, 0); PG8_SCHED; PG8_LDA(At, 0, 0); PG8_STAGE(PG8_SA(1, 1), a1 + hstepA, voffA);
            PG8_WAIT_L(8); PG8_BAR; PG8_WAIT_L(0); PG8_MMA(0, 0, At, B0); PG8_BAR; PG8_SCHED;
            PG8_LDB(B1, 0, 1); PG8_STAGE(PG8_SB(0, 0), b2, voffB);
            PG8_BAR; PG8_WAIT_L(0); PG8_MMA(0, 1, At, B1); PG8_BAR;
            PG8_LDA(At, 0, 1); PG8_STAGE(PG8_SA(0, 0), a2, voffA);
            PG8_BAR; PG8_WAIT_L(0); PG8_MMA(1, 0, At, B0); PG8_BAR; PG8_SCHED;
            PG8_STAGE(PG8_SB(0, 1), b2 + hstepB, voffB);
            PG8_WAIT_V(6); PG8_BAR; PG8_MMA(1, 1, At, B1); PG8_BAR;
            PG8_LDB(B0, 1, 0); PG8_SCHED; PG8_LDA(At, 1, 0); PG8_STAGE(PG8_SA(0, 1), a2 + hstepA, voffA);
            PG8_WAIT_L(8); PG8_BAR; PG8_WAIT_L(0); PG8_MMA(0, 0, At, B0); PG8_BAR; PG8_SCHED;
            PG8_LDB(B1, 1, 1); PG8_STAGE(PG8_SB(1, 0), b3, voffB);
            PG8_BAR; PG8_WAIT_L(0); PG8_MMA(0, 1, At, B1); PG8_BAR;
            PG8_LDA(At, 1, 1); PG8_STAGE(PG8_SA(1, 0), a3, voffA);
            PG8_BAR; PG8_WAIT_L(0); PG8_MMA(1, 0, At, B0); PG8_BAR; PG8_SCHED;
            PG8_STAGE(PG8_SB(1, 1), b3 + hstepB, voffB);
            PG8_WAIT_V(6); PG8_BAR; PG8_MMA(1, 1, At, B1); PG8_BAR;
            }
        }
        if constexpr (ALIGN_EPI) { if (wr == 0) PG8_BAR; }
        if constexpr (!Epi::AFTER_DRAIN) { E(acc, cur, wr, wc, fr, fq); S.done(cur); }
        if (!has_next) break;
#pragma unroll
        for (int a = 0; a < 2; ++a)
#pragma unroll
            for (int b = 0; b < 2; ++b)
#pragma unroll
                for (int m = 0; m < 4; ++m)
#pragma unroll
                    for (int n = 0; n < 2; ++n) acc[a][b][m][n] = (f32x4){0.f, 0.f, 0.f, 0.f};
        cur = nxt; cA = nA; cB = nB; ++ui;
        if constexpr (ALIGN_EPI) { if (wr == 1) PG8_BAR; }
    }
    PG8_WAIT_V(0);
    if constexpr (!ALIGN_EPI) { if (wr == 0) PG8_BAR; }
    PG8_BAR;
    if constexpr (Epi::AFTER_DRAIN) { E.fused(acc, cur, wr, wc, fr, fq, lds, wid, lane); S.done(cur); }
#undef PG8_SA
#undef PG8_SB
#undef PG8_STAGE
#undef PG8_LDA
#undef PG8_LDB
#undef PG8_MMA
#undef PG8_WAIT_V
#undef PG8_WAIT_L
#undef PG8_BAR
#undef PG8_SCHED
}
}

namespace pg8 {
struct EpiResidM {
    static constexpr bool PERM = false, AFTER_DRAIN = false;
    float* xlat; float* xctx; const float* slat; const float* sctx; const float* mod; int which; float* slab; int ntk_;
    __device__ __forceinline__ void operator()(const f32x4 (&acc)[2][2][4][2], const Unit& u, int wr, int wc, int fr, int fq) const {
        const int modrow = u.pm < ML / 256 ? (u.pm * 256) / SEQ : BATCH;
        const float* gp = mod + ((size_t)modrow * 6 + which) * D_MODEL;
        const int col0 = u.pn * BM + wc * 32 + 4 * fq;
        f32x4 gv[2][2], res[2][2][4][2];
        if (u.nt) {
            const int sl = u.kb / (BK * 2) / ((((ntk_ / 4) + 1) & ~1));
#pragma unroll
            for (int ai = 0; ai < 2; ++ai)
#pragma unroll
                for (int m = 0; m < 4; ++m) { const int r = u.pm * BM + ai * HALF + wr * 64 + m * 16 + fr - ML; float* sr = slab + ((size_t)sl * MC + r) * D_MODEL + col0;
#pragma unroll
                    for (int bj = 0; bj < 2; ++bj)
#pragma unroll
                        for (int n = 0; n < 2; ++n) st_wt((f32x4*)(sr + bj * HALF + n * 16), acc[ai][bj][m][n]); }
            return; }
#pragma unroll
        for (int bj = 0; bj < 2; ++bj)
#pragma unroll
            for (int n = 0; n < 2; ++n) gv[bj][n] = *(const f32x4*)(gp + col0 + bj * HALF + n * 16);
#pragma unroll
        for (int ai = 0; ai < 2; ++ai)
#pragma unroll
            for (int m = 0; m < 4; ++m) { const int r = u.pm * BM + ai * HALF + wr * 64 + m * 16 + fr;
                const float* xs = (r < ML ? slat + (size_t)r * D_MODEL : sctx + (size_t)(r - ML) * D_MODEL) + col0;
#pragma unroll
                for (int bj = 0; bj < 2; ++bj)
#pragma unroll
                    for (int n = 0; n < 2; ++n) res[ai][bj][m][n] = *(const f32x4*)(xs + bj * HALF + n * 16) + gv[bj][n] * acc[ai][bj][m][n]; }
        asm volatile("" ::: "memory");
#pragma unroll
        for (int ai = 0; ai < 2; ++ai)
#pragma unroll
            for (int m = 0; m < 4; ++m) { const int r = u.pm * BM + ai * HALF + wr * 64 + m * 16 + fr;
                float* xr = (r < ML ? xlat + (size_t)r * D_MODEL : xctx + (size_t)(r - ML) * D_MODEL) + col0;
#pragma unroll
                for (int bj = 0; bj < 2; ++bj)
#pragma unroll
                    for (int n = 0; n < 2; ++n) st_wt((f32x4*)(xr + bj * HALF + n * 16), res[ai][bj][m][n]); }
    }
};
__device__ __forceinline__ void unpack8(const u32x4 v, float* o) {
#pragma unroll
    for (int e = 0; e < 4; ++e) { o[2 * e] = __uint_as_float(v[e] << 16); o[2 * e + 1] = __uint_as_float(v[e] & 0xffff0000u); } }
struct EpiUpM {
    static constexpr bool PERM = true, AFTER_DRAIN = false;
    const bf16_t* GT; bf16_t* ACT; const float* cw; const float* cb;
    __device__ __forceinline__ void ldbatch(int b, const Unit& u, int wr, int wc, int fr, int fq, u32x4& gm, u32x4& gl, u32x4& gh) const {
        const int bj = b >> 3, ai = (b >> 2) & 1, m = b & 3, c = u.pn * BM + bj * HALF + wc * 32 + 8 * fq;
        const int r = u.pm * BM + ai * HALF + wr * 64 + m * 16 + fr;
        const int t = r < ML ? r % SEQ : (r - ML) % CTX_LEN, T = r < ML ? SEQ : CTX_LEN; const bf16_t* gp = GT + (size_t)r * D_FF + c;
        gm = *(const u32x4*)gp; gl = (u32x4){0u, 0u, 0u, 0u}; gh = (u32x4){0u, 0u, 0u, 0u};
        if (t > 0) gl = *(const u32x4*)(gp - D_FF);
        if (t < T - 1) gh = *(const u32x4*)(gp + D_FF);
    }
    __device__ __forceinline__ void operator()(const f32x4 (&acc)[2][2][4][2], const Unit& u, int wr, int wc, int fr, int fq) const {
        u32x4 gmA, glA, ghA, gmB, glB, ghB;
        ldbatch(0, u, wr, wc, fr, fq, gmA, glA, ghA);
#pragma unroll
        for (int bj = 0; bj < 2; ++bj) { const int c = u.pn * BM + bj * HALF + wc * 32 + 8 * fq;
            f32x4 w0[2], w1[2], w2[2], bb[2];
#pragma unroll
            for (int q = 0; q < 2; ++q) { w0[q] = *(const f32x4*)(cw + c + 4 * q); w1[q] = *(const f32x4*)(cw + D_FF + c + 4 * q); w2[q] = *(const f32x4*)(cw + 2 * D_FF + c + 4 * q); bb[q] = *(const f32x4*)(cb + c + 4 * q); }
#pragma unroll
            for (int i = 0; i < 8; ++i) { const int b = bj * 8 + i, ai = i >> 2, m = i & 3;
                u32x4& gm = (b & 1) ? gmB : gmA; u32x4& gl = (b & 1) ? glB : glA; u32x4& gh = (b & 1) ? ghB : ghA;
                if (b + 1 < 16) { if (b & 1) ldbatch(b + 1, u, wr, wc, fr, fq, gmA, glA, ghA); else ldbatch(b + 1, u, wr, wc, fr, fq, gmB, glB, ghB); }
                float g[8], x[8];
                unpack8(gm, x);
#pragma unroll
                for (int e = 0; e < 8; ++e) g[e] = bb[e >> 2][e & 3] + w1[e >> 2][e & 3] * x[e];
                unpack8(gl, x);
#pragma unroll
                for (int e = 0; e < 8; ++e) g[e] += w0[e >> 2][e & 3] * x[e];
                unpack8(gh, x);
#pragma unroll
                for (int e = 0; e < 8; ++e) g[e] += w2[e >> 2][e & 3] * x[e];
                const f32x4 v0 = acc[ai][bj][m][0], v1 = acc[ai][bj][m][1]; float o[8];
#pragma unroll
                for (int e = 0; e < 4; ++e) { o[e] = g[e] / (1.f + __expf(-g[e])) * v0[e]; o[4 + e] = g[4 + e] / (1.f + __expf(-g[4 + e])) * v1[e]; }
                u32x4 w; w.x = cvt_pk_bf16(o[0], o[1]); w.y = cvt_pk_bf16(o[2], o[3]); w.z = cvt_pk_bf16(o[4], o[5]); w.w = cvt_pk_bf16(o[6], o[7]);
                const int r = u.pm * BM + ai * HALF + wr * 64 + m * 16 + fr; *(u32x4*)(ACT + (size_t)r * D_FF + c) = w; } }
    }
};
struct EpiGluM {
    static constexpr bool PERM = false, AFTER_DRAIN = false;
    bf16_t* YM; const float* bg;
    __device__ __forceinline__ void operator()(const f32x4 (&acc)[2][2][4][2], const Unit& u, int wr, int wc, int fr, int fq) const {
#pragma unroll
        for (int n = 0; n < 2; ++n) { const int oc = u.pn * HALF + wc * 32 + 16 * n + 4 * fq;
            const f32x4 ba = *(const f32x4*)(bg + oc), bgt = *(const f32x4*)(bg + 256 + oc);
#pragma unroll
            for (int ai = 0; ai < 2; ++ai)
#pragma unroll
                for (int m = 0; m < 4; ++m) { const int r = u.pm * BM + ai * HALF + wr * 64 + m * 16 + fr;
                    const f32x4 a = acc[ai][0][m][n] + ba, g = acc[ai][1][m][n] + bgt; float o[4];
#pragma unroll
                    for (int e = 0; e < 4; ++e) o[e] = a[e] / (1.f + __expf(-g[e]));
                    typedef unsigned u32x2 __attribute__((ext_vector_type(2))); u32x2 w; w.x = cvt_pk_bf16(o[0], o[1]); w.y = cvt_pk_bf16(o[2], o[3]);
                    *(u32x2*)(YM + (size_t)r * D_MIX + 768 + oc) = w; } }
    }
};
struct EpiInProj {
    static constexpr bool PERM = true, AFTER_DRAIN = false;
    bf16_t* P; bf16_t* S5A; float* DTRAW;
    __device__ __forceinline__ void operator()(const f32x4 (&acc)[2][2][4][2], const Unit& u, int wr, int wc, int fr, int fq) const {
        const int row0 = u.pm * BM + wr * 64 + fr;
        if (u.pn == 9) { if (wc == 0 && fq == 0) {
#pragma unroll
                for (int ai = 0; ai < 2; ++ai)
#pragma unroll
                    for (int m = 0; m < 4; ++m) { float* d = DTRAW + (size_t)(row0 + ai * HALF + m * 16) * 8; *(f32x4*)d = acc[ai][0][m][0]; *(f32x4*)(d + 4) = acc[ai][0][m][1]; } }
            return; }
#pragma unroll
        for (int ai = 0; ai < 2; ++ai)
#pragma unroll
            for (int m = 0; m < 4; ++m) { const int r = row0 + ai * HALF + m * 16;
#pragma unroll
                for (int bj = 0; bj < 2; ++bj) { const f32x4 v0 = acc[ai][bj][m][0], v1 = acc[ai][bj][m][1];
                    u32x4 w; w.x = cvt_pk_bf16(v0[0], v0[1]); w.y = cvt_pk_bf16(v0[2], v0[3]); w.z = cvt_pk_bf16(v1[0], v1[1]); w.w = cvt_pk_bf16(v1[2], v1[3]);
                    const int cl = bj * HALF + wc * 32 + 8 * fq;
                    if (u.pn < 8) *(u32x4*)(P + (size_t)r * PLD + u.pn * BM + cl) = w;
                    else *(u32x4*)(S5A + ((size_t)(cl >> 4) * S5R + (r >> 4)) * 512 + (r & 15) * 16 + (cl & 15)) = w; } }
    }
};
struct BatchedOrder {
    int G, c;
    __device__ void init(int G_, int c_) { G = G_; c = c_; }
    __device__ bool next(int i, Unit& u) const { const int idx = i * G + (c + 16 * (S5R / 256)) % G;   if (idx >= 16 * (S5R / 256)) return false; u.pm = idx; u.pn = idx / (S5R / 256); return true; }
    __device__ __forceinline__ void a_ready(const Unit&) const {}
    __device__ __forceinline__ void done(const Unit&) const {}
};
constexpr int EX_OFF = MISC_OFF_ + 4096;
struct EpiGateUpM {
    static constexpr bool PERM = false, AFTER_DRAIN = false;
    bf16_t* ACT; const float* cw; const float* cb; float* EG; float* EU;
    __device__ __forceinline__ void operator()(const f32x4 (&acc)[2][2][4][2], const Unit& u, int wr, int wc, int fr_, int fq_) const {
        int fr = fr_, fq = fq_; asm volatile("" : "+v"(fr), "+v"(fq));
        extern __shared__ __attribute__((aligned(16))) unsigned char l_ex_[];
        PG8_LAS float* EXF = (PG8_LAS float*)((PG8_LAS unsigned char*)l_ex_ + EX_OFF); PG8_LAS float* EXL = EXF + 4 * 128;
        const int cl = wc * 32 + 4 * fq, lane = fq * 16 + fr, srcp = (lane & 48) | ((fr + 15) & 15), srcn = (lane & 48) | ((fr + 1) & 15);
#pragma unroll
        for (int ai = 0; ai < 2; ++ai) { const int blk = 2 * ai + wr;
#pragma unroll
            for (int n = 0; n < 2; ++n) {
                if (fr == 0) *(PG8_LAS f32x4*)(EXF + blk * 128 + cl + 16 * n) = acc[ai][0][0][n];
                if (fr == 15) *(PG8_LAS f32x4*)(EXL + blk * 128 + cl + 16 * n) = acc[ai][0][3][n]; } }
        asm volatile("s_waitcnt lgkmcnt(0)" ::: "memory"); __builtin_amdgcn_s_barrier(); asm volatile("" ::: "memory");
        const int c0 = u.pn * HALF + cl;
#pragma unroll
        for (int n = 0; n < 2; ++n) { const int c = c0 + 16 * n;
            const f32x4 w0 = *(const f32x4*)(cw + c), w1 = *(const f32x4*)(cw + D_FF + c), w2 = *(const f32x4*)(cw + 2 * D_FF + c), bb = *(const f32x4*)(cb + c);
#pragma unroll
            for (int ai = 0; ai < 2; ++ai) { const int blk = 2 * ai + wr;
                f32x4 eprev = (f32x4){0.f, 0.f, 0.f, 0.f}, enext = eprev;
                if (blk > 0) eprev = *(const PG8_LAS f32x4*)(EXL + (blk - 1) * 128 + cl + 16 * n);
                if (blk < 3) enext = *(const PG8_LAS f32x4*)(EXF + (blk + 1) * 128 + cl + 16 * n);
#pragma unroll
                for (int m = 0; m < 4; ++m) { const f32x4 g = acc[ai][0][m][n], up = acc[ai][1][m][n];
                    const f32x4 gm1 = acc[ai][0][m > 0 ? m - 1 : 0][n], gp1 = acc[ai][0][m < 3 ? m + 1 : 3][n]; f32x4 pv, nx;
#pragma unroll
                    for (int e = 0; e < 4; ++e) { pv[e] = __shfl(fr == 15 ? gm1[e] : g[e], srcp, 64); nx[e] = __shfl(fr == 0 ? gp1[e] : g[e], srcn, 64); }
                    if (fr == 0 && m == 0) pv = eprev;
                    if (fr == 15 && m == 3) nx = enext;
                    const f32x4 gc = bb + w0 * pv + w1 * g + w2 * nx; float o[4];
#pragma unroll
                    for (int e = 0; e < 4; ++e) o[e] = gc[e] * __builtin_amdgcn_rcpf(1.f + __expf(-gc[e])) * up[e];
                    typedef unsigned u32x2 __attribute__((ext_vector_type(2))); u32x2 w; w.x = cvt_pk_bf16(o[0], o[1]); w.y = cvt_pk_bf16(o[2], o[3]);
                    const int rl = ai * HALF + wr * 64 + m * 16 + fr;
                    *(u32x2*)(ACT + (size_t)(u.pm * BM + rl) * D_FF + c) = w;
                    if (rl < 2) { *(f32x4*)(EG + ((size_t)u.pm * 4 + rl) * D_FF + c) = g; if (rl == 0) *(f32x4*)(EU + ((size_t)u.pm * 2) * D_FF + c) = up; }
                    if (rl >= 254) { *(f32x4*)(EG + ((size_t)u.pm * 4 + rl - 252) * D_FF + c) = g; if (rl == 255) *(f32x4*)(EU + ((size_t)u.pm * 2 + 1) * D_FF + c) = up; } } } }
    }
};
struct TailSplitOrder {
    StaticOrder so; int G, c, ntk, nlat;
    __device__ void init(int K, int G_, int c_) { so.init(ML, D_MODEL, G_, c_); G = G_; c = c_; ntk = K / BK; nlat = (ML / BM) * (D_MODEL / BM); }
    __device__ bool next(int i, Unit& u) const {
        const int nl = c < nlat ? (nlat - c + G - 1) / G : 0;
        if (i < nl) { so.next(i, u); u.kb = 0; u.nt = 0; return true; }
        constexpr int NS = 4; const int j = (i - nl) * G + c; if (j >= 8 * NS) return false;
        const int tile = j / NS, sl = j % NS, per = ((ntk / NS) + 1) & ~1, k0 = sl * per;
        u.pm = ML / BM + tile / (D_MODEL / BM); u.pn = tile % (D_MODEL / BM); u.kb = k0 * BK * 2; u.nt = (sl == NS - 1) ? ntk - k0 : per; return true;
    }
    __device__ __forceinline__ void a_ready(const Unit&) const {}
    __device__ __forceinline__ void done(const Unit&) const {}
};
struct EpiS5E {
    static constexpr bool PERM = false, AFTER_DRAIN = false; float* E;
    __device__ __forceinline__ void operator()(const f32x4 (&acc)[2][2][4][2], const Unit& u, int wr, int wc, int fr, int fq) const {
        const int g = u.pn, sc0 = (u.pm - g * (S5R / 256)) * BM + wr * 64 + fr, col0 = wc * 32 + 4 * fq;
#pragma unroll
        for (int ai = 0; ai < 2; ++ai)
#pragma unroll
            for (int m = 0; m < 4; ++m) { const int sc = sc0 + ai * HALF + m * 16; if (sc < NSC) { float* e = E + ((size_t)g * NSC + sc) * 256 + col0;
#pragma unroll
                    for (int bj = 0; bj < 2; ++bj)
#pragma unroll
                        for (int n = 0; n < 2; ++n) *(f32x4*)(e + bj * HALF + n * 16) = acc[ai][bj][m][n]; } }
    }
};
struct EpiS5Y {
    static constexpr bool PERM = false, AFTER_DRAIN = false; bf16_t* P; int nsc;
    __device__ __forceinline__ void operator()(const f32x4 (&acc)[2][2][4][2], const Unit& u, int wr, int wc, int fr, int fq) const {
        const int g = u.pn, sc0 = (u.pm - g * (S5R / 256)) * BM + wr * 64 + fr, col0 = wc * 32 + 4 * fq;
        typedef unsigned u32x2 __attribute__((ext_vector_type(2)));
#pragma unroll
        for (int ai = 0; ai < 2; ++ai)
#pragma unroll
            for (int m = 0; m < 4; ++m) { const int sc = sc0 + ai * HALF + m * 16; if (sc < nsc) {
#pragma unroll
                    for (int bj = 0; bj < 2; ++bj)
#pragma unroll
                        for (int n = 0; n < 2; ++n) { const int ik = col0 + bj * HALF + n * 16; const f32x4 v = acc[ai][bj][m][n]; float o[4];
#pragma unroll
                            for (int e = 0; e < 4; ++e) { const float x = v[e], t = 0.7978845608028654f * (x + 0.044715f * x * x * x); o[e] = x / (1.f + __expf(-2.f * t)); }
                            u32x2 w; w.x = cvt_pk_bf16(o[0], o[1]); w.y = cvt_pk_bf16(o[2], o[3]);
                            *(u32x2*)(P + (size_t)(sc * 16 + (ik >> 4)) * PLD + YS5_OFF + g * 16 + (ik & 15)) = w; } } }
    }
};
}

__device__ __forceinline__ unsigned f2bf(float f) { unsigned u = __builtin_bit_cast(unsigned, f); return (u + 0x7fffu + ((u >> 16) & 1u)) >> 16; }
__device__ __forceinline__ unsigned pk2(float lo, float hi) { return f2bf(lo) | (f2bf(hi) << 16); }
typedef unsigned v4u __attribute__((ext_vector_type(4)));
__device__ __forceinline__ void transpose_item(const float* W, int ldw, int nblk, act_t* WT, int K, LAS float* scr, int item, int lane) {
    const int kb = item / nblk, nb = item % nblk, k0 = 64 * kb, n0 = 32 * nb;
#pragma unroll
    for (int i = 0; i < 32; ++i) { const int kk = 2 * i + (lane >> 5); scr[kk * 33 + (lane & 31)] = W[(size_t)(k0 + kk) * ldw + n0 + (lane & 31)]; }
    asm volatile("s_waitcnt lgkmcnt(0)" ::: "memory");
    const int c = lane & 7;
#pragma unroll
    for (int j = 0; j < 4; ++j) { const int n = (lane >> 3) + 8 * j; const LAS float* sp = scr + (8 * c) * 33 + n;
        v4u o; o.x = pk2(sp[0 * 33], sp[1 * 33]); o.y = pk2(sp[2 * 33], sp[3 * 33]); o.z = pk2(sp[4 * 33], sp[5 * 33]); o.w = pk2(sp[6 * 33], sp[7 * 33]);
        *(v4u*)(WT + (size_t)(n0 + n) * K + k0 + 8 * c) = o; }
    asm volatile("s_waitcnt lgkmcnt(0)" ::: "memory");
}
__device__ __forceinline__ void st_wprep(const Prm& p, int L, LAS unsigned char* lds, int g0, int gs, int part) {
    const int tl_ = TID_();
    const int lane = tl_ & 63, wave = __builtin_amdgcn_readfirstlane(tl_ >> 6);
    LAS float* scr = (LAS float*)(lds + wave * 16384);
    int gw = BIDX_() * (NTHREADS_ / 64) + wave, NGW = GDIM_() * (NTHREADS_ / 64);
    constexpr int I_IN1 = (D_MODEL / 64) * (1024 / 32), I_IN3 = (D_MODEL / 64) * (256 / 32), I_IN = 2 * I_IN1 + I_IN3, I_OUT = (D_MIX / 64) * (D_MODEL / 32), I_G = (D_MODEL / 64) * (D_FF / 32), I_D = (D_FF / 64) * (D_MODEL / 32);
    constexpr int NIT = I_IN + I_OUT + 2 * I_G + I_D;
    if (part == 1 && GDIM_() == 256) { const int bx = BIDX_();
        if (bx < 128) { gw = bx * 8 + wave; NGW = NIT; } else { gw = 1024 + (bx - 128) * 8 + wave; NGW = 1024; } }
    const int it0 = part ? I_IN + gw : gw, it1 = part ? NIT : I_IN;
    for (int it = it0; it < it1; it += NGW) { int r = it;
        if (r < I_IN) { const float* W = p.in[I_WIN] + (size_t)L * D_MODEL * D_IN; act_t* WT = WSP(act_t, WS_WIN);
            if (r < I_IN1) transpose_item(W, D_IN, 1024 / 32, WT, D_MODEL, scr, r, lane);
            else if (r < 2 * I_IN1) transpose_item(W + 1032, D_IN, 1024 / 32, WT + (size_t)1024 * D_MODEL, D_MODEL, scr, r - I_IN1, lane);
            else transpose_item(W + 2056, D_IN, 256 / 32, WT + (size_t)2048 * D_MODEL, D_MODEL, scr, r - 2 * I_IN1, lane);
            continue; } r -= I_IN;
        if (r < I_OUT) { transpose_item(p.in[I_WOUT] + (size_t)L * D_MIX * D_MODEL, D_MODEL, D_MODEL / 32, WSP(act_t, WS_WOUT), D_MIX, scr, r, lane); continue; } r -= I_OUT;
        if (r < 2 * I_G) { const bool isup = r >= I_G; const int rr = isup ? r - I_G : r, n0 = 32 * (rr % (D_FF / 32)), drow = (n0 >> 7) * 256 + (n0 & 127) + (isup ? 128 : 0);
            transpose_item(p.in[isup ? I_WUP : I_WGATE] + (size_t)L * D_MODEL * D_FF, D_FF, D_FF / 32, WSP(act_t, WS_WG) + (ptrdiff_t)(drow - n0) * D_MODEL, D_MODEL, scr, rr, lane); continue; } r -= 2 * I_G;
        transpose_item(p.in[I_WDOWN] + (size_t)L * D_FF * D_MODEL, D_MODEL, D_MODEL / 32, WSP(act_t, WS_WD), D_FF, scr, r, lane); }
    if (part) return;
    { const float* W = p.in[I_WIN] + (size_t)L * D_MODEL * D_IN; act_t* WT = WSP(act_t, WS_WIN);
      for (int i = g0; i < (int)((NIN - 2304) * D_MODEL); i += gs) { const int n = 2304 + (int)(i / D_MODEL), k = (int)(i % D_MODEL); stf(WT + (size_t)n * D_MODEL + k, n < 2312 ? W[(size_t)k * D_IN + 1024 + (n - 2304)] : 0.f); } }
    { const float* W = p.in[I_WGLU] + (size_t)L * 256 * 512; act_t* WT = WSP(act_t, WS_WGLU);
      for (int i = g0; i < (int)(512L * 256); i += gs) { const int j = (int)(i / 256), k = (int)(i % 256); const int pn = j >> 8, half = (j >> 7) & 1, o = j & 127; stf(WT + i, W[(size_t)k * 512 + half * 256 + 128 * pn + o]); } }
}
#include <hip/hip_bf16.h>
#include <cmath>
namespace attn_body {
using bf16=__hip_bfloat16;
using bf16x8=__attribute__((ext_vector_type(8)))short;
using s16x4=__attribute__((ext_vector_type(4)))short;
using f32x16=__attribute__((ext_vector_type(16)))float;
using u32x4=__attribute__((ext_vector_type(4)))unsigned;
constexpr int D=64,QKVP=PLD,OP=D_MIX;
constexpr int NW=8,QBLK=32,QB=QBLK*NW,KVBLK=64;
__device__ __forceinline__ int crow(int r,int hi){return (r&3)+8*(r>>2)+4*hi;}
#define SBAR() __builtin_amdgcn_sched_barrier(0)
__device__ __forceinline__ void wmask(f32x16&p0,f32x16&p1,int kbase,int qpos,int hi){
  const float NEG=-INFINITY; const int d0=kbase+4*hi-qpos;
  #pragma unroll
  for(int r=0;r<16;++r){const int dd=d0+(r&3)+8*(r>>2); if(dd<-128||dd>128)p0[r]=NEG; if(dd+32<-128||dd+32>128)p1[r]=NEG;}
}
constexpr int NSLOT=3, SLOTB=8192;
constexpr int LDS_K=0, LDS_V=NSLOT*SLOTB, LDS_WS=2*NSLOT*SLOTB, LDS_OST=LDS_WS+NW*64*4, LDS_BYTES=LDS_OST+NW*4096;
constexpr float C2=0.125f*1.4426950408889634f;
__device__ __forceinline__ void glds16(const void*gsrc,unsigned lds_dst){unsigned keep;
  asm volatile("s_mov_b32 %0, m0\n\ts_mov_b32 m0, %2\n\ts_nop 0\n\tglobal_load_lds_dwordx4 %1, off\n\ts_mov_b32 m0, %0":"=&s"(keep):"v"(gsrc),"s"(lds_dst):"memory");}
__device__ __forceinline__ float max3f(float a,float b,float c){float r;asm("v_max3_f32 %0, %1, %2, %3":"=v"(r):"v"(a),"v"(b),"v"(c));return r;}
__device__ __forceinline__ float max2f(float a,float b){float r;asm("v_max_f32_e32 %0, %1, %2":"=v"(r):"v"(a),"v"(b));return r;}
__device__ __forceinline__ float fadd_s(float a,float b){float r;asm("v_add_f32_e32 %0, %1, %2":"=v"(r):"v"(a),"v"(b));return r;}
__device__ __forceinline__ float fsub_s(float a,float b){float r;asm("v_sub_f32_e32 %0, %1, %2":"=v"(r):"v"(a),"v"(b));return r;}
typedef float f32x2_t __attribute__((ext_vector_type(2))); typedef __bf16 bf16x2_t __attribute__((ext_vector_type(2)));
__device__ __forceinline__ unsigned cvtpk_s(float lo,float hi){f32x2_t v={lo,hi};bf16x2_t b=__builtin_convertvector(v,bf16x2_t);return __builtin_bit_cast(unsigned,b);}
#define WAIT_BAR(N) asm volatile("s_waitcnt vmcnt(" #N ") lgkmcnt(0)\n\ts_barrier":::"memory")

__device__ __forceinline__ void qkt(f32x16&p0,f32x16&p1,const char*Kslot,const bf16x8*qr,const f32x16&negm,int r32,int hi){
  const char*kb=Kslot+hi*1024+r32*16;
  #pragma unroll
  for(int d0=0;d0<4;++d0){
    const bf16x8 b0=*reinterpret_cast<const bf16x8*>(kb+d0*2048);
    const bf16x8 b1=*reinterpret_cast<const bf16x8*>(kb+d0*2048+512);
    if(d0==0){p0=__builtin_amdgcn_mfma_f32_32x32x16_bf16(b0,qr[0],negm,0,0,0);p1=__builtin_amdgcn_mfma_f32_32x32x16_bf16(b1,qr[0],negm,0,0,0);}
    else{p0=__builtin_amdgcn_mfma_f32_32x32x16_bf16(b0,qr[d0],p0,0,0,0);p1=__builtin_amdgcn_mfma_f32_32x32x16_bf16(b1,qr[d0],p1,0,0,0);}}
}
typedef __attribute__((address_space(3))) const char* lds_cptr;
typedef short v4i16_t __attribute__((ext_vector_type(4)));
__device__ __forceinline__ void kload8(bf16x8*kf,lds_cptr kp){
  kf[0]=*(const __attribute__((address_space(3))) bf16x8*)(kp);      kf[1]=*(const __attribute__((address_space(3))) bf16x8*)(kp+512);
  kf[2]=*(const __attribute__((address_space(3))) bf16x8*)(kp+2048); kf[3]=*(const __attribute__((address_space(3))) bf16x8*)(kp+2560);
  kf[4]=*(const __attribute__((address_space(3))) bf16x8*)(kp+4096); kf[5]=*(const __attribute__((address_space(3))) bf16x8*)(kp+4608);
  kf[6]=*(const __attribute__((address_space(3))) bf16x8*)(kp+6144); kf[7]=*(const __attribute__((address_space(3))) bf16x8*)(kp+6656);
}
__device__ __forceinline__ void kload2(bf16x8*kf,lds_cptr kp,int j){ kf[2*j]=*(const __attribute__((address_space(3))) bf16x8*)(kp+j*2048); kf[2*j+1]=*(const __attribute__((address_space(3))) bf16x8*)(kp+j*2048+512); }
__device__ __forceinline__ s16x4 vtr(lds_cptr p){ return __builtin_bit_cast(s16x4,__builtin_amdgcn_ds_read_tr16_b64_v4i16((__attribute__((address_space(3))) v4i16_t*)p)); }
__device__ __forceinline__ float rowmax(const f32x16&p0,const f32x16&p1){
  float a=max3f(p0[0],p0[1],p1[0]),b=max3f(p0[2],p0[3],p1[1]);a=max3f(a,p1[2],p1[3]);
  #pragma unroll
  for(int r=4;r<16;r+=4){a=max3f(a,p0[r],p0[r+1]);b=max3f(b,p0[r+2],p0[r+3]);a=max3f(a,p1[r],p1[r+1]);b=max3f(b,p1[r+2],p1[r+3]);}
  const float m=max2f(a,b);
  auto rr=__builtin_amdgcn_permlane32_swap(__float_as_uint(m),__float_as_uint(m),false,false);
  return max2f(__uint_as_float(rr[0]),__uint_as_float(rr[1]));
}
__device__ __forceinline__ void pv(f32x16*o,int vb,bf16x8 pa0,bf16x8 pa1,bf16x8 pa2,bf16x8 pa3){
  #pragma unroll
  for(int d0=0;d0<2;++d0){s16x4 lo[4],hi[4];
    #pragma unroll
    for(int ks=0;ks<4;++ks){
      asm volatile("ds_read_b64_tr_b16 %0,%1 offset:%c2":"=&v"(lo[ks]):"v"(vb),"i"(d0*4096+ks*1024):"memory");
      asm volatile("ds_read_b64_tr_b16 %0,%1 offset:%c2":"=&v"(hi[ks]):"v"(vb),"i"(d0*4096+ks*1024+512):"memory");}
    asm volatile("s_waitcnt lgkmcnt(0)":::"memory");SBAR();
    #define PK(k) (bf16x8){lo[k][0],lo[k][1],lo[k][2],lo[k][3],hi[k][0],hi[k][1],hi[k][2],hi[k][3]}
    o[d0]=__builtin_amdgcn_mfma_f32_32x32x16_bf16(pa0,PK(0),o[d0],0,0,0);
    o[d0]=__builtin_amdgcn_mfma_f32_32x32x16_bf16(pa1,PK(1),o[d0],0,0,0);
    o[d0]=__builtin_amdgcn_mfma_f32_32x32x16_bf16(pa2,PK(2),o[d0],0,0,0);
    o[d0]=__builtin_amdgcn_mfma_f32_32x32x16_bf16(pa3,PK(3),o[d0],0,0,0);
    #undef PK
  }
}

#ifndef ATTN_STORE16
#define ATTN_STORE16(p,v) (*(u32x4*)(p)=(v))
#endif
template<int THRL,bool WIN> __device__ __forceinline__ void attn_unit(const bf16*Pm,int qrow0,int qoff,int koff,int voff,int ctx0,int lat0,int NT,int qpos0,int kpos0,float sinkl2,bf16*Ob,char*shm){
  const int tid=TID_(),lane=tid&63,r32=lane&31,hi=lane>>5; const int wid=__builtin_amdgcn_readfirstlane(tid>>6);
  const bf16*Qw=Pm+(long)(qrow0+wid*QBLK)*QKVP+qoff;
  const unsigned lds0=(unsigned)(uintptr_t)shm;
  float*wsf=(float*)(shm+LDS_WS)+wid*64;
  const bf16*ksrc=Pm+(long)lane*QKVP+koff+wid*8;
  const bf16*vsrc=Pm+(long)(16*(wid&3)+(lane>>2))*QKVP+voff+(wid>>2)*32+(lane&3)*8;
  #define KROW(t) ((t)<4?ctx0+64*(t):lat0+64*((t)-4))
  const unsigned kdst=lds0+LDS_K+wid*1024, vdst=lds0+LDS_V+wid*1024;
  #define DMA_K(t,slot) glds16(ksrc+(long)KROW(t)*QKVP,(unsigned)__builtin_amdgcn_readfirstlane(kdst+(slot)))
  #define DMA_V(t,slot) glds16(vsrc+(long)KROW(t)*QKVP,(unsigned)__builtin_amdgcn_readfirstlane(vdst+(slot)))
  const int vb0=(int)(lds0+LDS_V)+((lane>>4)&1)*32+(lane&3)*8+(4*hi+((lane&15)>>2))*64;
  const char*Kbase=shm+LDS_K; bf16x8 kf[8];
  const lds_cptr shm3=(lds_cptr)shm; const lds_cptr kp0=shm3+LDS_K+hi*1024+r32*16; const lds_cptr vp0=shm3+LDS_V+((lane>>4)&1)*32+(lane&3)*8+(4*hi+((lane&15)>>2))*64;
  DMA_K(0,0);DMA_V(0,0);DMA_K(1,SLOTB);
  bf16x8 qr[4];
  #pragma unroll
  for(int d0=0;d0<4;++d0)qr[d0]=*reinterpret_cast<const bf16x8*>(&Qw[(long)r32*QKVP+d0*16+hi*8]);
  float mhat=0.f,l_reg=0.f;f32x16 o[2];o[0]=f32x16{};o[1]=f32x16{};f32x16 negm=f32x16{};asm volatile("":"+v"(negm));
  const int qpos=qpos0+wid*QBLK+r32;
  #define CMASK(P0,P1,t) do{ if(WIN){ if((t)>=4) wmask(P0,P1,kpos0+64*((t)-4),qpos,hi); } }while(0)
  bool resc=false;
  #define START(P0,P1) do{ const float rm=rowmax(P0,P1); resc=false; \
    { const float dl=rm; mhat=fadd_s(mhat,dl); \
      _Pragma("unroll") for(int r=0;r<16;++r){P0[r]=fsub_s(P0[r],dl);P1[r]=fsub_s(P1[r],dl);} \
      _Pragma("unroll") for(int r=0;r<16;++r)negm[r]=-mhat; asm volatile("":"+v"(negm)); } \
    _Pragma("unroll") for(int r=0;r<16;++r)P0[r]=__builtin_amdgcn_exp2f(P0[r]); }while(0)
  #define RESC() do{ if(resc){ asm volatile("s_waitcnt lgkmcnt(0)":::"memory"); \
      _Pragma("unroll") for(int d_=0;d_<2;++d_) _Pragma("unroll") for(int r=0;r<16;++r)o[d_][r]*=wsf[crow(r,hi)]; } }while(0)
  f32x16 pA0,pA1,pB0,pB1;
  int sl_prev=0,sl_cur=0,sl_next=SLOTB;
  #define ROT() do{sl_prev=sl_cur;sl_cur=sl_next;sl_next=(sl_next==(NSLOT-1)*SLOTB)?0:sl_next+SLOTB;}while(0)
  DMA_K(2,2*SLOTB);
  WAIT_BAR(3);
  qkt(pA0,pA1,Kbase,qr,negm,r32,hi);asm volatile("s_nop 15\n\ts_nop 7":"+v"(pA0),"+v"(pA1));CMASK(pA0,pA1,0);
  START(pA0,pA1);
  _Pragma("unroll") for(int r=0;r<16;++r)pA1[r]=__builtin_amdgcn_exp2f(pA1[r]);
  WAIT_BAR(0);
  DMA_K(3,0);DMA_V(1,SLOTB);
  ROT();
  kload8(kf,kp0+sl_cur);
  WAIT_BAR(2);
  s16x4 vlo[8],vhi[8]; u32x4 pw0,pw1,pw2,pw3;
  #define PKW(P,B) cvtpk_s(P[B],P[B+1])
  #define PAF(k) __builtin_bit_cast(bf16x8,pw##k)
  #define VFR(i) (bf16x8){vlo[i][0],vlo[i][1],vlo[i][2],vlo[i][3],vhi[i][0],vhi[i][1],vhi[i][2],vhi[i][3]}
  #define PIN(x) asm volatile("":"+v"(x))
  #define MX3(a,b,c) __builtin_fmaxf(__builtin_fmaxf((a),(b)),(c))
  #define GAPA(MF,A0,A1,A2,A3,W0,W1,PW) do{ MF; sacc+=A0; sacc+=A1; sacc+=A2; sacc+=A3; PIN(sacc); W0; W1; PIN(PW); SBAR(); }while(0)
  #define EX(v) __builtin_amdgcn_exp2f(v)
  #define GAPB(MF,X,B) do{ MF; X[B]=EX(X[B]); X[B+1]=EX(X[B+1]); X[B+2]=EX(X[B+2]); X[B+3]=EX(X[B+3]); PIN(X); SBAR(); }while(0)
  #define VRD(i) do{ vlo[i]=vtr(vp_+(((i)>>2)*4096+((i)&3)*1024)); vhi[i]=vtr(vp_+(((i)>>2)*4096+((i)&3)*1024+512)); }while(0)
  #define KRD(G,j) do{ if(G){ kload2(kf,kp0+sl_next,j); SBAR(); } }while(0)
  #define STEP(C0,C1,P0,P1,t,GK,GV,GL) do{ SBAR(); \
    const lds_cptr vp_=vp0+sl_prev; \
    VRD(0); SBAR(); float sacc=(P0[0]+P0[1]); \
    GAPA(C0=__builtin_amdgcn_mfma_f32_32x32x16_bf16(kf[0],qr[0],negm,0,0,0), P0[2],P0[3],P0[4],P0[5],     pw0[0]=PKW(P0,0), pw0[1]=PKW(P0,2), pw0); \
    VRD(4); SBAR(); GAPA(C1=__builtin_amdgcn_mfma_f32_32x32x16_bf16(kf[1],qr[0],negm,0,0,0), P0[6],P0[7],P0[8],P0[9],     pw0[2]=PKW(P0,4), pw0[3]=PKW(P0,6), pw0); \
    VRD(1); SBAR(); GAPA(C0=__builtin_amdgcn_mfma_f32_32x32x16_bf16(kf[2],qr[1],C0,0,0,0),   P0[10],P0[11],P0[12],P0[13], pw1[0]=PKW(P0,8), pw1[1]=PKW(P0,10), pw1); \
    VRD(5); SBAR(); GAPA(C1=__builtin_amdgcn_mfma_f32_32x32x16_bf16(kf[3],qr[1],C1,0,0,0),   P0[14],P0[15],P1[0],P1[1],   pw1[2]=PKW(P0,12),pw1[3]=PKW(P0,14), pw1); \
    VRD(2); SBAR(); GAPA(C0=__builtin_amdgcn_mfma_f32_32x32x16_bf16(kf[4],qr[2],C0,0,0,0),   P1[2],P1[3],P1[4],P1[5],     pw2[0]=PKW(P1,0), pw2[1]=PKW(P1,2), pw2); \
    VRD(6); SBAR(); GAPA(C1=__builtin_amdgcn_mfma_f32_32x32x16_bf16(kf[5],qr[2],C1,0,0,0),   P1[6],P1[7],P1[8],P1[9],     pw2[2]=PKW(P1,4), pw2[3]=PKW(P1,6), pw2); \
    VRD(3); SBAR(); GAPA(C0=__builtin_amdgcn_mfma_f32_32x32x16_bf16(kf[6],qr[3],C0,0,0,0),   P1[10],P1[11],P1[12],P1[13], pw3[0]=PKW(P1,8), pw3[1]=PKW(P1,10), pw3); \
    VRD(7); SBAR(); GAPA(C1=__builtin_amdgcn_mfma_f32_32x32x16_bf16(kf[7],qr[3],C1,0,0,0),   P1[14],P1[15],0.f,0.f,       pw3[2]=PKW(P1,12),pw3[3]=PKW(P1,14), pw3); \
    l_reg+=sacc; \
    if(GK){DMA_K((t)+3,sl_cur);} if(GV){DMA_V((t)+1,sl_next);} \
    CMASK(C0,C1,t); \
    { float a=MX3(C0[0],C0[1],C1[0]),b=MX3(C0[2],C0[3],C1[1]); a=MX3(a,C1[2],C1[3]); \
      _Pragma("unroll") for(int r=4;r<16;r+=4){a=MX3(a,C0[r],C0[r+1]);b=MX3(b,C0[r+2],C0[r+3]);a=MX3(a,C1[r],C1[r+1]);b=MX3(b,C1[r+2],C1[r+3]);} \
      float rm=__builtin_fmaxf(a,b); { auto rr=__builtin_amdgcn_permlane32_swap(__float_as_uint(rm),__float_as_uint(rm),false,false); rm=__builtin_fmaxf(__uint_as_float(rr[0]),__uint_as_float(rr[1])); } \
      resc=false; \
      if(__builtin_expect(__any(rm>(float)THRL),0)){ const float dl=__builtin_fmaxf(rm,0.f); mhat+=dl; \
        _Pragma("unroll") for(int r=0;r<16;++r){C0[r]-=dl;C1[r]-=dl;} \
        _Pragma("unroll") for(int r=0;r<16;++r)negm[r]=-mhat; asm volatile("":"+v"(negm)); \
        const float f=__builtin_amdgcn_exp2f(-dl); l_reg*=f; if(hi==0)wsf[r32]=f; resc=true; } } \
    SBAR(); \
    GAPB(o[0]=__builtin_amdgcn_mfma_f32_32x32x16_bf16(PAF(0),VFR(0),o[0],0,0,0), C0,0); \
    GAPB(o[1]=__builtin_amdgcn_mfma_f32_32x32x16_bf16(PAF(0),VFR(4),o[1],0,0,0), C0,4); \
    KRD(GL,0); GAPB(o[0]=__builtin_amdgcn_mfma_f32_32x32x16_bf16(PAF(1),VFR(1),o[0],0,0,0), C0,8); \
    KRD(GL,1); GAPB(o[1]=__builtin_amdgcn_mfma_f32_32x32x16_bf16(PAF(1),VFR(5),o[1],0,0,0), C0,12); \
    KRD(GL,2); GAPB(o[0]=__builtin_amdgcn_mfma_f32_32x32x16_bf16(PAF(2),VFR(2),o[0],0,0,0), C1,0); \
    KRD(GL,3); GAPB(o[1]=__builtin_amdgcn_mfma_f32_32x32x16_bf16(PAF(2),VFR(6),o[1],0,0,0), C1,4); \
    GAPB(o[0]=__builtin_amdgcn_mfma_f32_32x32x16_bf16(PAF(3),VFR(3),o[0],0,0,0), C1,8); \
    GAPB(o[1]=__builtin_amdgcn_mfma_f32_32x32x16_bf16(PAF(3),VFR(7),o[1],0,0,0), C1,12); \
    }while(0)
  int t=1;
  for(;t+5<NT;t+=2){
    STEP(pB0,pB1,pA0,pA1,t,true,true,true);     WAIT_BAR(2); RESC(); ROT();
    STEP(pA0,pA1,pB0,pB1,t+1,true,true,true);   WAIT_BAR(2); RESC(); ROT();
  }
  #define ENDW(tt) do{ if((tt)+3<NT){WAIT_BAR(2);} else if((tt)+2<NT){WAIT_BAR(1);} else {WAIT_BAR(0);} }while(0)
  for(;t+1<NT;t+=2){
    STEP(pB0,pB1,pA0,pA1,t,(t+3<NT),(t+1<NT),(t+1<NT));       ENDW(t);   RESC(); ROT();
    STEP(pA0,pA1,pB0,pB1,t+1,(t+4<NT),(t+2<NT),(t+2<NT));     ENDW(t+1); RESC(); ROT();
  }
  STEP(pB0,pB1,pA0,pA1,NT-1,false,false,false); RESC();
  { float sacc=pB0[0]+pB0[1]; _Pragma("unroll") for(int r=2;r<16;++r)sacc+=pB0[r]; _Pragma("unroll") for(int r=0;r<16;++r)sacc+=pB1[r]; l_reg+=sacc;
    pw0=(u32x4){PKW(pB0,0),PKW(pB0,2),PKW(pB0,4),PKW(pB0,6)};pw1=(u32x4){PKW(pB0,8),PKW(pB0,10),PKW(pB0,12),PKW(pB0,14)};pw2=(u32x4){PKW(pB1,0),PKW(pB1,2),PKW(pB1,4),PKW(pB1,6)};pw3=(u32x4){PKW(pB1,8),PKW(pB1,10),PKW(pB1,12),PKW(pB1,14)};
    SBAR(); pv(o,vb0+sl_cur,PAF(0),PAF(1),PAF(2),PAF(3)); }
  #undef PKW
  #undef PAF
  #undef VFR
  #undef PIN
  #undef MX3
  #undef GAPA
  #undef GAPB
  #undef EX
  #undef VRD
  #undef KRD
  #undef STEP
  #undef ENDW
  {auto rr=__builtin_amdgcn_permlane32_swap(__float_as_uint(l_reg),__float_as_uint(l_reg),false,false);l_reg=__uint_as_float(rr[0])+__uint_as_float(rr[1]);}
  if(WIN)l_reg+=__builtin_amdgcn_exp2f(sinkl2-mhat);
  if(hi==0)wsf[32+r32]=l_reg;asm volatile("s_waitcnt lgkmcnt(0)":::"memory");
  float rli[16];
  #pragma unroll
  for(int r=0;r<16;++r)rli[r]=__builtin_amdgcn_rcpf(wsf[32+crow(r,hi)]);
  bf16*Ow=Ob+(long)(wid*QBLK)*OP;
  { bf16*stg=(bf16*)(shm+LDS_OST)+wid*2048;
    #pragma unroll
    for(int r=0;r<16;++r){const int orow=crow(r,hi);
      #pragma unroll
      for(int d0=0;d0<2;++d0)stg[orow*64+d0*32+r32]=__float2bfloat16(o[d0][r]*rli[r]);}
    asm volatile("s_waitcnt lgkmcnt(0)":::"memory");
    #pragma unroll
    for(int i=0;i<4;++i){const int row=i*8+(lane>>3),ch=lane&7; const u32x4 v=*(const u32x4*)(stg+row*64+ch*8); ATTN_STORE16(Ow+(long)row*OP+ch*8,v);} }
  asm volatile("s_waitcnt lgkmcnt(0)\n\ts_barrier":::"memory");
  #undef DMA_K
  #undef DMA_V
  #undef KROW
  #undef CMASK
  #undef START
  #undef RESC
  #undef ROT
}
constexpr int ATTN_LDS_BYTES=LDS_BYTES;
#undef SBAR
#undef WAIT_BAR
}

__device__ __forceinline__ void st_attn_mfma(const Prm& p, int L, int mode, char* shm) {
    using namespace attn_body;
    const bf16* Pm = (const bf16*)(p.ws + WS_P); bf16* YM = (bf16*)(p.ws + WS_YMIX);
    const int G = GDIM_(), bx = BIDX_(); const int vcu = (G % 8 == 0) ? (bx % 8) * (G / 8) + bx / 8 : bx;
    const int cu0 = G >= MT / 128 + 16 ? MT / 128 : 0, nmain = 512;
    int u0 = vcu, u1 = nmain, us = G; if (mode) { if (bx < cu0 || bx >= cu0 + 16) return; u0 = nmain + (bx - cu0); u1 = nmain + 16; us = 16; }
    for (int u = u0; u < u1; u += us) {
        int isw, b, hq, qrow0, ctx0, lat0, NT, qpos0 = 0, kpos0 = 0, orow0;
        if (u < 512) { const int v = u & 255, qb = v & 31; isw = u >> 8; b = v >> 7; hq = (v >> 5) & 3; qrow0 = b * SEQ + qb * 256; orow0 = qrow0; ctx0 = ML + b * CTX_LEN;
            if (!isw) { lat0 = b * SEQ; NT = 4 + SEQ / 64; }
            else { const int lt0 = 4 * qb - 2 < 0 ? 0 : 4 * qb - 2, lt1 = 4 * qb + 6 > SEQ / 64 ? SEQ / 64 : 4 * qb + 6; lat0 = b * SEQ + 64 * lt0; NT = 4 + lt1 - lt0; qpos0 = qb * 256; kpos0 = 64 * lt0; } }
        else { const int v = u - 512; isw = v >> 3; b = (v >> 2) & 1; hq = v & 3; qrow0 = ML + b * CTX_LEN; orow0 = qrow0; ctx0 = qrow0; lat0 = 0; NT = 4; }
        const int kv = hq >> 1;
        bf16* Ob = YM + (size_t)orow0 * D_MIX + (isw ? 512 : 256) + hq * 64;
        if (isw) attn_unit<8, true>(Pm, qrow0, WAQ + hq * 64, WAK + kv * 64, WAV + kv * 64, ctx0, lat0, NT, qpos0, kpos0, p.in[I_SINK][L * 4 + hq] * 1.4426950408889634f, Ob, shm);
        else attn_unit<8, false>(Pm, qrow0, GAQ + hq * 64, GAK + kv * 64, GAV + kv * 64, ctx0, lat0, NT, 0, 0, 0.f, Ob, shm);
    }
}

typedef float f32x4_t __attribute__((ext_vector_type(4)));
typedef unsigned u32x2_t __attribute__((ext_vector_type(2)));
__device__ __forceinline__ float wave_sum_(float v) {
#pragma unroll
    for (int o = 1; o < 64; o <<= 1) v += __shfl_xor(v, o);
    return v;
}
__device__ __forceinline__ int wave_id_() { const int t = TID_(); return BIDX_() * (NTHREADS_ / 64) + __builtin_amdgcn_readfirstlane(t >> 6); }
__device__ __forceinline__ int lane_id_() { unsigned m_ = ~0u; asm volatile("" : "+s"(m_)); return (int)__builtin_amdgcn_mbcnt_hi(m_, __builtin_amdgcn_mbcnt_lo(m_, 0u)); }
__device__ __forceinline__ const float* xsrc_(const Prm& p, int r, bool from_input) { return from_input ? (r < ML ? p.in[I_X] + (size_t)r * D_MODEL : p.in[I_CTX] + (size_t)(r - ML) * D_MODEL) : xrow(p, r); }
__device__ __forceinline__ void st_norm_fused(const Prm& p, int L, int which, int nrows, const float* pend) {
    const int lane = lane_id_(), NGW = GDIM_() * (NTHREADS_ / 64); act_t* xn = WSP(act_t, WS_XN);
    const float* gw = p.in[which ? I_GFFN : I_GMIX] + (size_t)L * D_MODEL;
    for (int r = wave_id_(); r < nrows; r += NGW) {
        const f32x4_t* xr = (const f32x4_t*)xsrc_(p, r, L == 0 && which == 0) + lane; const int modrow = r < ML ? r / SEQ : BATCH;
        const f32x4_t* sh = (const f32x4_t*)modp(p, L, modrow, which ? 3 : 0) + lane; const f32x4_t* sc = (const f32x4_t*)modp(p, L, modrow, which ? 4 : 1) + lane; const f32x4_t* gp = (const f32x4_t*)gw + lane;
        f32x4_t v[D_MODEL / 256]; float ss = 0.f;
#pragma unroll
        for (int j = 0; j < D_MODEL / 256; ++j) v[j] = xr[64 * j];
        if (pend && r >= ML) { const f32x4_t* sl = (const f32x4_t*)(WSP(float, WS_SLAB) + (size_t)(r - ML) * D_MODEL) + lane; const f32x4_t* pg = (const f32x4_t*)pend + lane; f32x4_t* xw = (f32x4_t*)xrow(p, r) + lane;
#pragma unroll
            for (int j = 0; j < D_MODEL / 256; ++j) { const f32x4_t t = (sl[64 * j] + sl[64 * j + (size_t)MC * D_MODEL / 4]) + (sl[64 * j + (size_t)2 * MC * D_MODEL / 4] + sl[64 * j + (size_t)3 * MC * D_MODEL / 4]); v[j] = v[j] + pg[64 * j] * t; xw[64 * j] = v[j]; } }
#pragma unroll
        for (int j = 0; j < D_MODEL / 256; ++j) ss += (v[j].x * v[j].x + v[j].y * v[j].y) + (v[j].z * v[j].z + v[j].w * v[j].w);
        const float rs = 1.0f / sqrtf(wave_sum_(ss) * (1.0f / D_MODEL) + NORM_EPS);
        u32x2_t* o8 = (u32x2_t*)(xn + (size_t)r * D_MODEL) + lane;
#pragma unroll
        for (int j = 0; j < D_MODEL / 256; ++j) { const f32x4_t g4 = gp[64 * j], s4 = sc[64 * j], h4 = sh[64 * j]; const f32x4_t y = v[j] * rs * g4 * (s4 + 1.0f) + h4;
            u32x2_t w; w.x = pk2(y.x, y.y); w.y = pk2(y.z, y.w); o8[64 * j] = w; }
    }
}
__device__ __forceinline__ void st_final_fused(const Prm& p) {
    const int lane = lane_id_(), NGW = GDIM_() * (NTHREADS_ / 64); const f32x4_t* gp = (const f32x4_t*)p.in[I_GFIN] + lane;
    for (int r = wave_id_(); r < ML; r += NGW) { f32x4_t* xr = (f32x4_t*)(p.out + (size_t)r * D_MODEL) + lane; f32x4_t v[D_MODEL / 256]; float ss = 0.f;
#pragma unroll
        for (int j = 0; j < D_MODEL / 256; ++j) { v[j] = xr[64 * j]; ss += (v[j].x * v[j].x + v[j].y * v[j].y) + (v[j].z * v[j].z + v[j].w * v[j].w); }
        const float rs = 1.0f / sqrtf(wave_sum_(ss) * (1.0f / D_MODEL) + NORM_EPS);
#pragma unroll
        for (int j = 0; j < D_MODEL / 256; ++j) xr[64 * j] = v[j] * rs * gp[64 * j]; }
}
__device__ __forceinline__ void unpack4_(const u32x2_t v, float* o) { o[0] = __uint_as_float(v.x << 16); o[1] = __uint_as_float(v.x & 0xffff0000u); o[2] = __uint_as_float(v.y << 16); o[3] = __uint_as_float(v.y & 0xffff0000u); }
__device__ __forceinline__ void st_ssd_out_w(const Prm& p, int L, int nrows) {
    const int lane = lane_id_(), NGW = GDIM_() * (NTHREADS_ / 64); const act_t* P = WSP(act_t, WS_P); act_t* ym = WSP(act_t, WS_YMIX);
    const f32x4_t g4 = *((const f32x4_t*)(p.in[I_SNG] + L * 256) + lane);
    for (int r = wave_id_(); r < nrows; r += NGW) { float y[4], z[4];
        unpack4_(*((const u32x2_t*)(P + (size_t)r * PLD + YSSD_OFF) + lane), y); unpack4_(*((const u32x2_t*)(P + (size_t)r * PLD + Z_OFF) + lane), z);
        float v[4], ss = 0.f;
#pragma unroll
        for (int e = 0; e < 4; ++e) { v[e] = y[e] * z[e] / (1.f + __expf(-z[e])); ss += v[e] * v[e]; }
        const float rn = 1.0f / sqrtf(wave_sum_(ss) * (1.f / 256.f) + NORM_EPS);
        u32x2_t w; w.x = pk2(v[0] * rn * g4.x, v[1] * rn * g4.y); w.y = pk2(v[2] * rn * g4.z, v[3] * rn * g4.w);
        *((u32x2_t*)(ym + (size_t)r * D_MIX) + lane) = w; }
}
__device__ __forceinline__ void st_ssd_cs_w(const Prm& p, int L) {
    const int lane = lane_id_(), NGW = GDIM_() * (NTHREADS_ / 64); const act_t* P = WSP(act_t, WS_P); float* DT = WSP(float, WS_DT); float* CS = WSP(float, WS_CS);
    for (int it = wave_id_(); it < NCH * 8; it += NGW) { const int dh = it & 7, c = it >> 3, d = dh >> 2;
        const float a = -expf(p.in[I_SALOG][L * 8 + dh]), bias = p.in[I_SDTB][L * 8 + dh];
        const size_t r0 = (size_t)c * 128 + lane, r1 = r0 + 64;
        const float* dtr = WSP(float, WS_DTRAW); const float dt0 = softplusf_(dtr[r0 * 8 + dh] + bias), dt1 = softplusf_(dtr[r1 * 8 + dh] + bias);
        float s0 = dt0 * a, s1 = dt1 * a; const float a0 = s0, a1 = s1;
#pragma unroll
        for (int o = 1; o < 64; o <<= 1) { const float t0 = __shfl_up(s0, o), t1 = __shfl_up(s1, o); if (lane >= o) { s0 += t0; s1 += t1; } }
        const float tot0 = __shfl(s0, 63); s1 += tot0; const float tot = __shfl(s1, 63);
        DT[r0 * 8 + dh] = dt0; DT[r1 * 8 + dh] = dt1;
        CS[r0 * 8 + dh] = d ? tot - s0 + a0 : s0; CS[r1 * 8 + dh] = d ? tot - s1 + a1 : s1; }
}
__device__ __forceinline__ void st_s5tabB_v(const Prm& p, int layer, int g0, int gs) {
    typedef float f32x2_t __attribute__((ext_vector_type(2)));
    const float* lamp = WSP(float, WS_LAMP) + (size_t)layer * 2 * 16 * 64 * 17 * 2; const float* bbar = WSP(float, WS_BBAR) + (size_t)layer * 2 * 16 * 64 * 16 * 2; const float* kt = WSP(float, WS_KT) + (size_t)layer * 2 * 16 * 16 * 256;
    act_t* BY = WSP(act_t, WS_S5BY); act_t* BE = WSP(act_t, WS_S5BE);
    constexpr int NBY = 16 * 256 * 512 / 8, NBE = 16 * 256 * 256 / 8;
    for (int it = g0; it < NBY + NBE; it += gs) { float v[8]; act_t* dst;
        if (it < NBY) { const int idx = it * 8, q = idx & 511, ik = (idx >> 9) & 255, g = idx >> 17, i = ik >> 4, k = ik & 15; dst = BY + idx;
            if (q < 256) { const int j = q >> 4, kp0 = q & 15;
                if (j != i) { const float* s0 = kt + ((j < i ? g * 16 + (i - j) : (16 + g) * 16 + (j - i)) * 16 + k) * 16 + kp0; const f32x4_t a = *(const f32x4_t*)s0, b = *(const f32x4_t*)(s0 + 4);
#pragma unroll
                    for (int e = 0; e < 4; ++e) { v[e] = a[e]; v[4 + e] = b[e]; } }
                else { const float* s0 = kt + ((g * 16) * 16 + k) * 16 + kp0; const float* s1 = kt + (((16 + g) * 16) * 16 + k) * 16 + kp0; const float dsk = p.in[I_S5D][layer * 256 + g * 16 + k];
                    const f32x4_t a0 = *(const f32x4_t*)s0, b0 = *(const f32x4_t*)(s0 + 4), a1 = *(const f32x4_t*)s1, b1 = *(const f32x4_t*)(s1 + 4);
#pragma unroll
                    for (int e = 0; e < 4; ++e) { v[e] = a0[e] + a1[e] + (k == kp0 + e ? dsk : 0.f); v[4 + e] = b0[e] + b1[e] + (k == kp0 + 4 + e ? dsk : 0.f); } } }
            else { const int dd = (q - 256) >> 7, n0 = ((q - 256) & 127) >> 1, pw = dd ? 16 - i : i + 1; const int dg = (layer * 2 + dd) * 16 + g, dgn = (dd * 16 + g) * 64 + n0;
                const f32x4_t cr = *(const f32x4_t*)(p.in[I_CRE] + (dg * 16 + k) * 64 + n0), ci = *(const f32x4_t*)(p.in[I_CIM] + (dg * 16 + k) * 64 + n0);
#pragma unroll
                for (int m = 0; m < 4; ++m) { const f32x2_t l = *(const f32x2_t*)(lamp + ((dgn + m) * 17 + pw) * 2); v[2 * m] = cr[m] * l.x - ci[m] * l.y; v[2 * m + 1] = -(cr[m] * l.y + ci[m] * l.x); } } }
        else { const int idx = (it - NBY) * 8, q = idx & 255, rr = (idx >> 8) & 255, g = idx >> 16, dd = rr >> 7, n = (rr & 127) >> 1, c = rr & 1, j = q >> 4, kp0 = q & 15, pw = dd ? j : 15 - j; dst = BE + idx;
            const int dgn = (dd * 16 + g) * 64 + n; const f32x2_t l = *(const f32x2_t*)(lamp + (dgn * 17 + pw) * 2); const float* bs = bbar + (dgn * 16 + kp0) * 2;
#pragma unroll
            for (int h = 0; h < 4; ++h) { const f32x4_t bb = *(const f32x4_t*)(bs + 4 * h);
                v[2 * h] = c ? (l.x * bb[1] + l.y * bb[0]) : (l.x * bb[0] - l.y * bb[1]); v[2 * h + 1] = c ? (l.x * bb[3] + l.y * bb[2]) : (l.x * bb[2] - l.y * bb[3]); } }
        v4u o; o.x = pk2(v[0], v[1]); o.y = pk2(v[2], v[3]); o.z = pk2(v[4], v[5]); o.w = pk2(v[6], v[7]); *(v4u*)dst = o; }
}
__device__ __forceinline__ void st_s5tab2_lds(const Prm& p, LAS unsigned char* lds) {
    typedef float f32x2_t __attribute__((ext_vector_type(2)));
    const float* lamp = WSP(float, WS_LAMP); const float* bbar = WSP(float, WS_BBAR); float* kt = WSP(float, WS_KT); const int tid = TID_();
    LAS float* CR = (LAS float*)lds; LAS float* CI = CR + 1024; LAS f32x2_t* LM = (LAS f32x2_t*)(CI + 1024); LAS f32x2_t* BB = LM + 256;
    for (int u = BIDX_(); u < DEPTH * 2 * 16 * 4; u += GDIM_()) { const int ldg = u >> 2, tq = u & 3;
#pragma unroll
        for (int i = 0; i < 2; ++i) { const int q = tid + 512 * i; CR[q] = p.in[I_CRE][ldg * 1024 + q]; CI[q] = p.in[I_CIM][ldg * 1024 + q]; BB[q] = *(const f32x2_t*)(bbar + (size_t)(ldg * 1024 + q) * 2); }
        if (tid < 256) { const int n = tid >> 2, tl = tid & 3; LM[tid] = *(const f32x2_t*)(lamp + (size_t)((ldg * 64 + n) * 17 + 4 * tq + tl) * 2); }
        __syncthreads();
#pragma unroll
        for (int i = 0; i < 2; ++i) { const int o = tid + 512 * i, tl = o >> 8, k = (o >> 4) & 15, kp = o & 15; float acc = 0.f;
#pragma unroll 8
            for (int n = 0; n < 64; ++n) { const float cr = CR[k * 64 + n], ci = CI[k * 64 + n]; const f32x2_t lm = LM[n * 4 + tl], bb = BB[n * 16 + kp];
                const float tr = lm.x * bb.x - lm.y * bb.y, ti = lm.x * bb.y + lm.y * bb.x; acc += cr * tr - ci * ti; }
            kt[(size_t)(ldg * 16 + 4 * tq + tl) * 256 + k * 16 + kp] = acc; }
        __syncthreads(); }
}
__device__ __forceinline__ void st_mod_atomic(const Prm& p, LAS unsigned char* lds) {
    const int tid = TID_(), lane = tid & 63, wave = __builtin_amdgcn_readfirstlane(tid >> 6); LAS float* sl = (LAS float*)lds;
    LAS f32x4_t* red = (LAS f32x4_t*)(lds + 16384);
    for (int i = tid; i < (BATCH + 1) * D_MODEL; i += NTHREADS_) { const float cv = i < BATCH * D_MODEL ? p.in[I_C][i] : p.in[I_CCTX][i - BATCH * D_MODEL]; sl[i] = cv / (1.f + __expf(-cv)); }
    __syncthreads();
    float* mod = WSP(float, WS_MOD); constexpr int NJ4 = 6 * D_MODEL / 4, KC = 32, NJB = NJ4 / 64, NKG = D_MODEL / (8 * KC); static_assert(NJ4 % 64 == 0 && D_MODEL % (8 * KC) == 0 && BATCH == 2, "modulation units");
    for (int u = BIDX_(); u < DEPTH * NJB * NKG; u += GDIM_()) { const int l = u / (NJB * NKG), jb = u % NJB, kg = (u / NJB) % NKG, j4 = jb * 64 + lane, k0 = (kg * 8 + wave) * KC;
        const f32x4_t* w = (const f32x4_t*)(p.in[I_WMOD] + (size_t)l * D_MODEL * 6 * D_MODEL) + j4; f32x4_t acc[BATCH + 1];
#pragma unroll
        for (int m = 0; m <= BATCH; ++m) acc[m] = (f32x4_t){0.f, 0.f, 0.f, 0.f};
#pragma unroll
        for (int k = 0; k < KC; ++k) { const f32x4_t wv = w[(size_t)(k0 + k) * NJ4];
#pragma unroll
            for (int m = 0; m <= BATCH; ++m) acc[m] += sl[m * D_MODEL + k0 + k] * wv; }
        if (kg == 0 && wave == 0) { const f32x4_t bv = *((const f32x4_t*)(p.in[I_BMOD] + (size_t)l * 6 * D_MODEL) + j4);
#pragma unroll
            for (int m = 0; m <= BATCH; ++m) acc[m] += bv; }
#pragma unroll
        for (int m = 0; m <= BATCH; ++m) red[(wave * (BATCH + 1) + m) * 64 + lane] = acc[m];
        __syncthreads();
        if (tid < (BATCH + 1) * 64) { const int m = tid >> 6; f32x4_t sum = red[m * 64 + lane];
#pragma unroll
            for (int wv = 1; wv < 8; ++wv) sum += red[(wv * (BATCH + 1) + m) * 64 + lane];
            float* o = mod + ((size_t)(l * (BATCH + 1) + m) * 6 * D_MODEL) + 4 * j4;
#pragma unroll
            for (int e = 0; e < 4; ++e) (void)__hip_atomic_fetch_add(o + e, sum[e], __ATOMIC_RELAXED, __HIP_MEMORY_SCOPE_AGENT); }
        __syncthreads(); }
}
__device__ __forceinline__ void st_ssd_carry_b(const Prm& p, int g0, int gs) {
    float* sst = WSP(float, WS_SST); const float* CS = WSP(float, WS_CS);
    constexpr int NJ = (CTX_LEN + SEQ) / 128, BL = 11; static_assert(NJ % BL == 0, "carry block");
    for (int i = g0; i < BATCH * 2 * 4 * 64 * 128; i += gs) { const int e = i % 8192, h = (i / 8192) % 4, d = (i / 32768) % 2, b = i / 65536, dh = d * 4 + h; float hst = 0.f;
#pragma clang loop unroll(disable)
        for (int j0 = 0; j0 < NJ; j0 += BL) { float tmp[BL], dec[BL]; int so[BL];
#pragma unroll
            for (int u = 0; u < BL; ++u) { const int c = ssd_chunk_of(b, d, j0 + u); so[u] = ((c * 2 + d) * 4 + h) * 8192 + e; tmp[u] = sst[so[u]]; dec[u] = CS[(c * 128 + (d ? 0 : 127)) * 8 + dh]; }
#pragma unroll
            for (int u = 0; u < BL; ++u) { sst[so[u]] = hst; hst = hst * __expf(dec[u]) + tmp[u]; } } }
}
__device__ __forceinline__ void st_s5_carry_b(const Prm& p, int L, LAS unsigned char* lds) {
    typedef float f32x2_t __attribute__((ext_vector_type(2)));
    const int tid = TID_();
    const float* lamp = WSP(float, WS_LAMP) + (size_t)L * 2 * 16 * 64 * 17 * 2; const float* E = WSP(float, WS_S5E); act_t* A = WSP(act_t, WS_S5A);
    constexpr int NJ = (CTX_LEN + SEQ) / 16, NSEG = 16, SL = NJ / NSEG, BL = 11, NPW = NTHREADS_ / NSEG; static_assert(NJ % NSEG == 0 && SL % BL == 0 && 64 % NPW == 0, "carry segments");
    LAS f32x2_t* T = (LAS f32x2_t*)lds;
    const int nl = tid % NPW, seg = tid / NPW;
    for (int u = BIDX_(); u < BATCH * 2 * 16 * (64 / NPW); u += GDIM_()) { const int nh = u % (64 / NPW), g = (u / (64 / NPW)) & 15, d = (u / (64 / NPW) >> 4) & 1, b = u / (64 / NPW) >> 5, n = nh * NPW + nl; const int dgn = (d * 16 + g) * 64 + n;
        const float lr = lamp[(dgn * 17 + 16) * 2], li = lamp[(dgn * 17 + 16) * 2 + 1];
        const float* Eb = E + (size_t)g * NSC * 256 + d * 128 + 2 * n; act_t* Ab = A + (size_t)g * S5R * 512 + 256 + d * 128 + 2 * n;
        float hr = 0.f, hi = 0.f;
#pragma clang loop unroll(disable)
        for (int j0 = seg * SL; j0 < (seg + 1) * SL; j0 += BL) { f32x2_t t[BL];
#pragma unroll
            for (int q = 0; q < BL; ++q) t[q] = *(const f32x2_t*)(Eb + s5_sc_of(b, d, j0 + q) * 256);
#pragma unroll
            for (int q = 0; q < BL; ++q) { const float nr = lr * hr - li * hi + t[q].x, ni = lr * hi + li * hr + t[q].y; hr = nr; hi = ni; } }
        T[seg * NPW + nl] = (f32x2_t){hr, hi};
        float pr = 1.f, pi = 0.f;
        for (int q = 0; q < SL; ++q) { const float nr = pr * lr - pi * li, ni = pr * li + pi * lr; pr = nr; pi = ni; }
        __syncthreads();
        hr = 0.f; hi = 0.f;
        for (int sg = 0; sg < seg; ++sg) { const f32x2_t tt = T[sg * NPW + nl]; const float nr = pr * hr - pi * hi + tt.x, ni = pr * hi + pi * hr + tt.y; hr = nr; hi = ni; }
#pragma clang loop unroll(disable)
        for (int j0 = seg * SL; j0 < (seg + 1) * SL; j0 += BL) { f32x2_t t[BL]; int scs[BL];
#pragma unroll
            for (int q = 0; q < BL; ++q) { scs[q] = s5_sc_of(b, d, j0 + q); t[q] = *(const f32x2_t*)(Eb + scs[q] * 256); }
#pragma unroll
            for (int q = 0; q < BL; ++q) { *(unsigned*)(Ab + scs[q] * 512) = pk2(hr, hi); const float nr = lr * hr - li * hi + t[q].x, ni = lr * hi + li * hr + t[q].y; hr = nr; hi = ni; } }
        __syncthreads(); }
}

namespace ssdm {
typedef short bf16x8 __attribute__((ext_vector_type(8)));
typedef float f32x4 __attribute__((ext_vector_type(4)));
typedef unsigned u32x4 __attribute__((ext_vector_type(4)));
typedef unsigned u32x2 __attribute__((ext_vector_type(2)));
constexpr int RS = 136;
constexpr int L_CM = 0, L_BM = 128 * RS * 2, L_X = 2 * 128 * RS * 2, L_H = L_X + 64 * RS * 2, L_F = L_H + 64 * RS * 2, L_H2 = L_F + 2 * 4 * 128 * 4, L_END = L_H2 + 64 * RS * 2;
static_assert(L_END <= 131072, "SSD LDS map");
#define SSD_MFMA(a, b, c) __builtin_amdgcn_mfma_f32_16x16x32_bf16(a, b, c, 0, 0, 0)
__device__ __forceinline__ bf16x8 frag(const LAS unsigned short* base, int row, int k0, int quad) { return *(const LAS bf16x8*)(base + row * RS + k0 + 8 * quad); }
__device__ __forceinline__ unsigned cvtpk_(float lo, float hi) { typedef float f2_ __attribute__((ext_vector_type(2))); typedef __bf16 b2_ __attribute__((ext_vector_type(2))); f2_ v = {lo, hi}; return __builtin_bit_cast(unsigned, __builtin_convertvector(v, b2_)); }
__device__ __forceinline__ void lds_fence() { asm volatile("s_waitcnt lgkmcnt(0)" ::: "memory"); }
__device__ __forceinline__ void stage_dtcs(const Prm& p, LAS float* F, size_t r0, int g, int tid) {
    const int combo = tid >> 7, l = tid & 127, dh = (combo >> 1) * 4 + 2 * g + (combo & 1);
    F[tid] = WSP(float, WS_DT)[(r0 + l) * 8 + dh]; F[512 + tid] = WSP(float, WS_CS)[(r0 + l) * 8 + dh];
}
__device__ __forceinline__ void ssd_states_unit(const Prm& p, LAS unsigned char* lds, int c, int g, int tid) {
    const int lane = tid & 63, wave = __builtin_amdgcn_readfirstlane(tid >> 6), quad = lane >> 4, l15 = lane & 15;
    const act_t* xbc = WSP(act_t, WS_XBC); float* sst = WSP(float, WS_SST); const int r0 = c * 128;
    LAS unsigned short* BT = (LAS unsigned short*)(lds + L_BM); LAS unsigned short* XT0 = (LAS unsigned short*)(lds + L_X); LAS unsigned short* XT1 = (LAS unsigned short*)(lds + L_H); LAS float* F = (LAS float*)(lds + L_F);
#pragma unroll
    for (int i = 0; i < 4; ++i) { const int q = tid + 512 * i, l = q >> 4, n0 = (q & 15) * 8; const u32x4 v = *(const u32x4*)(xbc + (r0 + l) * 768 + 256 + g * 128 + n0);
#pragma unroll
        for (int e = 0; e < 4; ++e) { BT[(n0 + 2 * e) * RS + l] = (unsigned short)(v[e] & 0xffffu); BT[(n0 + 2 * e + 1) * RS + l] = (unsigned short)(v[e] >> 16); } }
#pragma unroll
    for (int hh = 0; hh < 2; ++hh) { LAS unsigned short* XT = hh ? XT1 : XT0;
#pragma unroll
        for (int i = 0; i < 2; ++i) { const int q = tid + 512 * i, l = q >> 3, p0 = (q & 7) * 8; const u32x4 v = *(const u32x4*)(xbc + (r0 + l) * 768 + (2 * g + hh) * 64 + p0);
#pragma unroll
            for (int e = 0; e < 4; ++e) { XT[(p0 + 2 * e) * RS + l] = (unsigned short)(v[e] & 0xffffu); XT[(p0 + 2 * e + 1) * RS + l] = (unsigned short)(v[e] >> 16); } } }
    { const int combo = tid >> 7, l = tid & 127, d = combo >> 1, dh = d * 4 + 2 * g + (combo & 1); const float* DTg = WSP(float, WS_DT); const float* CSg = WSP(float, WS_CS);
      F[tid] = DTg[(r0 + l) * 8 + dh] * __expf(CSg[(r0 + (d ? 0 : 127)) * 8 + dh] - CSg[(r0 + l) * 8 + dh]); }
    __syncthreads();
    const int rt = wave & 3, cb0 = 4 * (wave >> 2);
#pragma clang loop unroll(disable)
    for (int combo = 0; combo < 4; ++combo) { const int d = combo >> 1, h = 2 * g + (combo & 1); const LAS unsigned short* XT = (combo & 1) ? XT1 : XT0; f32x4 acc[4];
#pragma unroll
        for (int j = 0; j < 4; ++j) acc[j] = (f32x4){0.f, 0.f, 0.f, 0.f};
#pragma unroll
        for (int ks = 0; ks < 4; ++ks) { const bf16x8 ar = frag(XT, 16 * rt + l15, 32 * ks, quad);
            const f32x4 w0 = *(const LAS f32x4*)(F + combo * 128 + 32 * ks + 8 * quad), w1 = *(const LAS f32x4*)(F + combo * 128 + 32 * ks + 8 * quad + 4);
            const u32x4 au = __builtin_bit_cast(u32x4, ar); u32x4 sc;
            sc[0] = cvtpk_(__uint_as_float(au[0] << 16) * w0[0], __uint_as_float(au[0] & 0xffff0000u) * w0[1]); sc[1] = cvtpk_(__uint_as_float(au[1] << 16) * w0[2], __uint_as_float(au[1] & 0xffff0000u) * w0[3]);
            sc[2] = cvtpk_(__uint_as_float(au[2] << 16) * w1[0], __uint_as_float(au[2] & 0xffff0000u) * w1[1]); sc[3] = cvtpk_(__uint_as_float(au[3] << 16) * w1[2], __uint_as_float(au[3] & 0xffff0000u) * w1[3]);
            const bf16x8 a = __builtin_bit_cast(bf16x8, sc);
#pragma unroll
            for (int j = 0; j < 4; ++j) acc[j] = SSD_MFMA(a, frag(BT, 16 * (cb0 + j) + l15, 32 * ks, quad), acc[j]); }
        float* o = sst + ((c * 2 + d) * 4 + h) * 8192;
#pragma unroll
        for (int j = 0; j < 4; ++j)
#pragma unroll
            for (int e = 0; e < 4; ++e) o[(16 * rt + 4 * quad + e) * 128 + 16 * (cb0 + j) + l15] = acc[j][e]; }
    __syncthreads();
}
__device__ __forceinline__ void ssd_y_unit(const Prm& p, int L, LAS unsigned char* lds, int c, int g, int tid) {
    const int lane = tid & 63, wave = __builtin_amdgcn_readfirstlane(tid >> 6), quad = lane >> 4, l15 = lane & 15;
    const act_t* xbc = WSP(act_t, WS_XBC); const float* sst = WSP(float, WS_SST); act_t* P = WSP(act_t, WS_P); const int r0 = c * 128;
    LAS unsigned short* CM = (LAS unsigned short*)(lds + L_CM); LAS unsigned short* BM = (LAS unsigned short*)(lds + L_BM); LAS unsigned short* XT = (LAS unsigned short*)(lds + L_X); LAS unsigned short* HN = (LAS unsigned short*)(lds + L_H); LAS float* F = (LAS float*)(lds + L_F);
    const int lrow = 16 * wave + l15, wks = wave >> 1;
#pragma unroll
    for (int i = 0; i < 4; ++i) { const int q = tid + 512 * i, l = q >> 4, n0 = (q & 15) * 8;
        *(LAS u32x4*)(CM + l * RS + n0) = *(const u32x4*)(xbc + (r0 + l) * 768 + 512 + g * 128 + n0); *(LAS u32x4*)(BM + l * RS + n0) = *(const u32x4*)(xbc + (r0 + l) * 768 + 256 + g * 128 + n0); }
    stage_dtcs(p, F, r0, g, tid);
    u32x4 xr[2][2]; u32x2 xsk[2][4]; f32x4 ph[2][4];
#pragma unroll
    for (int hh = 0; hh < 2; ++hh) {
#pragma unroll
        for (int i = 0; i < 2; ++i) { const int q = tid + 512 * i; xr[hh][i] = *(const u32x4*)(xbc + (r0 + (q >> 3)) * 768 + (2 * g + hh) * 64 + (q & 7) * 8); }
#pragma unroll
        for (int j = 0; j < 4; ++j) xsk[hh][j] = *(const u32x2*)(xbc + (r0 + lrow) * 768 + (2 * g + hh) * 64 + 16 * j + 4 * quad); }
#define SSD_LOADH2(hh_) do { _Pragma("unroll") for (int d_ = 0; d_ < 2; ++d_) { const float* hin_ = sst + ((c * 2 + d_) * 4 + 2 * g + (hh_)) * 8192; \
        _Pragma("unroll") for (int i = 0; i < 4; ++i) { const int q = tid + 512 * i; ph[d_][i] = *(const f32x4*)(hin_ + (q >> 5) * 128 + (q & 31) * 4); } } } while (0)
    SSD_LOADH2(0);
    __syncthreads();
    f32x4 cb[8]; bf16x8 bc[4];
#pragma unroll
    for (int j = 0; j < 8; ++j) cb[j] = (f32x4){0.f, 0.f, 0.f, 0.f};
#pragma unroll
    for (int ks = 0; ks < 4; ++ks) { bc[ks] = frag(CM, lrow, 32 * ks, quad);
#pragma unroll
        for (int j = 0; j < 8; ++j) cb[j] = SSD_MFMA(frag(BM, 16 * j + l15, 32 * ks, quad), bc[ks], cb[j]); }
    __syncthreads();
    LAS unsigned short* HN1 = (LAS unsigned short*)(lds + L_H2);
#pragma unroll
    for (int hh = 0; hh < 2; ++hh) { const int h = 2 * g + hh;
        const LAS float* dt0 = F + hh * 128; const LAS float* cs0 = F + 512 + hh * 128; const LAS float* dt1 = F + (2 + hh) * 128; const LAS float* cs1 = F + 512 + (2 + hh) * 128;
#pragma unroll
        for (int i = 0; i < 2; ++i) { const int q = tid + 512 * i, l = q >> 3, p0 = (q & 7) * 8; const u32x4 v = xr[hh][i];
#pragma unroll
            for (int e = 0; e < 4; ++e) { XT[(p0 + 2 * e) * RS + l] = (unsigned short)(v[e] & 0xffffu); XT[(p0 + 2 * e + 1) * RS + l] = (unsigned short)(v[e] >> 16); } }
#pragma unroll
        for (int i = 0; i < 4; ++i) { const int q = tid + 512 * i, pp = q >> 5, n0 = (q & 31) * 4; u32x2 w0, w1; w0.x = cvtpk_(ph[0][i][0], ph[0][i][1]); w0.y = cvtpk_(ph[0][i][2], ph[0][i][3]); w1.x = cvtpk_(ph[1][i][0], ph[1][i][1]); w1.y = cvtpk_(ph[1][i][2], ph[1][i][3]);
            *(LAS u32x2*)(HN + pp * RS + n0) = w0; *(LAS u32x2*)(HN1 + pp * RS + n0) = w1; }
        if (hh == 0) SSD_LOADH2(1);
        const float c0l = cs0[lrow], c1l = cs1[lrow];
#pragma unroll
        for (int j = 0; j < 8; ++j) { float m4[4]; const int s0i = 16 * j + 4 * quad;
            if (j < wave) { const f32x4 cs4 = *(const LAS f32x4*)(cs0 + s0i), dt4 = *(const LAS f32x4*)(dt0 + s0i);
#pragma unroll
                for (int e = 0; e < 4; ++e) m4[e] = cb[j][e] * dt4[e] * __expf(fminf(c0l - cs4[e], 0.f)); }
            else if (j > wave) { const f32x4 cs4 = *(const LAS f32x4*)(cs1 + s0i), dt4 = *(const LAS f32x4*)(dt1 + s0i);
#pragma unroll
                for (int e = 0; e < 4; ++e) m4[e] = cb[j][e] * dt4[e] * __expf(fminf(c1l - cs4[e], 0.f)); }
            else { const f32x4 ca4 = *(const LAS f32x4*)(cs0 + s0i), da4 = *(const LAS f32x4*)(dt0 + s0i), cb4 = *(const LAS f32x4*)(cs1 + s0i), db4 = *(const LAS f32x4*)(dt1 + s0i);
#pragma unroll
                for (int e = 0; e < 4; ++e) { const int sidx = s0i + e; const float t0 = sidx <= lrow ? da4[e] * __expf(fminf(c0l - ca4[e], 0.f)) : 0.f, t1 = sidx >= lrow ? db4[e] * __expf(fminf(c1l - cb4[e], 0.f)) : 0.f; m4[e] = cb[j][e] * (t0 + t1); } }
            u32x2 w; w.x = cvtpk_(m4[0], m4[1]); w.y = cvtpk_(m4[2], m4[3]); *(LAS u32x2*)(BM + lrow * RS + s0i) = w; }
        __syncthreads();
        f32x4 dg[4], o0[4], o1[4];
#pragma unroll
        for (int j = 0; j < 4; ++j) { dg[j] = (f32x4){0.f, 0.f, 0.f, 0.f}; o0[j] = dg[j]; o1[j] = dg[j]; }
#pragma unroll
        for (int ks = 0; ks < 4; ++ks) { const bf16x8 bm_ = frag(BM, lrow, 32 * ks, quad);
#pragma unroll
            for (int j = 0; j < 4; ++j) { dg[j] = SSD_MFMA(frag(XT, 16 * j + l15, 32 * ks, quad), bm_, dg[j]); o0[j] = SSD_MFMA(frag(HN, 16 * j + l15, 32 * ks, quad), bc[ks], o0[j]); o1[j] = SSD_MFMA(frag(HN1, 16 * j + l15, 32 * ks, quad), bc[ks], o1[j]); } }
        const float sc0 = __expf(c0l), sc1 = __expf(c1l), dsk = p.in[I_SD][L * 4 + h];
        __syncthreads();
#pragma unroll
        for (int j = 0; j < 4; ++j) { const int r = r0 + lrow; const int hp = h * 64 + 16 * j + 4 * quad; float xv[4]; const u32x2 xr_ = xsk[hh][j]; const f32x4 yv = dg[j] + sc0 * o0[j] + sc1 * o1[j];
            xv[0] = __uint_as_float(xr_.x << 16); xv[1] = __uint_as_float(xr_.x & 0xffff0000u); xv[2] = __uint_as_float(xr_.y << 16); xv[3] = __uint_as_float(xr_.y & 0xffff0000u);
            u32x2 w; w.x = cvtpk_(yv[0] + dsk * xv[0], yv[1] + dsk * xv[1]); w.y = cvtpk_(yv[2] + dsk * xv[2], yv[3] + dsk * xv[3]);
            *(u32x2*)(P + r * PLD + YSSD_OFF + hp) = w; } }
#undef SSD_LOADH2
}
__device__ __forceinline__ void ssd_y_chunk(const Prm& p, int L, LAS unsigned char* lds, int c, int tid) {
#pragma clang loop unroll(disable)
    for (int g_ = 0; g_ < 2; ++g_) { int g = g_, t2 = tid; asm volatile("" : "+s"(g), "+v"(t2)); ssd_y_unit(p, L, lds, c, g, t2); }
    const int lane = tid & 63, wave = __builtin_amdgcn_readfirstlane(tid >> 6), quad = lane >> 4, l15 = lane & 15; const int r = c * 128 + 16 * wave + l15;
    const act_t* P = WSP(act_t, WS_P); act_t* ym = WSP(act_t, WS_YMIX); const float* ng = p.in[I_SNG] + L * 256; float ss = 0.f;
    u32x2 zq[4][4], yq[4][4];
#pragma unroll
    for (int h = 0; h < 4; ++h)
#pragma unroll
        for (int j = 0; j < 4; ++j) { const int hp = h * 64 + 16 * j + 4 * quad; zq[h][j] = *(const u32x2*)(P + r * PLD + Z_OFF + hp); if (h < 2) yq[h][j] = *(const u32x2*)(P + r * PLD + YSSD_OFF + hp); }
    asm volatile("s_waitcnt vmcnt(0)" ::: "memory");
#pragma unroll
    for (int h = 2; h < 4; ++h)
#pragma unroll
        for (int j = 0; j < 4; ++j) yq[h][j] = *(const u32x2*)(P + r * PLD + YSSD_OFF + h * 64 + 16 * j + 4 * quad);
#pragma unroll
    for (int h = 0; h < 4; ++h)
#pragma unroll
        for (int j = 0; j < 4; ++j) { const u32x2 zr = zq[h][j], yr = yq[h][j]; float z[4], y[4];
            z[0] = __uint_as_float(zr.x << 16); z[1] = __uint_as_float(zr.x & 0xffff0000u); z[2] = __uint_as_float(zr.y << 16); z[3] = __uint_as_float(zr.y & 0xffff0000u);
            y[0] = __uint_as_float(yr.x << 16); y[1] = __uint_as_float(yr.x & 0xffff0000u); y[2] = __uint_as_float(yr.y << 16); y[3] = __uint_as_float(yr.y & 0xffff0000u);
#pragma unroll
            for (int e = 0; e < 4; ++e) { const float v = y[e] * z[e] * __builtin_amdgcn_rcpf(1.f + __expf(-z[e])); ss += v * v; } }
    ss += __shfl_xor(ss, 16); ss += __shfl_xor(ss, 32);
    const float rn = 1.0f / sqrtf(ss * (1.f / 256.f) + NORM_EPS);
#pragma unroll
    for (int h = 0; h < 4; ++h)
#pragma unroll
        for (int j = 0; j < 4; ++j) { const int hp = h * 64 + 16 * j + 4 * quad; const f32x4 g4 = *(const f32x4*)(ng + hp); const u32x2 zr = zq[h][j], yr = yq[h][j]; float z[4], y[4], o[4];
            z[0] = __uint_as_float(zr.x << 16); z[1] = __uint_as_float(zr.x & 0xffff0000u); z[2] = __uint_as_float(zr.y << 16); z[3] = __uint_as_float(zr.y & 0xffff0000u);
            y[0] = __uint_as_float(yr.x << 16); y[1] = __uint_as_float(yr.x & 0xffff0000u); y[2] = __uint_as_float(yr.y << 16); y[3] = __uint_as_float(yr.y & 0xffff0000u);
#pragma unroll
            for (int e = 0; e < 4; ++e) o[e] = y[e] * z[e] * __builtin_amdgcn_rcpf(1.f + __expf(-z[e])) * rn * g4[e];
            u32x2 w; w.x = pk2(o[0], o[1]); w.y = pk2(o[2], o[3]); *(u32x2*)(ym + r * D_MIX + hp) = w; }
}
#undef SSD_MFMA
}
__device__ __forceinline__ void st_ssd_states_m(const Prm& p, LAS unsigned char* lds) {
    const int t = TID_(); const int G = GDIM_(), bx = BIDX_();
    const int nps = G >= 160 ? G - 16 * (S5R / 256) : G;
    if (bx < nps) for (int u = bx; u < NCH * 2; u += nps) ssdm::ssd_states_unit(p, lds, u >> 1, u & 1, TID_());
}
__device__ __forceinline__ void st_ssd_y_m(const Prm& p, int L, int nrows, LAS unsigned char* lds) {
    const int t = TID_(); const int G = GDIM_(), bx = BIDX_();
    (void)t; for (int u = bx; u < nrows / 128; u += G) ssdm::ssd_y_chunk(p, L, lds, u, TID_());
}

typedef unsigned u32x4v_t __attribute__((ext_vector_type(4)));
__device__ __forceinline__ void unpack8_(const u32x4v_t v, float* o) {
#pragma unroll
    for (int e = 0; e < 4; ++e) { o[2 * e] = __uint_as_float(v[e] << 16); o[2 * e + 1] = __uint_as_float(v[e] & 0xffff0000u); } }
__device__ __forceinline__ u32x4v_t pack8_(const float* o) { u32x4v_t w; w.x = pk2(o[0], o[1]); w.y = pk2(o[2], o[3]); w.z = pk2(o[4], o[5]); w.w = pk2(o[6], o[7]); return w; }
__device__ __forceinline__ void st_ssd_conv_v(const Prm& p, int L) {
    const int tid = TID_(), cg = tid % 96, rs_ = tid / 96; if (rs_ >= 5) return;
    const act_t* P = WSP(act_t, WS_P); act_t* xbc = WSP(act_t, WS_XBC); const int c = cg * 8;
    const float* cw = p.in[I_SCW] + (size_t)L * 3 * SSD_XBC; const float* cb = p.in[I_SCB] + (size_t)L * SSD_XBC;
    float w0[8], w1[8], w2[8], bb[8];
#pragma unroll
    for (int e = 0; e < 8; ++e) { w0[e] = cw[c + e]; w1[e] = cw[SSD_XBC + c + e]; w2[e] = cw[2 * SSD_XBC + c + e]; bb[e] = cb[c + e]; }
    const int stride = GDIM_() * 5;
    for (int r0 = BIDX_() * 5 + rs_; r0 < MT; r0 += 4 * stride) { u32x4v_t vm[4], vl[4], vh[4];
#pragma unroll
        for (int u = 0; u < 4; ++u) { const int r = r0 + u * stride; vm[u] = (u32x4v_t){0u, 0u, 0u, 0u}; vl[u] = vm[u]; vh[u] = vm[u];
            if (r < MT) { const int t = r < ML ? r % SEQ : (r - ML) % CTX_LEN, T = r < ML ? SEQ : CTX_LEN; const act_t* src = P + (size_t)r * PLD + XBC_OFF + c;
                vm[u] = *(const u32x4v_t*)src; if (t > 0) vl[u] = *(const u32x4v_t*)(src - PLD); if (t < T - 1) vh[u] = *(const u32x4v_t*)(src + PLD); } }
#pragma unroll
        for (int u = 0; u < 4; ++u) { const int r = r0 + u * stride; if (r < MT) { float x[8], v[8];
                unpack8_(vm[u], x);
#pragma unroll
                for (int e = 0; e < 8; ++e) v[e] = bb[e] + w1[e] * x[e];
                unpack8_(vl[u], x);
#pragma unroll
                for (int e = 0; e < 8; ++e) v[e] += w0[e] * x[e];
                unpack8_(vh[u], x);
#pragma unroll
                for (int e = 0; e < 8; ++e) v[e] += w2[e] * x[e];
#pragma unroll
                for (int e = 0; e < 8; ++e) v[e] = v[e] * __builtin_amdgcn_rcpf(1.f + __expf(-v[e]));
                *(u32x4v_t*)(xbc + (size_t)r * SSD_XBC + c) = pack8_(v); } } }
}
__device__ __forceinline__ void st_qk_prep_v(const Prm& p, int L, int g0, int gs) {
    act_t* P = WSP(act_t, WS_P); const float* rc = WSP(float, WS_ROPE); const float* rs = rc + (size_t)SEQ * 32;
    for (int i = g0; i < MT * 12; i += gs) { const int r = i / 12, s = i % 12; const bool isctx = r >= ML; const int t = r % SEQ;
        int off; const float* gn = nullptr; float scale = 1.f;
        if (s < 4) { off = GAQ + s * 64; gn = p.in[I_GAQN] + L * 64; scale = QSCALE; }
        else if (s < 6) { off = GAK + (s - 4) * 64; gn = p.in[I_GAKN] + L * 64; }
        else if (s < 10) { off = WAQ + (s - 6) * 64; scale = QSCALE; }
        else { off = WAK + (s - 10) * 64; if (isctx) continue; }
        act_t* v = P + (size_t)r * PLD + off; float x[64];
#pragma unroll
        for (int c = 0; c < 8; ++c) unpack8_(*(const u32x4v_t*)(v + 8 * c), x + 8 * c);
        float rn = scale;
        if (gn) { float ssq = 0.f;
#pragma unroll
            for (int e = 0; e < 64; ++e) ssq += x[e] * x[e];
            rn = scale / sqrtf(ssq * (1.f / 64.f) + NORM_EPS);
#pragma unroll
            for (int e = 0; e < 64; ++e) x[e] *= gn[e]; }
        if (!isctx) {
#pragma unroll
            for (int e4 = 0; e4 < 8; ++e4) { const f32x4_t c4 = *((const f32x4_t*)(rc + (size_t)t * 32) + e4), s4 = *((const f32x4_t*)(rs + (size_t)t * 32) + e4);
#pragma unroll
                for (int q = 0; q < 4; ++q) { const int e = 4 * e4 + q; const float x1 = x[e], x2 = x[e + 32]; x[e] = x1 * c4[q] - x2 * s4[q]; x[e + 32] = x2 * c4[q] + x1 * s4[q]; } } }
#pragma unroll
        for (int e = 0; e < 64; ++e) x[e] *= rn;
#pragma unroll
        for (int c = 0; c < 8; ++c) *(u32x4v_t*)(v + 8 * c) = pack8_(x + 8 * c); }
}

__device__ __forceinline__ void st_ffn_fixup(const Prm& p, int L, int g0, int gs) {
    const float* EG = WSP(float, WS_EG); const float* EU = WSP(float, WS_EU); act_t* ACT = WSP(act_t, WS_ACT);
    const float* cw = p.in[I_FCW] + (size_t)L * 3 * D_FF; const float* cb = p.in[I_FCB] + (size_t)L * D_FF;
    constexpr int NB = ML / 256 - 1;
    for (int i = g0; i < NB * D_FF; i += gs) { const int pm = i / D_FF, c = i % D_FF; if (((pm + 1) * 256) % SEQ == 0) continue;
        const float gA = EG[((size_t)pm * 4 + 2) * D_FF + c], gB = EG[((size_t)pm * 4 + 3) * D_FF + c], gC = EG[((size_t)(pm + 1) * 4 + 0) * D_FF + c], gD = EG[((size_t)(pm + 1) * 4 + 1) * D_FF + c];
        const float uB = EU[((size_t)pm * 2 + 1) * D_FF + c], uC = EU[((size_t)(pm + 1) * 2) * D_FF + c];
        const float w0 = cw[c], w1 = cw[D_FF + c], w2 = cw[2 * D_FF + c], b = cb[c];
        const float x0 = b + w0 * gA + w1 * gB + w2 * gC, x1 = b + w0 * gB + w1 * gC + w2 * gD;
        const size_t R = (size_t)(pm + 1) * 256 - 1;
        stf(ACT + R * D_FF + c, x0 / (1.f + __expf(-x0)) * uB); stf(ACT + (R + 1) * D_FF + c, x1 / (1.f + __expf(-x1)) * uC); }
}

__device__ __forceinline__ void sub_barrier(unsigned* cnt, unsigned np, bool arrive) {
    asm volatile("s_waitcnt vmcnt(0)" ::: "memory");
    __syncthreads();
    if (TID_() == 0) {
        if (arrive) { __builtin_amdgcn_fence(__ATOMIC_RELEASE, "agent"); asm volatile("s_waitcnt vmcnt(0)" ::: "memory");
            (void)__hip_atomic_fetch_add(cnt, 1u, __ATOMIC_RELAXED, __HIP_MEMORY_SCOPE_AGENT); }
        unsigned sp = 0; while (__hip_atomic_load(cnt, __ATOMIC_RELAXED, __HIP_MEMORY_SCOPE_AGENT) < np) { __builtin_amdgcn_s_sleep(2); if (++sp > (1u << 22)) break; }
        __builtin_amdgcn_fence(__ATOMIC_ACQUIRE, "agent"); asm volatile("s_waitcnt vmcnt(0)" ::: "memory");
    }
    __syncthreads();
}
#endif

HD void run_step(const Prm& p, int st, int L, int g0_, int gs_) {
#ifdef CPU_TEST
    const int g0 = g0_, gs = gs_;
#else
    extern __shared__ __attribute__((aligned(16))) unsigned char lds_dyn_[];
    LAS unsigned char* const ldsb = (LAS unsigned char*)lds_dyn_;
    const int tidl_ = TID_();
    const int g0 = BIDX_() * NTHREADS_ + tidl_, gs = GDIM_() * NTHREADS_;
#endif
    const int nrows = (L < DEPTH - 1) ? MT : ML;
#ifndef CPU_TEST
    using namespace pg8;
    const float* modL = (const float*)(p.ws + WS_MOD) + (size_t)L * (BATCH + 1) * 6 * D_MODEL;
    const int G = GDIM_(), bid = BIDX_();
#endif
    switch (st) {
#ifdef CPU_TEST
    case S_MOD: st_mod(p, g0, gs); break;
#else
    case S_MOD: st_mod_atomic(p, ldsb); break;
#endif
#ifdef CPU_TEST
    case S_INIT: st_init(p, g0, gs); break;
#else
    case S_INIT: st_rope_tab(p, g0, gs); { float* xc = WSP(float, WS_XC); for (int i = g0; i < MC * D_MODEL; i += gs) xc[i] = p.in[I_CTX][i]; } break;
#endif
    case S_TAB1: st_s5tab1(p, g0, gs); break;
#ifdef CPU_TEST
    case S_TAB2: st_s5tab2(p, g0, gs); break;
#else
    case S_TAB2: st_s5tab2_lds(p, ldsb); break;
#endif
#ifdef CPU_TEST
    case S_ROWSS: st_rowss(p, MT, g0, gs); break;
    case S_NORM_MIX: st_normmod(p, L, 0, MT, g0, gs); break;
    case S_NORM_FFN: st_normmod(p, L, 1, nrows, g0, gs); break;
    case S_ROWSS_FIN: st_rowss(p, ML, g0, gs); break;
    case S_FINAL: st_final(p, g0, gs); break;
    case S_CS: st_ssd_cs(p, L, g0, gs); break;
    case S_SSD_CARRY: st_ssd_carry(p, g0, gs); break;
    case S_S5_CARRY: st_s5_carry(p, L, g0, gs); break;
    case S_SSD_OUT: st_ssd_out(p, L, nrows, g0, gs); break;
#else
    case S_NORM_MIX: st_norm_fused(p, L, 0, MT, L > 0 ? modp(p, L - 1, BATCH, 5) : nullptr); break;
    case S_NORM_FFN: st_norm_fused(p, L, 1, nrows, nrows > ML ? modp(p, L, BATCH, 2) : nullptr); break;
    case S_FINAL: st_final_fused(p); break;
    case S_CS: st_ssd_cs_w(p, L); break;
    case S_SSD_CARRY: st_ssd_carry_b(p, g0, gs); break;
    case S_S5_CARRY: st_s5_carry_b(p, L, ldsb); break;
    case S_SSD_OUT: st_ssd_out_w(p, L, nrows); break;
#endif
#ifdef CPU_TEST
    case S_TABB: st_s5tabB(p, L, g0, gs); break;
#else
    case S_TABB: { const int nfull = (MT / 256) * (NIN / 256) - 2 * GDIM_();
        const int b_ = BIDX_(), G_ = GDIM_(); if (nfull > 0 && nfull < G_) { if (b_ >= nfull) st_s5tabB_v(p, L, (b_ - nfull) * NTHREADS_ + TID_(), (G_ - nfull) * NTHREADS_); } else st_s5tabB_v(p, L, g0, gs); } break;
#endif
#ifdef CPU_TEST
    case S_ATTN: st_attn(p, L, nrows, g0, gs); break;
#else
    case S_ATTN: st_attn_mfma(p, L, 0, (char*)lds_dyn_); break;
    case S_ATTNC: if (L < DEPTH - 1) st_attn_mfma(p, L, 1, (char*)lds_dyn_); break;
#endif
#ifdef CPU_TEST
    case S_WPREP: case S_WPREP2: case S_ATTNC: break;
    case S_CONV: st_ssd_conv(p, L, g0, gs); break;
    case S_QK: st_qk_prep(p, L, g0, gs); break;
    case S_STATE: st_ssd_state(p, g0, gs); break;
    case S_CB: st_ssd_cb(p, g0, gs); break;
    case S_SSD_Y: st_ssd_y(p, L, nrows, g0, gs); break;
    case S_S5E: st_s5_E_naive(p, g0, gs); break;
    case S_S5_Y: st_s5_Y_naive(p, nrows, g0, gs); break;
    case S_GEMM_IN: { EpiStoreIn e{&p}; naive_gemm(WSP(act_t, WS_XN), D_MODEL, p.in[I_WIN] + (size_t)L * D_MODEL * D_IN, D_IN, MT, D_IN, D_MODEL, e, g0, gs); } break;
    case S_GLU: st_glu(p, L, nrows, g0, gs); break;
    case S_GEMM_OUT: { EpiResid e{&p, L, 2}; naive_gemm(WSP(act_t, WS_YMIX), D_MIX, p.in[I_WOUT] + (size_t)L * D_MIX * D_MODEL, D_MODEL, nrows, D_MODEL, D_MIX, e, g0, gs); } break;
    case S_GEMM_GATE: { EpiStore e{WSP(act_t, WS_GT), D_FF}; naive_gemm(WSP(act_t, WS_XN), D_MODEL, p.in[I_WGATE] + (size_t)L * D_MODEL * D_FF, D_FF, nrows, D_FF, D_MODEL, e, g0, gs); } break;
    case S_GEMM_UP: { EpiUp e{&p, L}; naive_gemm(WSP(act_t, WS_XN), D_MODEL, p.in[I_WUP] + (size_t)L * D_MODEL * D_FF, D_FF, nrows, D_FF, D_MODEL, e, g0, gs); } break;
    case S_GEMM_DOWN: { EpiResid e{&p, L, 5}; naive_gemm(WSP(act_t, WS_ACT), D_FF, p.in[I_WDOWN] + (size_t)L * D_FF * D_MODEL, D_MODEL, nrows, D_MODEL, D_FF, e, g0, gs); } break;
#else
    case S_WPREP: st_wprep(p, L, ldsb, g0, gs, 0); break;
    case S_WPREP2: st_wprep(p, L, ldsb, g0, gs, 1); break;
    case S_CONV: st_ssd_conv_v(p, L); break;
    case S_QK: st_qk_prep_v(p, L, g0, gs); break;
    case S_STATE: st_ssd_states_m(p, ldsb); break;
    case S_SSD_Y: st_ssd_y_m(p, L, nrows, ldsb); break;
    case S_GEMM_IN: { Gemm g{WSP(act_t, WS_XN), WSP(act_t, WS_WIN), MT, NIN, D_MODEL, D_MODEL}; StaticOrder S; S.init(MT, NIN, G, bid);
        EpiInProj E{WSP(act_t, WS_P), WSP(act_t, WS_S5A), WSP(float, WS_DTRAW)}; gemm_phase<EpiInProj, StaticOrder, true, true>(ldsb, g, S, E); } break;
    case S_S5E: { int k5 = 256; asm volatile("" : "+s"(k5)); Gemm g{WSP(act_t, WS_S5A), WSP(act_t, WS_S5BE), 16 * S5R, 16 * 256, k5, 512}; BatchedOrder S; S.init(G, bid);
        EpiS5E E{WSP(float, WS_S5E)}; gemm_phase<EpiS5E, BatchedOrder, true, true>(ldsb, g, S, E); } break;
    case S_S5_Y: { Gemm g{WSP(act_t, WS_S5A), WSP(act_t, WS_S5BY), 16 * S5R, 16 * 256, 512, 512}; BatchedOrder S; S.init(G, bid);
        EpiS5Y E{WSP(act_t, WS_P), nrows / 16}; gemm_phase<EpiS5Y, BatchedOrder, true, true>(ldsb, g, S, E); } break;
    case S_SUBGLU: { constexpr int NP = 16 * (S5R / 256); const int nssd = nrows / 128, pi = bid - nssd; if (pi >= 0 && G - nssd >= NP) {
            sub_barrier((unsigned*)(p.ws + WS_CTL) + 1024 + 64 * L, NP, bid >= G - NP);
            int kglu = 256; asm volatile("" : "+s"(kglu)); Gemm g{WSP(act_t, WS_P) + YS5_OFF, WSP(act_t, WS_WGLU), nrows, 512, kglu, PLD}; StaticOrder S; S.init(nrows, 512, G - nssd, pi);
            EpiGluM E{WSP(act_t, WS_YMIX), p.in[I_BGLU] + L * 512}; gemm_phase<EpiGluM, StaticOrder, true, true>(ldsb, g, S, E); } } break;
    case S_GLU: { int kglu = 256; asm volatile("" : "+s"(kglu)); Gemm g{WSP(act_t, WS_P) + YS5_OFF, WSP(act_t, WS_WGLU), nrows, 512, kglu, PLD}; StaticOrder S; S.init(nrows, 512, G, bid);
        EpiGluM E{WSP(act_t, WS_YMIX), p.in[I_BGLU] + L * 512}; gemm_phase<EpiGluM, StaticOrder, true, true>(ldsb, g, S, E); } break;
    case S_GEMM_OUT: { Gemm g{WSP(act_t, WS_YMIX), WSP(act_t, WS_WOUT), nrows, D_MODEL, D_MIX, D_MIX};
        EpiResidM E{p.out, WSP(float, WS_XC), L == 0 ? p.in[I_X] : p.out, WSP(float, WS_XC), modL, 2, WSP(float, WS_SLAB), D_MIX / 64};
        if (nrows > ML) { TailSplitOrder S; S.init(D_MIX, G, bid); gemm_phase<EpiResidM, TailSplitOrder, true, true>(ldsb, g, S, E); }
        else { StaticOrder S; S.init(nrows, D_MODEL, G, bid); gemm_phase<EpiResidM, StaticOrder, true, true>(ldsb, g, S, E); } } break;
    case S_GEMM_GU: { Gemm g{WSP(act_t, WS_XN), WSP(act_t, WS_WG), nrows, 2 * D_FF, D_MODEL, D_MODEL}; StaticOrder S; S.init(nrows, 2 * D_FF, G, bid);
        EpiGateUpM E{WSP(act_t, WS_ACT), p.in[I_FCW] + (size_t)L * 3 * D_FF, p.in[I_FCB] + (size_t)L * D_FF, WSP(float, WS_EG), WSP(float, WS_EU)}; gemm_phase<EpiGateUpM, StaticOrder, true, true>(ldsb, g, S, E); } break;
    case S_FIXUP: st_ffn_fixup(p, L, g0, gs); break;
    case S_GEMM_GATE: { Gemm g{WSP(act_t, WS_XN), WSP(act_t, WS_WG), nrows, D_FF, D_MODEL, D_MODEL}; StaticOrder S; S.init(nrows, D_FF, G, bid);
        EpiBf16<0> E{WSP(act_t, WS_GT), D_FF, nullptr, 0, 0, 1.f}; gemm_phase<EpiBf16<0>, StaticOrder, true, true>(ldsb, g, S, E); } break;
    case S_GEMM_UP: { Gemm g{WSP(act_t, WS_XN), WSP(act_t, WS_WU), nrows, D_FF, D_MODEL, D_MODEL}; StaticOrder S; S.init(nrows, D_FF, G, bid);
        EpiUpM E{WSP(act_t, WS_GT), WSP(act_t, WS_ACT), p.in[I_FCW] + (size_t)L * 3 * D_FF, p.in[I_FCB] + (size_t)L * D_FF}; gemm_phase<EpiUpM, StaticOrder, true, true>(ldsb, g, S, E); } break;
    case S_GEMM_DOWN: { Gemm g{WSP(act_t, WS_ACT), WSP(act_t, WS_WD), nrows, D_MODEL, D_FF, D_FF};
        EpiResidM E{p.out, WSP(float, WS_XC), p.out, WSP(float, WS_XC), modL, 5, WSP(float, WS_SLAB), D_FF / 64};
        if (nrows > ML) { TailSplitOrder S; S.init(D_FF, G, bid); gemm_phase<EpiResidM, TailSplitOrder, true, true>(ldsb, g, S, E); }
        else { StaticOrder S; S.init(nrows, D_MODEL, G, bid); gemm_phase<EpiResidM, StaticOrder, true, true>(ldsb, g, S, E); } } break;
#endif
    default: break;
    }
}

#ifndef CPU_TEST
#define XB_TMO      128
#define XB_XCNT(j)  (256  + 64 * (j))
#define XB_XSUB(j)  (1280 + 64 * (j))
#define XB_XGEN(j)  (2304 + 64 * (j))
#define XB_TOP      3328
#define XB_TOPGEN   3392
#define XCD_BAR_WORDS 3456
#define XB_SPIN_CAP (1u << 22)
__device__ __forceinline__ unsigned xb_ld(unsigned* p)              { return __hip_atomic_load(p, __ATOMIC_RELAXED, __HIP_MEMORY_SCOPE_AGENT); }
__device__ __forceinline__ unsigned xb_add(unsigned* p, unsigned v) { return __hip_atomic_fetch_add(p, v, __ATOMIC_RELAXED, __HIP_MEMORY_SCOPE_AGENT); }
__device__ __forceinline__ unsigned xb_xcc_id() { return (unsigned)__builtin_amdgcn_s_getreg((3 << 11) | 20) & 0xFu; }
#define XB_SPIN(cond, bar) do { unsigned _sp = 0; while (cond) { __builtin_amdgcn_s_sleep(1); \
    if ((++_sp & 255u) == 0u) { if (xb_ld(&(bar)[XB_TMO])) break; if (_sp > XB_SPIN_CAP) { atomicAdd(&(bar)[XB_TMO], 1u); break; } } } } while (0)
struct XcdBarrier { unsigned* bar; unsigned x; volatile LAS unsigned* st; };
__device__ __forceinline__ XcdBarrier xcd_barrier_post(unsigned* bar, volatile LAS unsigned* st) {
    XcdBarrier b; b.bar = bar; b.x = xb_xcc_id(); b.st = st;
    if (TID_() == 0) (void)xb_add(&bar[XB_XCNT(b.x)], 1u);
    return b;
}
__device__ __forceinline__ void xcd_barrier_complete(unsigned* bar, unsigned x, unsigned& nloc, unsigned& nx) {
    const unsigned G = gridDim.x * gridDim.y * gridDim.z;
    unsigned sum, cnt, mine, sp = 0u;
    for (;;) {
        sum = 0u; cnt = 0u; mine = 0u;
#pragma unroll
        for (unsigned j = 0; j < 16; ++j) { const unsigned c = xb_ld(&bar[XB_XCNT(j)]); sum += c; cnt += (c > 0u) ? 1u : 0u; mine = (j == x) ? c : mine; }
        if (sum == G) break;
        __builtin_amdgcn_s_sleep(1);
        if ((++sp & 255u) == 0u) { if (xb_ld(&bar[XB_TMO])) break; if (sp > XB_SPIN_CAP) { atomicAdd(&bar[XB_TMO], 1u); break; } }
    }
    nloc = mine > 0u ? mine : 1u; nx = cnt > 0u ? cnt : 1u;
}
__device__ __forceinline__ void xcd_barrier(const XcdBarrier& b) {
    asm volatile("s_waitcnt vmcnt(0)" ::: "memory");
    __syncthreads();
    if (TID_() == 0) {
        unsigned* bar = b.bar;
        __builtin_amdgcn_s_waitcnt(0);
        unsigned nloc = b.st[0], nx = b.st[1];
        if (nloc == 0u) { xcd_barrier_complete(bar, b.x, nloc, nx); b.st[0] = nloc; b.st[1] = nx; }
        const unsigned old = xb_add(&bar[XB_XSUB(b.x)], 1u);
        const unsigned gen = old / nloc;
        if (old + 1u == (gen + 1u) * nloc) {
            __builtin_amdgcn_fence(__ATOMIC_RELEASE, "agent");
            asm volatile("s_waitcnt vmcnt(0)" ::: "memory");
            const unsigned og = xb_add(&bar[XB_TOP], 1u);
            const unsigned tg = og / nx;
            if (og + 1u == (tg + 1u) * nx) xb_add(&bar[XB_TOPGEN], 1u);
            else XB_SPIN(xb_ld(&bar[XB_TOPGEN]) == tg, bar);
            __builtin_amdgcn_fence(__ATOMIC_ACQUIRE, "agent");
            xb_add(&bar[XB_XGEN(b.x)], 1u);
            asm volatile("s_waitcnt vmcnt(0)" ::: "memory");
        } else {
            XB_SPIN(xb_ld(&bar[XB_XGEN(b.x)]) == gen, bar);
            __builtin_amdgcn_fence(__ATOMIC_ACQUIRE, "agent");
            asm volatile("s_waitcnt vmcnt(0)" ::: "memory");
        }
    }
    __syncthreads();
}

constexpr int LDS_BYTES = 147456;
constexpr int MISC_OFF = MISC_OFF_;
constexpr int CW_BAR = 4096;
__global__ void __launch_bounds__(NTHREADS_, 2) mk_fwd(Prm p) {
    extern __shared__ __attribute__((aligned(16))) unsigned char lds[];
    { volatile LAS unsigned* MISC = (volatile LAS unsigned*)((LAS unsigned char*)lds + MISC_OFF);
      for (int u = threadIdx.x; u < (LDS_BYTES - MISC_OFF) / 4; u += NTHREADS_) MISC[u] = 0u;
      __syncthreads();
      if ((threadIdx.x & 63) == 0) MISC[WTAB_ + HWSLOT_()] = threadIdx.x >> 6;
      __syncthreads();
      const XcdBarrier b0 = xcd_barrier_post((unsigned*)(p.ws + WS_CTL) + CW_BAR, MISC + 8);
      if (TID_() == 0) MISC[10] = b0.x;
      __syncthreads(); }
#define KARG() const __attribute__((address_space(4))) Prm* pp_ = (const __attribute__((address_space(4))) Prm*)__builtin_amdgcn_kernarg_segment_ptr(); asm volatile("" : "+s"(pp_))
#define RUN(st, L) do { KARG(); run_step(*(const Prm*)pp_, st, L, 0, 0); __syncthreads(); } while (0)
#define SYNC() do { asm volatile("s_waitcnt vmcnt(0)" ::: "memory");     \
        KARG(); volatile LAS unsigned* MISC = (volatile LAS unsigned*)((LAS unsigned char*)lds + MISC_OFF); XcdBarrier b_; b_.bar = (unsigned*)(((const Prm*)pp_)->ws + WS_CTL) + CW_BAR; b_.x = MISC[10]; b_.st = MISC + 8; xcd_barrier(b_); } while (0)
    RUN(S_MOD, 0); RUN(S_INIT, 0); RUN(S_TAB1, 0); RUN(S_WPREP, 0); SYNC();
#define LAYER(L) do { \
        if (L > 0) RUN(S_WPREP, L); else RUN(S_TAB2, 0); \
        RUN(S_NORM_MIX, L); SYNC(); RUN(S_GEMM_IN, L); RUN(S_TABB, L); SYNC(); \
        RUN(S_CONV, L); RUN(S_CS, L); RUN(S_QK, L); SYNC(); \
        RUN(S_STATE, L); RUN(S_S5E, L); RUN(S_ATTN, L); SYNC(); \
        RUN(S_SSD_CARRY, L); RUN(S_S5_CARRY, L); RUN(S_WPREP2, L); SYNC(); \
        RUN(S_SSD_Y, L); RUN(S_S5_Y, L); RUN(S_ATTNC, L); RUN(S_SUBGLU, L); SYNC(); \
        RUN(S_GEMM_OUT, L); SYNC(); RUN(S_NORM_FFN, L); SYNC(); \
        RUN(S_GEMM_GU, L); SYNC(); RUN(S_FIXUP, L); SYNC(); RUN(S_GEMM_DOWN, L); SYNC(); } while (0)
    LAYER(0); LAYER(1);
    static_assert(DEPTH == 2, "layer program written out for two layers");
#undef LAYER
    RUN(S_FINAL, 0);
#undef RUN
#undef SYNC
#undef KARG
}
extern "C" void kernel_launch(void* const* d_in, const int* in_sizes, int n_in, void* d_out, int out_size, void* d_ws, size_t ws_size, hipStream_t stream) {
    if (n_in != 35 || out_size != ML * D_MODEL || ws_size < WS_TOTAL) { fprintf(stderr, "kernel_launch: unexpected shapes (n_in %d out %d ws %zu need %zu)\n", n_in, out_size, ws_size, (size_t)WS_TOTAL); return; }
    Prm p{};
    for (int i = 0; i < 35; ++i) p.in[i] = (const float*)d_in[i];
    p.out = (float*)d_out; p.ws = (unsigned char*)d_ws;
    static int grid = 0;
    if (grid == 0) {
        int dev = 0, cus = 0;
        if (hipGetDevice(&dev) != hipSuccess || hipDeviceGetAttribute(&cus, hipDeviceAttributeMultiprocessorCount, dev) != hipSuccess) { fprintf(stderr, "kernel_launch: device query failed\n"); grid = -1; return; }
        if (hipFuncSetAttribute((const void*)mk_fwd, hipFuncAttributeMaxDynamicSharedMemorySize, LDS_BYTES) != hipSuccess) { fprintf(stderr, "kernel_launch: hipFuncSetAttribute failed\n"); grid = -1; return; }
        int per_cu = 0;
        if (hipOccupancyMaxActiveBlocksPerMultiprocessor(&per_cu, (const void*)mk_fwd, NTHREADS_, LDS_BYTES) != hipSuccess || per_cu < 1) fprintf(stderr, "kernel_launch: note: occupancy query reports %d blocks per CU\n", per_cu);
        (void)hipGetLastError();
        grid = cus;
    }
    if (grid < 0) return;
    if (hipMemsetAsync((char*)d_ws + WS_CTL, 0, CTL_BYTES, stream) != hipSuccess) { fprintf(stderr, "kernel_launch: memset failed\n"); return; }
    hipLaunchKernelGGL(mk_fwd, dim3(grid), dim3(NTHREADS_), LDS_BYTES, stream, p);
}
#endif
```

```cpp
#ifndef CPU_TEST
#include <hip/hip_runtime.h>
#include <cstdio>
#include <cstdint>
#define HD __device__ __forceinline__
#define HDM __device__ __forceinline__
#else
#include <cmath>
#include <cstdio>
#include <cstdint>
#include <cstring>
#define HD static inline
#define HDM inline
#endif

#ifndef D_MODEL
#define D_MODEL 1024
#endif
#ifndef SEQ
#define SEQ 8192
#endif
#ifndef CTX_LEN
#define CTX_LEN 256
#endif
#ifndef D_FF
#define D_FF 2816
#endif
#define BATCH 2
#define DEPTH 2
#define GRID_W 64
#define HEAD_DIM 64
#define NORM_EPS 1e-6f
#define D_SSD 256
#define SSD_XBC 768
#define D_S5 256
#define D_MIX 1024
#define D_IN 2312
constexpr int NTHREADS_ = 512;
constexpr int ML = BATCH * SEQ, MC = BATCH * CTX_LEN, MT = ML + MC;
constexpr int NCH = MT / 128;
constexpr int NSC = MT / 16;
constexpr int PLD = 2048;
constexpr int NIN = 2560;
constexpr int S5R = 1280;
constexpr int Z_OFF = 0, XBC_OFF = 256, GAQ = 1024, GAK = 1280, GAV = 1408, WAQ = 1536, WAK = 1792, WAV = 1920;
constexpr int YSSD_OFF = 256, YS5_OFF = 512;

#ifdef CPU_TEST
typedef float act_t;
HD float ldf(const act_t* p) { return *p; }
HD void stf(act_t* p, float v) { *p = v; }
#else
typedef unsigned short act_t;
HD float ldf(const act_t* p) { return __uint_as_float(((unsigned)*p) << 16); }
HD void stf(act_t* p, float v) { unsigned u = __float_as_uint(v); u = (u + 0x7fffu + ((u >> 16) & 1u)) >> 16; *p = (act_t)u; }
#endif

constexpr size_t al256(size_t x) { return (x + 255) & ~(size_t)255; }
constexpr size_t WS_CTL = 0, CTL_BYTES = 1u << 20;
constexpr size_t WS_MOD = WS_CTL + 65536;
static_assert(65536 + (size_t)DEPTH * (BATCH + 1) * 6 * D_MODEL * 4 <= CTL_BYTES, "mod table inside the zeroed region");
constexpr size_t WS_ROPE = WS_CTL + CTL_BYTES;
constexpr size_t WS_LAMP = WS_ROPE + al256((size_t)SEQ * 64 * 4);
constexpr size_t WS_BBAR = WS_LAMP + al256((size_t)DEPTH * 2 * 16 * 64 * 17 * 2 * 4);
constexpr size_t WS_KT = WS_BBAR + al256((size_t)DEPTH * 2 * 16 * 64 * 16 * 2 * 4);
constexpr size_t WS_XC = WS_KT + al256((size_t)DEPTH * 2 * 16 * 16 * 256 * 4);
constexpr size_t WS_SS = WS_XC + al256((size_t)MC * D_MODEL * 4);
constexpr size_t WS_DT = WS_SS + al256((size_t)MT * 4);
constexpr size_t WS_CS = WS_DT + al256((size_t)MT * 8 * 4);
constexpr size_t WS_DTRAW = WS_CS + al256((size_t)MT * 8 * 4);
constexpr size_t WS_S5BY = WS_DTRAW + al256((size_t)MT * 8 * 4);
constexpr size_t WS_S5BE = WS_S5BY + al256((size_t)16 * 256 * 512 * sizeof(act_t));
constexpr size_t WS_ARENA = WS_S5BE + al256((size_t)16 * 256 * 256 * sizeof(act_t));
constexpr size_t WS_XN = WS_ARENA;
constexpr size_t WS_YMIX = WS_XN;
constexpr size_t WS_P = WS_XN + al256((size_t)MT * (D_MODEL > D_MIX ? D_MODEL : D_MIX) * sizeof(act_t));
constexpr size_t WS_XBC = WS_P + al256((size_t)MT * PLD * sizeof(act_t));
constexpr size_t WS_SST = WS_XBC + al256((size_t)MT * 768 * sizeof(act_t));
constexpr size_t WS_CB = WS_SST + al256((size_t)NCH * 2 * 4 * 64 * 128 * 4);
constexpr size_t WS_SLAB = WS_CB;
constexpr size_t WS_S5E = WS_CB + al256((size_t)NCH * 2 * 128 * 128 * 4);
constexpr size_t WS_S5A = WS_S5E + al256((size_t)16 * NSC * 256 * 4);
constexpr size_t WS_MIX_END = WS_S5A + al256((size_t)16 * S5R * 512 * sizeof(act_t));
constexpr size_t WS_GT = WS_P;
constexpr size_t WS_EG = WS_GT;
constexpr size_t WS_EU = WS_EG + al256((size_t)(MT / 256) * 4 * D_FF * 4);
constexpr size_t WS_ACT = WS_GT + al256((size_t)MT * D_FF * sizeof(act_t));
constexpr size_t WS_FFN_END = WS_ACT + al256((size_t)MT * D_FF * sizeof(act_t));
constexpr size_t WS_END = WS_MIX_END > WS_FFN_END ? WS_MIX_END : WS_FFN_END;
constexpr size_t WS_WIN = WS_END;
constexpr size_t WS_WOUT = WS_WIN + al256((size_t)NIN * D_MODEL * 2);
constexpr size_t WS_WG = WS_WOUT + al256((size_t)D_MODEL * D_MIX * 2);
constexpr size_t WS_WU = WS_WG + al256((size_t)D_FF * D_MODEL * 2);
constexpr size_t WS_WD = WS_WU + al256((size_t)D_FF * D_MODEL * 2);
constexpr size_t WS_WGLU = WS_WD + al256((size_t)D_MODEL * D_FF * 2);
constexpr size_t WS_TOTAL = WS_WGLU + al256((size_t)512 * 256 * 2);
#ifndef CPU_TEST
static_assert(WS_TOTAL <= ((size_t)256 << 20), "workspace map exceeds 256 MiB");
static_assert(WS_WU == WS_WG + (size_t)D_FF * D_MODEL * 2, "gate | up weight copies are one contiguous [2*D_FF][D] matrix");
#endif

struct Prm { const float* in[35]; float* out; unsigned char* ws; };
enum { I_X = 0, I_C, I_CTX, I_CCTX, I_WMOD, I_BMOD, I_GMIX, I_WIN, I_SCW, I_SCB, I_SALOG, I_SDTB, I_SD, I_SNG, I_GAQN, I_GAKN, I_SINK,
       I_LRE, I_LIM, I_LSTEP, I_BRE, I_BIM, I_CRE, I_CIM, I_S5D, I_WGLU, I_BGLU, I_WOUT, I_GFFN, I_WGATE, I_WUP, I_FCW, I_FCB, I_WDOWN, I_GFIN };

HD float sigmoidf_(float x) { return 1.f / (1.f + expf(-x)); }
HD float siluf_(float x) { return x * sigmoidf_(x); }
HD float softplusf_(float x) { return x > 20.f ? x : log1pf(expf(x)); }
HD float geluf_(float x) { return 0.5f * x * (1.f + tanhf(0.7978845608028654f * (x + 0.044715f * x * x * x))); }
struct RowInfo { int isctx, b, t, T, modrow; };
HD RowInfo rowinfo(int r) { RowInfo q; if (r < ML) { q.isctx = 0; q.b = r / SEQ; q.t = r % SEQ; q.T = SEQ; q.modrow = q.b; } else { const int rr = r - ML; q.isctx = 1; q.b = rr / CTX_LEN; q.t = rr % CTX_LEN; q.T = CTX_LEN; q.modrow = BATCH; } return q; }
HD float* xrow(const Prm& p, int r) { return r < ML ? p.out + (size_t)r * D_MODEL : (float*)(p.ws + WS_XC) + (size_t)(r - ML) * D_MODEL; }
HD const float* modp(const Prm& p, int layer, int modrow, int which) { return (const float*)(p.ws + WS_MOD) + ((size_t)(layer * (BATCH + 1) + modrow) * 6 + which) * D_MODEL; }
#define WSP(T, off) ((T*)(p.ws + (off)))
#ifdef CPU_TEST
#define QSCALE 0.125f
#else
#define QSCALE (0.125f * 1.4426950408889634f)
#endif

HD void st_mod(const Prm& p, int g0, int gs) {
    float* mod = WSP(float, WS_MOD);
    for (int i = g0; i < (int)(DEPTH * (BATCH + 1) * 6 * D_MODEL); i += gs) {
        const int j = (int)(i % (6 * D_MODEL)); const int m = (int)((i / (6 * D_MODEL)) % (BATCH + 1)); const int l = (int)(i / (6 * D_MODEL * (BATCH + 1)));
        const float* cv = m < BATCH ? p.in[I_C] + (size_t)m * D_MODEL : p.in[I_CCTX];
        const float* w = p.in[I_WMOD] + (size_t)l * D_MODEL * 6 * D_MODEL + j;
        float acc = 0.f;
        for (int k = 0; k < D_MODEL; ++k) acc += siluf_(cv[k]) * w[(size_t)k * 6 * D_MODEL];
        mod[i] = acc + p.in[I_BMOD][(size_t)l * 6 * D_MODEL + j];
    }
}
HD void st_init(const Prm& p, int g0, int gs) {
    for (int i = g0; i < (int)(ML * D_MODEL); i += gs) p.out[i] = p.in[I_X][i];
    float* xc = WSP(float, WS_XC);
    for (int i = g0; i < (int)(MC * D_MODEL); i += gs) xc[i] = p.in[I_CTX][i];
    float* rc = WSP(float, WS_ROPE); float* rs = rc + (size_t)SEQ * 32;
    for (int i = g0; i < (int)(SEQ * 32); i += gs) {
        const int t = (int)(i / 32), f = (int)(i % 32); const int pos = f < 16 ? t / GRID_W : t % GRID_W; const int fi = f & 15;
        const double inv = exp(-(double)fi * 0.5756462732485115); const double ang = (double)pos * inv;
        rc[i] = (float)cos(ang); rs[i] = (float)sin(ang);
    }
}
HD void st_rope_tab(const Prm& p, int g0, int gs) {
    float* rc = WSP(float, WS_ROPE); float* rs = rc + (size_t)SEQ * 32;
    for (int i = g0; i < (int)(SEQ * 32); i += gs) {
        const int t = (int)(i / 32), f = (int)(i % 32); const int pos = f < 16 ? t / GRID_W : t % GRID_W; const int fi = f & 15;
        const double inv = exp(-(double)fi * 0.5756462732485115); const double ang = (double)pos * inv;
        rc[i] = (float)cos(ang); rs[i] = (float)sin(ang);
    }
}
HD void st_s5tab1(const Prm& p, int g0, int gs) {
    float* lamp = WSP(float, WS_LAMP); float* bbar = WSP(float, WS_BBAR);
    for (int idx = g0; idx < (int)(DEPTH * 2 * 16 * 64 * 17); idx += gs) { const int i = idx / 17, tau = idx % 17, ldg = i / 64;
        const double lre = fmin((double)p.in[I_LRE][i], -1e-4), lim = (double)p.in[I_LIM][i], step = exp((double)p.in[I_LSTEP][ldg]);
        const double mag = exp(lre * step * tau), ang = lim * step * tau;
        lamp[(size_t)idx * 2 + 0] = (float)(mag * cos(ang)); lamp[(size_t)idx * 2 + 1] = (float)(mag * sin(ang)); }
    for (int i = gs - 1 - g0; i < (int)(DEPTH * 2 * 16 * 64); i += gs) { const int ldg = i / 64;
        const double lre = fmin((double)p.in[I_LRE][i], -1e-4), lim = (double)p.in[I_LIM][i], step = exp((double)p.in[I_LSTEP][ldg]);
        const double mag = exp(lre * step), ang = lim * step;
        const double nr = mag * cos(ang) - 1.0, ni = mag * sin(ang);
        const double den = lre * lre + lim * lim;
        const double fr = (nr * lre + ni * lim) / den, fi = (ni * lre - nr * lim) / den;
#pragma unroll
        for (int k = 0; k < 16; ++k) { const double br = p.in[I_BRE][i * 16 + k], bi = p.in[I_BIM][i * 16 + k];
            bbar[((size_t)i * 16 + k) * 2 + 0] = (float)(fr * br - fi * bi); bbar[((size_t)i * 16 + k) * 2 + 1] = (float)(fr * bi + fi * br); } }
}
HD void st_s5tab2(const Prm& p, int g0, int gs) {
    const float* lamp = WSP(float, WS_LAMP); const float* bbar = WSP(float, WS_BBAR); float* kt = WSP(float, WS_KT);
    for (int i = g0; i < (int)(DEPTH * 2 * 16 * 16 * 256); i += gs) {
        const int kp = (int)(i % 16), k = (int)((i / 16) % 16), tau = (int)((i / 256) % 16); const int ldg = i / 4096;
        float acc = 0.f;
        for (int n = 0; n < 64; ++n) {
            const float cr = p.in[I_CRE][(ldg * 16 + k) * 64 + n], ci = p.in[I_CIM][(ldg * 16 + k) * 64 + n];
            const float lr = lamp[((ldg * 64 + n) * 17 + tau) * 2], li = lamp[((ldg * 64 + n) * 17 + tau) * 2 + 1];
            const float br = bbar[((ldg * 64 + n) * 16 + kp) * 2], bi = bbar[((ldg * 64 + n) * 16 + kp) * 2 + 1];
            const float tr = lr * br - li * bi, ti = lr * bi + li * br;
            acc += cr * tr - ci * ti;
        }
        kt[i] = acc;
    }
}

HD void st_rowss(const Prm& p, int nrows, int g0, int gs) {
    float* ss = WSP(float, WS_SS);
    for (int r = g0; r < nrows; r += gs) { const float* x = xrow(p, (int)r); float s = 0.f; for (int k = 0; k < D_MODEL; ++k) s += x[k] * x[k]; ss[r] = s; }
}
HD void st_normmod(const Prm& p, int layer, int which  , int nrows, int g0, int gs) {
    const float* ss = WSP(float, WS_SS); act_t* xn = WSP(act_t, WS_XN);
    const float* gw = p.in[which ? I_GFFN : I_GMIX] + (size_t)layer * D_MODEL;
    for (int i = g0; i < (int)(nrows * D_MODEL); i += gs) {
        const int r = (int)(i / D_MODEL), k = (int)(i % D_MODEL); const RowInfo q = rowinfo(r);
        const float rs = 1.0f / sqrtf(ss[r] * (1.0f / D_MODEL) + NORM_EPS);
        const float sh = modp(p, layer, q.modrow, which ? 3 : 0)[k], sc = modp(p, layer, q.modrow, which ? 4 : 1)[k];
        stf(xn + i, xrow(p, r)[k] * rs * gw[k] * (1.f + sc) + sh);
    }
}
HD void st_final(const Prm& p, int g0, int gs) {
    const float* ss = WSP(float, WS_SS);
    for (int i = g0; i < (int)(ML * D_MODEL); i += gs) { const int r = (int)(i / D_MODEL), k = (int)(i % D_MODEL);
        p.out[i] = p.out[i] * (1.0f / sqrtf(ss[r] * (1.0f / D_MODEL) + NORM_EPS)) * p.in[I_GFIN][k]; }
}

template <class Epi> HD void naive_gemm(const act_t* A, int lda, const float* W, int ldw, int M, int N, int K, const Epi& epi, int g0, int gs) {
    const long n4 = N / 4, total = (long)(M / 4) * n4;
    for (long i = g0; i < total; i += gs) {
        const int r0 = (int)(i / n4) * 4, c0 = (int)(i % n4) * 4;
        float acc[4][4];
#pragma unroll
        for (int a = 0; a < 4; ++a)
#pragma unroll
            for (int b = 0; b < 4; ++b) acc[a][b] = 0.f;
        for (int k = 0; k < K; ++k) {
            float av[4], wv[4];
#pragma unroll
            for (int a = 0; a < 4; ++a) av[a] = ldf(A + (size_t)(r0 + a) * lda + k);
#pragma unroll
            for (int b = 0; b < 4; ++b) wv[b] = W[(size_t)k * ldw + c0 + b];
#pragma unroll
            for (int a = 0; a < 4; ++a)
#pragma unroll
                for (int b = 0; b < 4; ++b) acc[a][b] += av[a] * wv[b];
        }
#pragma unroll
        for (int a = 0; a < 4; ++a)
#pragma unroll
            for (int b = 0; b < 4; ++b) epi(r0 + a, c0 + b, acc[a][b]);
    }
}
HD void in_store(const Prm& p, int r, int c, float v) {
    if (c < 1024) stf((act_t*)(p.ws + WS_P) + (size_t)r * PLD + c, v);
    else if (c < 1032) ((float*)(p.ws + WS_DTRAW))[(size_t)r * 8 + (c - 1024)] = v;
    else if (c < 2056) stf((act_t*)(p.ws + WS_P) + (size_t)r * PLD + (c - 8), v);
    else { const int g = (c - 2056) >> 4, k = (c - 2056) & 15; stf((act_t*)(p.ws + WS_S5A) + ((size_t)g * S5R + (r >> 4)) * 512 + (r & 15) * 16 + k, v); }
}
struct EpiStoreIn { const Prm* p; HDM void operator()(int r, int c, float v) const { in_store(*p, r, c, v); } };
struct EpiStore { act_t* O; int ldo; HDM void operator()(int r, int c, float v) const { stf(O + (size_t)r * ldo + c, v); } };
struct EpiResid { const Prm* p; int layer, which; HDM void operator()(int r, int c, float v) const { const RowInfo q = rowinfo(r); xrow(*p, r)[c] += modp(*p, layer, q.modrow, which)[c] * v; } };
struct EpiUp { const Prm* p; int layer; HDM void operator()(int r, int c, float v) const {
    const RowInfo q = rowinfo(r); const act_t* gt = (const act_t*)(p->ws + WS_GT); const float* cw = p->in[I_FCW] + (size_t)layer * 3 * D_FF; const float* cb = p->in[I_FCB] + (size_t)layer * D_FF;
    float g = cb[c] + cw[D_FF + c] * ldf(gt + (size_t)r * D_FF + c);
    if (q.t > 0) g += cw[c] * ldf(gt + (size_t)(r - 1) * D_FF + c);
    if (q.t < q.T - 1) g += cw[2 * D_FF + c] * ldf(gt + (size_t)(r + 1) * D_FF + c);
    stf((act_t*)(p->ws + WS_ACT) + (size_t)r * D_FF + c, siluf_(g) * v); } };

HD void st_ssd_conv(const Prm& p, int layer, int g0, int gs) {
    const act_t* P = WSP(act_t, WS_P); act_t* xbc = WSP(act_t, WS_XBC);
    const float* cw = p.in[I_SCW] + (size_t)layer * 3 * SSD_XBC; const float* cb = p.in[I_SCB] + (size_t)layer * SSD_XBC;
    for (int i = g0; i < (int)(MT * SSD_XBC); i += gs) {
        const int r = (int)(i / SSD_XBC), c = (int)(i % SSD_XBC); const RowInfo q = rowinfo(r);
        float v = cb[c] + cw[SSD_XBC + c] * ldf(P + (size_t)r * PLD + XBC_OFF + c);
        if (q.t > 0) v += cw[c] * ldf(P + (size_t)(r - 1) * PLD + XBC_OFF + c);
        if (q.t < q.T - 1) v += cw[2 * SSD_XBC + c] * ldf(P + (size_t)(r + 1) * PLD + XBC_OFF + c);
        stf(xbc + i, siluf_(v));
    }
}
HD void st_ssd_cs(const Prm& p, int layer, int g0, int gs) {
    const act_t* P = WSP(act_t, WS_P); float* DT = WSP(float, WS_DT); float* CS = WSP(float, WS_CS);
    for (int i = g0; i < (int)(NCH * 8); i += gs) {
        const int dh = (int)(i % 8), c = (int)(i / 8), d = dh >> 2;
        const float a = -expf(p.in[I_SALOG][layer * 8 + dh]), bias = p.in[I_SDTB][layer * 8 + dh];
        float run = 0.f;
        for (int j = 0; j < 128; ++j) { const int l = d ? 127 - j : j; const size_t r = (size_t)c * 128 + l;
            const float dt = softplusf_(WSP(float, WS_DTRAW)[r * 8 + dh] + bias); run += dt * a; DT[r * 8 + dh] = dt; CS[r * 8 + dh] = run; }
    }
}
HD void st_qk_prep(const Prm& p, int layer, int g0, int gs) {
    act_t* P = WSP(act_t, WS_P); const float* rc = WSP(float, WS_ROPE); const float* rs = rc + (size_t)SEQ * 32;
    for (int i = g0; i < (int)(MT * 12); i += gs) {
        const int r = (int)(i / 12), s = (int)(i % 12); const RowInfo q = rowinfo(r);
        int off; const float* gn = nullptr; float scale = 1.f;
        if (s < 4) { off = GAQ + s * 64; gn = p.in[I_GAQN] + layer * 64; scale = QSCALE; }
        else if (s < 6) { off = GAK + (s - 4) * 64; gn = p.in[I_GAKN] + layer * 64; }
        else if (s < 10) { off = WAQ + (s - 6) * 64; scale = QSCALE; }
        else off = WAK + (s - 10) * 64;
        act_t* v = P + (size_t)r * PLD + off;
        float rn = 1.f;
        if (gn) { float ssq = 0.f; for (int e = 0; e < 64; ++e) { const float x = ldf(v + e); ssq += x * x; } rn = 1.0f / sqrtf(ssq * (1.f / 64.f) + NORM_EPS); }
        for (int e = 0; e < 32; ++e) {
            float x1 = ldf(v + e) * rn, x2 = ldf(v + e + 32) * rn;
            if (gn) { x1 *= gn[e]; x2 *= gn[e + 32]; }
            float o1 = x1, o2 = x2;
            if (!q.isctx) { const float c = rc[(size_t)q.t * 32 + e], sn = rs[(size_t)q.t * 32 + e]; o1 = x1 * c - x2 * sn; o2 = x2 * c + x1 * sn; }
            stf(v + e, o1 * scale); stf(v + e + 32, o2 * scale);
        }
    }
}

HD void st_ssd_state(const Prm& p, int g0, int gs) {
    const act_t* xbc = WSP(act_t, WS_XBC); const float* DT = WSP(float, WS_DT); const float* CS = WSP(float, WS_CS); float* sst = WSP(float, WS_SST);
    for (int i = g0; i < (int)(NCH * 2 * 4 * 64 * 128); i += gs) {
        const int n = (int)(i % 128), pp = (int)((i / 128) % 64), h = (int)((i / 8192) % 4), d = (int)((i / 32768) % 2), c = (int)(i / 65536);
        const int dh = d * 4 + h, g = h >> 1; const size_t r0 = (size_t)c * 128;
        const float aend = CS[(r0 + (d ? 0 : 127)) * 8 + dh];
        float acc = 0.f;
        for (int l = 0; l < 128; ++l) { const size_t r = r0 + l;
            acc += ldf(xbc + r * 768 + 256 + g * 128 + n) * ldf(xbc + r * 768 + h * 64 + pp) * DT[r * 8 + dh] * expf(aend - CS[r * 8 + dh]); }
        sst[i] = acc;
    }
}
HD void st_ssd_cb(const Prm& p, int g0, int gs) {
    const act_t* xbc = WSP(act_t, WS_XBC); float* cb = WSP(float, WS_CB);
    for (int i = g0; i < (int)(NCH * 2 * 128 * 128); i += gs) {
        const int s = (int)(i % 128), l = (int)((i / 128) % 128), g = (int)((i / 16384) % 2), c = (int)(i / 32768); const size_t r0 = (size_t)c * 128;
        float acc = 0.f;
        for (int n = 0; n < 128; ++n) acc += ldf(xbc + (r0 + l) * 768 + 512 + g * 128 + n) * ldf(xbc + (r0 + s) * 768 + 256 + g * 128 + n);
        cb[i] = acc;
    }
}
HD int ssd_chunk_of(int b, int d, int j) {
    constexpr int CC = CTX_LEN / 128, LC = SEQ / 128;
    if (j < CC) return ML / 128 + b * CC + (d ? CC - 1 - j : j);
    const int jj = j - CC; return b * LC + (d ? LC - 1 - jj : jj);
}
HD void st_ssd_carry(const Prm& p, int g0, int gs) {
    float* sst = WSP(float, WS_SST); const float* CS = WSP(float, WS_CS);
    for (int i = g0; i < (int)(BATCH * 2 * 4 * 64 * 128); i += gs) {
        const int e = (int)(i % 8192), h = (int)((i / 8192) % 4), d = (int)((i / 32768) % 2), b = (int)(i / 65536); const int dh = d * 4 + h;
        float hst = 0.f;
        for (int j = 0; j < (CTX_LEN + SEQ) / 128; ++j) { const int c = ssd_chunk_of(b, d, j);
            const float dec = expf(CS[((size_t)c * 128 + (d ? 0 : 127)) * 8 + dh]); float* sp = sst + ((size_t)(c * 2 + d) * 4 + h) * 8192 + e;
            const float tmp = *sp; *sp = hst; hst = hst * dec + tmp; }
    }
}
HD void st_ssd_y(const Prm& p, int layer, int nrows, int g0, int gs) {
    const act_t* xbc = WSP(act_t, WS_XBC); const float* DT = WSP(float, WS_DT); const float* CS = WSP(float, WS_CS); const float* sst = WSP(float, WS_SST); const float* cb = WSP(float, WS_CB);
    act_t* P = WSP(act_t, WS_P);
    for (int i = g0; i < (int)(nrows * 256); i += gs) {
        const int r = (int)(i / 256), hp = (int)(i % 256), h = hp >> 6, pp = hp & 63, g = h >> 1; const int c = r >> 7, l = r & 127; const size_t r0 = (size_t)c * 128;
        float y = p.in[I_SD][layer * 4 + h] * ldf(xbc + (size_t)r * 768 + hp);
        for (int d = 0; d < 2; ++d) { const int dh = d * 4 + h; const float csl = CS[(size_t)r * 8 + dh];
            const int s0 = d ? l : 0, s1 = d ? 127 : l; float acc = 0.f;
            for (int s = s0; s <= s1; ++s) { const size_t rs_ = r0 + s;
                acc += cb[((size_t)(c * 2 + g) * 128 + l) * 128 + s] * expf(csl - CS[rs_ * 8 + dh]) * ldf(xbc + rs_ * 768 + hp) * DT[rs_ * 8 + dh]; }
            float off = 0.f; const float* hin = sst + ((size_t)(c * 2 + d) * 4 + h) * 8192 + (size_t)pp * 128;
            for (int n = 0; n < 128; ++n) off += ldf(xbc + (size_t)r * 768 + 512 + g * 128 + n) * hin[n];
            y += acc + off * expf(csl); }
        stf(P + (size_t)r * PLD + YSSD_OFF + hp, y);
    }
}
HD void st_ssd_out(const Prm& p, int layer, int nrows, int g0, int gs) {
    const act_t* P = WSP(act_t, WS_P); act_t* ym = WSP(act_t, WS_YMIX); const float* ng = p.in[I_SNG] + layer * 256;
    for (int r = g0; r < nrows; r += gs) { float ssq = 0.f;
        for (int c = 0; c < 256; ++c) { const float v = ldf(P + (size_t)r * PLD + YSSD_OFF + c) * siluf_(ldf(P + (size_t)r * PLD + Z_OFF + c)); ssq += v * v; }
        const float rn = 1.0f / sqrtf(ssq * (1.f / 256.f) + NORM_EPS);
        for (int c = 0; c < 256; ++c) { const float v = ldf(P + (size_t)r * PLD + YSSD_OFF + c) * siluf_(ldf(P + (size_t)r * PLD + Z_OFF + c)); stf(ym + (size_t)r * D_MIX + c, v * rn * ng[c]); } }
}

HD void st_s5tabB(const Prm& p, int layer, int g0, int gs) {
    const float* lamp = WSP(float, WS_LAMP) + (size_t)layer * 2 * 16 * 64 * 17 * 2; const float* bbar = WSP(float, WS_BBAR) + (size_t)layer * 2 * 16 * 64 * 16 * 2; const float* kt = WSP(float, WS_KT) + (size_t)layer * 2 * 16 * 16 * 256;
    act_t* BY = WSP(act_t, WS_S5BY); act_t* BE = WSP(act_t, WS_S5BE);
    for (int idx = g0; idx < 16 * 256 * 512; idx += gs) { const int q = idx & 511, ik = (idx >> 9) & 255, g = idx >> 17, i = ik >> 4, k = ik & 15; float v;
        if (q < 256) { const int j = q >> 4, kp = q & 15;
            if (j < i) v = kt[(((size_t)(0 * 16 + g) * 16 + (i - j)) * 16 + k) * 16 + kp];
            else if (j > i) v = kt[(((size_t)(1 * 16 + g) * 16 + (j - i)) * 16 + k) * 16 + kp];
            else v = kt[(((size_t)(0 * 16 + g) * 16) * 16 + k) * 16 + kp] + kt[(((size_t)(1 * 16 + g) * 16) * 16 + k) * 16 + kp] + (k == kp ? p.in[I_S5D][layer * 256 + g * 16 + k] : 0.f); }
        else { const int dd = (q - 256) >> 7, n = ((q - 256) & 127) >> 1, c = q & 1, pw = dd ? 16 - i : i + 1; const size_t dg = (size_t)(layer * 2 + dd) * 16 + g, dgn = (size_t)(dd * 16 + g) * 64 + n;
            const float cr = p.in[I_CRE][(dg * 16 + k) * 64 + n], ci = p.in[I_CIM][(dg * 16 + k) * 64 + n], lr = lamp[(dgn * 17 + pw) * 2], li = lamp[(dgn * 17 + pw) * 2 + 1];
            v = c ? -(cr * li + ci * lr) : (cr * lr - ci * li); }
        stf(BY + idx, v); }
    for (int idx = g0; idx < 16 * 256 * 256; idx += gs) { const int q = idx & 255, rr = (idx >> 8) & 255, g = idx >> 16, dd = rr >> 7, n = (rr & 127) >> 1, c = rr & 1, j = q >> 4, kp = q & 15, pw = dd ? j : 15 - j;
        const size_t dgn = (size_t)(dd * 16 + g) * 64 + n; const float lr = lamp[(dgn * 17 + pw) * 2], li = lamp[(dgn * 17 + pw) * 2 + 1], br = bbar[(dgn * 16 + kp) * 2], bi = bbar[(dgn * 16 + kp) * 2 + 1];
        stf(BE + idx, c ? (lr * bi + li * br) : (lr * br - li * bi)); }
}
HD void st_s5_E_naive(const Prm& p, int g0, int gs) {
    const act_t* A = WSP(act_t, WS_S5A); const act_t* BE = WSP(act_t, WS_S5BE); float* E = WSP(float, WS_S5E);
    for (int idx = g0; idx < 16 * NSC * 256; idx += gs) { const int rr = idx & 255, sc = (idx >> 8) % NSC, g = (idx >> 8) / NSC; float acc = 0.f;
        for (int q = 0; q < 256; ++q) acc += ldf(A + ((size_t)g * S5R + sc) * 512 + q) * ldf(BE + ((size_t)g * 256 + rr) * 256 + q);
        E[idx] = acc; }
}
HD int s5_sc_of(int b, int d, int j) {
    constexpr int CC = CTX_LEN / 16, LC = SEQ / 16;
    if (j < CC) return ML / 16 + b * CC + (d ? CC - 1 - j : j);
    const int jj = j - CC; return b * LC + (d ? LC - 1 - jj : jj);
}
HD void st_s5_carry(const Prm& p, int layer, int g0, int gs) {
    const float* lamp = WSP(float, WS_LAMP) + (size_t)layer * 2 * 16 * 64 * 17 * 2; const float* E = WSP(float, WS_S5E); act_t* A = WSP(act_t, WS_S5A);
    for (int i = g0; i < BATCH * 2 * 16 * 64; i += gs) {
        const int n = i & 63, g = (i >> 6) & 15, d = (i >> 10) & 1, b = i >> 11; const size_t dgn = (size_t)(d * 16 + g) * 64 + n;
        const float lr = lamp[(dgn * 17 + 16) * 2], li = lamp[(dgn * 17 + 16) * 2 + 1];
        float hr = 0.f, hi = 0.f;
        for (int j = 0; j < (CTX_LEN + SEQ) / 16; ++j) { const int sc = s5_sc_of(b, d, j); const float* e = E + ((size_t)g * NSC + sc) * 256 + d * 128 + 2 * n; act_t* a = A + ((size_t)g * S5R + sc) * 512 + 256 + d * 128 + 2 * n;
            const float tr = e[0], ti = e[1]; stf(a, hr); stf(a + 1, hi); const float nr = lr * hr - li * hi + tr, ni = lr * hi + li * hr + ti; hr = nr; hi = ni; }
    }
}
HD void s5y_store(const Prm& p, int g, int sc, int ik, float v) { const int r = sc * 16 + (ik >> 4); stf((act_t*)(p.ws + WS_P) + (size_t)r * PLD + YS5_OFF + g * 16 + (ik & 15), geluf_(v)); }
HD void st_s5_Y_naive(const Prm& p, int nrows, int g0, int gs) {
    const act_t* A = WSP(act_t, WS_S5A); const act_t* BY = WSP(act_t, WS_S5BY);
    for (int idx = g0; idx < 16 * (nrows / 16) * 256; idx += gs) { const int ik = idx & 255, sc = (idx >> 8) % (nrows / 16), g = (idx >> 8) / (nrows / 16); float acc = 0.f;
        for (int q = 0; q < 512; ++q) acc += ldf(A + ((size_t)g * S5R + sc) * 512 + q) * ldf(BY + ((size_t)g * 256 + ik) * 512 + q);
        s5y_store(p, g, sc, ik, acc); }
}
HD void st_glu(const Prm& p, int layer, int nrows, int g0, int gs) {
    const act_t* P = WSP(act_t, WS_P); act_t* ym = WSP(act_t, WS_YMIX); const float* w = p.in[I_WGLU] + (size_t)layer * 256 * 512; const float* bg = p.in[I_BGLU] + layer * 512;
    for (int i = g0; i < (int)(nrows * 256); i += gs) { const int r = (int)(i / 256), n = (int)(i % 256); float a = bg[n], g = bg[256 + n];
        for (int k = 0; k < 256; ++k) { const float y = ldf(P + (size_t)r * PLD + YS5_OFF + k); a += y * w[(size_t)k * 512 + n]; g += y * w[(size_t)k * 512 + 256 + n]; }
        stf(ym + (size_t)r * D_MIX + 768 + n, a * sigmoidf_(g)); }
}

struct AttnAcc { float m, l; float o[32]; };
#ifdef CPU_TEST
HD void ld8(const act_t* p, float* o) { for (int e = 0; e < 8; ++e) o[e] = p[e]; }
#else
typedef unsigned u32x4_t __attribute__((ext_vector_type(4)));
HD void ld8(const act_t* p, float* o) { const u32x4_t v = *(const u32x4_t*)p;
#pragma unroll
    for (int e = 0; e < 4; ++e) { o[2 * e] = __uint_as_float(v[e] << 16); o[2 * e + 1] = __uint_as_float(v[e] & 0xffff0000u); } }
#endif
HD void attn_seg(AttnAcc& A, const act_t* q, const act_t* P, int row0, int cnt, int koff, int voff) {
#pragma clang loop unroll(disable)
    for (int j = 0; j < cnt; ++j) { const act_t* kr = P + (size_t)(row0 + j) * PLD;
        float s = 0.f;
#pragma clang loop unroll(disable)
        for (int c = 0; c < 8; ++c) { float qv[8], kv[8]; ld8(q + c * 8, qv); ld8(kr + koff + c * 8, kv);
#pragma unroll
            for (int e = 0; e < 8; ++e) s += qv[e] * kv[e]; }
        if (s > A.m) { const float f = expf(A.m - s); A.l *= f;
#pragma unroll
            for (int e = 0; e < 32; ++e) A.o[e] *= f;
            A.m = s; }
        const float pexp = expf(s - A.m); A.l += pexp;
#pragma unroll
        for (int c = 0; c < 4; ++c) { float vv[8]; ld8(kr + voff + c * 8, vv);
#pragma unroll
            for (int e = 0; e < 8; ++e) A.o[c * 8 + e] += pexp * vv[e]; } }
}
HD void st_attn(const Prm& p, int layer, int nrows, int g0, int gs) {
    const act_t* P = WSP(act_t, WS_P); act_t* ym = WSP(act_t, WS_YMIX);
    for (int i = g0; i < (int)(nrows * 16); i += gs) {
        const int r = (int)(i / 16), s = (int)((i % 16) >> 1), half = (int)(i & 1); const RowInfo qi = rowinfo(r); const int isw = s >= 4, hq = s & 3, kv = hq >> 1;
        const int qoff = (isw ? WAQ : GAQ) + hq * 64, koff = (isw ? WAK : GAK) + kv * 64, voff = (isw ? WAV : GAV) + kv * 64 + half * 32;
        const act_t* q = P + (size_t)r * PLD + qoff;
        AttnAcc A; A.m = -1e30f; A.l = 0.f;
#pragma unroll
        for (int e = 0; e < 32; ++e) A.o[e] = 0.f;
        attn_seg(A, q, P, ML + qi.b * CTX_LEN, CTX_LEN, koff, voff);
        if (!qi.isctx) {
            if (!isw) attn_seg(A, q, P, qi.b * SEQ, SEQ, koff, voff);
            else { const int t0 = qi.t - 128 < 0 ? 0 : qi.t - 128, t1 = qi.t + 128 > SEQ - 1 ? SEQ - 1 : qi.t + 128; attn_seg(A, q, P, qi.b * SEQ + t0, t1 - t0 + 1, koff, voff); }
        }
        if (isw) { const float sk = p.in[I_SINK][layer * 4 + hq]; if (sk > A.m) { const float f = expf(A.m - sk); A.l *= f;
#pragma unroll
                for (int e = 0; e < 32; ++e) A.o[e] *= f;
                A.m = sk; }
            A.l += expf(sk - A.m); }
        const float inv = 1.f / A.l;
#pragma unroll
        for (int e = 0; e < 32; ++e) stf(ym + (size_t)r * D_MIX + 256 + s * 64 + half * 32 + e, A.o[e] * inv);
    }
}

enum { S_SYNC = 0, S_MOD, S_INIT, S_TAB1, S_TAB2, S_ROWSS, S_NORM_MIX, S_GEMM_IN, S_CONV, S_CS, S_QK, S_STATE, S_CB, S_S5E, S_ATTN, S_SSD_CARRY, S_S5_CARRY,
       S_SSD_Y, S_S5_Y, S_SSD_OUT, S_GLU, S_GEMM_OUT, S_NORM_FFN, S_GEMM_GATE, S_GEMM_UP, S_GEMM_DOWN, S_ROWSS_FIN, S_FINAL, S_WPREP, S_MODR, S_TABB, S_GEMM_GU, S_FIXUP, S_SUBGLU, S_WPREP2, S_ATTNC };
struct Step { int st, layer; };
#define LAYER_STEPS(L) {S_WPREP, L}, {S_TABB, L}, {S_ROWSS, L}, {S_SYNC, 0}, {S_NORM_MIX, L}, {S_SYNC, 0}, {S_GEMM_IN, L}, {S_SYNC, 0}, {S_CONV, L}, {S_CS, L}, {S_QK, L}, {S_SYNC, 0}, \
    {S_STATE, L}, {S_CB, L}, {S_S5E, L}, {S_ATTN, L}, {S_SYNC, 0}, {S_SSD_CARRY, L}, {S_S5_CARRY, L}, {S_SYNC, 0}, {S_SSD_Y, L}, {S_S5_Y, L}, {S_SYNC, 0}, \
    {S_SSD_OUT, L}, {S_GLU, L}, {S_SYNC, 0}, {S_GEMM_OUT, L}, {S_SYNC, 0}, {S_ROWSS, L}, {S_SYNC, 0}, {S_NORM_FFN, L}, {S_SYNC, 0}, {S_GEMM_GATE, L}, {S_SYNC, 0}, \
    {S_GEMM_UP, L}, {S_SYNC, 0}, {S_GEMM_DOWN, L}, {S_SYNC, 0}
#ifdef CPU_TEST
static const Step PROG[] = {
#else
__constant__ Step PROG_D[] = {
#endif
    {S_MOD, 0}, {S_INIT, 0}, {S_TAB1, 0}, {S_SYNC, 0}, {S_TAB2, 0}, {S_SYNC, 0}, LAYER_STEPS(0), LAYER_STEPS(1), {S_ROWSS_FIN, 0}, {S_SYNC, 0}, {S_FINAL, 0} };
#ifndef CPU_TEST
static const Step PROG[] = { {S_MOD, 0}, {S_INIT, 0}, {S_TAB1, 0}, {S_SYNC, 0}, {S_TAB2, 0}, {S_SYNC, 0}, LAYER_STEPS(0), LAYER_STEPS(1), {S_ROWSS_FIN, 0}, {S_SYNC, 0}, {S_FINAL, 0} };
#endif
constexpr int NPROG = 6 + 2 * 38 + 3;

#ifndef CPU_TEST
#define LAS __attribute__((address_space(3)))
__device__ __forceinline__ int BIDX_() { int v = blockIdx.x; asm volatile("" : "+s"(v)); return v; }
__device__ __forceinline__ int GDIM_() { int v = gridDim.x; asm volatile("" : "+s"(v)); return v; }
constexpr int MISC_OFF_ = 131072, WTAB_ = 32;
__device__ __forceinline__ int HWSLOT_() { return (int)(__builtin_amdgcn_s_getreg((5 << 11) | 4) & 0x3f); }
__device__ __forceinline__ int TID_() { extern __shared__ __attribute__((aligned(16))) unsigned char l_dyn_[];
    const int w = __builtin_amdgcn_readfirstlane(((volatile LAS int*)((LAS unsigned char*)l_dyn_ + MISC_OFF_))[WTAB_ + HWSLOT_()]);
    unsigned m_ = ~0u; asm volatile("" : "+s"(m_));
    return w * 64 + (int)__builtin_amdgcn_mbcnt_hi(m_, __builtin_amdgcn_mbcnt_lo(m_, 0u)); }
namespace pg8 {
#define PG8_LAS __attribute__((address_space(3)))
typedef unsigned short bf16_t;
typedef short bf16x8 __attribute__((ext_vector_type(8)));
typedef float f32x4 __attribute__((ext_vector_type(4)));
typedef unsigned u32x4 __attribute__((ext_vector_type(4)));
constexpr int BM = 256, BK = 64, HALF = 128, HTB = HALF * BK * 2  , STAGE_BYTES = 8 * HTB, NXCD = 8, WGM = 8;

__host__ __device__ __forceinline__ int lds_byte(int r, int c) { const int st = (r >> 4) * 2 + (c >> 5), rr = r & 15, cc = c & 31, ob = rr * 64 + cc * 2; return st * 1024 + (ob ^ (((ob >> 9) & 1) << 5)); }
__host__ __device__ __forceinline__ void stage_rc(int b, int& R, int& C) { const int st = b / 1024, sb = b % 1024, swz = sb ^ (((sb >> 9) & 1) << 5); R = (st >> 1) * 16 + swz / 64; C = (st & 1) * 32 + (swz % 64) / 2; }
__host__ __device__ __forceinline__ int perm32(int rho) { const int n = rho >> 4, i = rho & 15; return 8 * (i >> 2) + 4 * n + (i & 3); }

struct Unit { int pm, pn, kb = 0, nt = 0; };
struct Gemm { const bf16_t* A; const bf16_t* Bt; int M, N, K, lda; };

struct StaticOrder {
    int nM, nN, nwg, G, c;
    __host__ __device__ void init(int M, int N, int G_, int c_) { nM = M / BM; nN = N / BM; nwg = nM * nN; G = G_; c = c_; }
    __host__ __device__ bool next(int i, Unit& u) const {
        const long L = (long)i * G + c; if (L >= nwg) return false;
        int wgid = (int)L; { const int q = nwg / NXCD, r = nwg % NXCD, xcd = wgid % NXCD, off = wgid / NXCD; wgid = (xcd < r ? xcd * (q + 1) : r * (q + 1) + (xcd - r) * q) + off; }
        const int nig = WGM * nN, gid = wgid / nig, fm = gid * WGM, gsz = (nM - fm) < WGM ? (nM - fm) : WGM;
        u.pm = fm + ((wgid % nig) % gsz); u.pn = (wgid % nig) / gsz; return true;
    }
    __device__ __forceinline__ void a_ready(const Unit&) const {}
    __device__ __forceinline__ void done(const Unit&) const {}
};

__device__ __forceinline__ unsigned cvt_pk_bf16(float lo, float hi) { unsigned r; asm volatile("v_cvt_pk_bf16_f32 %0, %1, %2" : "=v"(r) : "v"(lo), "v"(hi)); return r; }
typedef float f32x2 __attribute__((ext_vector_type(2)));
__device__ __forceinline__ void st_wt(f32x4* p, f32x4 v) { asm volatile("global_store_dwordx4 %0, %1, off sc1\n\ts_nop 1" :: "v"(p), "v"(v) : "memory"); }
__device__ __forceinline__ void st_wt(u32x4* p, u32x4 v) { asm volatile("global_store_dwordx4 %0, %1, off sc1\n\ts_nop 1" :: "v"(p), "v"(v) : "memory"); }
typedef unsigned u32x2w __attribute__((ext_vector_type(2)));
__device__ __forceinline__ void st_wt(u32x2w* p, u32x2w v) { asm volatile("global_store_dwordx2 %0, %1, off sc1" :: "v"(p), "v"(v) : "memory"); }
__device__ __forceinline__ f32x2 gelu_pk(f32x2 v) {
    const f32x2 av = __builtin_elementwise_abs(v), d = av * 0.2316418882f + 1.0f;
    f32x2 t; t.x = __builtin_amdgcn_rcpf(d.x); t.y = __builtin_amdgcn_rcpf(d.y);
    f32x2 q = t * 0.5307027145f + (-0.7265760135f); q = q * t + 0.7107068705f; q = q * t + (-0.142248368f); q = q * t + 0.127414796f; q = q * t;
    const f32x2 s = (v * v) * (-0.72134752044f);
    f32x2 e; e.x = __builtin_amdgcn_exp2f(s.x); e.y = __builtin_amdgcn_exp2f(s.y);
    const f32x2 m = v * (q * e), r = v - m;
    f32x2 o; o.x = v.x < 0.f ? m.x : r.x; o.y = v.y < 0.f ? m.y : r.y; return o;
}

template <int ACT  > struct EpiBf16 {
    static constexpr bool PERM = true, AFTER_DRAIN = false; static_assert(ACT == 0 || ACT == 1, "EpiBf16: ACT is 0 (none) or 1 (gelu_pk)");
    bf16_t* O; int ldc; const float* bias; int split_cols; size_t split_stride; float scale0;
    __device__ __forceinline__ void operator()(const f32x4 (&acc)[2][2][4][2], const Unit& u, int wr, int wc, int fr, int fq) const {
        const int row0 = u.pm * BM + wr * 64 + fr; int colt = u.pn * BM; bf16_t* base = O;
        float sc = 1.f; if (split_cols) { const int t = colt / split_cols; base += (size_t)t * split_stride; colt -= t * split_cols; if (t == 0) sc = scale0; }
        const int col0 = colt + wc * 32 + 8 * fq, bcol0 = u.pn * BM + wc * 32 + 8 * fq;
        f32x4 bv[2][2];
#pragma unroll
        for (int bj = 0; bj < 2; ++bj)
#pragma unroll
            for (int n = 0; n < 2; ++n) bv[bj][n] = bias ? *(const f32x4*)(bias + bcol0 + bj * HALF + 4 * n) : (f32x4){0.f, 0.f, 0.f, 0.f};
#pragma unroll
        for (int ai = 0; ai < 2; ++ai)
#pragma unroll
            for (int m = 0; m < 4; ++m) { bf16_t* rowp = base + (size_t)(row0 + ai * HALF + m * 16) * ldc + col0;
#pragma unroll
                for (int bj = 0; bj < 2; ++bj) { f32x4 v0 = acc[ai][bj][m][0] + bv[bj][0], v1 = acc[ai][bj][m][1] + bv[bj][1];
                    if (ACT == 1) { f32x2 a = gelu_pk((f32x2){v0[0], v0[1]}), b = gelu_pk((f32x2){v0[2], v0[3]}), c = gelu_pk((f32x2){v1[0], v1[1]}), d = gelu_pk((f32x2){v1[2], v1[3]});
                        v0 = (f32x4){a.x, a.y, b.x, b.y}; v1 = (f32x4){c.x, c.y, d.x, d.y}; }
                    v0 = v0 * sc; v1 = v1 * sc; u32x4 w; w.x = cvt_pk_bf16(v0[0], v0[1]); w.y = cvt_pk_bf16(v0[2], v0[3]); w.z = cvt_pk_bf16(v1[0], v1[1]); w.w = cvt_pk_bf16(v1[2], v1[3]);
                    *(u32x4*)(rowp + bj * HALF) = w; } }
    }
};
template <class Epi, class Sched, bool ALIGN_EPI = false, bool SP2 = false>
__device__ __forceinline__ void gemm_phase(PG8_LAS unsigned char* lds, const Gemm g, const Sched& S, const Epi& E) {
    const int tid = TID_(),
        wid = __builtin_amdgcn_readfirstlane(tid >> 6), lane = tid & 63, wr = wid >> 2, wc = wid & 3, fr = lane & 15, fq = lane >> 4;
    const int K = g.K, nt = K / BK;
    unsigned voffA[2], voffB[2];
#pragma unroll
    for (int i = 0; i < 2; ++i) { int R, C; stage_rc(tid * 16 + i * 8192, R, C); const int Rb = Epi::PERM ? ((R & ~31) + perm32(R & 31)) : R;
        voffA[i] = (unsigned)(R * g.lda + C) * 2u; voffB[i] = (unsigned)(Rb * K + C) * 2u; }
    const size_t kstep = (size_t)(BK * 2);
    const size_t hstepA = (size_t)HALF * g.lda * 2, hstepB = (size_t)HALF * K * 2;
    const size_t tstepA = 2 * hstepA, tstepB = 2 * hstepB;
    const unsigned ldsw = (unsigned)wid * 1024u;
    const int aoff = lds_byte(wr * 64 + fr, fq * 8), boff = lds_byte(wc * 32 + fr, fq * 8);
#define PG8_SA(b, h) (((b) * 2 + (h)) * HTB)
#define PG8_SB(b, h) ((4 + (b) * 2 + (h)) * HTB)
#define PG8_STAGE(bufoff, gbase, voff) do { _Pragma("unroll") for (int _i = 0; _i < 2; ++_i) \
        __builtin_amdgcn_global_load_lds((const unsigned*)((const char*)(gbase) + (voff)[_i]), (PG8_LAS unsigned*)(lds + (bufoff) + ldsw + _i * 8192), 16, 0, 0); } while (0)
#define PG8_LDA(dst, b, h) do { _Pragma("unroll") for (int m = 0; m < 4; ++m) _Pragma("unroll") for (int k = 0; k < 2; ++k) dst[m][k] = *(const PG8_LAS bf16x8*)(lds + PG8_SA(b, h) + aoff + m * 2048 + k * 1024); } while (0)
#define PG8_LDB(dst, b, h) do { _Pragma("unroll") for (int n = 0; n < 2; ++n) _Pragma("unroll") for (int k = 0; k < 2; ++k) dst[n][k] = *(const PG8_LAS bf16x8*)(lds + PG8_SB(b, h) + boff + n * 2048 + k * 1024); } while (0)
#define PG8_MMA(ai, bj, At, Bt) do { __builtin_amdgcn_s_setprio(1); _Pragma("unroll") for (int m = 0; m < 4; ++m) _Pragma("unroll") for (int n = 0; n < 2; ++n) _Pragma("unroll") for (int k = 0; k < 2; ++k) \
        acc[ai][bj][m][n] = __builtin_amdgcn_mfma_f32_16x16x32_bf16(Bt[n][k], At[m][k], acc[ai][bj][m][n], 0, 0, 0); __builtin_amdgcn_s_setprio(0); } while (0)
#define PG8_WAIT_V(n) asm volatile("s_waitcnt vmcnt(" #n ")" ::: "memory")
#define PG8_WAIT_L(n) asm volatile("s_waitcnt lgkmcnt(" #n ")" ::: "memory")
#define PG8_BAR __builtin_amdgcn_s_barrier()
#define PG8_SCHED __builtin_amdgcn_sched_barrier(0)
    Unit cur, nxt; int ui = 0;
    if (!S.next(0, cur)) return;
    f32x4 acc[2][2][4][2];
#pragma unroll
    for (int a = 0; a < 2; ++a)
#pragma unroll
        for (int b = 0; b < 2; ++b)
#pragma unroll
            for (int m = 0; m < 4; ++m)
#pragma unroll
                for (int n = 0; n < 2; ++n) acc[a][b][m][n] = (f32x4){0.f, 0.f, 0.f, 0.f};
    bf16x8 At[4][2], B0[2][2], B1[2][2];
    const char* cA = (const char*)g.A + (size_t)cur.pm * tstepA + cur.kb; const char* cB = (const char*)g.Bt + (size_t)cur.pn * tstepB + cur.kb;
    S.a_ready(cur);
    if constexpr (SP2) {
        PG8_STAGE(PG8_SB(0, 0), cB, voffB); PG8_STAGE(PG8_SB(0, 1), cB + hstepB, voffB); PG8_STAGE(PG8_SA(0, 0), cA, voffA); PG8_STAGE(PG8_SA(0, 1), cA + hstepA, voffA);
        if (wr == 1) PG8_BAR;
        PG8_WAIT_V(2); PG8_BAR;
        PG8_STAGE(PG8_SB(1, 0), cB + kstep, voffB); PG8_STAGE(PG8_SA(1, 0), cA + kstep, voffA); PG8_STAGE(PG8_SB(1, 1), cB + hstepB + kstep, voffB);
        PG8_WAIT_V(6); PG8_BAR;
    } else {
        PG8_STAGE(PG8_SB(0, 0), cB, voffB); PG8_STAGE(PG8_SA(0, 0), cA, voffA); PG8_STAGE(PG8_SB(0, 1), cB + hstepB, voffB); PG8_STAGE(PG8_SA(0, 1), cA + hstepA, voffA);
        if (wr == 1) PG8_BAR;
        PG8_WAIT_V(4); PG8_BAR;
        PG8_STAGE(PG8_SB(1, 0), cB + kstep, voffB); PG8_STAGE(PG8_SA(1, 0), cA + kstep, voffA); PG8_STAGE(PG8_SB(1, 1), cB + hstepB + kstep, voffB);
        PG8_WAIT_V(6); PG8_BAR;
    }
    for (;;) {
        const bool has_next = S.next(ui + 1, nxt);
        const char* nA = has_next ? (const char*)g.A + (size_t)nxt.pm * tstepA + nxt.kb : cA; const char* nB = has_next ? (const char*)g.Bt + (size_t)nxt.pn * tstepB + nxt.kb : cB;
        const int unt = cur.nt ? cur.nt : nt;
        for (int t = 0; t < unt; t += 2) {
            const bool last = (t == unt - 2);
            const char* a1 = cA + (size_t)(t + 1) * kstep;
            const char* a2 = last ? nA : cA + (size_t)(t + 2) * kstep; const char* b2 = last ? nB : cB + (size_t)(t + 2) * kstep;
            const char* a3 = a2 + kstep; const char* b3 = b2 + kstep;
            if (last && has_next) S.a_ready(nxt);
            if constexpr (SP2) {
            PG8_LDB(B0, 0, 0); PG8_LDB(B1, 0, 1); PG8_SCHED; PG8_LDA(At, 0, 0); PG8_STAGE(PG8_SA(1, 1), a1 + hstepA, voffA);
            PG8_WAIT_V(8); PG8_WAIT_L(0); PG8_BAR; PG8_MMA(0, 0, At, B0); PG8_MMA(0, 1, At, B1); PG8_BAR; PG8_SCHED;
            PG8_LDA(At, 0, 1); PG8_STAGE(PG8_SB(0, 0), b2, voffB); PG8_STAGE(PG8_SB(0, 1), b2 + hstepB, voffB); PG8_STAGE(PG8_SA(0, 0), a2, voffA);
            PG8_WAIT_V(8); PG8_WAIT_L(0); PG8_BAR; PG8_MMA(1, 0, At, B0); PG8_MMA(1, 1, At, B1); PG8_BAR; PG8_SCHED;
            PG8_LDB(B0, 1, 0); PG8_LDB(B1, 1, 1); PG8_SCHED; PG8_LDA(At, 1, 0); PG8_STAGE(PG8_SA(0, 1), a2 + hstepA, voffA);
            PG8_WAIT_V(8); PG8_WAIT_L(0); PG8_BAR; PG8_MMA(0, 0, At, B0); PG8_MMA(0, 1, At, B1); PG8_BAR; PG8_SCHED;
            PG8_LDA(At, 1, 1); PG8_STAGE(PG8_SB(1, 0), b3, voffB); PG8_STAGE(PG8_SB(1, 1), b3 + hstepB, voffB); PG8_STAGE(PG8_SA(1, 0), a3, voffA);
            PG8_WAIT_V(8); PG8_WAIT_L(0); PG8_BAR; PG8_MMA(1, 0, At, B0); PG8_MMA(1, 1, At, B1); PG8_BAR; PG8_SCHED;
            } else {
            PG8_LDB(B0, 0, 0); PG8_SCHED; PG8_LDA(At, 0, 0); PG8_STAGE(PG8_SA(1, 1), a1 + hstepA, voffA);
            PG8_WAIT_L(8); PG8_BAR; PG8_WAIT_L(0); PG8_MMA(0, 0, At, B0); PG8_BAR; PG8_SCHED;
            PG8_LDB(B1, 0, 1); PG8_STAGE(PG8_SB(0, 0), b2, voffB);
            PG8_BAR; PG8_WAIT_L(0); PG8_MMA(0, 1, At, B1); PG8_BAR;
            PG8_LDA(At, 0, 1); PG8_STAGE(PG8_SA(0, 0), a2, voffA);
            PG8_BAR; PG8_WAIT_L(0); PG8_MMA(1, 0, At, B0); PG8_BAR; PG8_SCHED;
            PG8_STAGE(PG8_SB(0, 1), b2 + hstepB, voffB);
            PG8_WAIT_V(6); PG8_BAR; PG8_MMA(1, 1, At, B1); PG8_BAR;
            PG8_LDB(B0, 1, 0); PG8_SCHED; PG8_LDA(At, 1, 0); PG8_STAGE(PG8_SA(0, 1), a2 + hstepA, voffA);
            PG8_WAIT_L(8); PG8_BAR; PG8_WAIT_L(0); PG8_MMA(0, 0, At, B0); PG8_BAR; PG8_SCHED;
            PG8_LDB(B1, 1, 1); PG8_STAGE(PG8_SB(1, 0), b3, voffB);
            PG8_BAR; PG8_WAIT_L(0); PG8_MMA(0, 1, At, B1); PG8_BAR;
            PG8_LDA(At, 1, 1); PG8_STAGE(PG8_SA(1, 0), a3, voffA);
            PG8_BAR; PG8_WAIT_L(0); PG8_MMA(1, 0, At, B0); PG8_BAR; PG8_SCHED;
            PG8_STAGE(PG8_SB(1, 1), b3 + hstepB, voffB);
            PG8_WAIT_V(6); PG8_BAR; PG8_MMA(1, 1, At, B1); PG8_BAR;
            }
        }
        if constexpr (ALIGN_EPI) { if (wr == 0) PG8_BAR; }
        if constexpr (!Epi::AFTER_DRAIN) { E(acc, cur, wr, wc, fr, fq); S.done(cur); }
        if (!has_next) break;
#pragma unroll
        for (int a = 0; a < 2; ++a)
#pragma unroll
            for (int b = 0; b < 2; ++b)
#pragma unroll
                for (int m = 0; m < 4; ++m)
#pragma unroll
                    for (int n = 0; n < 2; ++n) acc[a][b][m][n] = (f32x4){0.f, 0.f, 0.f, 0.f};
        cur = nxt; cA = nA; cB = nB; ++ui;
        if constexpr (ALIGN_EPI) { if (wr == 1) PG8_BAR; }
    }
    PG8_WAIT_V(0);
    if constexpr (!ALIGN_EPI) { if (wr == 0) PG8_BAR; }
    PG8_BAR;
    if constexpr (Epi::AFTER_DRAIN) { E.fused(acc, cur, wr, wc, fr, fq, lds, wid, lane); S.done(cur); }
#undef PG8_SA
#undef PG8_SB
#undef PG8_STAGE
#undef PG8_LDA
#undef PG8_LDB
#undef PG8_MMA
#undef PG8_WAIT_V
#undef PG8_WAIT_L
#undef PG8_BAR
#undef PG8_SCHED
}
}

namespace pg8 {
struct EpiResidM {
    static constexpr bool PERM = false, AFTER_DRAIN = false;
    float* xlat; float* xctx; const float* slat; const float* sctx; const float* mod; int which; float* slab; int ntk_;
    __device__ __forceinline__ void operator()(const f32x4 (&acc)[2][2][4][2], const Unit& u, int wr, int wc, int fr, int fq) const {
        const int modrow = u.pm < ML / 256 ? (u.pm * 256) / SEQ : BATCH;
        const float* gp = mod + ((size_t)modrow * 6 + which) * D_MODEL;
        const int col0 = u.pn * BM + wc * 32 + 4 * fq;
        f32x4 gv[2][2], res[2][2][4][2];
        if (u.nt) {
            const int sl = u.kb / (BK * 2) / ((((ntk_ / 4) + 1) & ~1));
#pragma unroll
            for (int ai = 0; ai < 2; ++ai)
#pragma unroll
                for (int m = 0; m < 4; ++m) { const int r = u.pm * BM + ai * HALF + wr * 64 + m * 16 + fr - ML; float* sr = slab + ((size_t)sl * MC + r) * D_MODEL + col0;
#pragma unroll
                    for (int bj = 0; bj < 2; ++bj)
#pragma unroll
                        for (int n = 0; n < 2; ++n) *(f32x4*)(sr + bj * HALF + n * 16) = acc[ai][bj][m][n]; }
            return; }
#pragma unroll
        for (int bj = 0; bj < 2; ++bj)
#pragma unroll
            for (int n = 0; n < 2; ++n) gv[bj][n] = *(const f32x4*)(gp + col0 + bj * HALF + n * 16);
#pragma unroll
        for (int ai = 0; ai < 2; ++ai)
#pragma unroll
            for (int m = 0; m < 4; ++m) { const int r = u.pm * BM + ai * HALF + wr * 64 + m * 16 + fr;
                const float* xs = (r < ML ? slat + (size_t)r * D_MODEL : sctx + (size_t)(r - ML) * D_MODEL) + col0;
#pragma unroll
                for (int bj = 0; bj < 2; ++bj)
#pragma unroll
                    for (int n = 0; n < 2; ++n) res[ai][bj][m][n] = *(const f32x4*)(xs + bj * HALF + n * 16) + gv[bj][n] * acc[ai][bj][m][n]; }
        asm volatile("" ::: "memory");
#pragma unroll
        for (int ai = 0; ai < 2; ++ai)
#pragma unroll
            for (int m = 0; m < 4; ++m) { const int r = u.pm * BM + ai * HALF + wr * 64 + m * 16 + fr;
                float* xr = (r < ML ? xlat + (size_t)r * D_MODEL : xctx + (size_t)(r - ML) * D_MODEL) + col0;
#pragma unroll
                for (int bj = 0; bj < 2; ++bj)
#pragma unroll
                    for (int n = 0; n < 2; ++n) st_wt((f32x4*)(xr + bj * HALF + n * 16), res[ai][bj][m][n]); }
    }
};
__device__ __forceinline__ void unpack8(const u32x4 v, float* o) {
#pragma unroll
    for (int e = 0; e < 4; ++e) { o[2 * e] = __uint_as_float(v[e] << 16); o[2 * e + 1] = __uint_as_float(v[e] & 0xffff0000u); } }
struct EpiUpM {
    static constexpr bool PERM = true, AFTER_DRAIN = false;
    const bf16_t* GT; bf16_t* ACT; const float* cw; const float* cb;
    __device__ __forceinline__ void ldbatch(int b, const Unit& u, int wr, int wc, int fr, int fq, u32x4& gm, u32x4& gl, u32x4& gh) const {
        const int bj = b >> 3, ai = (b >> 2) & 1, m = b & 3, c = u.pn * BM + bj * HALF + wc * 32 + 8 * fq;
        const int r = u.pm * BM + ai * HALF + wr * 64 + m * 16 + fr;
        const int t = r < ML ? r % SEQ : (r - ML) % CTX_LEN, T = r < ML ? SEQ : CTX_LEN; const bf16_t* gp = GT + (size_t)r * D_FF + c;
        gm = *(const u32x4*)gp; gl = (u32x4){0u, 0u, 0u, 0u}; gh = (u32x4){0u, 0u, 0u, 0u};
        if (t > 0) gl = *(const u32x4*)(gp - D_FF);
        if (t < T - 1) gh = *(const u32x4*)(gp + D_FF);
    }
    __device__ __forceinline__ void operator()(const f32x4 (&acc)[2][2][4][2], const Unit& u, int wr, int wc, int fr, int fq) const {
        u32x4 gmA, glA, ghA, gmB, glB, ghB;
        ldbatch(0, u, wr, wc, fr, fq, gmA, glA, ghA);
#pragma unroll
        for (int bj = 0; bj < 2; ++bj) { const int c = u.pn * BM + bj * HALF + wc * 32 + 8 * fq;
            f32x4 w0[2], w1[2], w2[2], bb[2];
#pragma unroll
            for (int q = 0; q < 2; ++q) { w0[q] = *(const f32x4*)(cw + c + 4 * q); w1[q] = *(const f32x4*)(cw + D_FF + c + 4 * q); w2[q] = *(const f32x4*)(cw + 2 * D_FF + c + 4 * q); bb[q] = *(const f32x4*)(cb + c + 4 * q); }
#pragma unroll
            for (int i = 0; i < 8; ++i) { const int b = bj * 8 + i, ai = i >> 2, m = i & 3;
                u32x4& gm = (b & 1) ? gmB : gmA; u32x4& gl = (b & 1) ? glB : glA; u32x4& gh = (b & 1) ? ghB : ghA;
                if (b + 1 < 16) { if (b & 1) ldbatch(b + 1, u, wr, wc, fr, fq, gmA, glA, ghA); else ldbatch(b + 1, u, wr, wc, fr, fq, gmB, glB, ghB); }
                float g[8], x[8];
                unpack8(gm, x);
#pragma unroll
                for (int e = 0; e < 8; ++e) g[e] = bb[e >> 2][e & 3] + w1[e >> 2][e & 3] * x[e];
                unpack8(gl, x);
#pragma unroll
                for (int e = 0; e < 8; ++e) g[e] += w0[e >> 2][e & 3] * x[e];
                unpack8(gh, x);
#pragma unroll
                for (int e = 0; e < 8; ++e) g[e] += w2[e >> 2][e & 3] * x[e];
                const f32x4 v0 = acc[ai][bj][m][0], v1 = acc[ai][bj][m][1]; float o[8];
#pragma unroll
                for (int e = 0; e < 4; ++e) { o[e] = g[e] / (1.f + __expf(-g[e])) * v0[e]; o[4 + e] = g[4 + e] / (1.f + __expf(-g[4 + e])) * v1[e]; }
                u32x4 w; w.x = cvt_pk_bf16(o[0], o[1]); w.y = cvt_pk_bf16(o[2], o[3]); w.z = cvt_pk_bf16(o[4], o[5]); w.w = cvt_pk_bf16(o[6], o[7]);
                const int r = u.pm * BM + ai * HALF + wr * 64 + m * 16 + fr; *(u32x4*)(ACT + (size_t)r * D_FF + c) = w; } }
    }
};
struct EpiGluM {
    static constexpr bool PERM = false, AFTER_DRAIN = false;
    bf16_t* YM; const float* bg;
    __device__ __forceinline__ void operator()(const f32x4 (&acc)[2][2][4][2], const Unit& u, int wr, int wc, int fr, int fq) const {
#pragma unroll
        for (int n = 0; n < 2; ++n) { const int oc = u.pn * HALF + wc * 32 + 16 * n + 4 * fq;
            const f32x4 ba = *(const f32x4*)(bg + oc), bgt = *(const f32x4*)(bg + 256 + oc);
#pragma unroll
            for (int ai = 0; ai < 2; ++ai)
#pragma unroll
                for (int m = 0; m < 4; ++m) { const int r = u.pm * BM + ai * HALF + wr * 64 + m * 16 + fr;
                    const f32x4 a = acc[ai][0][m][n] + ba, g = acc[ai][1][m][n] + bgt; float o[4];
#pragma unroll
                    for (int e = 0; e < 4; ++e) o[e] = a[e] / (1.f + __expf(-g[e]));
                    typedef unsigned u32x2 __attribute__((ext_vector_type(2))); u32x2 w; w.x = cvt_pk_bf16(o[0], o[1]); w.y = cvt_pk_bf16(o[2], o[3]);
                    *(u32x2*)(YM + (size_t)r * D_MIX + 768 + oc) = w; } }
    }
};
struct EpiInProj {
    static constexpr bool PERM = true, AFTER_DRAIN = false;
    bf16_t* P; bf16_t* S5A; float* DTRAW;
    __device__ __forceinline__ void operator()(const f32x4 (&acc)[2][2][4][2], const Unit& u, int wr, int wc, int fr, int fq) const {
        const int row0 = u.pm * BM + wr * 64 + fr;
        if (u.pn == 9) { if (wc == 0 && fq == 0) {
#pragma unroll
                for (int ai = 0; ai < 2; ++ai)
#pragma unroll
                    for (int m = 0; m < 4; ++m) { float* d = DTRAW + (size_t)(row0 + ai * HALF + m * 16) * 8; *(f32x4*)d = acc[ai][0][m][0]; *(f32x4*)(d + 4) = acc[ai][0][m][1]; } }
            return; }
#pragma unroll
        for (int ai = 0; ai < 2; ++ai)
#pragma unroll
            for (int m = 0; m < 4; ++m) { const int r = row0 + ai * HALF + m * 16;
#pragma unroll
                for (int bj = 0; bj < 2; ++bj) { const f32x4 v0 = acc[ai][bj][m][0], v1 = acc[ai][bj][m][1];
                    u32x4 w; w.x = cvt_pk_bf16(v0[0], v0[1]); w.y = cvt_pk_bf16(v0[2], v0[3]); w.z = cvt_pk_bf16(v1[0], v1[1]); w.w = cvt_pk_bf16(v1[2], v1[3]);
                    const int cl = bj * HALF + wc * 32 + 8 * fq;
                    if (u.pn < 8) *(u32x4*)(P + (size_t)r * PLD + u.pn * BM + cl) = w;
                    else *(u32x4*)(S5A + ((size_t)(cl >> 4) * S5R + (r >> 4)) * 512 + (r & 15) * 16 + (cl & 15)) = w; } }
    }
};
struct BatchedOrder {
    int G, c;
    __device__ void init(int G_, int c_) { G = G_; c = c_; }
    __device__ bool next(int i, Unit& u) const { const int idx = i * G + (c + 16 * (S5R / 256)) % G;   if (idx >= 16 * (S5R / 256)) return false; u.pm = idx; u.pn = idx / (S5R / 256); return true; }
    __device__ __forceinline__ void a_ready(const Unit&) const {}
    __device__ __forceinline__ void done(const Unit&) const {}
};
constexpr int EX_OFF = MISC_OFF_ + 4096;
struct EpiGateUpM {
    static constexpr bool PERM = false, AFTER_DRAIN = false;
    bf16_t* ACT; const float* cw; const float* cb; float* EG; float* EU;
    __device__ __forceinline__ void operator()(const f32x4 (&acc)[2][2][4][2], const Unit& u, int wr, int wc, int fr_, int fq_) const {
        int fr = fr_, fq = fq_; asm volatile("" : "+v"(fr), "+v"(fq));
        extern __shared__ __attribute__((aligned(16))) unsigned char l_ex_[];
        PG8_LAS float* EXF = (PG8_LAS float*)((PG8_LAS unsigned char*)l_ex_ + EX_OFF); PG8_LAS float* EXL = EXF + 4 * 128;
        const int cl = wc * 32 + 4 * fq, lane = fq * 16 + fr, srcp = (lane & 48) | ((fr + 15) & 15), srcn = (lane & 48) | ((fr + 1) & 15);
#pragma unroll
        for (int ai = 0; ai < 2; ++ai) { const int blk = 2 * ai + wr;
#pragma unroll
            for (int n = 0; n < 2; ++n) {
                if (fr == 0) *(PG8_LAS f32x4*)(EXF + blk * 128 + cl + 16 * n) = acc[ai][0][0][n];
                if (fr == 15) *(PG8_LAS f32x4*)(EXL + blk * 128 + cl + 16 * n) = acc[ai][0][3][n]; } }
        asm volatile("s_waitcnt lgkmcnt(0)" ::: "memory"); __builtin_amdgcn_s_barrier(); asm volatile("" ::: "memory");
        const int c0 = u.pn * HALF + cl;
#pragma unroll
        for (int n = 0; n < 2; ++n) { const int c = c0 + 16 * n;
            const f32x4 w0 = *(const f32x4*)(cw + c), w1 = *(const f32x4*)(cw + D_FF + c), w2 = *(const f32x4*)(cw + 2 * D_FF + c), bb = *(const f32x4*)(cb + c);
#pragma unroll
            for (int ai = 0; ai < 2; ++ai) { const int blk = 2 * ai + wr;
                f32x4 eprev = (f32x4){0.f, 0.f, 0.f, 0.f}, enext = eprev;
                if (blk > 0) eprev = *(const PG8_LAS f32x4*)(EXL + (blk - 1) * 128 + cl + 16 * n);
                if (blk < 3) enext = *(const PG8_LAS f32x4*)(EXF + (blk + 1) * 128 + cl + 16 * n);
#pragma unroll
                for (int m = 0; m < 4; ++m) { const f32x4 g = acc[ai][0][m][n], up = acc[ai][1][m][n];
                    const f32x4 gm1 = acc[ai][0][m > 0 ? m - 1 : 0][n], gp1 = acc[ai][0][m < 3 ? m + 1 : 3][n]; f32x4 pv, nx;
#pragma unroll
                    for (int e = 0; e < 4; ++e) { pv[e] = __shfl(fr == 15 ? gm1[e] : g[e], srcp, 64); nx[e] = __shfl(fr == 0 ? gp1[e] : g[e], srcn, 64); }
                    if (fr == 0 && m == 0) pv = eprev;
                    if (fr == 15 && m == 3) nx = enext;
                    const f32x4 gc = bb + w0 * pv + w1 * g + w2 * nx; float o[4];
#pragma unroll
                    for (int e = 0; e < 4; ++e) o[e] = gc[e] * __builtin_amdgcn_rcpf(1.f + __expf(-gc[e])) * up[e];
                    typedef unsigned u32x2 __attribute__((ext_vector_type(2))); u32x2 w; w.x = cvt_pk_bf16(o[0], o[1]); w.y = cvt_pk_bf16(o[2], o[3]);
                    const int rl = ai * HALF + wr * 64 + m * 16 + fr;
                    *(u32x2*)(ACT + (size_t)(u.pm * BM + rl) * D_FF + c) = w;
                    if (rl < 2) { *(f32x4*)(EG + ((size_t)u.pm * 4 + rl) * D_FF + c) = g; if (rl == 0) *(f32x4*)(EU + ((size_t)u.pm * 2) * D_FF + c) = up; }
                    if (rl >= 254) { *(f32x4*)(EG + ((size_t)u.pm * 4 + rl - 252) * D_FF + c) = g; if (rl == 255) *(f32x4*)(EU + ((size_t)u.pm * 2 + 1) * D_FF + c) = up; } } } }
    }
};
struct TailSplitOrder {
    StaticOrder so; int G, c, ntk, nlat;
    __device__ void init(int K, int G_, int c_) { so.init(ML, D_MODEL, G_, c_); G = G_; c = c_; ntk = K / BK; nlat = (ML / BM) * (D_MODEL / BM); }
    __device__ bool next(int i, Unit& u) const {
        const int nl = c < nlat ? (nlat - c + G - 1) / G : 0;
        if (i < nl) { so.next(i, u); u.kb = 0; u.nt = 0; return true; }
        constexpr int NS = 4; const int j = (i - nl) * G + c; if (j >= 8 * NS) return false;
        const int tile = j / NS, sl = j % NS, per = ((ntk / NS) + 1) & ~1, k0 = sl * per;
        u.pm = ML / BM + tile / (D_MODEL / BM); u.pn = tile % (D_MODEL / BM); u.kb = k0 * BK * 2; u.nt = (sl == NS - 1) ? ntk - k0 : per; return true;
    }
    __device__ __forceinline__ void a_ready(const Unit&) const {}
    __device__ __forceinline__ void done(const Unit&) const {}
};
struct EpiS5E {
    static constexpr bool PERM = false, AFTER_DRAIN = false; float* E;
    __device__ __forceinline__ void operator()(const f32x4 (&acc)[2][2][4][2], const Unit& u, int wr, int wc, int fr, int fq) const {
        const int g = u.pn, sc0 = (u.pm - g * (S5R / 256)) * BM + wr * 64 + fr, col0 = wc * 32 + 4 * fq;
#pragma unroll
        for (int ai = 0; ai < 2; ++ai)
#pragma unroll
            for (int m = 0; m < 4; ++m) { const int sc = sc0 + ai * HALF + m * 16; if (sc < NSC) { float* e = E + ((size_t)g * NSC + sc) * 256 + col0;
#pragma unroll
                    for (int bj = 0; bj < 2; ++bj)
#pragma unroll
                        for (int n = 0; n < 2; ++n) *(f32x4*)(e + bj * HALF + n * 16) = acc[ai][bj][m][n]; } }
    }
};
struct EpiS5Y {
    static constexpr bool PERM = false, AFTER_DRAIN = false; bf16_t* P; int nsc;
    __device__ __forceinline__ void operator()(const f32x4 (&acc)[2][2][4][2], const Unit& u, int wr, int wc, int fr, int fq) const {
        const int g = u.pn, sc0 = (u.pm - g * (S5R / 256)) * BM + wr * 64 + fr, col0 = wc * 32 + 4 * fq;
        typedef unsigned u32x2 __attribute__((ext_vector_type(2)));
#pragma unroll
        for (int ai = 0; ai < 2; ++ai)
#pragma unroll
            for (int m = 0; m < 4; ++m) { const int sc = sc0 + ai * HALF + m * 16; if (sc < nsc) {
#pragma unroll
                    for (int bj = 0; bj < 2; ++bj)
#pragma unroll
                        for (int n = 0; n < 2; ++n) { const int ik = col0 + bj * HALF + n * 16; const f32x4 v = acc[ai][bj][m][n]; float o[4];
#pragma unroll
                            for (int e = 0; e < 4; ++e) { const float x = v[e], t = 0.7978845608028654f * (x + 0.044715f * x * x * x); o[e] = x / (1.f + __expf(-2.f * t)); }
                            u32x2 w; w.x = cvt_pk_bf16(o[0], o[1]); w.y = cvt_pk_bf16(o[2], o[3]);
                            *(u32x2*)(P + (size_t)(sc * 16 + (ik >> 4)) * PLD + YS5_OFF + g * 16 + (ik & 15)) = w; } } }
    }
};
}

__device__ __forceinline__ unsigned f2bf(float f) { unsigned u = __builtin_bit_cast(unsigned, f); return (u + 0x7fffu + ((u >> 16) & 1u)) >> 16; }
__device__ __forceinline__ unsigned pk2(float lo, float hi) { return f2bf(lo) | (f2bf(hi) << 16); }
typedef unsigned v4u __attribute__((ext_vector_type(4)));
__device__ __forceinline__ void transpose_item(const float* W, int ldw, int nblk, act_t* WT, int K, LAS float* scr, int item, int lane) {
    const int kb = item / nblk, nb = item % nblk, k0 = 64 * kb, n0 = 32 * nb;
#pragma unroll
    for (int i = 0; i < 32; ++i) { const int kk = 2 * i + (lane >> 5); scr[kk * 33 + (lane & 31)] = W[(size_t)(k0 + kk) * ldw + n0 + (lane & 31)]; }
    asm volatile("s_waitcnt lgkmcnt(0)" ::: "memory");
    const int c = lane & 7;
#pragma unroll
    for (int j = 0; j < 4; ++j) { const int n = (lane >> 3) + 8 * j; const LAS float* sp = scr + (8 * c) * 33 + n;
        v4u o; o.x = pk2(sp[0 * 33], sp[1 * 33]); o.y = pk2(sp[2 * 33], sp[3 * 33]); o.z = pk2(sp[4 * 33], sp[5 * 33]); o.w = pk2(sp[6 * 33], sp[7 * 33]);
        *(v4u*)(WT + (size_t)(n0 + n) * K + k0 + 8 * c) = o; }
    asm volatile("s_waitcnt lgkmcnt(0)" ::: "memory");
}
__device__ __forceinline__ void st_wprep(const Prm& p, int L, LAS unsigned char* lds, int g0, int gs, int part) {
    const int tl_ = TID_();
    const int lane = tl_ & 63, wave = __builtin_amdgcn_readfirstlane(tl_ >> 6);
    LAS float* scr = (LAS float*)(lds + wave * 16384);
    int gw = BIDX_() * (NTHREADS_ / 64) + wave, NGW = GDIM_() * (NTHREADS_ / 64);
    constexpr int I_IN1 = (D_MODEL / 64) * (1024 / 32), I_IN3 = (D_MODEL / 64) * (256 / 32), I_IN = 2 * I_IN1 + I_IN3, I_OUT = (D_MIX / 64) * (D_MODEL / 32), I_G = (D_MODEL / 64) * (D_FF / 32), I_D = (D_FF / 64) * (D_MODEL / 32);
    constexpr int NIT = I_IN + I_OUT + 2 * I_G + I_D;
    if (part == 1 && GDIM_() == 256) { const int bx = BIDX_();
        if (bx < 128) { gw = bx * 8 + wave; NGW = NIT; } else { gw = 1024 + (bx - 128) * 8 + wave; NGW = 1024; } }
    const int it0 = part ? I_IN + gw : gw, it1 = part ? NIT : I_IN;
    for (int it = it0; it < it1; it += NGW) { int r = it;
        if (r < I_IN) { const float* W = p.in[I_WIN] + (size_t)L * D_MODEL * D_IN; act_t* WT = WSP(act_t, WS_WIN);
            if (r < I_IN1) transpose_item(W, D_IN, 1024 / 32, WT, D_MODEL, scr, r, lane);
            else if (r < 2 * I_IN1) transpose_item(W + 1032, D_IN, 1024 / 32, WT + (size_t)1024 * D_MODEL, D_MODEL, scr, r - I_IN1, lane);
            else transpose_item(W + 2056, D_IN, 256 / 32, WT + (size_t)2048 * D_MODEL, D_MODEL, scr, r - 2 * I_IN1, lane);
            continue; } r -= I_IN;
        if (r < I_OUT) { transpose_item(p.in[I_WOUT] + (size_t)L * D_MIX * D_MODEL, D_MODEL, D_MODEL / 32, WSP(act_t, WS_WOUT), D_MIX, scr, r, lane); continue; } r -= I_OUT;
        if (r < 2 * I_G) { const bool isup = r >= I_G; const int rr = isup ? r - I_G : r, n0 = 32 * (rr % (D_FF / 32)), drow = (n0 >> 7) * 256 + (n0 & 127) + (isup ? 128 : 0);
            transpose_item(p.in[isup ? I_WUP : I_WGATE] + (size_t)L * D_MODEL * D_FF, D_FF, D_FF / 32, WSP(act_t, WS_WG) + (ptrdiff_t)(drow - n0) * D_MODEL, D_MODEL, scr, rr, lane); continue; } r -= 2 * I_G;
        transpose_item(p.in[I_WDOWN] + (size_t)L * D_FF * D_MODEL, D_MODEL, D_MODEL / 32, WSP(act_t, WS_WD), D_FF, scr, r, lane); }
    if (part) return;
    { const float* W = p.in[I_WIN] + (size_t)L * D_MODEL * D_IN; act_t* WT = WSP(act_t, WS_WIN);
      for (int i = g0; i < (int)((NIN - 2304) * D_MODEL); i += gs) { const int n = 2304 + (int)(i / D_MODEL), k = (int)(i % D_MODEL); stf(WT + (size_t)n * D_MODEL + k, n < 2312 ? W[(size_t)k * D_IN + 1024 + (n - 2304)] : 0.f); } }
    { const float* W = p.in[I_WGLU] + (size_t)L * 256 * 512; act_t* WT = WSP(act_t, WS_WGLU);
      for (int i = g0; i < (int)(512L * 256); i += gs) { const int j = (int)(i / 256), k = (int)(i % 256); const int pn = j >> 8, half = (j >> 7) & 1, o = j & 127; stf(WT + i, W[(size_t)k * 512 + half * 256 + 128 * pn + o]); } }
}
#include <hip/hip_bf16.h>
#include <cmath>
namespace attn_body {
using bf16=__hip_bfloat16;
using bf16x8=__attribute__((ext_vector_type(8)))short;
using s16x4=__attribute__((ext_vector_type(4)))short;
using f32x16=__attribute__((ext_vector_type(16)))float;
using u32x4=__attribute__((ext_vector_type(4)))unsigned;
constexpr int D=64,QKVP=PLD,OP=D_MIX;
constexpr int NW=8,QBLK=32,QB=QBLK*NW,KVBLK=64;
__device__ __forceinline__ int crow(int r,int hi){return (r&3)+8*(r>>2)+4*hi;}
#define SBAR() __builtin_amdgcn_sched_barrier(0)
__device__ __forceinline__ void wmask(f32x16&p0,f32x16&p1,int kbase,int qpos,int hi){
  const float NEG=-INFINITY; const int d0=kbase+4*hi-qpos;
  #pragma unroll
  for(int r=0;r<16;++r){const int dd=d0+(r&3)+8*(r>>2); if(dd<-128||dd>128)p0[r]=NEG; if(dd+32<-128||dd+32>128)p1[r]=NEG;}
}
constexpr int NSLOT=3, SLOTB=8192;
constexpr int LDS_K=0, LDS_V=NSLOT*SLOTB, LDS_WS=2*NSLOT*SLOTB, LDS_OST=LDS_WS+NW*64*4, LDS_BYTES=LDS_OST+NW*4096;
constexpr float C2=0.125f*1.4426950408889634f;
__device__ __forceinline__ void glds16(const void*gsrc,unsigned lds_dst){unsigned keep;
  asm volatile("s_mov_b32 %0, m0\n\ts_mov_b32 m0, %2\n\ts_nop 0\n\tglobal_load_lds_dwordx4 %1, off\n\ts_mov_b32 m0, %0":"=&s"(keep):"v"(gsrc),"s"(lds_dst):"memory");}
__device__ __forceinline__ float max3f(float a,float b,float c){float r;asm("v_max3_f32 %0, %1, %2, %3":"=v"(r):"v"(a),"v"(b),"v"(c));return r;}
__device__ __forceinline__ float max2f(float a,float b){float r;asm("v_max_f32_e32 %0, %1, %2":"=v"(r):"v"(a),"v"(b));return r;}
__device__ __forceinline__ float fadd_s(float a,float b){float r;asm("v_add_f32_e32 %0, %1, %2":"=v"(r):"v"(a),"v"(b));return r;}
__device__ __forceinline__ float fsub_s(float a,float b){float r;asm("v_sub_f32_e32 %0, %1, %2":"=v"(r):"v"(a),"v"(b));return r;}
typedef float f32x2_t __attribute__((ext_vector_type(2))); typedef __bf16 bf16x2_t __attribute__((ext_vector_type(2)));
__device__ __forceinline__ unsigned cvtpk_s(float lo,float hi){f32x2_t v={lo,hi};bf16x2_t b=__builtin_convertvector(v,bf16x2_t);return __builtin_bit_cast(unsigned,b);}
#define WAIT_BAR(N) asm volatile("s_waitcnt vmcnt(" #N ") lgkmcnt(0)\n\ts_barrier":::"memory")

__device__ __forceinline__ void qkt(f32x16&p0,f32x16&p1,const char*Kslot,const bf16x8*qr,const f32x16&negm,int r32,int hi){
  const char*kb=Kslot+hi*1024+r32*16;
  #pragma unroll
  for(int d0=0;d0<4;++d0){
    const bf16x8 b0=*reinterpret_cast<const bf16x8*>(kb+d0*2048);
    const bf16x8 b1=*reinterpret_cast<const bf16x8*>(kb+d0*2048+512);
    if(d0==0){p0=__builtin_amdgcn_mfma_f32_32x32x16_bf16(b0,qr[0],negm,0,0,0);p1=__builtin_amdgcn_mfma_f32_32x32x16_bf16(b1,qr[0],negm,0,0,0);}
    else{p0=__builtin_amdgcn_mfma_f32_32x32x16_bf16(b0,qr[d0],p0,0,0,0);p1=__builtin_amdgcn_mfma_f32_32x32x16_bf16(b1,qr[d0],p1,0,0,0);}}
}
typedef __attribute__((address_space(3))) const char* lds_cptr;
typedef short v4i16_t __attribute__((ext_vector_type(4)));
__device__ __forceinline__ void kload8(bf16x8*kf,lds_cptr kp){
  kf[0]=*(const __attribute__((address_space(3))) bf16x8*)(kp);      kf[1]=*(const __attribute__((address_space(3))) bf16x8*)(kp+512);
  kf[2]=*(const __attribute__((address_space(3))) bf16x8*)(kp+2048); kf[3]=*(const __attribute__((address_space(3))) bf16x8*)(kp+2560);
  kf[4]=*(const __attribute__((address_space(3))) bf16x8*)(kp+4096); kf[5]=*(const __attribute__((address_space(3))) bf16x8*)(kp+4608);
  kf[6]=*(const __attribute__((address_space(3))) bf16x8*)(kp+6144); kf[7]=*(const __attribute__((address_space(3))) bf16x8*)(kp+6656);
}
__device__ __forceinline__ void kload2(bf16x8*kf,lds_cptr kp,int j){ kf[2*j]=*(const __attribute__((address_space(3))) bf16x8*)(kp+j*2048); kf[2*j+1]=*(const __attribute__((address_space(3))) bf16x8*)(kp+j*2048+512); }
__device__ __forceinline__ s16x4 vtr(lds_cptr p){ return __builtin_bit_cast(s16x4,__builtin_amdgcn_ds_read_tr16_b64_v4i16((__attribute__((address_space(3))) v4i16_t*)p)); }
__device__ __forceinline__ float rowmax(const f32x16&p0,const f32x16&p1){
  float a=max3f(p0[0],p0[1],p1[0]),b=max3f(p0[2],p0[3],p1[1]);a=max3f(a,p1[2],p1[3]);
  #pragma unroll
  for(int r=4;r<16;r+=4){a=max3f(a,p0[r],p0[r+1]);b=max3f(b,p0[r+2],p0[r+3]);a=max3f(a,p1[r],p1[r+1]);b=max3f(b,p1[r+2],p1[r+3]);}
  const float m=max2f(a,b);
  auto rr=__builtin_amdgcn_permlane32_swap(__float_as_uint(m),__float_as_uint(m),false,false);
  return max2f(__uint_as_float(rr[0]),__uint_as_float(rr[1]));
}
__device__ __forceinline__ void pv(f32x16*o,int vb,bf16x8 pa0,bf16x8 pa1,bf16x8 pa2,bf16x8 pa3){
  #pragma unroll
  for(int d0=0;d0<2;++d0){s16x4 lo[4],hi[4];
    #pragma unroll
    for(int ks=0;ks<4;++ks){
      asm volatile("ds_read_b64_tr_b16 %0,%1 offset:%c2":"=&v"(lo[ks]):"v"(vb),"i"(d0*4096+ks*1024):"memory");
      asm volatile("ds_read_b64_tr_b16 %0,%1 offset:%c2":"=&v"(hi[ks]):"v"(vb),"i"(d0*4096+ks*1024+512):"memory");}
    asm volatile("s_waitcnt lgkmcnt(0)":::"memory");SBAR();
    #define PK(k) (bf16x8){lo[k][0],lo[k][1],lo[k][2],lo[k][3],hi[k][0],hi[k][1],hi[k][2],hi[k][3]}
    o[d0]=__builtin_amdgcn_mfma_f32_32x32x16_bf16(pa0,PK(0),o[d0],0,0,0);
    o[d0]=__builtin_amdgcn_mfma_f32_32x32x16_bf16(pa1,PK(1),o[d0],0,0,0);
    o[d0]=__builtin_amdgcn_mfma_f32_32x32x16_bf16(pa2,PK(2),o[d0],0,0,0);
    o[d0]=__builtin_amdgcn_mfma_f32_32x32x16_bf16(pa3,PK(3),o[d0],0,0,0);
    #undef PK
  }
}

#ifndef ATTN_STORE16
#define ATTN_STORE16(p,v) (*(u32x4*)(p)=(v))
#endif
template<int THRL,bool WIN> __device__ __forceinline__ void attn_unit(const bf16*Pm,int qrow0,int qoff,int koff,int voff,int ctx0,int lat0,int NT,int qpos0,int kpos0,float sinkl2,bf16*Ob,char*shm){
  const int tid=TID_(),lane=tid&63,r32=lane&31,hi=lane>>5; const int wid=__builtin_amdgcn_readfirstlane(tid>>6);
  const bf16*Qw=Pm+(long)(qrow0+wid*QBLK)*QKVP+qoff;
  const unsigned lds0=(unsigned)(uintptr_t)shm;
  float*wsf=(float*)(shm+LDS_WS)+wid*64;
  const bf16*ksrc=Pm+(long)lane*QKVP+koff+wid*8;
  const bf16*vsrc=Pm+(long)(16*(wid&3)+(lane>>2))*QKVP+voff+(wid>>2)*32+(lane&3)*8;
  #define KROW(t) ((t)<4?ctx0+64*(t):lat0+64*((t)-4))
  const unsigned kdst=lds0+LDS_K+wid*1024, vdst=lds0+LDS_V+wid*1024;
  #define DMA_K(t,slot) glds16(ksrc+(long)KROW(t)*QKVP,(unsigned)__builtin_amdgcn_readfirstlane(kdst+(slot)))
  #define DMA_V(t,slot) glds16(vsrc+(long)KROW(t)*QKVP,(unsigned)__builtin_amdgcn_readfirstlane(vdst+(slot)))
  const int vb0=(int)(lds0+LDS_V)+((lane>>4)&1)*32+(lane&3)*8+(4*hi+((lane&15)>>2))*64;
  const char*Kbase=shm+LDS_K; bf16x8 kf[8];
  const lds_cptr shm3=(lds_cptr)shm; const lds_cptr kp0=shm3+LDS_K+hi*1024+r32*16; const lds_cptr vp0=shm3+LDS_V+((lane>>4)&1)*32+(lane&3)*8+(4*hi+((lane&15)>>2))*64;
  DMA_K(0,0);DMA_V(0,0);DMA_K(1,SLOTB);
  bf16x8 qr[4];
  #pragma unroll
  for(int d0=0;d0<4;++d0)qr[d0]=*reinterpret_cast<const bf16x8*>(&Qw[(long)r32*QKVP+d0*16+hi*8]);
  float mhat=0.f,l_reg=0.f;f32x16 o[2];o[0]=f32x16{};o[1]=f32x16{};f32x16 negm=f32x16{};asm volatile("":"+v"(negm));
  const int qpos=qpos0+wid*QBLK+r32;
  #define CMASK(P0,P1,t) do{ if(WIN){ if((t)>=4) wmask(P0,P1,kpos0+64*((t)-4),qpos,hi); } }while(0)
  bool resc=false;
  #define START(P0,P1) do{ const float rm=rowmax(P0,P1); resc=false; \
    { const float dl=rm; mhat=fadd_s(mhat,dl); \
      _Pragma("unroll") for(int r=0;r<16;++r){P0[r]=fsub_s(P0[r],dl);P1[r]=fsub_s(P1[r],dl);} \
      _Pragma("unroll") for(int r=0;r<16;++r)negm[r]=-mhat; asm volatile("":"+v"(negm)); } \
    _Pragma("unroll") for(int r=0;r<16;++r)P0[r]=__builtin_amdgcn_exp2f(P0[r]); }while(0)
  #define RESC() do{ if(resc){ asm volatile("s_waitcnt lgkmcnt(0)":::"memory"); \
      _Pragma("unroll") for(int d_=0;d_<2;++d_) _Pragma("unroll") for(int r=0;r<16;++r)o[d_][r]*=wsf[crow(r,hi)]; } }while(0)
  f32x16 pA0,pA1,pB0,pB1;
  int sl_prev=0,sl_cur=0,sl_next=SLOTB;
  #define ROT() do{sl_prev=sl_cur;sl_cur=sl_next;sl_next=(sl_next==(NSLOT-1)*SLOTB)?0:sl_next+SLOTB;}while(0)
  DMA_K(2,2*SLOTB);
  WAIT_BAR(3);
  qkt(pA0,pA1,Kbase,qr,negm,r32,hi);asm volatile("s_nop 15\n\ts_nop 7":"+v"(pA0),"+v"(pA1));CMASK(pA0,pA1,0);
  START(pA0,pA1);
  _Pragma("unroll") for(int r=0;r<16;++r)pA1[r]=__builtin_amdgcn_exp2f(pA1[r]);
  WAIT_BAR(0);
  DMA_K(3,0);DMA_V(1,SLOTB);
  ROT();
  kload8(kf,kp0+sl_cur);
  WAIT_BAR(2);
  s16x4 vlo[8],vhi[8]; u32x4 pw0,pw1,pw2,pw3;
  #define PKW(P,B) cvtpk_s(P[B],P[B+1])
  #define PAF(k) __builtin_bit_cast(bf16x8,pw##k)
  #define VFR(i) (bf16x8){vlo[i][0],vlo[i][1],vlo[i][2],vlo[i][3],vhi[i][0],vhi[i][1],vhi[i][2],vhi[i][3]}
  #define PIN(x) asm volatile("":"+v"(x))
  #define MX3(a,b,c) __builtin_fmaxf(__builtin_fmaxf((a),(b)),(c))
  #define GAPA(MF,A0,A1,A2,A3,W0,W1,PW) do{ MF; sacc+=A0; sacc+=A1; sacc+=A2; sacc+=A3; PIN(sacc); W0; W1; PIN(PW); SBAR(); }while(0)
  #define EX(v) __builtin_amdgcn_exp2f(v)
  #define GAPB(MF,X,B) do{ MF; X[B]=EX(X[B]); X[B+1]=EX(X[B+1]); X[B+2]=EX(X[B+2]); X[B+3]=EX(X[B+3]); PIN(X); SBAR(); }while(0)
  #define VRD(i) do{ vlo[i]=vtr(vp_+(((i)>>2)*4096+((i)&3)*1024)); vhi[i]=vtr(vp_+(((i)>>2)*4096+((i)&3)*1024+512)); }while(0)
  #define KRD(G,j) do{ if(G){ kload2(kf,kp0+sl_next,j); SBAR(); } }while(0)
  #define STEP(C0,C1,P0,P1,t,GK,GV,GL) do{ SBAR(); \
    const lds_cptr vp_=vp0+sl_prev; \
    VRD(0); SBAR(); float sacc=(P0[0]+P0[1]); \
    GAPA(C0=__builtin_amdgcn_mfma_f32_32x32x16_bf16(kf[0],qr[0],negm,0,0,0), P0[2],P0[3],P0[4],P0[5],     pw0[0]=PKW(P0,0), pw0[1]=PKW(P0,2), pw0); \
    VRD(4); SBAR(); GAPA(C1=__builtin_amdgcn_mfma_f32_32x32x16_bf16(kf[1],qr[0],negm,0,0,0), P0[6],P0[7],P0[8],P0[9],     pw0[2]=PKW(P0,4), pw0[3]=PKW(P0,6), pw0); \
    VRD(1); SBAR(); GAPA(C0=__builtin_amdgcn_mfma_f32_32x32x16_bf16(kf[2],qr[1],C0,0,0,0),   P0[10],P0[11],P0[12],P0[13], pw1[0]=PKW(P0,8), pw1[1]=PKW(P0,10), pw1); \
    VRD(5); SBAR(); GAPA(C1=__builtin_amdgcn_mfma_f32_32x32x16_bf16(kf[3],qr[1],C1,0,0,0),   P0[14],P0[15],P1[0],P1[1],   pw1[2]=PKW(P0,12),pw1[3]=PKW(P0,14), pw1); \
    VRD(2); SBAR(); GAPA(C0=__builtin_amdgcn_mfma_f32_32x32x16_bf16(kf[4],qr[2],C0,0,0,0),   P1[2],P1[3],P1[4],P1[5],     pw2[0]=PKW(P1,0), pw2[1]=PKW(P1,2), pw2); \
    VRD(6); SBAR(); GAPA(C1=__builtin_amdgcn_mfma_f32_32x32x16_bf16(kf[5],qr[2],C1,0,0,0),   P1[6],P1[7],P1[8],P1[9],     pw2[2]=PKW(P1,4), pw2[3]=PKW(P1,6), pw2); \
    VRD(3); SBAR(); GAPA(C0=__builtin_amdgcn_mfma_f32_32x32x16_bf16(kf[6],qr[3],C0,0,0,0),   P1[10],P1[11],P1[12],P1[13], pw3[0]=PKW(P1,8), pw3[1]=PKW(P1,10), pw3); \
    VRD(7); SBAR(); GAPA(C1=__builtin_amdgcn_mfma_f32_32x32x16_bf16(kf[7],qr[3],C1,0,0,0),   P1[14],P1[15],0.f,0.f,       pw3[2]=PKW(P1,12),pw3[3]=PKW(P1,14), pw3); \
    l_reg+=sacc; \
    if(GK){DMA_K((t)+3,sl_cur);} if(GV){DMA_V((t)+1,sl_next);} \
    CMASK(C0,C1,t); \
    { float a=MX3(C0[0],C0[1],C1[0]),b=MX3(C0[2],C0[3],C1[1]); a=MX3(a,C1[2],C1[3]); \
      _Pragma("unroll") for(int r=4;r<16;r+=4){a=MX3(a,C0[r],C0[r+1]);b=MX3(b,C0[r+2],C0[r+3]);a=MX3(a,C1[r],C1[r+1]);b=MX3(b,C1[r+2],C1[r+3]);} \
      float rm=__builtin_fmaxf(a,b); { auto rr=__builtin_amdgcn_permlane32_swap(__float_as_uint(rm),__float_as_uint(rm),false,false); rm=__builtin_fmaxf(__uint_as_float(rr[0]),__uint_as_float(rr[1])); } \
      resc=false; \
      if(__builtin_expect(__any(rm>(float)THRL),0)){ const float dl=__builtin_fmaxf(rm,0.f); mhat+=dl; \
        _Pragma("unroll") for(int r=0;r<16;++r){C0[r]-=dl;C1[r]-=dl;} \
        _Pragma("unroll") for(int r=0;r<16;++r)negm[r]=-mhat; asm volatile("":"+v"(negm)); \
        const float f=__builtin_amdgcn_exp2f(-dl); l_reg*=f; if(hi==0)wsf[r32]=f; resc=true; } } \
    SBAR(); \
    GAPB(o[0]=__builtin_amdgcn_mfma_f32_32x32x16_bf16(PAF(0),VFR(0),o[0],0,0,0), C0,0); \
    GAPB(o[1]=__builtin_amdgcn_mfma_f32_32x32x16_bf16(PAF(0),VFR(4),o[1],0,0,0), C0,4); \
    KRD(GL,0); GAPB(o[0]=__builtin_amdgcn_mfma_f32_32x32x16_bf16(PAF(1),VFR(1),o[0],0,0,0), C0,8); \
    KRD(GL,1); GAPB(o[1]=__builtin_amdgcn_mfma_f32_32x32x16_bf16(PAF(1),VFR(5),o[1],0,0,0), C0,12); \
    KRD(GL,2); GAPB(o[0]=__builtin_amdgcn_mfma_f32_32x32x16_bf16(PAF(2),VFR(2),o[0],0,0,0), C1,0); \
    KRD(GL,3); GAPB(o[1]=__builtin_amdgcn_mfma_f32_32x32x16_bf16(PAF(2),VFR(6),o[1],0,0,0), C1,4); \
    GAPB(o[0]=__builtin_amdgcn_mfma_f32_32x32x16_bf16(PAF(3),VFR(3),o[0],0,0,0), C1,8); \
    GAPB(o[1]=__builtin_amdgcn_mfma_f32_32x32x16_bf16(PAF(3),VFR(7),o[1],0,0,0), C1,12); \
    }while(0)
  int t=1;
  for(;t+5<NT;t+=2){
    STEP(pB0,pB1,pA0,pA1,t,true,true,true);     WAIT_BAR(2); RESC(); ROT();
    STEP(pA0,pA1,pB0,pB1,t+1,true,true,true);   WAIT_BAR(2); RESC(); ROT();
  }
  #define ENDW(tt) do{ if((tt)+3<NT){WAIT_BAR(2);} else if((tt)+2<NT){WAIT_BAR(1);} else {WAIT_BAR(0);} }while(0)
  for(;t+1<NT;t+=2){
    STEP(pB0,pB1,pA0,pA1,t,(t+3<NT),(t+1<NT),(t+1<NT));       ENDW(t);   RESC(); ROT();
    STEP(pA0,pA1,pB0,pB1,t+1,(t+4<NT),(t+2<NT),(t+2<NT));     ENDW(t+1); RESC(); ROT();
  }
  STEP(pB0,pB1,pA0,pA1,NT-1,false,false,false); RESC();
  { float sacc=pB0[0]+pB0[1]; _Pragma("unroll") for(int r=2;r<16;++r)sacc+=pB0[r]; _Pragma("unroll") for(int r=0;r<16;++r)sacc+=pB1[r]; l_reg+=sacc;
    pw0=(u32x4){PKW(pB0,0),PKW(pB0,2),PKW(pB0,4),PKW(pB0,6)};pw1=(u32x4){PKW(pB0,8),PKW(pB0,10),PKW(pB0,12),PKW(pB0,14)};pw2=(u32x4){PKW(pB1,0),PKW(pB1,2),PKW(pB1,4),PKW(pB1,6)};pw3=(u32x4){PKW(pB1,8),PKW(pB1,10),PKW(pB1,12),PKW(pB1,14)};
    SBAR(); pv(o,vb0+sl_cur,PAF(0),PAF(1),PAF(2),PAF(3)); }
  #undef PKW
  #undef PAF
  #undef VFR
  #undef PIN
  #undef MX3
  #undef GAPA
  #undef GAPB
  #undef EX
  #undef VRD
  #undef KRD
  #undef STEP
  #undef ENDW
  {auto rr=__builtin_amdgcn_permlane32_swap(__float_as_uint(l_reg),__float_as_uint(l_reg),false,false);l_reg=__uint_as_float(rr[0])+__uint_as_float(rr[1]);}
  if(WIN)l_reg+=__builtin_amdgcn_exp2f(sinkl2-mhat);
  if(hi==0)wsf[32+r32]=l_reg;asm volatile("s_waitcnt lgkmcnt(0)":::"memory");
  float rli[16];
  #pragma unroll
  for(int r=0;r<16;++r)rli[r]=__builtin_amdgcn_rcpf(wsf[32+crow(r,hi)]);
  bf16*Ow=Ob+(long)(wid*QBLK)*OP;
  { bf16*stg=(bf16*)(shm+LDS_OST)+wid*2048;
    #pragma unroll
    for(int r=0;r<16;++r){const int orow=crow(r,hi);
      #pragma unroll
      for(int d0=0;d0<2;++d0)stg[orow*64+d0*32+r32]=__float2bfloat16(o[d0][r]*rli[r]);}
    asm volatile("s_waitcnt lgkmcnt(0)":::"memory");
    #pragma unroll
    for(int i=0;i<4;++i){const int row=i*8+(lane>>3),ch=lane&7; const u32x4 v=*(const u32x4*)(stg+row*64+ch*8); ATTN_STORE16(Ow+(long)row*OP+ch*8,v);} }
  asm volatile("s_waitcnt lgkmcnt(0)\n\ts_barrier":::"memory");
  #undef DMA_K
  #undef DMA_V
  #undef KROW
  #undef CMASK
  #undef START
  #undef RESC
  #undef ROT
}
constexpr int ATTN_LDS_BYTES=LDS_BYTES;
#undef SBAR
#undef WAIT_BAR
}

__device__ __forceinline__ void st_attn_mfma(const Prm& p, int L, int mode, char* shm) {
    using namespace attn_body;
    const bf16* Pm = (const bf16*)(p.ws + WS_P); bf16* YM = (bf16*)(p.ws + WS_YMIX);
    const int G = GDIM_(), bx = BIDX_(); const int vcu = (G % 8 == 0) ? (bx % 8) * (G / 8) + bx / 8 : bx;
    const int cu0 = G >= MT / 128 + 16 ? MT / 128 : 0, nmain = 512;
    int u0 = vcu, u1 = nmain, us = G; if (mode) { if (bx < cu0 || bx >= cu0 + 16) return; u0 = nmain + (bx - cu0); u1 = nmain + 16; us = 16; }
    for (int u = u0; u < u1; u += us) {
        int isw, b, hq, qrow0, ctx0, lat0, NT, qpos0 = 0, kpos0 = 0, orow0;
        if (u < 512) { const int v = u & 255, qb = v & 31; isw = u >> 8; b = v >> 7; hq = (v >> 5) & 3; qrow0 = b * SEQ + qb * 256; orow0 = qrow0; ctx0 = ML + b * CTX_LEN;
            if (!isw) { lat0 = b * SEQ; NT = 4 + SEQ / 64; }
            else { const int lt0 = 4 * qb - 2 < 0 ? 0 : 4 * qb - 2, lt1 = 4 * qb + 6 > SEQ / 64 ? SEQ / 64 : 4 * qb + 6; lat0 = b * SEQ + 64 * lt0; NT = 4 + lt1 - lt0; qpos0 = qb * 256; kpos0 = 64 * lt0; } }
        else { const int v = u - 512; isw = v >> 3; b = (v >> 2) & 1; hq = v & 3; qrow0 = ML + b * CTX_LEN; orow0 = qrow0; ctx0 = qrow0; lat0 = 0; NT = 4; }
        const int kv = hq >> 1;
        bf16* Ob = YM + (size_t)orow0 * D_MIX + (isw ? 512 : 256) + hq * 64;
        if (isw) attn_unit<8, true>(Pm, qrow0, WAQ + hq * 64, WAK + kv * 64, WAV + kv * 64, ctx0, lat0, NT, qpos0, kpos0, p.in[I_SINK][L * 4 + hq] * 1.4426950408889634f, Ob, shm);
        else attn_unit<8, false>(Pm, qrow0, GAQ + hq * 64, GAK + kv * 64, GAV + kv * 64, ctx0, lat0, NT, 0, 0, 0.f, Ob, shm);
    }
}

typedef float f32x4_t __attribute__((ext_vector_type(4)));
typedef unsigned u32x2_t __attribute__((ext_vector_type(2)));
__device__ __forceinline__ float wave_sum_(float v) {
#pragma unroll
    for (int o = 1; o < 64; o <<= 1) v += __shfl_xor(v, o);
    return v;
}
__device__ __forceinline__ int wave_id_() { const int t = TID_(); return BIDX_() * (NTHREADS_ / 64) + __builtin_amdgcn_readfirstlane(t >> 6); }
__device__ __forceinline__ int lane_id_() { unsigned m_ = ~0u; asm volatile("" : "+s"(m_)); return (int)__builtin_amdgcn_mbcnt_hi(m_, __builtin_amdgcn_mbcnt_lo(m_, 0u)); }
__device__ __forceinline__ const float* xsrc_(const Prm& p, int r, bool from_input) { return from_input ? (r < ML ? p.in[I_X] + (size_t)r * D_MODEL : p.in[I_CTX] + (size_t)(r - ML) * D_MODEL) : xrow(p, r); }
#define JX_(j) (128 * ((j) >> 1) + ((j) & 1))
__device__ __forceinline__ void st_norm_fused(const Prm& p, int L, int which, int nrows, const float* pend) {
    const int lane = lane_id_(), NGW = GDIM_() * (NTHREADS_ / 64); act_t* xn = WSP(act_t, WS_XN);
    const float* gw = p.in[which ? I_GFFN : I_GMIX] + (size_t)L * D_MODEL;
    for (int r = wave_id_(); r < nrows; r += NGW) {
        const f32x4_t* xr = (const f32x4_t*)xsrc_(p, r, L == 0 && which == 0) + 2 * lane; const int modrow = r < ML ? r / SEQ : BATCH;
        const f32x4_t* sh = (const f32x4_t*)modp(p, L, modrow, which ? 3 : 0) + 2 * lane; const f32x4_t* sc = (const f32x4_t*)modp(p, L, modrow, which ? 4 : 1) + 2 * lane; const f32x4_t* gp = (const f32x4_t*)gw + 2 * lane;
        f32x4_t v[D_MODEL / 256]; float ss = 0.f;
#pragma unroll
        for (int j = 0; j < D_MODEL / 256; ++j) v[j] = xr[JX_(j)];
        if (pend && r >= ML) { const f32x4_t* sl = (const f32x4_t*)(WSP(float, WS_SLAB) + (size_t)(r - ML) * D_MODEL) + 2 * lane; const f32x4_t* pg = (const f32x4_t*)pend + 2 * lane; f32x4_t* xw = (f32x4_t*)xrow(p, r) + 2 * lane;
#pragma unroll
            for (int j = 0; j < D_MODEL / 256; ++j) { const f32x4_t t = (sl[JX_(j)] + sl[JX_(j) + (size_t)MC * D_MODEL / 4]) + (sl[JX_(j) + (size_t)2 * MC * D_MODEL / 4] + sl[JX_(j) + (size_t)3 * MC * D_MODEL / 4]); v[j] = v[j] + pg[JX_(j)] * t; xw[JX_(j)] = v[j]; } }
#pragma unroll
        for (int j = 0; j < D_MODEL / 256; ++j) ss += (v[j].x * v[j].x + v[j].y * v[j].y) + (v[j].z * v[j].z + v[j].w * v[j].w);
        const float rs = 1.0f / sqrtf(wave_sum_(ss) * (1.0f / D_MODEL) + NORM_EPS);
        pg8::u32x4* o16 = (pg8::u32x4*)(xn + (size_t)r * D_MODEL) + lane;
#pragma unroll
        for (int jj = 0; jj < D_MODEL / 512; ++jj) { pg8::u32x4 w;
#pragma unroll
            for (int h = 0; h < 2; ++h) { const int j = 2 * jj + h; const f32x4_t g4 = gp[JX_(j)], s4 = sc[JX_(j)], h4 = sh[JX_(j)]; const f32x4_t y = v[j] * rs * g4 * (s4 + 1.0f) + h4; w[2 * h] = pk2(y.x, y.y); w[2 * h + 1] = pk2(y.z, y.w); }
            pg8::st_wt(o16 + 64 * jj, w); }
    }
}
#undef JX_
__device__ __forceinline__ void st_final_fused(const Prm& p) {
    const int lane = lane_id_(), NGW = GDIM_() * (NTHREADS_ / 64); const f32x4_t* gp = (const f32x4_t*)p.in[I_GFIN] + lane;
    for (int r = wave_id_(); r < ML; r += NGW) { f32x4_t* xr = (f32x4_t*)(p.out + (size_t)r * D_MODEL) + lane; f32x4_t v[D_MODEL / 256]; float ss = 0.f;
#pragma unroll
        for (int j = 0; j < D_MODEL / 256; ++j) { v[j] = xr[64 * j]; ss += (v[j].x * v[j].x + v[j].y * v[j].y) + (v[j].z * v[j].z + v[j].w * v[j].w); }
        const float rs = 1.0f / sqrtf(wave_sum_(ss) * (1.0f / D_MODEL) + NORM_EPS);
#pragma unroll
        for (int j = 0; j < D_MODEL / 256; ++j) xr[64 * j] = v[j] * rs * gp[64 * j]; }
}
__device__ __forceinline__ void unpack4_(const u32x2_t v, float* o) { o[0] = __uint_as_float(v.x << 16); o[1] = __uint_as_float(v.x & 0xffff0000u); o[2] = __uint_as_float(v.y << 16); o[3] = __uint_as_float(v.y & 0xffff0000u); }
__device__ __forceinline__ void st_ssd_out_w(const Prm& p, int L, int nrows) {
    const int lane = lane_id_(), NGW = GDIM_() * (NTHREADS_ / 64); const act_t* P = WSP(act_t, WS_P); act_t* ym = WSP(act_t, WS_YMIX);
    const f32x4_t g4 = *((const f32x4_t*)(p.in[I_SNG] + L * 256) + lane);
    for (int r = wave_id_(); r < nrows; r += NGW) { float y[4], z[4];
        unpack4_(*((const u32x2_t*)(P + (size_t)r * PLD + YSSD_OFF) + lane), y); unpack4_(*((const u32x2_t*)(P + (size_t)r * PLD + Z_OFF) + lane), z);
        float v[4], ss = 0.f;
#pragma unroll
        for (int e = 0; e < 4; ++e) { v[e] = y[e] * z[e] / (1.f + __expf(-z[e])); ss += v[e] * v[e]; }
        const float rn = 1.0f / sqrtf(wave_sum_(ss) * (1.f / 256.f) + NORM_EPS);
        u32x2_t w; w.x = pk2(v[0] * rn * g4.x, v[1] * rn * g4.y); w.y = pk2(v[2] * rn * g4.z, v[3] * rn * g4.w);
        *((u32x2_t*)(ym + (size_t)r * D_MIX) + lane) = w; }
}
__device__ __forceinline__ void st_ssd_cs_w(const Prm& p, int L) {
    const int lane = lane_id_(), NGW = GDIM_() * (NTHREADS_ / 64); const act_t* P = WSP(act_t, WS_P); float* DT = WSP(float, WS_DT); float* CS = WSP(float, WS_CS);
    for (int it = wave_id_(); it < NCH * 8; it += NGW) { const int dh = it & 7, c = it >> 3, d = dh >> 2;
        const float a = -expf(p.in[I_SALOG][L * 8 + dh]), bias = p.in[I_SDTB][L * 8 + dh];
        const size_t r0 = (size_t)c * 128 + lane, r1 = r0 + 64;
        const float* dtr = WSP(float, WS_DTRAW); const float dt0 = softplusf_(dtr[r0 * 8 + dh] + bias), dt1 = softplusf_(dtr[r1 * 8 + dh] + bias);
        float s0 = dt0 * a, s1 = dt1 * a; const float a0 = s0, a1 = s1;
#pragma unroll
        for (int o = 1; o < 64; o <<= 1) { const float t0 = __shfl_up(s0, o), t1 = __shfl_up(s1, o); if (lane >= o) { s0 += t0; s1 += t1; } }
        const float tot0 = __shfl(s0, 63); s1 += tot0; const float tot = __shfl(s1, 63);
        DT[r0 * 8 + dh] = dt0; DT[r1 * 8 + dh] = dt1;
        CS[r0 * 8 + dh] = d ? tot - s0 + a0 : s0; CS[r1 * 8 + dh] = d ? tot - s1 + a1 : s1; }
}
__device__ __forceinline__ void st_s5tabB_v(const Prm& p, int layer, int g0, int gs) {
    typedef float f32x2_t __attribute__((ext_vector_type(2)));
    const float* lamp = WSP(float, WS_LAMP) + (size_t)layer * 2 * 16 * 64 * 17 * 2; const float* bbar = WSP(float, WS_BBAR) + (size_t)layer * 2 * 16 * 64 * 16 * 2; const float* kt = WSP(float, WS_KT) + (size_t)layer * 2 * 16 * 16 * 256;
    act_t* BY = WSP(act_t, WS_S5BY); act_t* BE = WSP(act_t, WS_S5BE);
    constexpr int NBY = 16 * 256 * 512 / 8, NBE = 16 * 256 * 256 / 8;
    for (int it = g0; it < NBY + NBE; it += gs) { float v[8]; act_t* dst;
        if (it < NBY) { const int idx = it * 8, q = idx & 511, ik = (idx >> 9) & 255, g = idx >> 17, i = ik >> 4, k = ik & 15; dst = BY + idx;
            if (q < 256) { const int j = q >> 4, kp0 = q & 15;
                if (j != i) { const float* s0 = kt + ((j < i ? g * 16 + (i - j) : (16 + g) * 16 + (j - i)) * 16 + k) * 16 + kp0; const f32x4_t a = *(const f32x4_t*)s0, b = *(const f32x4_t*)(s0 + 4);
#pragma unroll
                    for (int e = 0; e < 4; ++e) { v[e] = a[e]; v[4 + e] = b[e]; } }
                else { const float* s0 = kt + ((g * 16) * 16 + k) * 16 + kp0; const float* s1 = kt + (((16 + g) * 16) * 16 + k) * 16 + kp0; const float dsk = p.in[I_S5D][layer * 256 + g * 16 + k];
                    const f32x4_t a0 = *(const f32x4_t*)s0, b0 = *(const f32x4_t*)(s0 + 4), a1 = *(const f32x4_t*)s1, b1 = *(const f32x4_t*)(s1 + 4);
#pragma unroll
                    for (int e = 0; e < 4; ++e) { v[e] = a0[e] + a1[e] + (k == kp0 + e ? dsk : 0.f); v[4 + e] = b0[e] + b1[e] + (k == kp0 + 4 + e ? dsk : 0.f); } } }
            else { const int dd = (q - 256) >> 7, n0 = ((q - 256) & 127) >> 1, pw = dd ? 16 - i : i + 1; const int dg = (layer * 2 + dd) * 16 + g, dgn = (dd * 16 + g) * 64 + n0;
                const f32x4_t cr = *(const f32x4_t*)(p.in[I_CRE] + (dg * 16 + k) * 64 + n0), ci = *(const f32x4_t*)(p.in[I_CIM] + (dg * 16 + k) * 64 + n0);
#pragma unroll
                for (int m = 0; m < 4; ++m) { const f32x2_t l = *(const f32x2_t*)(lamp + ((dgn + m) * 17 + pw) * 2); v[2 * m] = cr[m] * l.x - ci[m] * l.y; v[2 * m + 1] = -(cr[m] * l.y + ci[m] * l.x); } } }
        else { const int idx = (it - NBY) * 8, q = idx & 255, rr = (idx >> 8) & 255, g = idx >> 16, dd = rr >> 7, n = (rr & 127) >> 1, c = rr & 1, j = q >> 4, kp0 = q & 15, pw = dd ? j : 15 - j; dst = BE + idx;
            const int dgn = (dd * 16 + g) * 64 + n; const f32x2_t l = *(const f32x2_t*)(lamp + (dgn * 17 + pw) * 2); const float* bs = bbar + (dgn * 16 + kp0) * 2;
#pragma unroll
            for (int h = 0; h < 4; ++h) { const f32x4_t bb = *(const f32x4_t*)(bs + 4 * h);
                v[2 * h] = c ? (l.x * bb[1] + l.y * bb[0]) : (l.x * bb[0] - l.y * bb[1]); v[2 * h + 1] = c ? (l.x * bb[3] + l.y * bb[2]) : (l.x * bb[2] - l.y * bb[3]); } }
        v4u o; o.x = pk2(v[0], v[1]); o.y = pk2(v[2], v[3]); o.z = pk2(v[4], v[5]); o.w = pk2(v[6], v[7]); *(v4u*)dst = o; }
}
__device__ __forceinline__ void st_s5tab2_lds(const Prm& p, LAS unsigned char* lds) {
    typedef float f32x2_t __attribute__((ext_vector_type(2)));
    const float* lamp = WSP(float, WS_LAMP); const float* bbar = WSP(float, WS_BBAR); float* kt = WSP(float, WS_KT); const int tid = TID_();
    LAS float* CR = (LAS float*)lds; LAS float* CI = CR + 1024; LAS f32x2_t* LM = (LAS f32x2_t*)(CI + 1024); LAS f32x2_t* BB = LM + 256;
    for (int u = BIDX_(); u < DEPTH * 2 * 16 * 4; u += GDIM_()) { const int ldg = u >> 2, tq = u & 3;
#pragma unroll
        for (int i = 0; i < 2; ++i) { const int q = tid + 512 * i; CR[q] = p.in[I_CRE][ldg * 1024 + q]; CI[q] = p.in[I_CIM][ldg * 1024 + q]; BB[q] = *(const f32x2_t*)(bbar + (size_t)(ldg * 1024 + q) * 2); }
        if (tid < 256) { const int n = tid >> 2, tl = tid & 3; LM[tid] = *(const f32x2_t*)(lamp + (size_t)((ldg * 64 + n) * 17 + 4 * tq + tl) * 2); }
        __syncthreads();
#pragma unroll
        for (int i = 0; i < 2; ++i) { const int o = tid + 512 * i, tl = o >> 8, k = (o >> 4) & 15, kp = o & 15; float acc = 0.f;
#pragma unroll 8
            for (int n = 0; n < 64; ++n) { const float cr = CR[k * 64 + n], ci = CI[k * 64 + n]; const f32x2_t lm = LM[n * 4 + tl], bb = BB[n * 16 + kp];
                const float tr = lm.x * bb.x - lm.y * bb.y, ti = lm.x * bb.y + lm.y * bb.x; acc += cr * tr - ci * ti; }
            kt[(size_t)(ldg * 16 + 4 * tq + tl) * 256 + k * 16 + kp] = acc; }
        __syncthreads(); }
}
__device__ __forceinline__ void st_mod_atomic(const Prm& p, LAS unsigned char* lds) {
    const int tid = TID_(), lane = tid & 63, wave = __builtin_amdgcn_readfirstlane(tid >> 6); LAS float* sl = (LAS float*)lds;
    LAS f32x4_t* red = (LAS f32x4_t*)(lds + 16384);
    for (int i = tid; i < (BATCH + 1) * D_MODEL; i += NTHREADS_) { const float cv = i < BATCH * D_MODEL ? p.in[I_C][i] : p.in[I_CCTX][i - BATCH * D_MODEL]; sl[i] = cv / (1.f + __expf(-cv)); }
    __syncthreads();
    float* mod = WSP(float, WS_MOD); constexpr int NJ4 = 6 * D_MODEL / 4, KC = 32, NJB = NJ4 / 64, NKG = D_MODEL / (8 * KC); static_assert(NJ4 % 64 == 0 && D_MODEL % (8 * KC) == 0 && BATCH == 2, "modulation units");
    for (int u = BIDX_(); u < DEPTH * NJB * NKG; u += GDIM_()) { const int l = u / (NJB * NKG), jb = u % NJB, kg = (u / NJB) % NKG, j4 = jb * 64 + lane, k0 = (kg * 8 + wave) * KC;
        const f32x4_t* w = (const f32x4_t*)(p.in[I_WMOD] + (size_t)l * D_MODEL * 6 * D_MODEL) + j4; f32x4_t acc[BATCH + 1];
#pragma unroll
        for (int m = 0; m <= BATCH; ++m) acc[m] = (f32x4_t){0.f, 0.f, 0.f, 0.f};
#pragma unroll
        for (int k = 0; k < KC; ++k) { const f32x4_t wv = w[(size_t)(k0 + k) * NJ4];
#pragma unroll
            for (int m = 0; m <= BATCH; ++m) acc[m] += sl[m * D_MODEL + k0 + k] * wv; }
        if (kg == 0 && wave == 0) { const f32x4_t bv = *((const f32x4_t*)(p.in[I_BMOD] + (size_t)l * 6 * D_MODEL) + j4);
#pragma unroll
            for (int m = 0; m <= BATCH; ++m) acc[m] += bv; }
#pragma unroll
        for (int m = 0; m <= BATCH; ++m) red[(wave * (BATCH + 1) + m) * 64 + lane] = acc[m];
        __syncthreads();
        if (tid < (BATCH + 1) * 64) { const int m = tid >> 6; f32x4_t sum = red[m * 64 + lane];
#pragma unroll
            for (int wv = 1; wv < 8; ++wv) sum += red[(wv * (BATCH + 1) + m) * 64 + lane];
            float* o = mod + ((size_t)(l * (BATCH + 1) + m) * 6 * D_MODEL) + 4 * j4;
#pragma unroll
            for (int e = 0; e < 4; ++e) (void)__hip_atomic_fetch_add(o + e, sum[e], __ATOMIC_RELAXED, __HIP_MEMORY_SCOPE_AGENT); }
        __syncthreads(); }
}
__device__ __forceinline__ void st_ssd_carry_b(const Prm& p, int g0, int gs) {
    float* sst = WSP(float, WS_SST); const float* CS = WSP(float, WS_CS);
    constexpr int NJ = (CTX_LEN + SEQ) / 128, BL = 11; static_assert(NJ % BL == 0, "carry block");
    for (int i = g0; i < BATCH * 2 * 4 * 64 * 128; i += gs) { const int e = i % 8192, h = (i / 8192) % 4, d = (i / 32768) % 2, b = i / 65536, dh = d * 4 + h; float hst = 0.f;
#pragma clang loop unroll(disable)
        for (int j0 = 0; j0 < NJ; j0 += BL) { float tmp[BL], dec[BL]; int so[BL];
#pragma unroll
            for (int u = 0; u < BL; ++u) { const int c = ssd_chunk_of(b, d, j0 + u); so[u] = ((c * 2 + d) * 4 + h) * 8192 + e; tmp[u] = sst[so[u]]; dec[u] = CS[(c * 128 + (d ? 0 : 127)) * 8 + dh]; }
#pragma unroll
            for (int u = 0; u < BL; ++u) { sst[so[u]] = hst; hst = hst * __expf(dec[u]) + tmp[u]; } } }
}
__device__ __forceinline__ void st_s5_carry_b(const Prm& p, int L, LAS unsigned char* lds) {
    typedef float f32x2_t __attribute__((ext_vector_type(2)));
    const int tid = TID_();
    const float* lamp = WSP(float, WS_LAMP) + (size_t)L * 2 * 16 * 64 * 17 * 2; const float* E = WSP(float, WS_S5E); act_t* A = WSP(act_t, WS_S5A);
    constexpr int NJ = (CTX_LEN + SEQ) / 16, NSEG = 16, SL = NJ / NSEG, BL = 11, NPW = NTHREADS_ / NSEG; static_assert(NJ % NSEG == 0 && SL % BL == 0 && 64 % NPW == 0, "carry segments");
    LAS f32x2_t* T = (LAS f32x2_t*)lds;
    const int nl = tid % NPW, seg = tid / NPW;
    for (int u = BIDX_(); u < BATCH * 2 * 16 * (64 / NPW); u += GDIM_()) { const int nh = u % (64 / NPW), g = (u / (64 / NPW)) & 15, d = (u / (64 / NPW) >> 4) & 1, b = u / (64 / NPW) >> 5, n = nh * NPW + nl; const int dgn = (d * 16 + g) * 64 + n;
        const float lr = lamp[(dgn * 17 + 16) * 2], li = lamp[(dgn * 17 + 16) * 2 + 1];
        const float* Eb = E + (size_t)g * NSC * 256 + d * 128 + 2 * n; act_t* Ab = A + (size_t)g * S5R * 512 + 256 + d * 128 + 2 * n;
        float hr = 0.f, hi = 0.f;
#pragma clang loop unroll(disable)
        for (int j0 = seg * SL; j0 < (seg + 1) * SL; j0 += BL) { f32x2_t t[BL];
#pragma unroll
            for (int q = 0; q < BL; ++q) t[q] = *(const f32x2_t*)(Eb + s5_sc_of(b, d, j0 + q) * 256);
#pragma unroll
            for (int q = 0; q < BL; ++q) { const float nr = lr * hr - li * hi + t[q].x, ni = lr * hi + li * hr + t[q].y; hr = nr; hi = ni; } }
        T[seg * NPW + nl] = (f32x2_t){hr, hi};
        float pr = 1.f, pi = 0.f;
        for (int q = 0; q < SL; ++q) { const float nr = pr * lr - pi * li, ni = pr * li + pi * lr; pr = nr; pi = ni; }
        __syncthreads();
        hr = 0.f; hi = 0.f;
        for (int sg = 0; sg < seg; ++sg) { const f32x2_t tt = T[sg * NPW + nl]; const float nr = pr * hr - pi * hi + tt.x, ni = pr * hi + pi * hr + tt.y; hr = nr; hi = ni; }
#pragma clang loop unroll(disable)
        for (int j0 = seg * SL; j0 < (seg + 1) * SL; j0 += BL) { f32x2_t t[BL]; int scs[BL];
#pragma unroll
            for (int q = 0; q < BL; ++q) { scs[q] = s5_sc_of(b, d, j0 + q); t[q] = *(const f32x2_t*)(Eb + scs[q] * 256); }
#pragma unroll
            for (int q = 0; q < BL; ++q) { *(unsigned*)(Ab + scs[q] * 512) = pk2(hr, hi); const float nr = lr * hr - li * hi + t[q].x, ni = lr * hi + li * hr + t[q].y; hr = nr; hi = ni; } }
        __syncthreads(); }
}

namespace ssdm {
typedef short bf16x8 __attribute__((ext_vector_type(8)));
typedef float f32x4 __attribute__((ext_vector_type(4)));
typedef unsigned u32x4 __attribute__((ext_vector_type(4)));
typedef unsigned u32x2 __attribute__((ext_vector_type(2)));
constexpr int RS = 136;
constexpr int L_CM = 0, L_BM = 128 * RS * 2, L_X = 2 * 128 * RS * 2, L_H = L_X + 64 * RS * 2, L_F = L_H + 64 * RS * 2, L_H2 = L_F + 2 * 4 * 128 * 4, L_END = L_H2 + 64 * RS * 2;
static_assert(L_END <= 131072, "SSD LDS map");
#define SSD_MFMA(a, b, c) __builtin_amdgcn_mfma_f32_16x16x32_bf16(a, b, c, 0, 0, 0)
__device__ __forceinline__ bf16x8 frag(const LAS unsigned short* base, int row, int k0, int quad) { return *(const LAS bf16x8*)(base + row * RS + k0 + 8 * quad); }
__device__ __forceinline__ unsigned cvtpk_(float lo, float hi) { typedef float f2_ __attribute__((ext_vector_type(2))); typedef __bf16 b2_ __attribute__((ext_vector_type(2))); f2_ v = {lo, hi}; return __builtin_bit_cast(unsigned, __builtin_convertvector(v, b2_)); }
__device__ __forceinline__ void lds_fence() { asm volatile("s_waitcnt lgkmcnt(0)" ::: "memory"); }
__device__ __forceinline__ void stage_dtcs(const Prm& p, LAS float* F, size_t r0, int g, int tid) {
    const int combo = tid >> 7, l = tid & 127, dh = (combo >> 1) * 4 + 2 * g + (combo & 1);
    F[tid] = WSP(float, WS_DT)[(r0 + l) * 8 + dh]; F[512 + tid] = WSP(float, WS_CS)[(r0 + l) * 8 + dh];
}
__device__ __forceinline__ void ssd_states_unit(const Prm& p, LAS unsigned char* lds, int c, int g, int tid) {
    const int lane = tid & 63, wave = __builtin_amdgcn_readfirstlane(tid >> 6), quad = lane >> 4, l15 = lane & 15;
    const act_t* xbc = WSP(act_t, WS_XBC); float* sst = WSP(float, WS_SST); const int r0 = c * 128;
    LAS unsigned short* BT = (LAS unsigned short*)(lds + L_BM); LAS unsigned short* XT0 = (LAS unsigned short*)(lds + L_X); LAS unsigned short* XT1 = (LAS unsigned short*)(lds + L_H); LAS float* F = (LAS float*)(lds + L_F);
#pragma unroll
    for (int i = 0; i < 4; ++i) { const int q = tid + 512 * i, l = q >> 4, n0 = (q & 15) * 8; const u32x4 v = *(const u32x4*)(xbc + (r0 + l) * 768 + 256 + g * 128 + n0);
#pragma unroll
        for (int e = 0; e < 4; ++e) { BT[(n0 + 2 * e) * RS + l] = (unsigned short)(v[e] & 0xffffu); BT[(n0 + 2 * e + 1) * RS + l] = (unsigned short)(v[e] >> 16); } }
#pragma unroll
    for (int hh = 0; hh < 2; ++hh) { LAS unsigned short* XT = hh ? XT1 : XT0;
#pragma unroll
        for (int i = 0; i < 2; ++i) { const int q = tid + 512 * i, l = q >> 3, p0 = (q & 7) * 8; const u32x4 v = *(const u32x4*)(xbc + (r0 + l) * 768 + (2 * g + hh) * 64 + p0);
#pragma unroll
            for (int e = 0; e < 4; ++e) { XT[(p0 + 2 * e) * RS + l] = (unsigned short)(v[e] & 0xffffu); XT[(p0 + 2 * e + 1) * RS + l] = (unsigned short)(v[e] >> 16); } } }
    { const int combo = tid >> 7, l = tid & 127, d = combo >> 1, dh = d * 4 + 2 * g + (combo & 1); const float* DTg = WSP(float, WS_DT); const float* CSg = WSP(float, WS_CS);
      F[tid] = DTg[(r0 + l) * 8 + dh] * __expf(CSg[(r0 + (d ? 0 : 127)) * 8 + dh] - CSg[(r0 + l) * 8 + dh]); }
    __syncthreads();
    const int rt = wave & 3, cb0 = 4 * (wave >> 2);
#pragma clang loop unroll(disable)
    for (int combo = 0; combo < 4; ++combo) { const int d = combo >> 1, h = 2 * g + (combo & 1); const LAS unsigned short* XT = (combo & 1) ? XT1 : XT0; f32x4 acc[4];
#pragma unroll
        for (int j = 0; j < 4; ++j) acc[j] = (f32x4){0.f, 0.f, 0.f, 0.f};
#pragma unroll
        for (int ks = 0; ks < 4; ++ks) { const bf16x8 ar = frag(XT, 16 * rt + l15, 32 * ks, quad);
            const f32x4 w0 = *(const LAS f32x4*)(F + combo * 128 + 32 * ks + 8 * quad), w1 = *(const LAS f32x4*)(F + combo * 128 + 32 * ks + 8 * quad + 4);
            const u32x4 au = __builtin_bit_cast(u32x4, ar); u32x4 sc;
            sc[0] = cvtpk_(__uint_as_float(au[0] << 16) * w0[0], __uint_as_float(au[0] & 0xffff0000u) * w0[1]); sc[1] = cvtpk_(__uint_as_float(au[1] << 16) * w0[2], __uint_as_float(au[1] & 0xffff0000u) * w0[3]);
            sc[2] = cvtpk_(__uint_as_float(au[2] << 16) * w1[0], __uint_as_float(au[2] & 0xffff0000u) * w1[1]); sc[3] = cvtpk_(__uint_as_float(au[3] << 16) * w1[2], __uint_as_float(au[3] & 0xffff0000u) * w1[3]);
            const bf16x8 a = __builtin_bit_cast(bf16x8, sc);
#pragma unroll
            for (int j = 0; j < 4; ++j) acc[j] = SSD_MFMA(a, frag(BT, 16 * (cb0 + j) + l15, 32 * ks, quad), acc[j]); }
        float* o = sst + ((c * 2 + d) * 4 + h) * 8192;
#pragma unroll
        for (int j = 0; j < 4; ++j)
#pragma unroll
            for (int e = 0; e < 4; ++e) o[(16 * rt + 4 * quad + e) * 128 + 16 * (cb0 + j) + l15] = acc[j][e]; }
    __syncthreads();
}
__device__ __forceinline__ void ssd_y_unit(const Prm& p, int L, LAS unsigned char* lds, int c, int g, int tid) {
    const int lane = tid & 63, wave = __builtin_amdgcn_readfirstlane(tid >> 6), quad = lane >> 4, l15 = lane & 15;
    const act_t* xbc = WSP(act_t, WS_XBC); const float* sst = WSP(float, WS_SST); act_t* P = WSP(act_t, WS_P); const int r0 = c * 128;
    LAS unsigned short* CM = (LAS unsigned short*)(lds + L_CM); LAS unsigned short* BM = (LAS unsigned short*)(lds + L_BM); LAS unsigned short* XT = (LAS unsigned short*)(lds + L_X); LAS unsigned short* HN = (LAS unsigned short*)(lds + L_H); LAS float* F = (LAS float*)(lds + L_F);
    const int lrow = 16 * wave + l15, wks = wave >> 1;
#pragma unroll
    for (int i = 0; i < 4; ++i) { const int q = tid + 512 * i, l = q >> 4, n0 = (q & 15) * 8;
        *(LAS u32x4*)(CM + l * RS + n0) = *(const u32x4*)(xbc + (r0 + l) * 768 + 512 + g * 128 + n0); *(LAS u32x4*)(BM + l * RS + n0) = *(const u32x4*)(xbc + (r0 + l) * 768 + 256 + g * 128 + n0); }
    stage_dtcs(p, F, r0, g, tid);
    u32x4 xr[2][2]; u32x2 xsk[2][4]; f32x4 ph[2][4];
#pragma unroll
    for (int hh = 0; hh < 2; ++hh) {
#pragma unroll
        for (int i = 0; i < 2; ++i) { const int q = tid + 512 * i; xr[hh][i] = *(const u32x4*)(xbc + (r0 + (q >> 3)) * 768 + (2 * g + hh) * 64 + (q & 7) * 8); }
#pragma unroll
        for (int j = 0; j < 4; ++j) xsk[hh][j] = *(const u32x2*)(xbc + (r0 + lrow) * 768 + (2 * g + hh) * 64 + 16 * j + 4 * quad); }
#define SSD_LOADH2(hh_) do { _Pragma("unroll") for (int d_ = 0; d_ < 2; ++d_) { const float* hin_ = sst + ((c * 2 + d_) * 4 + 2 * g + (hh_)) * 8192; \
        _Pragma("unroll") for (int i = 0; i < 4; ++i) { const int q = tid + 512 * i; ph[d_][i] = *(const f32x4*)(hin_ + (q >> 5) * 128 + (q & 31) * 4); } } } while (0)
    SSD_LOADH2(0);
    __syncthreads();
    f32x4 cb[8]; bf16x8 bc[4];
#pragma unroll
    for (int j = 0; j < 8; ++j) cb[j] = (f32x4){0.f, 0.f, 0.f, 0.f};
#pragma unroll
    for (int ks = 0; ks < 4; ++ks) { bc[ks] = frag(CM, lrow, 32 * ks, quad);
#pragma unroll
        for (int j = 0; j < 8; ++j) cb[j] = SSD_MFMA(frag(BM, 16 * j + l15, 32 * ks, quad), bc[ks], cb[j]); }
    __syncthreads();
    LAS unsigned short* HN1 = (LAS unsigned short*)(lds + L_H2);
#pragma unroll
    for (int hh = 0; hh < 2; ++hh) { const int h = 2 * g + hh;
        const LAS float* dt0 = F + hh * 128; const LAS float* cs0 = F + 512 + hh * 128; const LAS float* dt1 = F + (2 + hh) * 128; const LAS float* cs1 = F + 512 + (2 + hh) * 128;
#pragma unroll
        for (int i = 0; i < 2; ++i) { const int q = tid + 512 * i, l = q >> 3, p0 = (q & 7) * 8; const u32x4 v = xr[hh][i];
#pragma unroll
            for (int e = 0; e < 4; ++e) { XT[(p0 + 2 * e) * RS + l] = (unsigned short)(v[e] & 0xffffu); XT[(p0 + 2 * e + 1) * RS + l] = (unsigned short)(v[e] >> 16); } }
#pragma unroll
        for (int i = 0; i < 4; ++i) { const int q = tid + 512 * i, pp = q >> 5, n0 = (q & 31) * 4; u32x2 w0, w1; w0.x = cvtpk_(ph[0][i][0], ph[0][i][1]); w0.y = cvtpk_(ph[0][i][2], ph[0][i][3]); w1.x = cvtpk_(ph[1][i][0], ph[1][i][1]); w1.y = cvtpk_(ph[1][i][2], ph[1][i][3]);
            *(LAS u32x2*)(HN + pp * RS + n0) = w0; *(LAS u32x2*)(HN1 + pp * RS + n0) = w1; }
        if (hh == 0) SSD_LOADH2(1);
        const float c0l = cs0[lrow], c1l = cs1[lrow];
#pragma unroll
        for (int j = 0; j < 8; ++j) { float m4[4]; const int s0i = 16 * j + 4 * quad;
            if (j < wave) { const f32x4 cs4 = *(const LAS f32x4*)(cs0 + s0i), dt4 = *(const LAS f32x4*)(dt0 + s0i);
#pragma unroll
                for (int e = 0; e < 4; ++e) m4[e] = cb[j][e] * dt4[e] * __expf(fminf(c0l - cs4[e], 0.f)); }
            else if (j > wave) { const f32x4 cs4 = *(const LAS f32x4*)(cs1 + s0i), dt4 = *(const LAS f32x4*)(dt1 + s0i);
#pragma unroll
                for (int e = 0; e < 4; ++e) m4[e] = cb[j][e] * dt4[e] * __expf(fminf(c1l - cs4[e], 0.f)); }
            else { const f32x4 ca4 = *(const LAS f32x4*)(cs0 + s0i), da4 = *(const LAS f32x4*)(dt0 + s0i), cb4 = *(const LAS f32x4*)(cs1 + s0i), db4 = *(const LAS f32x4*)(dt1 + s0i);
#pragma unroll
                for (int e = 0; e < 4; ++e) { const int sidx = s0i + e; const float t0 = sidx <= lrow ? da4[e] * __expf(fminf(c0l - ca4[e], 0.f)) : 0.f, t1 = sidx >= lrow ? db4[e] * __expf(fminf(c1l - cb4[e], 0.f)) : 0.f; m4[e] = cb[j][e] * (t0 + t1); } }
            u32x2 w; w.x = cvtpk_(m4[0], m4[1]); w.y = cvtpk_(m4[2], m4[3]); *(LAS u32x2*)(BM + lrow * RS + s0i) = w; }
        __syncthreads();
        f32x4 dg[4], o0[4], o1[4];
#pragma unroll
        for (int j = 0; j < 4; ++j) { dg[j] = (f32x4){0.f, 0.f, 0.f, 0.f}; o0[j] = dg[j]; o1[j] = dg[j]; }
#pragma unroll
        for (int ks = 0; ks < 4; ++ks) { const bf16x8 bm_ = frag(BM, lrow, 32 * ks, quad);
#pragma unroll
            for (int j = 0; j < 4; ++j) { dg[j] = SSD_MFMA(frag(XT, 16 * j + l15, 32 * ks, quad), bm_, dg[j]); o0[j] = SSD_MFMA(frag(HN, 16 * j + l15, 32 * ks, quad), bc[ks], o0[j]); o1[j] = SSD_MFMA(frag(HN1, 16 * j + l15, 32 * ks, quad), bc[ks], o1[j]); } }
        const float sc0 = __expf(c0l), sc1 = __expf(c1l), dsk = p.in[I_SD][L * 4 + h];
        __syncthreads();
#pragma unroll
        for (int j = 0; j < 4; ++j) { const int r = r0 + lrow; const int hp = h * 64 + 16 * j + 4 * quad; float xv[4]; const u32x2 xr_ = xsk[hh][j]; const f32x4 yv = dg[j] + sc0 * o0[j] + sc1 * o1[j];
            xv[0] = __uint_as_float(xr_.x << 16); xv[1] = __uint_as_float(xr_.x & 0xffff0000u); xv[2] = __uint_as_float(xr_.y << 16); xv[3] = __uint_as_float(xr_.y & 0xffff0000u);
            u32x2 w; w.x = cvtpk_(yv[0] + dsk * xv[0], yv[1] + dsk * xv[1]); w.y = cvtpk_(yv[2] + dsk * xv[2], yv[3] + dsk * xv[3]);
            *(u32x2*)(P + r * PLD + YSSD_OFF + hp) = w; } }
#undef SSD_LOADH2
}
__device__ __forceinline__ void ssd_y_chunk(const Prm& p, int L, LAS unsigned char* lds, int c, int tid) {
#pragma clang loop unroll(disable)
    for (int g_ = 0; g_ < 2; ++g_) { int g = g_, t2 = tid; asm volatile("" : "+s"(g), "+v"(t2)); ssd_y_unit(p, L, lds, c, g, t2); }
    const int lane = tid & 63, wave = __builtin_amdgcn_readfirstlane(tid >> 6), quad = lane >> 4, l15 = lane & 15; const int r = c * 128 + 16 * wave + l15;
    const act_t* P = WSP(act_t, WS_P); act_t* ym = WSP(act_t, WS_YMIX); const float* ng = p.in[I_SNG] + L * 256; float ss = 0.f;
    u32x2 zq[4][4], yq[4][4];
#pragma unroll
    for (int h = 0; h < 4; ++h)
#pragma unroll
        for (int j = 0; j < 4; ++j) { const int hp = h * 64 + 16 * j + 4 * quad; zq[h][j] = *(const u32x2*)(P + r * PLD + Z_OFF + hp); if (h < 2) yq[h][j] = *(const u32x2*)(P + r * PLD + YSSD_OFF + hp); }
    asm volatile("s_waitcnt vmcnt(0)" ::: "memory");
#pragma unroll
    for (int h = 2; h < 4; ++h)
#pragma unroll
        for (int j = 0; j < 4; ++j) yq[h][j] = *(const u32x2*)(P + r * PLD + YSSD_OFF + h * 64 + 16 * j + 4 * quad);
#pragma unroll
    for (int h = 0; h < 4; ++h)
#pragma unroll
        for (int j = 0; j < 4; ++j) { const u32x2 zr = zq[h][j], yr = yq[h][j]; float z[4], y[4];
            z[0] = __uint_as_float(zr.x << 16); z[1] = __uint_as_float(zr.x & 0xffff0000u); z[2] = __uint_as_float(zr.y << 16); z[3] = __uint_as_float(zr.y & 0xffff0000u);
            y[0] = __uint_as_float(yr.x << 16); y[1] = __uint_as_float(yr.x & 0xffff0000u); y[2] = __uint_as_float(yr.y << 16); y[3] = __uint_as_float(yr.y & 0xffff0000u);
#pragma unroll
            for (int e = 0; e < 4; ++e) { const float v = y[e] * z[e] * __builtin_amdgcn_rcpf(1.f + __expf(-z[e])); ss += v * v; } }
    ss += __shfl_xor(ss, 16); ss += __shfl_xor(ss, 32);
    const float rn = 1.0f / sqrtf(ss * (1.f / 256.f) + NORM_EPS);
#pragma unroll
    for (int h = 0; h < 4; ++h)
#pragma unroll
        for (int j = 0; j < 4; ++j) { const int hp = h * 64 + 16 * j + 4 * quad; const f32x4 g4 = *(const f32x4*)(ng + hp); const u32x2 zr = zq[h][j], yr = yq[h][j]; float z[4], y[4], o[4];
            z[0] = __uint_as_float(zr.x << 16); z[1] = __uint_as_float(zr.x & 0xffff0000u); z[2] = __uint_as_float(zr.y << 16); z[3] = __uint_as_float(zr.y & 0xffff0000u);
            y[0] = __uint_as_float(yr.x << 16); y[1] = __uint_as_float(yr.x & 0xffff0000u); y[2] = __uint_as_float(yr.y << 16); y[3] = __uint_as_float(yr.y & 0xffff0000u);
#pragma unroll
            for (int e = 0; e < 4; ++e) o[e] = y[e] * z[e] * __builtin_amdgcn_rcpf(1.f + __expf(-z[e])) * rn * g4[e];
            u32x2 w; w.x = pk2(o[0], o[1]); w.y = pk2(o[2], o[3]); *(u32x2*)(ym + r * D_MIX + hp) = w; }
}
#undef SSD_MFMA
}
__device__ __forceinline__ void st_ssd_states_m(const Prm& p, LAS unsigned char* lds) {
    const int t = TID_(); const int G = GDIM_(), bx = BIDX_();
    const int nps = G >= 160 ? G - 16 * (S5R / 256) : G;
    if (bx < nps) for (int u = bx; u < NCH * 2; u += nps) ssdm::ssd_states_unit(p, lds, u >> 1, u & 1, TID_());
}
__device__ __forceinline__ void st_ssd_y_m(const Prm& p, int L, int nrows, LAS unsigned char* lds) {
    const int t = TID_(); const int G = GDIM_(), bx = BIDX_();
    (void)t; for (int u = bx; u < nrows / 128; u += G) ssdm::ssd_y_chunk(p, L, lds, u, TID_());
}

typedef unsigned u32x4v_t __attribute__((ext_vector_type(4)));
__device__ __forceinline__ void unpack8_(const u32x4v_t v, float* o) {
#pragma unroll
    for (int e = 0; e < 4; ++e) { o[2 * e] = __uint_as_float(v[e] << 16); o[2 * e + 1] = __uint_as_float(v[e] & 0xffff0000u); } }
__device__ __forceinline__ u32x4v_t pack8_(const float* o) { u32x4v_t w; w.x = pk2(o[0], o[1]); w.y = pk2(o[2], o[3]); w.z = pk2(o[4], o[5]); w.w = pk2(o[6], o[7]); return w; }
__device__ __forceinline__ void st_ssd_conv_v(const Prm& p, int L) {
    const int tid = TID_(), cg = tid % 96, rs_ = tid / 96; if (rs_ >= 5) return;
    const act_t* P = WSP(act_t, WS_P); act_t* xbc = WSP(act_t, WS_XBC); const int c = cg * 8;
    const float* cw = p.in[I_SCW] + (size_t)L * 3 * SSD_XBC; const float* cb = p.in[I_SCB] + (size_t)L * SSD_XBC;
    float w0[8], w1[8], w2[8], bb[8];
#pragma unroll
    for (int e = 0; e < 8; ++e) { w0[e] = cw[c + e]; w1[e] = cw[SSD_XBC + c + e]; w2[e] = cw[2 * SSD_XBC + c + e]; bb[e] = cb[c + e]; }
    const int stride = GDIM_() * 5;
    for (int r0 = BIDX_() * 5 + rs_; r0 < MT; r0 += 4 * stride) { u32x4v_t vm[4], vl[4], vh[4];
#pragma unroll
        for (int u = 0; u < 4; ++u) { const int r = r0 + u * stride; vm[u] = (u32x4v_t){0u, 0u, 0u, 0u}; vl[u] = vm[u]; vh[u] = vm[u];
            if (r < MT) { const int t = r < ML ? r % SEQ : (r - ML) % CTX_LEN, T = r < ML ? SEQ : CTX_LEN; const act_t* src = P + (size_t)r * PLD + XBC_OFF + c;
                vm[u] = *(const u32x4v_t*)src; if (t > 0) vl[u] = *(const u32x4v_t*)(src - PLD); if (t < T - 1) vh[u] = *(const u32x4v_t*)(src + PLD); } }
#pragma unroll
        for (int u = 0; u < 4; ++u) { const int r = r0 + u * stride; if (r < MT) { float x[8], v[8];
                unpack8_(vm[u], x);
#pragma unroll
                for (int e = 0; e < 8; ++e) v[e] = bb[e] + w1[e] * x[e];
                unpack8_(vl[u], x);
#pragma unroll
                for (int e = 0; e < 8; ++e) v[e] += w0[e] * x[e];
                unpack8_(vh[u], x);
#pragma unroll
                for (int e = 0; e < 8; ++e) v[e] += w2[e] * x[e];
#pragma unroll
                for (int e = 0; e < 8; ++e) v[e] = v[e] * __builtin_amdgcn_rcpf(1.f + __expf(-v[e]));
                *(u32x4v_t*)(xbc + (size_t)r * SSD_XBC + c) = pack8_(v); } } }
}
__device__ __forceinline__ void st_qk_prep_v(const Prm& p, int L, int g0, int gs) {
    act_t* P = WSP(act_t, WS_P); const float* rc = WSP(float, WS_ROPE); const float* rs = rc + (size_t)SEQ * 32;
    for (int i = g0; i < MT * 12; i += gs) { const int r = i / 12, s = i % 12; const bool isctx = r >= ML; const int t = r % SEQ;
        int off; const float* gn = nullptr; float scale = 1.f;
        if (s < 4) { off = GAQ + s * 64; gn = p.in[I_GAQN] + L * 64; scale = QSCALE; }
        else if (s < 6) { off = GAK + (s - 4) * 64; gn = p.in[I_GAKN] + L * 64; }
        else if (s < 10) { off = WAQ + (s - 6) * 64; scale = QSCALE; }
        else { off = WAK + (s - 10) * 64; if (isctx) continue; }
        act_t* v = P + (size_t)r * PLD + off; float x[64];
#pragma unroll
        for (int c = 0; c < 8; ++c) unpack8_(*(const u32x4v_t*)(v + 8 * c), x + 8 * c);
        float rn = scale;
        if (gn) { float ssq = 0.f;
#pragma unroll
            for (int e = 0; e < 64; ++e) ssq += x[e] * x[e];
            rn = scale / sqrtf(ssq * (1.f / 64.f) + NORM_EPS);
#pragma unroll
            for (int e = 0; e < 64; ++e) x[e] *= gn[e]; }
        if (!isctx) {
#pragma unroll
            for (int e4 = 0; e4 < 8; ++e4) { const f32x4_t c4 = *((const f32x4_t*)(rc + (size_t)t * 32) + e4), s4 = *((const f32x4_t*)(rs + (size_t)t * 32) + e4);
#pragma unroll
                for (int q = 0; q < 4; ++q) { const int e = 4 * e4 + q; const float x1 = x[e], x2 = x[e + 32]; x[e] = x1 * c4[q] - x2 * s4[q]; x[e + 32] = x2 * c4[q] + x1 * s4[q]; } } }
#pragma unroll
        for (int e = 0; e < 64; ++e) x[e] *= rn;
#pragma unroll
        for (int c = 0; c < 8; ++c) *(u32x4v_t*)(v + 8 * c) = pack8_(x + 8 * c); }
}

__device__ __forceinline__ void st_ffn_fixup(const Prm& p, int L, int g0, int gs) {
    const float* EG = WSP(float, WS_EG); const float* EU = WSP(float, WS_EU); act_t* ACT = WSP(act_t, WS_ACT);
    const float* cw = p.in[I_FCW] + (size_t)L * 3 * D_FF; const float* cb = p.in[I_FCB] + (size_t)L * D_FF;
    constexpr int NB = ML / 256 - 1;
    for (int i = g0; i < NB * D_FF; i += gs) { const int pm = i / D_FF, c = i % D_FF; if (((pm + 1) * 256) % SEQ == 0) continue;
        const float gA = EG[((size_t)pm * 4 + 2) * D_FF + c], gB = EG[((size_t)pm * 4 + 3) * D_FF + c], gC = EG[((size_t)(pm + 1) * 4 + 0) * D_FF + c], gD = EG[((size_t)(pm + 1) * 4 + 1) * D_FF + c];
        const float uB = EU[((size_t)pm * 2 + 1) * D_FF + c], uC = EU[((size_t)(pm + 1) * 2) * D_FF + c];
        const float w0 = cw[c], w1 = cw[D_FF + c], w2 = cw[2 * D_FF + c], b = cb[c];
        const float x0 = b + w0 * gA + w1 * gB + w2 * gC, x1 = b + w0 * gB + w1 * gC + w2 * gD;
        const size_t R = (size_t)(pm + 1) * 256 - 1;
        stf(ACT + R * D_FF + c, x0 / (1.f + __expf(-x0)) * uB); stf(ACT + (R + 1) * D_FF + c, x1 / (1.f + __expf(-x1)) * uC); }
}

__device__ __forceinline__ void sub_barrier(unsigned* cnt, unsigned np, bool arrive) {
    asm volatile("s_waitcnt vmcnt(0)" ::: "memory");
    __syncthreads();
    if (TID_() == 0) {
        if (arrive) { __builtin_amdgcn_fence(__ATOMIC_RELEASE, "agent"); asm volatile("s_waitcnt vmcnt(0)" ::: "memory");
            (void)__hip_atomic_fetch_add(cnt, 1u, __ATOMIC_RELAXED, __HIP_MEMORY_SCOPE_AGENT); }
        unsigned sp = 0; while (__hip_atomic_load(cnt, __ATOMIC_RELAXED, __HIP_MEMORY_SCOPE_AGENT) < np) { __builtin_amdgcn_s_sleep(2); if (++sp > (1u << 22)) break; }
        __builtin_amdgcn_fence(__ATOMIC_ACQUIRE, "agent"); asm volatile("s_waitcnt vmcnt(0)" ::: "memory");
    }
    __syncthreads();
}
#endif

HD void run_step(const Prm& p, int st, int L, int g0_, int gs_) {
#ifdef CPU_TEST
    const int g0 = g0_, gs = gs_;
#else
    extern __shared__ __attribute__((aligned(16))) unsigned char lds_dyn_[];
    LAS unsigned char* const ldsb = (LAS unsigned char*)lds_dyn_;
    const int tidl_ = TID_();
    const int g0 = BIDX_() * NTHREADS_ + tidl_, gs = GDIM_() * NTHREADS_;
#endif
    const int nrows = (L < DEPTH - 1) ? MT : ML;
#ifndef CPU_TEST
    using namespace pg8;
    const float* modL = (const float*)(p.ws + WS_MOD) + (size_t)L * (BATCH + 1) * 6 * D_MODEL;
    const int G = GDIM_(), bid = BIDX_();
#endif
    switch (st) {
#ifdef CPU_TEST
    case S_MOD: st_mod(p, g0, gs); break;
#else
    case S_MOD: st_mod_atomic(p, ldsb); break;
#endif
#ifdef CPU_TEST
    case S_INIT: st_init(p, g0, gs); break;
#else
    case S_INIT: st_rope_tab(p, g0, gs); { float* xc = WSP(float, WS_XC); for (int i = g0; i < MC * D_MODEL; i += gs) xc[i] = p.in[I_CTX][i]; } break;
#endif
    case S_TAB1: st_s5tab1(p, g0, gs); break;
#ifdef CPU_TEST
    case S_TAB2: st_s5tab2(p, g0, gs); break;
#else
    case S_TAB2: st_s5tab2_lds(p, ldsb); break;
#endif
#ifdef CPU_TEST
    case S_ROWSS: st_rowss(p, MT, g0, gs); break;
    case S_NORM_MIX: st_normmod(p, L, 0, MT, g0, gs); break;
    case S_NORM_FFN: st_normmod(p, L, 1, nrows, g0, gs); break;
    case S_ROWSS_FIN: st_rowss(p, ML, g0, gs); break;
    case S_FINAL: st_final(p, g0, gs); break;
    case S_CS: st_ssd_cs(p, L, g0, gs); break;
    case S_SSD_CARRY: st_ssd_carry(p, g0, gs); break;
    case S_S5_CARRY: st_s5_carry(p, L, g0, gs); break;
    case S_SSD_OUT: st_ssd_out(p, L, nrows, g0, gs); break;
#else
    case S_NORM_MIX: st_norm_fused(p, L, 0, MT, L > 0 ? modp(p, L - 1, BATCH, 5) : nullptr); break;
    case S_NORM_FFN: st_norm_fused(p, L, 1, nrows, nrows > ML ? modp(p, L, BATCH, 2) : nullptr); break;
    case S_FINAL: st_final_fused(p); break;
    case S_CS: st_ssd_cs_w(p, L); break;
    case S_SSD_CARRY: st_ssd_carry_b(p, g0, gs); break;
    case S_S5_CARRY: st_s5_carry_b(p, L, ldsb); break;
    case S_SSD_OUT: st_ssd_out_w(p, L, nrows); break;
#endif
#ifdef CPU_TEST
    case S_TABB: st_s5tabB(p, L, g0, gs); break;
#else
    case S_TABB: { const int nfull = (MT / 256) * (NIN / 256) - 2 * GDIM_();
        const int b_ = BIDX_(), G_ = GDIM_(); if (nfull > 0 && nfull < G_) { if (b_ >= nfull) st_s5tabB_v(p, L, (b_ - nfull) * NTHREADS_ + TID_(), (G_ - nfull) * NTHREADS_); } else st_s5tabB_v(p, L, g0, gs); } break;
#endif
#ifdef CPU_TEST
    case S_ATTN: st_attn(p, L, nrows, g0, gs); break;
#else
    case S_ATTN: st_attn_mfma(p, L, 0, (char*)lds_dyn_); break;
    case S_ATTNC: if (L < DEPTH - 1) st_attn_mfma(p, L, 1, (char*)lds_dyn_); break;
#endif
#ifdef CPU_TEST
    case S_WPREP: case S_WPREP2: case S_ATTNC: break;
    case S_CONV: st_ssd_conv(p, L, g0, gs); break;
    case S_QK: st_qk_prep(p, L, g0, gs); break;
    case S_STATE: st_ssd_state(p, g0, gs); break;
    case S_CB: st_ssd_cb(p, g0, gs); break;
    case S_SSD_Y: st_ssd_y(p, L, nrows, g0, gs); break;
    case S_S5E: st_s5_E_naive(p, g0, gs); break;
    case S_S5_Y: st_s5_Y_naive(p, nrows, g0, gs); break;
    case S_GEMM_IN: { EpiStoreIn e{&p}; naive_gemm(WSP(act_t, WS_XN), D_MODEL, p.in[I_WIN] + (size_t)L * D_MODEL * D_IN, D_IN, MT, D_IN, D_MODEL, e, g0, gs); } break;
    case S_GLU: st_glu(p, L, nrows, g0, gs); break;
    case S_GEMM_OUT: { EpiResid e{&p, L, 2}; naive_gemm(WSP(act_t, WS_YMIX), D_MIX, p.in[I_WOUT] + (size_t)L * D_MIX * D_MODEL, D_MODEL, nrows, D_MODEL, D_MIX, e, g0, gs); } break;
    case S_GEMM_GATE: { EpiStore e{WSP(act_t, WS_GT), D_FF}; naive_gemm(WSP(act_t, WS_XN), D_MODEL, p.in[I_WGATE] + (size_t)L * D_MODEL * D_FF, D_FF, nrows, D_FF, D_MODEL, e, g0, gs); } break;
    case S_GEMM_UP: { EpiUp e{&p, L}; naive_gemm(WSP(act_t, WS_XN), D_MODEL, p.in[I_WUP] + (size_t)L * D_MODEL * D_FF, D_FF, nrows, D_FF, D_MODEL, e, g0, gs); } break;
    case S_GEMM_DOWN: { EpiResid e{&p, L, 5}; naive_gemm(WSP(act_t, WS_ACT), D_FF, p.in[I_WDOWN] + (size_t)L * D_FF * D_MODEL, D_MODEL, nrows, D_MODEL, D_FF, e, g0, gs); } break;
#else
    case S_WPREP: st_wprep(p, L, ldsb, g0, gs, 0); break;
    case S_WPREP2: st_wprep(p, L, ldsb, g0, gs, 1); break;
    case S_CONV: st_ssd_conv_v(p, L); break;
    case S_QK: st_qk_prep_v(p, L, g0, gs); break;
    case S_STATE: st_ssd_states_m(p, ldsb); break;
    case S_SSD_Y: st_ssd_y_m(p, L, nrows, ldsb); break;
    case S_GEMM_IN: { Gemm g{WSP(act_t, WS_XN), WSP(act_t, WS_WIN), MT, NIN, D_MODEL, D_MODEL}; StaticOrder S; S.init(MT, NIN, G, bid);
        EpiInProj E{WSP(act_t, WS_P), WSP(act_t, WS_S5A), WSP(float, WS_DTRAW)}; gemm_phase<EpiInProj, StaticOrder, true, true>(ldsb, g, S, E); } break;
    case S_S5E: { int k5 = 256; asm volatile("" : "+s"(k5)); Gemm g{WSP(act_t, WS_S5A), WSP(act_t, WS_S5BE), 16 * S5R, 16 * 256, k5, 512}; BatchedOrder S; S.init(G, bid);
        EpiS5E E{WSP(float, WS_S5E)}; gemm_phase<EpiS5E, BatchedOrder, true, true>(ldsb, g, S, E); } break;
    case S_S5_Y: { Gemm g{WSP(act_t, WS_S5A), WSP(act_t, WS_S5BY), 16 * S5R, 16 * 256, 512, 512}; BatchedOrder S; S.init(G, bid);
        EpiS5Y E{WSP(act_t, WS_P), nrows / 16}; gemm_phase<EpiS5Y, BatchedOrder, true, true>(ldsb, g, S, E); } break;
    case S_SUBGLU: { constexpr int NP = 16 * (S5R / 256); const int nssd = nrows / 128, pi = bid - nssd; if (pi >= 0 && G - nssd >= NP) {
            sub_barrier((unsigned*)(p.ws + WS_CTL) + 1024 + 64 * L, NP, bid >= G - NP);
            int kglu = 256; asm volatile("" : "+s"(kglu)); Gemm g{WSP(act_t, WS_P) + YS5_OFF, WSP(act_t, WS_WGLU), nrows, 512, kglu, PLD}; StaticOrder S; S.init(nrows, 512, G - nssd, pi);
            EpiGluM E{WSP(act_t, WS_YMIX), p.in[I_BGLU] + L * 512}; gemm_phase<EpiGluM, StaticOrder, true, true>(ldsb, g, S, E); } } break;
    case S_GLU: { int kglu = 256; asm volatile("" : "+s"(kglu)); Gemm g{WSP(act_t, WS_P) + YS5_OFF, WSP(act_t, WS_WGLU), nrows, 512, kglu, PLD}; StaticOrder S; S.init(nrows, 512, G, bid);
        EpiGluM E{WSP(act_t, WS_YMIX), p.in[I_BGLU] + L * 512}; gemm_phase<EpiGluM, StaticOrder, true, true>(ldsb, g, S, E); } break;
    case S_GEMM_OUT: { Gemm g{WSP(act_t, WS_YMIX), WSP(act_t, WS_WOUT), nrows, D_MODEL, D_MIX, D_MIX};
        EpiResidM E{p.out, WSP(float, WS_XC), L == 0 ? p.in[I_X] : p.out, WSP(float, WS_XC), modL, 2, WSP(float, WS_SLAB), D_MIX / 64};
        if (nrows > ML) { TailSplitOrder S; S.init(D_MIX, G, bid); gemm_phase<EpiResidM, TailSplitOrder, true, true>(ldsb, g, S, E); }
        else { StaticOrder S; S.init(nrows, D_MODEL, G, bid); gemm_phase<EpiResidM, StaticOrder, true, true>(ldsb, g, S, E); } } break;
    case S_GEMM_GU: { Gemm g{WSP(act_t, WS_XN), WSP(act_t, WS_WG), nrows, 2 * D_FF, D_MODEL, D_MODEL}; StaticOrder S; S.init(nrows, 2 * D_FF, G, bid);
        EpiGateUpM E{WSP(act_t, WS_ACT), p.in[I_FCW] + (size_t)L * 3 * D_FF, p.in[I_FCB] + (size_t)L * D_FF, WSP(float, WS_EG), WSP(float, WS_EU)}; gemm_phase<EpiGateUpM, StaticOrder, true, true>(ldsb, g, S, E); } break;
    case S_FIXUP: st_ffn_fixup(p, L, g0, gs); break;
    case S_GEMM_GATE: { Gemm g{WSP(act_t, WS_XN), WSP(act_t, WS_WG), nrows, D_FF, D_MODEL, D_MODEL}; StaticOrder S; S.init(nrows, D_FF, G, bid);
        EpiBf16<0> E{WSP(act_t, WS_GT), D_FF, nullptr, 0, 0, 1.f}; gemm_phase<EpiBf16<0>, StaticOrder, true, true>(ldsb, g, S, E); } break;
    case S_GEMM_UP: { Gemm g{WSP(act_t, WS_XN), WSP(act_t, WS_WU), nrows, D_FF, D_MODEL, D_MODEL}; StaticOrder S; S.init(nrows, D_FF, G, bid);
        EpiUpM E{WSP(act_t, WS_GT), WSP(act_t, WS_ACT), p.in[I_FCW] + (size_t)L * 3 * D_FF, p.in[I_FCB] + (size_t)L * D_FF}; gemm_phase<EpiUpM, StaticOrder, true, true>(ldsb, g, S, E); } break;
    case S_GEMM_DOWN: { Gemm g{WSP(act_t, WS_ACT), WSP(act_t, WS_WD), nrows, D_MODEL, D_FF, D_FF};
        EpiResidM E{p.out, WSP(float, WS_XC), p.out, WSP(float, WS_XC), modL, 5, WSP(float, WS_SLAB), D_FF / 64};
        if (nrows > ML) { TailSplitOrder S; S.init(D_FF, G, bid); gemm_phase<EpiResidM, TailSplitOrder, true, true>(ldsb, g, S, E); }
        else { StaticOrder S; S.init(nrows, D_MODEL, G, bid); gemm_phase<EpiResidM, StaticOrder, true, true>(ldsb, g, S, E); } } break;
#endif
    default: break;
    }
}

#ifndef CPU_TEST
#define XB_TMO      128
#define XB_XCNT(j)  (256  + 64 * (j))
#define XB_XSUB(j)  (1280 + 64 * (j))
#define XB_XGEN(j)  (2304 + 64 * (j))
#define XB_TOP      3328
#define XB_TOPGEN   3392
#define XCD_BAR_WORDS 3456
#define XB_SPIN_CAP (1u << 22)
__device__ __forceinline__ unsigned xb_ld(unsigned* p)              { return __hip_atomic_load(p, __ATOMIC_RELAXED, __HIP_MEMORY_SCOPE_AGENT); }
__device__ __forceinline__ unsigned xb_add(unsigned* p, unsigned v) { return __hip_atomic_fetch_add(p, v, __ATOMIC_RELAXED, __HIP_MEMORY_SCOPE_AGENT); }
__device__ __forceinline__ unsigned xb_xcc_id() { return (unsigned)__builtin_amdgcn_s_getreg((3 << 11) | 20) & 0xFu; }
#define XB_SPIN(cond, bar) do { unsigned _sp = 0; while (cond) { __builtin_amdgcn_s_sleep(1); \
    if ((++_sp & 255u) == 0u) { if (xb_ld(&(bar)[XB_TMO])) break; if (_sp > XB_SPIN_CAP) { atomicAdd(&(bar)[XB_TMO], 1u); break; } } } } while (0)
struct XcdBarrier { unsigned* bar; unsigned x; volatile LAS unsigned* st; };
__device__ __forceinline__ XcdBarrier xcd_barrier_post(unsigned* bar, volatile LAS unsigned* st) {
    XcdBarrier b; b.bar = bar; b.x = xb_xcc_id(); b.st = st;
    if (TID_() == 0) (void)xb_add(&bar[XB_XCNT(b.x)], 1u);
    return b;
}
__device__ __forceinline__ void xcd_barrier_complete(unsigned* bar, unsigned x, unsigned& nloc, unsigned& nx) {
    const unsigned G = gridDim.x * gridDim.y * gridDim.z;
    unsigned sum, cnt, mine, sp = 0u;
    for (;;) {
        sum = 0u; cnt = 0u; mine = 0u;
#pragma unroll
        for (unsigned j = 0; j < 16; ++j) { const unsigned c = xb_ld(&bar[XB_XCNT(j)]); sum += c; cnt += (c > 0u) ? 1u : 0u; mine = (j == x) ? c : mine; }
        if (sum == G) break;
        __builtin_amdgcn_s_sleep(1);
        if ((++sp & 255u) == 0u) { if (xb_ld(&bar[XB_TMO])) break; if (sp > XB_SPIN_CAP) { atomicAdd(&bar[XB_TMO], 1u); break; } }
    }
    nloc = mine > 0u ? mine : 1u; nx = cnt > 0u ? cnt : 1u;
}
__device__ __forceinline__ void xcd_barrier(const XcdBarrier& b) {
    asm volatile("s_waitcnt vmcnt(0)" ::: "memory");
    __syncthreads();
    if (TID_() == 0) {
        unsigned* bar = b.bar;
        __builtin_amdgcn_s_waitcnt(0);
        unsigned nloc = b.st[0], nx = b.st[1];
        if (nloc == 0u) { xcd_barrier_complete(bar, b.x, nloc, nx); b.st[0] = nloc; b.st[1] = nx; }
        const unsigned old = xb_add(&bar[XB_XSUB(b.x)], 1u);
        const unsigned gen = old / nloc;
        if (old + 1u == (gen + 1u) * nloc) {
            __builtin_amdgcn_fence(__ATOMIC_RELEASE, "agent");
            asm volatile("s_waitcnt vmcnt(0)" ::: "memory");
            const unsigned og = xb_add(&bar[XB_TOP], 1u);
            const unsigned tg = og / nx;
            if (og + 1u == (tg + 1u) * nx) xb_add(&bar[XB_TOPGEN], 1u);
            else XB_SPIN(xb_ld(&bar[XB_TOPGEN]) == tg, bar);
            __builtin_amdgcn_fence(__ATOMIC_ACQUIRE, "agent");
            xb_add(&bar[XB_XGEN(b.x)], 1u);
            asm volatile("s_waitcnt vmcnt(0)" ::: "memory");
        } else {
            XB_SPIN(xb_ld(&bar[XB_XGEN(b.x)]) == gen, bar);
            __builtin_amdgcn_fence(__ATOMIC_ACQUIRE, "agent");
            asm volatile("s_waitcnt vmcnt(0)" ::: "memory");
        }
    }
    __syncthreads();
}

constexpr int LDS_BYTES = 147456;
constexpr int MISC_OFF = MISC_OFF_;
constexpr int CW_BAR = 4096;
__global__ void __launch_bounds__(NTHREADS_, 2) mk_fwd(Prm p) {
    extern __shared__ __attribute__((aligned(16))) unsigned char lds[];
    { volatile LAS unsigned* MISC = (volatile LAS unsigned*)((LAS unsigned char*)lds + MISC_OFF);
      for (int u = threadIdx.x; u < (LDS_BYTES - MISC_OFF) / 4; u += NTHREADS_) MISC[u] = 0u;
      __syncthreads();
      if ((threadIdx.x & 63) == 0) MISC[WTAB_ + HWSLOT_()] = threadIdx.x >> 6;
      __syncthreads();
      const XcdBarrier b0 = xcd_barrier_post((unsigned*)(p.ws + WS_CTL) + CW_BAR, MISC + 8);
      if (TID_() == 0) MISC[10] = b0.x;
      __syncthreads(); }
#define KARG() const __attribute__((address_space(4))) Prm* pp_ = (const __attribute__((address_space(4))) Prm*)__builtin_amdgcn_kernarg_segment_ptr(); asm volatile("" : "+s"(pp_))
#define RUN(st, L) do { KARG(); run_step(*(const Prm*)pp_, st, L, 0, 0); __syncthreads(); } while (0)
#define SYNC() do { asm volatile("s_waitcnt vmcnt(0)" ::: "memory");     \
        KARG(); volatile LAS unsigned* MISC = (volatile LAS unsigned*)((LAS unsigned char*)lds + MISC_OFF); XcdBarrier b_; b_.bar = (unsigned*)(((const Prm*)pp_)->ws + WS_CTL) + CW_BAR; b_.x = MISC[10]; b_.st = MISC + 8; xcd_barrier(b_); } while (0)
    RUN(S_MOD, 0); RUN(S_INIT, 0); RUN(S_TAB1, 0); RUN(S_WPREP, 0); SYNC();
#define LAYER(L) do { \
        if (L > 0) RUN(S_WPREP, L); else RUN(S_TAB2, 0); \
        RUN(S_NORM_MIX, L); SYNC(); RUN(S_GEMM_IN, L); RUN(S_TABB, L); SYNC(); \
        RUN(S_CONV, L); RUN(S_CS, L); RUN(S_QK, L); SYNC(); \
        RUN(S_STATE, L); RUN(S_S5E, L); RUN(S_ATTN, L); SYNC(); \
        RUN(S_SSD_CARRY, L); RUN(S_S5_CARRY, L); RUN(S_WPREP2, L); SYNC(); \
        RUN(S_SSD_Y, L); RUN(S_S5_Y, L); RUN(S_ATTNC, L); RUN(S_SUBGLU, L); SYNC(); \
        RUN(S_GEMM_OUT, L); SYNC(); RUN(S_NORM_FFN, L); SYNC(); \
        RUN(S_GEMM_GU, L); SYNC(); RUN(S_FIXUP, L); SYNC(); RUN(S_GEMM_DOWN, L); SYNC(); } while (0)
    LAYER(0); LAYER(1);
    static_assert(DEPTH == 2, "layer program written out for two layers");
#undef LAYER
    RUN(S_FINAL, 0);
#undef RUN
#undef SYNC
#undef KARG
}
extern "C" void kernel_launch(void* const* d_in, const int* in_sizes, int n_in, void* d_out, int out_size, void* d_ws, size_t ws_size, hipStream_t stream) {
    if (n_in != 35 || out_size != ML * D_MODEL || ws_size < WS_TOTAL) { fprintf(stderr, "kernel_launch: unexpected shapes (n_in %d out %d ws %zu need %zu)\n", n_in, out_size, ws_size, (size_t)WS_TOTAL); return; }
    Prm p{};
    for (int i = 0; i < 35; ++i) p.in[i] = (const float*)d_in[i];
    p.out = (float*)d_out; p.ws = (unsigned char*)d_ws;
    static int grid = 0;
    if (grid == 0) {
        int dev = 0, cus = 0;
        if (hipGetDevice(&dev) != hipSuccess || hipDeviceGetAttribute(&cus, hipDeviceAttributeMultiprocessorCount, dev) != hipSuccess) { fprintf(stderr, "kernel_launch: device query failed\n"); grid = -1; return; }
        if (hipFuncSetAttribute((const void*)mk_fwd, hipFuncAttributeMaxDynamicSharedMemorySize, LDS_BYTES) != hipSuccess) { fprintf(stderr, "kernel_launch: hipFuncSetAttribute failed\n"); grid = -1; return; }
        int per_cu = 0;
        if (hipOccupancyMaxActiveBlocksPerMultiprocessor(&per_cu, (const void*)mk_fwd, NTHREADS_, LDS_BYTES) != hipSuccess || per_cu < 1) fprintf(stderr, "kernel_launch: note: occupancy query reports %d blocks per CU\n", per_cu);
        (void)hipGetLastError();
        grid = cus;
    }
    if (grid < 0) return;
    if (hipMemsetAsync((char*)d_ws + WS_CTL, 0, CTL_BYTES, stream) != hipSuccess) { fprintf(stderr, "kernel_launch: memset failed\n"); return; }
    hipLaunchKernelGGL(mk_fwd, dim3(grid), dim3(NTHREADS_), LDS_BYTES, stream, p);
}
#endif
```

```cpp
#ifndef CPU_TEST
#include <hip/hip_runtime.h>
#include <cstdio>
#include <cstdint>
#define HD __device__ __forceinline__
#define HDM __device__ __forceinline__
#else
#include <cmath>
#include <cstdio>
#include <cstdint>
#include <cstring>
#define HD static inline
#define HDM inline
#endif

#ifndef D_MODEL
#define D_MODEL 1024
#endif
#ifndef SEQ
#define SEQ 8192
#endif
#ifndef CTX_LEN
#define CTX_LEN 256
#endif
#ifndef D_FF
#define D_FF 2816
#endif
#define BATCH 2
#define DEPTH 2
#define GRID_W 64
#define HEAD_DIM 64
#define NORM_EPS 1e-6f
#define D_SSD 256
#define SSD_XBC 768
#define D_S5 256
#define D_MIX 1024
#define D_IN 2312
constexpr int NTHREADS_ = 512;
constexpr int ML = BATCH * SEQ, MC = BATCH * CTX_LEN, MT = ML + MC;
constexpr int NCH = MT / 128;
constexpr int NSC = MT / 16;
constexpr int PLD = 2048;
constexpr int NIN = 2560;
constexpr int S5R = 1280;
constexpr int Z_OFF = 0, XBC_OFF = 256, GAQ = 1024, GAK = 1280, GAV = 1408, WAQ = 1536, WAK = 1792, WAV = 1920;
constexpr int YSSD_OFF = 256, YS5_OFF = 512;

#ifdef CPU_TEST
typedef float act_t;
HD float ldf(const act_t* p) { return *p; }
HD void stf(act_t* p, float v) { *p = v; }
#else
typedef unsigned short act_t;
HD float ldf(const act_t* p) { return __uint_as_float(((unsigned)*p) << 16); }
HD void stf(act_t* p, float v) { unsigned u = __float_as_uint(v); u = (u + 0x7fffu + ((u >> 16) & 1u)) >> 16; *p = (act_t)u; }
#endif

constexpr size_t al256(size_t x) { return (x + 255) & ~(size_t)255; }
constexpr size_t WS_CTL = 0, CTL_BYTES = 1u << 20;
constexpr size_t WS_MOD = WS_CTL + 65536;
static_assert(65536 + (size_t)DEPTH * (BATCH + 1) * 6 * D_MODEL * 4 <= CTL_BYTES, "mod table inside the zeroed region");
constexpr size_t WS_ROPE = WS_CTL + CTL_BYTES;
constexpr size_t WS_LAMP = WS_ROPE + al256((size_t)SEQ * 64 * 4);
constexpr size_t WS_BBAR = WS_LAMP + al256((size_t)DEPTH * 2 * 16 * 64 * 17 * 2 * 4);
constexpr size_t WS_KT = WS_BBAR + al256((size_t)DEPTH * 2 * 16 * 64 * 16 * 2 * 4);
constexpr size_t WS_XC = WS_KT + al256((size_t)DEPTH * 2 * 16 * 16 * 256 * 4);
constexpr size_t WS_SS = WS_XC + al256((size_t)MC * D_MODEL * 4);
constexpr size_t WS_DT = WS_SS + al256((size_t)MT * 4);
constexpr size_t WS_CS = WS_DT + al256((size_t)MT * 8 * 4);
constexpr size_t WS_DTRAW = WS_CS + al256((size_t)MT * 8 * 4);
constexpr size_t WS_S5BY = WS_DTRAW + al256((size_t)MT * 8 * 4);
constexpr size_t WS_S5BE = WS_S5BY + al256((size_t)16 * 256 * 512 * sizeof(act_t));
constexpr size_t WS_ARENA = WS_S5BE + al256((size_t)16 * 256 * 256 * sizeof(act_t));
constexpr size_t WS_XN = WS_ARENA;
constexpr size_t WS_YMIX = WS_XN;
constexpr size_t WS_P = WS_XN + al256((size_t)MT * (D_MODEL > D_MIX ? D_MODEL : D_MIX) * sizeof(act_t));
constexpr size_t WS_XBC = WS_P + al256((size_t)MT * PLD * sizeof(act_t));
constexpr size_t WS_SST = WS_XBC + al256((size_t)MT * 768 * sizeof(act_t));
constexpr size_t WS_CB = WS_SST + al256((size_t)NCH * 2 * 4 * 64 * 128 * 4);
constexpr size_t WS_SLAB = WS_CB;
constexpr size_t WS_S5E = WS_CB + al256((size_t)NCH * 2 * 128 * 128 * 4);
constexpr size_t WS_S5A = WS_S5E + al256((size_t)16 * NSC * 256 * 4);
constexpr size_t WS_MIX_END = WS_S5A + al256((size_t)16 * S5R * 512 * sizeof(act_t));
constexpr size_t WS_GT = WS_P;
constexpr size_t WS_EG = WS_GT;
constexpr size_t WS_EU = WS_EG + al256((size_t)(MT / 256) * 4 * D_FF * 4);
constexpr size_t WS_ACT = WS_GT + al256((size_t)MT * D_FF * sizeof(act_t));
constexpr size_t WS_FFN_END = WS_ACT + al256((size_t)MT * D_FF * sizeof(act_t));
constexpr size_t WS_END = WS_MIX_END > WS_FFN_END ? WS_MIX_END : WS_FFN_END;
constexpr size_t WS_WIN = WS_END;
constexpr size_t WS_WOUT = WS_WIN + al256((size_t)NIN * D_MODEL * 2);
constexpr size_t WS_WG = WS_WOUT + al256((size_t)D_MODEL * D_MIX * 2);
constexpr size_t WS_WU = WS_WG + al256((size_t)D_FF * D_MODEL * 2);
constexpr size_t WS_WD = WS_WU + al256((size_t)D_FF * D_MODEL * 2);
constexpr size_t WS_WGLU = WS_WD + al256((size_t)D_MODEL * D_FF * 2);
constexpr size_t WS_TOTAL = WS_WGLU + al256((size_t)512 * 256 * 2);
#ifndef CPU_TEST
static_assert(WS_TOTAL <= ((size_t)256 << 20), "workspace map exceeds 256 MiB");
static_assert(WS_WU == WS_WG + (size_t)D_FF * D_MODEL * 2, "gate | up weight copies are one contiguous [2*D_FF][D] matrix");
#endif

struct Prm { const float* in[35]; float* out; unsigned char* ws; };
enum { I_X = 0, I_C, I_CTX, I_CCTX, I_WMOD, I_BMOD, I_GMIX, I_WIN, I_SCW, I_SCB, I_SALOG, I_SDTB, I_SD, I_SNG, I_GAQN, I_GAKN, I_SINK,
       I_LRE, I_LIM, I_LSTEP, I_BRE, I_BIM, I_CRE, I_CIM, I_S5D, I_WGLU, I_BGLU, I_WOUT, I_GFFN, I_WGATE, I_WUP, I_FCW, I_FCB, I_WDOWN, I_GFIN };

HD float sigmoidf_(float x) { return 1.f / (1.f + expf(-x)); }
HD float siluf_(float x) { return x * sigmoidf_(x); }
HD float softplusf_(float x) { return x > 20.f ? x : log1pf(expf(x)); }
HD float geluf_(float x) { return 0.5f * x * (1.f + tanhf(0.7978845608028654f * (x + 0.044715f * x * x * x))); }
struct RowInfo { int isctx, b, t, T, modrow; };
HD RowInfo rowinfo(int r) { RowInfo q; if (r < ML) { q.isctx = 0; q.b = r / SEQ; q.t = r % SEQ; q.T = SEQ; q.modrow = q.b; } else { const int rr = r - ML; q.isctx = 1; q.b = rr / CTX_LEN; q.t = rr % CTX_LEN; q.T = CTX_LEN; q.modrow = BATCH; } return q; }
HD float* xrow(const Prm& p, int r) { return r < ML ? p.out + (size_t)r * D_MODEL : (float*)(p.ws + WS_XC) + (size_t)(r - ML) * D_MODEL; }
HD const float* modp(const Prm& p, int layer, int modrow, int which) { return (const float*)(p.ws + WS_MOD) + ((size_t)(layer * (BATCH + 1) + modrow) * 6 + which) * D_MODEL; }
#define WSP(T, off) ((T*)(p.ws + (off)))
#ifdef CPU_TEST
#define QSCALE 0.125f
#else
#define QSCALE (0.125f * 1.4426950408889634f)
#endif

HD void st_mod(const Prm& p, int g0, int gs) {
    float* mod = WSP(float, WS_MOD);
    for (int i = g0; i < (int)(DEPTH * (BATCH + 1) * 6 * D_MODEL); i += gs) {
        const int j = (int)(i % (6 * D_MODEL)); const int m = (int)((i / (6 * D_MODEL)) % (BATCH + 1)); const int l = (int)(i / (6 * D_MODEL * (BATCH + 1)));
        const float* cv = m < BATCH ? p.in[I_C] + (size_t)m * D_MODEL : p.in[I_CCTX];
        const float* w = p.in[I_WMOD] + (size_t)l * D_MODEL * 6 * D_MODEL + j;
        float acc = 0.f;
        for (int k = 0; k < D_MODEL; ++k) acc += siluf_(cv[k]) * w[(size_t)k * 6 * D_MODEL];
        mod[i] = acc + p.in[I_BMOD][(size_t)l * 6 * D_MODEL + j];
    }
}
HD void st_init(const Prm& p, int g0, int gs) {
    for (int i = g0; i < (int)(ML * D_MODEL); i += gs) p.out[i] = p.in[I_X][i];
    float* xc = WSP(float, WS_XC);
    for (int i = g0; i < (int)(MC * D_MODEL); i += gs) xc[i] = p.in[I_CTX][i];
    float* rc = WSP(float, WS_ROPE); float* rs = rc + (size_t)SEQ * 32;
    for (int i = g0; i < (int)(SEQ * 32); i += gs) {
        const int t = (int)(i / 32), f = (int)(i % 32); const int pos = f < 16 ? t / GRID_W : t % GRID_W; const int fi = f & 15;
        const double inv = exp(-(double)fi * 0.5756462732485115); const double ang = (double)pos * inv;
        rc[i] = (float)cos(ang); rs[i] = (float)sin(ang);
    }
}
HD void st_rope_tab(const Prm& p, int g0, int gs) {
    float* rc = WSP(float, WS_ROPE); float* rs = rc + (size_t)SEQ * 32;
    for (int i = g0; i < (int)(SEQ * 32); i += gs) {
        const int t = (int)(i / 32), f = (int)(i % 32); const int pos = f < 16 ? t / GRID_W : t % GRID_W; const int fi = f & 15;
        const double inv = exp(-(double)fi * 0.5756462732485115); const double ang = (double)pos * inv;
        rc[i] = (float)cos(ang); rs[i] = (float)sin(ang);
    }
}
HD void st_s5tab1(const Prm& p, int g0, int gs) {
    float* lamp = WSP(float, WS_LAMP); float* bbar = WSP(float, WS_BBAR);
    for (int idx = g0; idx < (int)(DEPTH * 2 * 16 * 64 * 17); idx += gs) { const int i = idx / 17, tau = idx % 17, ldg = i / 64;
        const double lre = fmin((double)p.in[I_LRE][i], -1e-4), lim = (double)p.in[I_LIM][i], step = exp((double)p.in[I_LSTEP][ldg]);
        const double mag = exp(lre * step * tau), ang = lim * step * tau;
        lamp[(size_t)idx * 2 + 0] = (float)(mag * cos(ang)); lamp[(size_t)idx * 2 + 1] = (float)(mag * sin(ang)); }
    for (int i = gs - 1 - g0; i < (int)(DEPTH * 2 * 16 * 64); i += gs) { const int ldg = i / 64;
        const double lre = fmin((double)p.in[I_LRE][i], -1e-4), lim = (double)p.in[I_LIM][i], step = exp((double)p.in[I_LSTEP][ldg]);
        const double mag = exp(lre * step), ang = lim * step;
        const double nr = mag * cos(ang) - 1.0, ni = mag * sin(ang);
        const double den = lre * lre + lim * lim;
        const double fr = (nr * lre + ni * lim) / den, fi = (ni * lre - nr * lim) / den;
#pragma unroll
        for (int k = 0; k < 16; ++k) { const double br = p.in[I_BRE][i * 16 + k], bi = p.in[I_BIM][i * 16 + k];
            bbar[((size_t)i * 16 + k) * 2 + 0] = (float)(fr * br - fi * bi); bbar[((size_t)i * 16 + k) * 2 + 1] = (float)(fr * bi + fi * br); } }
}
HD void st_s5tab2(const Prm& p, int g0, int gs) {
    const float* lamp = WSP(float, WS_LAMP); const float* bbar = WSP(float, WS_BBAR); float* kt = WSP(float, WS_KT);
    for (int i = g0; i < (int)(DEPTH * 2 * 16 * 16 * 256); i += gs) {
        const int kp = (int)(i % 16), k = (int)((i / 16) % 16), tau = (int)((i / 256) % 16); const int ldg = i / 4096;
        float acc = 0.f;
        for (int n = 0; n < 64; ++n) {
            const float cr = p.in[I_CRE][(ldg * 16 + k) * 64 + n], ci = p.in[I_CIM][(ldg * 16 + k) * 64 + n];
            const float lr = lamp[((ldg * 64 + n) * 17 + tau) * 2], li = lamp[((ldg * 64 + n) * 17 + tau) * 2 + 1];
            const float br = bbar[((ldg * 64 + n) * 16 + kp) * 2], bi = bbar[((ldg * 64 + n) * 16 + kp) * 2 + 1];
            const float tr = lr * br - li * bi, ti = lr * bi + li * br;
            acc += cr * tr - ci * ti;
        }
        kt[i] = acc;
    }
}

HD void st_rowss(const Prm& p, int nrows, int g0, int gs) {
    float* ss = WSP(float, WS_SS);
    for (int r = g0; r < nrows; r += gs) { const float* x = xrow(p, (int)r); float s = 0.f; for (int k = 0; k < D_MODEL; ++k) s += x[k] * x[k]; ss[r] = s; }
}
HD void st_normmod(const Prm& p, int layer, int which  , int nrows, int g0, int gs) {
    const float* ss = WSP(float, WS_SS); act_t* xn = WSP(act_t, WS_XN);
    const float* gw = p.in[which ? I_GFFN : I_GMIX] + (size_t)layer * D_MODEL;
    for (int i = g0; i < (int)(nrows * D_MODEL); i += gs) {
        const int r = (int)(i / D_MODEL), k = (int)(i % D_MODEL); const RowInfo q = rowinfo(r);
        const float rs = 1.0f / sqrtf(ss[r] * (1.0f / D_MODEL) + NORM_EPS);
        const float sh = modp(p, layer, q.modrow, which ? 3 : 0)[k], sc = modp(p, layer, q.modrow, which ? 4 : 1)[k];
        stf(xn + i, xrow(p, r)[k] * rs * gw[k] * (1.f + sc) + sh);
    }
}
HD void st_final(const Prm& p, int g0, int gs) {
    const float* ss = WSP(float, WS_SS);
    for (int i = g0; i < (int)(ML * D_MODEL); i += gs) { const int r = (int)(i / D_MODEL), k = (int)(i % D_MODEL);
        p.out[i] = p.out[i] * (1.0f / sqrtf(ss[r] * (1.0f / D_MODEL) + NORM_EPS)) * p.in[I_GFIN][k]; }
}

template <class Epi> HD void naive_gemm(const act_t* A, int lda, const float* W, int ldw, int M, int N, int K, const Epi& epi, int g0, int gs) {
    const long n4 = N / 4, total = (long)(M / 4) * n4;
    for (long i = g0; i < total; i += gs) {
        const int r0 = (int)(i / n4) * 4, c0 = (int)(i % n4) * 4;
        float acc[4][4];
#pragma unroll
        for (int a = 0; a < 4; ++a)
#pragma unroll
            for (int b = 0; b < 4; ++b) acc[a][b] = 0.f;
        for (int k = 0; k < K; ++k) {
            float av[4], wv[4];
#pragma unroll
            for (int a = 0; a < 4; ++a) av[a] = ldf(A + (size_t)(r0 + a) * lda + k);
#pragma unroll
            for (int b = 0; b < 4; ++b) wv[b] = W[(size_t)k * ldw + c0 + b];
#pragma unroll
            for (int a = 0; a < 4; ++a)
#pragma unroll
                for (int b = 0; b < 4; ++b) acc[a][b] += av[a] * wv[b];
        }
#pragma unroll
        for (int a = 0; a < 4; ++a)
#pragma unroll
            for (int b = 0; b < 4; ++b) epi(r0 + a, c0 + b, acc[a][b]);
    }
}
HD void in_store(const Prm& p, int r, int c, float v) {
    if (c < 1024) stf((act_t*)(p.ws + WS_P) + (size_t)r * PLD + c, v);
    else if (c < 1032) ((float*)(p.ws + WS_DTRAW))[(size_t)r * 8 + (c - 1024)] = v;
    else if (c < 2056) stf((act_t*)(p.ws + WS_P) + (size_t)r * PLD + (c - 8), v);
    else { const int g = (c - 2056) >> 4, k = (c - 2056) & 15; stf((act_t*)(p.ws + WS_S5A) + ((size_t)g * S5R + (r >> 4)) * 512 + (r & 15) * 16 + k, v); }
}
struct EpiStoreIn { const Prm* p; HDM void operator()(int r, int c, float v) const { in_store(*p, r, c, v); } };
struct EpiStore { act_t* O; int ldo; HDM void operator()(int r, int c, float v) const { stf(O + (size_t)r * ldo + c, v); } };
struct EpiResid { const Prm* p; int layer, which; HDM void operator()(int r, int c, float v) const { const RowInfo q = rowinfo(r); xrow(*p, r)[c] += modp(*p, layer, q.modrow, which)[c] * v; } };
struct EpiUp { const Prm* p; int layer; HDM void operator()(int r, int c, float v) const {
    const RowInfo q = rowinfo(r); const act_t* gt = (const act_t*)(p->ws + WS_GT); const float* cw = p->in[I_FCW] + (size_t)layer * 3 * D_FF; const float* cb = p->in[I_FCB] + (size_t)layer * D_FF;
    float g = cb[c] + cw[D_FF + c] * ldf(gt + (size_t)r * D_FF + c);
    if (q.t > 0) g += cw[c] * ldf(gt + (size_t)(r - 1) * D_FF + c);
    if (q.t < q.T - 1) g += cw[2 * D_FF + c] * ldf(gt + (size_t)(r + 1) * D_FF + c);
    stf((act_t*)(p->ws + WS_ACT) + (size_t)r * D_FF + c, siluf_(g) * v); } };

HD void st_ssd_conv(const Prm& p, int layer, int g0, int gs) {
    const act_t* P = WSP(act_t, WS_P); act_t* xbc = WSP(act_t, WS_XBC);
    const float* cw = p.in[I_SCW] + (size_t)layer * 3 * SSD_XBC; const float* cb = p.in[I_SCB] + (size_t)layer * SSD_XBC;
    for (int i = g0; i < (int)(MT * SSD_XBC); i += gs) {
        const int r = (int)(i / SSD_XBC), c = (int)(i % SSD_XBC); const RowInfo q = rowinfo(r);
        float v = cb[c] + cw[SSD_XBC + c] * ldf(P + (size_t)r * PLD + XBC_OFF + c);
        if (q.t > 0) v += cw[c] * ldf(P + (size_t)(r - 1) * PLD + XBC_OFF + c);
        if (q.t < q.T - 1) v += cw[2 * SSD_XBC + c] * ldf(P + (size_t)(r + 1) * PLD + XBC_OFF + c);
        stf(xbc + i, siluf_(v));
    }
}
HD void st_ssd_cs(const Prm& p, int layer, int g0, int gs) {
    const act_t* P = WSP(act_t, WS_P); float* DT = WSP(float, WS_DT); float* CS = WSP(float, WS_CS);
    for (int i = g0; i < (int)(NCH * 8); i += gs) {
        const int dh = (int)(i % 8), c = (int)(i / 8), d = dh >> 2;
        const float a = -expf(p.in[I_SALOG][layer * 8 + dh]), bias = p.in[I_SDTB][layer * 8 + dh];
        float run = 0.f;
        for (int j = 0; j < 128; ++j) { const int l = d ? 127 - j : j; const size_t r = (size_t)c * 128 + l;
            const float dt = softplusf_(WSP(float, WS_DTRAW)[r * 8 + dh] + bias); run += dt * a; DT[r * 8 + dh] = dt; CS[r * 8 + dh] = run; }
    }
}
HD void st_qk_prep(const Prm& p, int layer, int g0, int gs) {
    act_t* P = WSP(act_t, WS_P); const float* rc = WSP(float, WS_ROPE); const float* rs = rc + (size_t)SEQ * 32;
    for (int i = g0; i < (int)(MT * 12); i += gs) {
        const int r = (int)(i / 12), s = (int)(i % 12); const RowInfo q = rowinfo(r);
        int off; const float* gn = nullptr; float scale = 1.f;
        if (s < 4) { off = GAQ + s * 64; gn = p.in[I_GAQN] + layer * 64; scale = QSCALE; }
        else if (s < 6) { off = GAK + (s - 4) * 64; gn = p.in[I_GAKN] + layer * 64; }
        else if (s < 10) { off = WAQ + (s - 6) * 64; scale = QSCALE; }
        else off = WAK + (s - 10) * 64;
        act_t* v = P + (size_t)r * PLD + off;
        float rn = 1.f;
        if (gn) { float ssq = 0.f; for (int e = 0; e < 64; ++e) { const float x = ldf(v + e); ssq += x * x; } rn = 1.0f / sqrtf(ssq * (1.f / 64.f) + NORM_EPS); }
        for (int e = 0; e < 32; ++e) {
            float x1 = ldf(v + e) * rn, x2 = ldf(v + e + 32) * rn;
            if (gn) { x1 *= gn[e]; x2 *= gn[e + 32]; }
            float o1 = x1, o2 = x2;
            if (!q.isctx) { const float c = rc[(size_t)q.t * 32 + e], sn = rs[(size_t)q.t * 32 + e]; o1 = x1 * c - x2 * sn; o2 = x2 * c + x1 * sn; }
            stf(v + e, o1 * scale); stf(v + e + 32, o2 * scale);
        }
    }
}

HD void st_ssd_state(const Prm& p, int g0, int gs) {
    const act_t* xbc = WSP(act_t, WS_XBC); const float* DT = WSP(float, WS_DT); const float* CS = WSP(float, WS_CS); float* sst = WSP(float, WS_SST);
    for (int i = g0; i < (int)(NCH * 2 * 4 * 64 * 128); i += gs) {
        const int n = (int)(i % 128), pp = (int)((i / 128) % 64), h = (int)((i / 8192) % 4), d = (int)((i / 32768) % 2), c = (int)(i / 65536);
        const int dh = d * 4 + h, g = h >> 1; const size_t r0 = (size_t)c * 128;
        const float aend = CS[(r0 + (d ? 0 : 127)) * 8 + dh];
        float acc = 0.f;
        for (int l = 0; l < 128; ++l) { const size_t r = r0 + l;
            acc += ldf(xbc + r * 768 + 256 + g * 128 + n) * ldf(xbc + r * 768 + h * 64 + pp) * DT[r * 8 + dh] * expf(aend - CS[r * 8 + dh]); }
        sst[i] = acc;
    }
}
HD void st_ssd_cb(const Prm& p, int g0, int gs) {
    const act_t* xbc = WSP(act_t, WS_XBC); float* cb = WSP(float, WS_CB);
    for (int i = g0; i < (int)(NCH * 2 * 128 * 128); i += gs) {
        const int s = (int)(i % 128), l = (int)((i / 128) % 128), g = (int)((i / 16384) % 2), c = (int)(i / 32768); const size_t r0 = (size_t)c * 128;
        float acc = 0.f;
        for (int n = 0; n < 128; ++n) acc += ldf(xbc + (r0 + l) * 768 + 512 + g * 128 + n) * ldf(xbc + (r0 + s) * 768 + 256 + g * 128 + n);
        cb[i] = acc;
    }
}
HD int ssd_chunk_of(int b, int d, int j) {
    constexpr int CC = CTX_LEN / 128, LC = SEQ / 128;
    if (j < CC) return ML / 128 + b * CC + (d ? CC - 1 - j : j);
    const int jj = j - CC; return b * LC + (d ? LC - 1 - jj : jj);
}
HD void st_ssd_carry(const Prm& p, int g0, int gs) {
    float* sst = WSP(float, WS_SST); const float* CS = WSP(float, WS_CS);
    for (int i = g0; i < (int)(BATCH * 2 * 4 * 64 * 128); i += gs) {
        const int e = (int)(i % 8192), h = (int)((i / 8192) % 4), d = (int)((i / 32768) % 2), b = (int)(i / 65536); const int dh = d * 4 + h;
        float hst = 0.f;
        for (int j = 0; j < (CTX_LEN + SEQ) / 128; ++j) { const int c = ssd_chunk_of(b, d, j);
            const float dec = expf(CS[((size_t)c * 128 + (d ? 0 : 127)) * 8 + dh]); float* sp = sst + ((size_t)(c * 2 + d) * 4 + h) * 8192 + e;
            const float tmp = *sp; *sp = hst; hst = hst * dec + tmp; }
    }
}
HD void st_ssd_y(const Prm& p, int layer, int nrows, int g0, int gs) {
    const act_t* xbc = WSP(act_t, WS_XBC); const float* DT = WSP(float, WS_DT); const float* CS = WSP(float, WS_CS); const float* sst = WSP(float, WS_SST); const float* cb = WSP(float, WS_CB);
    act_t* P = WSP(act_t, WS_P);
    for (int i = g0; i < (int)(nrows * 256); i += gs) {
        const int r = (int)(i / 256), hp = (int)(i % 256), h = hp >> 6, pp = hp & 63, g = h >> 1; const int c = r >> 7, l = r & 127; const size_t r0 = (size_t)c * 128;
        float y = p.in[I_SD][layer * 4 + h] * ldf(xbc + (size_t)r * 768 + hp);
        for (int d = 0; d < 2; ++d) { const int dh = d * 4 + h; const float csl = CS[(size_t)r * 8 + dh];
            const int s0 = d ? l : 0, s1 = d ? 127 : l; float acc = 0.f;
            for (int s = s0; s <= s1; ++s) { const size_t rs_ = r0 + s;
                acc += cb[((size_t)(c * 2 + g) * 128 + l) * 128 + s] * expf(csl - CS[rs_ * 8 + dh]) * ldf(xbc + rs_ * 768 + hp) * DT[rs_ * 8 + dh]; }
            float off = 0.f; const float* hin = sst + ((size_t)(c * 2 + d) * 4 + h) * 8192 + (size_t)pp * 128;
            for (int n = 0; n < 128; ++n) off += ldf(xbc + (size_t)r * 768 + 512 + g * 128 + n) * hin[n];
            y += acc + off * expf(csl); }
        stf(P + (size_t)r * PLD + YSSD_OFF + hp, y);
    }
}
HD void st_ssd_out(const Prm& p, int layer, int nrows, int g0, int gs) {
    const act_t* P = WSP(act_t, WS_P); act_t* ym = WSP(act_t, WS_YMIX); const float* ng = p.in[I_SNG] + layer * 256;
    for (int r = g0; r < nrows; r += gs) { float ssq = 0.f;
        for (int c = 0; c < 256; ++c) { const float v = ldf(P + (size_t)r * PLD + YSSD_OFF + c) * siluf_(ldf(P + (size_t)r * PLD + Z_OFF + c)); ssq += v * v; }
        const float rn = 1.0f / sqrtf(ssq * (1.f / 256.f) + NORM_EPS);
        for (int c = 0; c < 256; ++c) { const float v = ldf(P + (size_t)r * PLD + YSSD_OFF + c) * siluf_(ldf(P + (size_t)r * PLD + Z_OFF + c)); stf(ym + (size_t)r * D_MIX + c, v * rn * ng[c]); } }
}

HD void st_s5tabB(const Prm& p, int layer, int g0, int gs) {
    const float* lamp = WSP(float, WS_LAMP) + (size_t)layer * 2 * 16 * 64 * 17 * 2; const float* bbar = WSP(float, WS_BBAR) + (size_t)layer * 2 * 16 * 64 * 16 * 2; const float* kt = WSP(float, WS_KT) + (size_t)layer * 2 * 16 * 16 * 256;
    act_t* BY = WSP(act_t, WS_S5BY); act_t* BE = WSP(act_t, WS_S5BE);
    for (int idx = g0; idx < 16 * 256 * 512; idx += gs) { const int q = idx & 511, ik = (idx >> 9) & 255, g = idx >> 17, i = ik >> 4, k = ik & 15; float v;
        if (q < 256) { const int j = q >> 4, kp = q & 15;
            if (j < i) v = kt[(((size_t)(0 * 16 + g) * 16 + (i - j)) * 16 + k) * 16 + kp];
            else if (j > i) v = kt[(((size_t)(1 * 16 + g) * 16 + (j - i)) * 16 + k) * 16 + kp];
            else v = kt[(((size_t)(0 * 16 + g) * 16) * 16 + k) * 16 + kp] + kt[(((size_t)(1 * 16 + g) * 16) * 16 + k) * 16 + kp] + (k == kp ? p.in[I_S5D][layer * 256 + g * 16 + k] : 0.f); }
        else { const int dd = (q - 256) >> 7, n = ((q - 256) & 127) >> 1, c = q & 1, pw = dd ? 16 - i : i + 1; const size_t dg = (size_t)(layer * 2 + dd) * 16 + g, dgn = (size_t)(dd * 16 + g) * 64 + n;
            const float cr = p.in[I_CRE][(dg * 16 + k) * 64 + n], ci = p.in[I_CIM][(dg * 16 + k) * 64 + n], lr = lamp[(dgn * 17 + pw) * 2], li = lamp[(dgn * 17 + pw) * 2 + 1];
            v = c ? -(cr * li + ci * lr) : (cr * lr - ci * li); }
        stf(BY + idx, v); }
    for (int idx = g0; idx < 16 * 256 * 256; idx += gs) { const int q = idx & 255, rr = (idx >> 8) & 255, g = idx >> 16, dd = rr >> 7, n = (rr & 127) >> 1, c = rr & 1, j = q >> 4, kp = q & 15, pw = dd ? j : 15 - j;
        const size_t dgn = (size_t)(dd * 16 + g) * 64 + n; const float lr = lamp[(dgn * 17 + pw) * 2], li = lamp[(dgn * 17 + pw) * 2 + 1], br = bbar[(dgn * 16 + kp) * 2], bi = bbar[(dgn * 16 + kp) * 2 + 1];
        stf(BE + idx, c ? (lr * bi + li * br) : (lr * br - li * bi)); }
}
HD void st_s5_E_naive(const Prm& p, int g0, int gs) {
    const act_t* A = WSP(act_t, WS_S5A); const act_t* BE = WSP(act_t, WS_S5BE); float* E = WSP(float, WS_S5E);
    for (int idx = g0; idx < 16 * NSC * 256; idx += gs) { const int rr = idx & 255, sc = (idx >> 8) % NSC, g = (idx >> 8) / NSC; float acc = 0.f;
        for (int q = 0; q < 256; ++q) acc += ldf(A + ((size_t)g * S5R + sc) * 512 + q) * ldf(BE + ((size_t)g * 256 + rr) * 256 + q);
        E[idx] = acc; }
}
HD int s5_sc_of(int b, int d, int j) {
    constexpr int CC = CTX_LEN / 16, LC = SEQ / 16;
    if (j < CC) return ML / 16 + b * CC + (d ? CC - 1 - j : j);
    const int jj = j - CC; return b * LC + (d ? LC - 1 - jj : jj);
}
HD void st_s5_carry(const Prm& p, int layer, int g0, int gs) {
    const float* lamp = WSP(float, WS_LAMP) + (size_t)layer * 2 * 16 * 64 * 17 * 2; const float* E = WSP(float, WS_S5E); act_t* A = WSP(act_t, WS_S5A);
    for (int i = g0; i < BATCH * 2 * 16 * 64; i += gs) {
        const int n = i & 63, g = (i >> 6) & 15, d = (i >> 10) & 1, b = i >> 11; const size_t dgn = (size_t)(d * 16 + g) * 64 + n;
        const float lr = lamp[(dgn * 17 + 16) * 2], li = lamp[(dgn * 17 + 16) * 2 + 1];
        float hr = 0.f, hi = 0.f;
        for (int j = 0; j < (CTX_LEN + SEQ) / 16; ++j) { const int sc = s5_sc_of(b, d, j); const float* e = E + ((size_t)g * NSC + sc) * 256 + d * 128 + 2 * n; act_t* a = A + ((size_t)g * S5R + sc) * 512 + 256 + d * 128 + 2 * n;
            const float tr = e[0], ti = e[1]; stf(a, hr); stf(a + 1, hi); const float nr = lr * hr - li * hi + tr, ni = lr * hi + li * hr + ti; hr = nr; hi = ni; }
    }
}
HD void s5y_store(const Prm& p, int g, int sc, int ik, float v) { const int r = sc * 16 + (ik >> 4); stf((act_t*)(p.ws + WS_P) + (size_t)r * PLD + YS5_OFF + g * 16 + (ik & 15), geluf_(v)); }
HD void st_s5_Y_naive(const Prm& p, int nrows, int g0, int gs) {
    const act_t* A = WSP(act_t, WS_S5A); const act_t* BY = WSP(act_t, WS_S5BY);
    for (int idx = g0; idx < 16 * (nrows / 16) * 256; idx += gs) { const int ik = idx & 255, sc = (idx >> 8) % (nrows / 16), g = (idx >> 8) / (nrows / 16); float acc = 0.f;
        for (int q = 0; q < 512; ++q) acc += ldf(A + ((size_t)g * S5R + sc) * 512 + q) * ldf(BY + ((size_t)g * 256 + ik) * 512 + q);
        s5y_store(p, g, sc, ik, acc); }
}
HD void st_glu(const Prm& p, int layer, int nrows, int g0, int gs) {
    const act_t* P = WSP(act_t, WS_P); act_t* ym = WSP(act_t, WS_YMIX); const float* w = p.in[I_WGLU] + (size_t)layer * 256 * 512; const float* bg = p.in[I_BGLU] + layer * 512;
    for (int i = g0; i < (int)(nrows * 256); i += gs) { const int r = (int)(i / 256), n = (int)(i % 256); float a = bg[n], g = bg[256 + n];
        for (int k = 0; k < 256; ++k) { const float y = ldf(P + (size_t)r * PLD + YS5_OFF + k); a += y * w[(size_t)k * 512 + n]; g += y * w[(size_t)k * 512 + 256 + n]; }
        stf(ym + (size_t)r * D_MIX + 768 + n, a * sigmoidf_(g)); }
}

struct AttnAcc { float m, l; float o[32]; };
#ifdef CPU_TEST
HD void ld8(const act_t* p, float* o) { for (int e = 0; e < 8; ++e) o[e] = p[e]; }
#else
typedef unsigned u32x4_t __attribute__((ext_vector_type(4)));
HD void ld8(const act_t* p, float* o) { const u32x4_t v = *(const u32x4_t*)p;
#pragma unroll
    for (int e = 0; e < 4; ++e) { o[2 * e] = __uint_as_float(v[e] << 16); o[2 * e + 1] = __uint_as_float(v[e] & 0xffff0000u); } }
#endif
HD void attn_seg(AttnAcc& A, const act_t* q, const act_t* P, int row0, int cnt, int koff, int voff) {
#pragma clang loop unroll(disable)
    for (int j = 0; j < cnt; ++j) { const act_t* kr = P + (size_t)(row0 + j) * PLD;
        float s = 0.f;
#pragma clang loop unroll(disable)
        for (int c = 0; c < 8; ++c) { float qv[8], kv[8]; ld8(q + c * 8, qv); ld8(kr + koff + c * 8, kv);
#pragma unroll
            for (int e = 0; e < 8; ++e) s += qv[e] * kv[e]; }
        if (s > A.m) { const float f = expf(A.m - s); A.l *= f;
#pragma unroll
            for (int e = 0; e < 32; ++e) A.o[e] *= f;
            A.m = s; }
        const float pexp = expf(s - A.m); A.l += pexp;
#pragma unroll
        for (int c = 0; c < 4; ++c) { float vv[8]; ld8(kr + voff + c * 8, vv);
#pragma unroll
            for (int e = 0; e < 8; ++e) A.o[c * 8 + e] += pexp * vv[e]; } }
}
HD void st_attn(const Prm& p, int layer, int nrows, int g0, int gs) {
    const act_t* P = WSP(act_t, WS_P); act_t* ym = WSP(act_t, WS_YMIX);
    for (int i = g0; i < (int)(nrows * 16); i += gs) {
        const int r = (int)(i / 16), s = (int)((i % 16) >> 1), half = (int)(i & 1); const RowInfo qi = rowinfo(r); const int isw = s >= 4, hq = s & 3, kv = hq >> 1;
        const int qoff = (isw ? WAQ : GAQ) + hq * 64, koff = (isw ? WAK : GAK) + kv * 64, voff = (isw ? WAV : GAV) + kv * 64 + half * 32;
        const act_t* q = P + (size_t)r * PLD + qoff;
        AttnAcc A; A.m = -1e30f; A.l = 0.f;
#pragma unroll
        for (int e = 0; e < 32; ++e) A.o[e] = 0.f;
        attn_seg(A, q, P, ML + qi.b * CTX_LEN, CTX_LEN, koff, voff);
        if (!qi.isctx) {
            if (!isw) attn_seg(A, q, P, qi.b * SEQ, SEQ, koff, voff);
            else { const int t0 = qi.t - 128 < 0 ? 0 : qi.t - 128, t1 = qi.t + 128 > SEQ - 1 ? SEQ - 1 : qi.t + 128; attn_seg(A, q, P, qi.b * SEQ + t0, t1 - t0 + 1, koff, voff); }
        }
        if (isw) { const float sk = p.in[I_SINK][layer * 4 + hq]; if (sk > A.m) { const float f = expf(A.m - sk); A.l *= f;
#pragma unroll
                for (int e = 0; e < 32; ++e) A.o[e] *= f;
                A.m = sk; }
            A.l += expf(sk - A.m); }
        const float inv = 1.f / A.l;
#pragma unroll
        for (int e = 0; e < 32; ++e) stf(ym + (size_t)r * D_MIX + 256 + s * 64 + half * 32 + e, A.o[e] * inv);
    }
}

enum { S_SYNC = 0, S_MOD, S_INIT, S_TAB1, S_TAB2, S_ROWSS, S_NORM_MIX, S_GEMM_IN, S_CONV, S_CS, S_QK, S_STATE, S_CB, S_S5E, S_ATTN, S_SSD_CARRY, S_S5_CARRY,
       S_SSD_Y, S_S5_Y, S_SSD_OUT, S_GLU, S_GEMM_OUT, S_NORM_FFN, S_GEMM_GATE, S_GEMM_UP, S_GEMM_DOWN, S_ROWSS_FIN, S_FINAL, S_WPREP, S_MODR, S_TABB, S_GEMM_GU, S_FIXUP, S_SUBGLU, S_WPREP2, S_ATTNC };
struct Step { int st, layer; };
#define LAYER_STEPS(L) {S_WPREP, L}, {S_TABB, L}, {S_ROWSS, L}, {S_SYNC, 0}, {S_NORM_MIX, L}, {S_SYNC, 0}, {S_GEMM_IN, L}, {S_SYNC, 0}, {S_CONV, L}, {S_CS, L}, {S_QK, L}, {S_SYNC, 0}, \
    {S_STATE, L}, {S_CB, L}, {S_S5E, L}, {S_ATTN, L}, {S_SYNC, 0}, {S_SSD_CARRY, L}, {S_S5_CARRY, L}, {S_SYNC, 0}, {S_SSD_Y, L}, {S_S5_Y, L}, {S_SYNC, 0}, \
    {S_SSD_OUT, L}, {S_GLU, L}, {S_SYNC, 0}, {S_GEMM_OUT, L}, {S_SYNC, 0}, {S_ROWSS, L}, {S_SYNC, 0}, {S_NORM_FFN, L}, {S_SYNC, 0}, {S_GEMM_GATE, L}, {S_SYNC, 0}, \
    {S_GEMM_UP, L}, {S_SYNC, 0}, {S_GEMM_DOWN, L}, {S_SYNC, 0}
#ifdef CPU_TEST
static const Step PROG[] = {
#else
__constant__ Step PROG_D[] = {
#endif
    {S_MOD, 0}, {S_INIT, 0}, {S_TAB1, 0}, {S_SYNC, 0}, {S_TAB2, 0}, {S_SYNC, 0}, LAYER_STEPS(0), LAYER_STEPS(1), {S_ROWSS_FIN, 0}, {S_SYNC, 0}, {S_FINAL, 0} };
#ifndef CPU_TEST
static const Step PROG[] = { {S_MOD, 0}, {S_INIT, 0}, {S_TAB1, 0}, {S_SYNC, 0}, {S_TAB2, 0}, {S_SYNC, 0}, LAYER_STEPS(0), LAYER_STEPS(1), {S_ROWSS_FIN, 0}, {S_SYNC, 0}, {S_FINAL, 0} };
#endif
constexpr int NPROG = 6 + 2 * 38 + 3;

#ifndef CPU_TEST
#define LAS __attribute__((address_space(3)))
__device__ __forceinline__ int BIDX_() { int v = blockIdx.x; asm volatile("" : "+s"(v)); return v; }
__device__ __forceinline__ int GDIM_() { int v = gridDim.x; asm volatile("" : "+s"(v)); return v; }
constexpr int MISC_OFF_ = 131072, WTAB_ = 32;
__device__ __forceinline__ int HWSLOT_() { return (int)(__builtin_amdgcn_s_getreg((5 << 11) | 4) & 0x3f); }
__device__ __forceinline__ int TID_() { extern __shared__ __attribute__((aligned(16))) unsigned char l_dyn_[];
    const int w = __builtin_amdgcn_readfirstlane(((volatile LAS int*)((LAS unsigned char*)l_dyn_ + MISC_OFF_))[WTAB_ + HWSLOT_()]);
    unsigned m_ = ~0u; asm volatile("" : "+s"(m_));
    return w * 64 + (int)__builtin_amdgcn_mbcnt_hi(m_, __builtin_amdgcn_mbcnt_lo(m_, 0u)); }
namespace pg8 {
#define PG8_LAS __attribute__((address_space(3)))
typedef unsigned short bf16_t;
typedef short bf16x8 __attribute__((ext_vector_type(8)));
typedef float f32x4 __attribute__((ext_vector_type(4)));
typedef unsigned u32x4 __attribute__((ext_vector_type(4)));
constexpr int BM = 256, BK = 64, HALF = 128, HTB = HALF * BK * 2  , STAGE_BYTES = 8 * HTB, NXCD = 8, WGM = 8;

__host__ __device__ __forceinline__ int lds_byte(int r, int c) { const int st = (r >> 4) * 2 + (c >> 5), rr = r & 15, cc = c & 31, ob = rr * 64 + cc * 2; return st * 1024 + (ob ^ (((ob >> 9) & 1) << 5)); }
__host__ __device__ __forceinline__ void stage_rc(int b, int& R, int& C) { const int st = b / 1024, sb = b % 1024, swz = sb ^ (((sb >> 9) & 1) << 5); R = (st >> 1) * 16 + swz / 64; C = (st & 1) * 32 + (swz % 64) / 2; }
__host__ __device__ __forceinline__ int perm32(int rho) { const int n = rho >> 4, i = rho & 15; return 8 * (i >> 2) + 4 * n + (i & 3); }

struct Unit { int pm, pn, kb = 0, nt = 0; };
struct Gemm { const bf16_t* A; const bf16_t* Bt; int M, N, K, lda; };

struct StaticOrder {
    int nM, nN, nwg, G, c;
    __host__ __device__ void init(int M, int N, int G_, int c_) { nM = M / BM; nN = N / BM; nwg = nM * nN; G = G_; c = c_; }
    __host__ __device__ bool next(int i, Unit& u) const {
        const long L = (long)i * G + c; if (L >= nwg) return false;
        int wgid = (int)L; { const int q = nwg / NXCD, r = nwg % NXCD, xcd = wgid % NXCD, off = wgid / NXCD; wgid = (xcd < r ? xcd * (q + 1) : r * (q + 1) + (xcd - r) * q) + off; }
        const int nig = WGM * nN, gid = wgid / nig, fm = gid * WGM, gsz = (nM - fm) < WGM ? (nM - fm) : WGM;
        u.pm = fm + ((wgid % nig) % gsz); u.pn = (wgid % nig) / gsz; return true;
    }
    __device__ __forceinline__ void a_ready(const Unit&) const {}
    __device__ __forceinline__ void done(const Unit&) const {}
};

__device__ __forceinline__ unsigned cvt_pk_bf16(float lo, float hi) { unsigned r; asm volatile("v_cvt_pk_bf16_f32 %0, %1, %2" : "=v"(r) : "v"(lo), "v"(hi)); return r; }
typedef float f32x2 __attribute__((ext_vector_type(2)));
__device__ __forceinline__ void st_wt(f32x4* p, f32x4 v) { asm volatile("global_store_dwordx4 %0, %1, off sc1\n\ts_nop 1" :: "v"(p), "v"(v) : "memory"); }
__device__ __forceinline__ void st_wt(u32x4* p, u32x4 v) { asm volatile("global_store_dwordx4 %0, %1, off sc1\n\ts_nop 1" :: "v"(p), "v"(v) : "memory"); }
typedef unsigned u32x2w __attribute__((ext_vector_type(2)));
__device__ __forceinline__ void st_wt(u32x2w* p, u32x2w v) { asm volatile("global_store_dwordx2 %0, %1, off sc1" :: "v"(p), "v"(v) : "memory"); }
__device__ __forceinline__ f32x2 gelu_pk(f32x2 v) {
    const f32x2 av = __builtin_elementwise_abs(v), d = av * 0.2316418882f + 1.0f;
    f32x2 t; t.x = __builtin_amdgcn_rcpf(d.x); t.y = __builtin_amdgcn_rcpf(d.y);
    f32x2 q = t * 0.5307027145f + (-0.7265760135f); q = q * t + 0.7107068705f; q = q * t + (-0.142248368f); q = q * t + 0.127414796f; q = q * t;
    const f32x2 s = (v * v) * (-0.72134752044f);
    f32x2 e; e.x = __builtin_amdgcn_exp2f(s.x); e.y = __builtin_amdgcn_exp2f(s.y);
    const f32x2 m = v * (q * e), r = v - m;
    f32x2 o; o.x = v.x < 0.f ? m.x : r.x; o.y = v.y < 0.f ? m.y : r.y; return o;
}

template <int ACT  > struct EpiBf16 {
    static constexpr bool PERM = true, AFTER_DRAIN = false; static_assert(ACT == 0 || ACT == 1, "EpiBf16: ACT is 0 (none) or 1 (gelu_pk)");
    bf16_t* O; int ldc; const float* bias; int split_cols; size_t split_stride; float scale0;
    __device__ __forceinline__ void operator()(const f32x4 (&acc)[2][2][4][2], const Unit& u, int wr, int wc, int fr, int fq) const {
        const int row0 = u.pm * BM + wr * 64 + fr; int colt = u.pn * BM; bf16_t* base = O;
        float sc = 1.f; if (split_cols) { const int t = colt / split_cols; base += (size_t)t * split_stride; colt -= t * split_cols; if (t == 0) sc = scale0; }
        const int col0 = colt + wc * 32 + 8 * fq, bcol0 = u.pn * BM + wc * 32 + 8 * fq;
        f32x4 bv[2][2];
#pragma unroll
        for (int bj = 0; bj < 2; ++bj)
#pragma unroll
            for (int n = 0; n < 2; ++n) bv[bj][n] = bias ? *(const f32x4*)(bias + bcol0 + bj * HALF + 4 * n) : (f32x4){0.f, 0.f, 0.f, 0.f};
#pragma unroll
        for (int ai = 0; ai < 2; ++ai)
#pragma unroll
            for (int m = 0; m < 4; ++m) { bf16_t* rowp = base + (size_t)(row0 + ai * HALF + m * 16) * ldc + col0;
#pragma unroll
                for (int bj = 0; bj < 2; ++bj) { f32x4 v0 = acc[ai][bj][m][0] + bv[bj][0], v1 = acc[ai][bj][m][1] + bv[bj][1];
                    if (ACT == 1) { f32x2 a = gelu_pk((f32x2){v0[0], v0[1]}), b = gelu_pk((f32x2){v0[2], v0[3]}), c = gelu_pk((f32x2){v1[0], v1[1]}), d = gelu_pk((f32x2){v1[2], v1[3]});
                        v0 = (f32x4){a.x, a.y, b.x, b.y}; v1 = (f32x4){c.x, c.y, d.x, d.y}; }
                    v0 = v0 * sc; v1 = v1 * sc; u32x4 w; w.x = cvt_pk_bf16(v0[0], v0[1]); w.y = cvt_pk_bf16(v0[2], v0[3]); w.z = cvt_pk_bf16(v1[0], v1[1]); w.w = cvt_pk_bf16(v1[2], v1[3]);
                    *(u32x4*)(rowp + bj * HALF) = w; } }
    }
};
template <class Epi, class Sched, bool ALIGN_EPI = false, bool SP2 = false>
__device__ __forceinline__ void gemm_phase(PG8_LAS unsigned char* lds, const Gemm g, const Sched& S, const Epi& E) {
    const int tid = TID_(),
        wid = __builtin_amdgcn_readfirstlane(tid >> 6), lane = tid & 63, wr = wid >> 2, wc = wid & 3, fr = lane & 15, fq = lane >> 4;
    const int K = g.K, nt = K / BK;
    unsigned voffA[2], voffB[2];
#pragma unroll
    for (int i = 0; i < 2; ++i) { int R, C; stage_rc(tid * 16 + i * 8192, R, C); const int Rb = Epi::PERM ? ((R & ~31) + perm32(R & 31)) : R;
        voffA[i] = (unsigned)(R * g.lda + C) * 2u; voffB[i] = (unsigned)(Rb * K + C) * 2u; }
    const size_t kstep = (size_t)(BK * 2);
    const size_t hstepA = (size_t)HALF * g.lda * 2, hstepB = (size_t)HALF * K * 2;
    const size_t tstepA = 2 * hstepA, tstepB = 2 * hstepB;
    const unsigned ldsw = (unsigned)wid * 1024u;
    const int aoff = lds_byte(wr * 64 + fr, fq * 8), boff = lds_byte(wc * 32 + fr, fq * 8);
#define PG8_SA(b, h) (((b) * 2 + (h)) * HTB)
#define PG8_SB(b, h) ((4 + (b) * 2 + (h)) * HTB)
#define PG8_STAGE(bufoff, gbase, voff) do { _Pragma("unroll") for (int _i = 0; _i < 2; ++_i) \
        __builtin_amdgcn_global_load_lds((const unsigned*)((const char*)(gbase) + (voff)[_i]), (PG8_LAS unsigned*)(lds + (bufoff) + ldsw + _i * 8192), 16, 0, 0); } while (0)
#define PG8_LDA(dst, b, h) do { _Pragma("unroll") for (int m = 0; m < 4; ++m) _Pragma("unroll") for (int k = 0; k < 2; ++k) dst[m][k] = *(const PG8_LAS bf16x8*)(lds + PG8_SA(b, h) + aoff + m * 2048 + k * 1024); } while (0)
#define PG8_LDB(dst, b, h) do { _Pragma("unroll") for (int n = 0; n < 2; ++n) _Pragma("unroll") for (int k = 0; k < 2; ++k) dst[n][k] = *(const PG8_LAS bf16x8*)(lds + PG8_SB(b, h) + boff + n * 2048 + k * 1024); } while (0)
#define PG8_MMA(ai, bj, At, Bt) do { __builtin_amdgcn_s_setprio(1); _Pragma("unroll") for (int m = 0; m < 4; ++m) _Pragma("unroll") for (int n = 0; n < 2; ++n) _Pragma("unroll") for (int k = 0; k < 2; ++k) \
        acc[ai][bj][m][n] = __builtin_amdgcn_mfma_f32_16x16x32_bf16(Bt[n][k], At[m][k], acc[ai][bj][m][n], 0, 0, 0); __builtin_amdgcn_s_setprio(0); } while (0)
#define PG8_WAIT_V(n) asm volatile("s_waitcnt vmcnt(" #n ")" ::: "memory")
#define PG8_WAIT_L(n) asm volatile("s_waitcnt lgkmcnt(" #n ")" ::: "memory")
#define PG8_BAR __builtin_amdgcn_s_barrier()
#define PG8_SCHED __builtin_amdgcn_sched_barrier(0)
    Unit cur, nxt; int ui = 0;
    if (!S.next(0, cur)) return;
    f32x4 acc[2][2][4][2];
#pragma unroll
    for (int a = 0; a < 2; ++a)
#pragma unroll
        for (int b = 0; b < 2; ++b)
#pragma unroll
            for (int m = 0; m < 4; ++m)
#pragma unroll
                for (int n = 0; n < 2; ++n) acc[a][b][m][n] = (f32x4){0.f, 0.f, 0.f, 0.f};
    bf16x8 At[4][2], B0[2][2], B1[2][2];
    const char* cA = (const char*)g.A + (size_t)cur.pm * tstepA + cur.kb; const char* cB = (const char*)g.Bt + (size_t)cur.pn * tstepB + cur.kb;
    S.a_ready(cur);
    if constexpr (SP2) {
        PG8_STAGE(PG8_SB(0, 0), cB, voffB); PG8_STAGE(PG8_SB(0, 1), cB + hstepB, voffB); PG8_STAGE(PG8_SA(0, 0), cA, voffA); PG8_STAGE(PG8_SA(0, 1), cA + hstepA, voffA);
        if (wr == 1) PG8_BAR;
        PG8_WAIT_V(2); PG8_BAR;
        PG8_STAGE(PG8_SB(1, 0), cB + kstep, voffB); PG8_STAGE(PG8_SA(1, 0), cA + kstep, voffA); PG8_STAGE(PG8_SB(1, 1), cB + hstepB + kstep, voffB);
        PG8_WAIT_V(6); PG8_BAR;
    } else {
        PG8_STAGE(PG8_SB(0, 0), cB, voffB); PG8_STAGE(PG8_SA(0, 0), cA, voffA); PG8_STAGE(PG8_SB(0, 1), cB + hstepB, voffB); PG8_STAGE(PG8_SA(0, 1), cA + hstepA, voffA);
        if (wr == 1) PG8_BAR;
        PG8_WAIT_V(4); PG8_BAR;
        PG8_STAGE(PG8_SB(1, 0), cB + kstep, voffB); PG8_STAGE(PG8_SA(1, 0), cA + kstep, voffA); PG8_STAGE(PG8_SB(1, 1), cB + hstepB + kstep, voffB);
        PG8_WAIT_V(6); PG8_BAR;
    }
    for (;;) {
        const bool has_next = S.next(ui + 1, nxt);
        const char* nA = has_next ? (const char*)g.A + (size_t)nxt.pm * tstepA + nxt.kb : cA; const char* nB = has_next ? (const char*)g.Bt + (size_t)nxt.pn * tstepB + nxt.kb : cB;
        const int unt = cur.nt ? cur.nt : nt;
        for (int t = 0; t < unt; t += 2) {
            const bool last = (t == unt - 2);
            const char* a1 = cA + (size_t)(t + 1) * kstep;
            const char* a2 = last ? nA : cA + (size_t)(t + 2) * kstep; const char* b2 = last ? nB : cB + (size_t)(t + 2) * kstep;
            const char* a3 = a2 + kstep; const char* b3 = b2 + kstep;
            if (last && has_next) S.a_ready(nxt);
            if constexpr (SP2) {
            PG8_LDB(B0, 0, 0); PG8_LDB(B1, 0, 1); PG8_SCHED; PG8_LDA(At, 0, 0); PG8_STAGE(PG8_SA(1, 1), a1 + hstepA, voffA);
            PG8_WAIT_V(8); PG8_WAIT_L(0); PG8_BAR; PG8_MMA(0, 0, At, B0); PG8_MMA(0, 1, At, B1); PG8_BAR; PG8_SCHED;
            PG8_LDA(At, 0, 1); PG8_STAGE(PG8_SB(0, 0), b2, voffB); PG8_STAGE(PG8_SB(0, 1), b2 + hstepB, voffB); PG8_STAGE(PG8_SA(0, 0), a2, voffA);
            PG8_WAIT_V(8); PG8_WAIT_L(0); PG8_BAR; PG8_MMA(1, 0, At, B0); PG8_MMA(1, 1, At, B1); PG8_BAR; PG8_SCHED;
            PG8_LDB(B0, 1, 0); PG8_LDB(B1, 1, 1); PG8_SCHED; PG8_LDA(At, 1, 0); PG8_STAGE(PG8_SA(0, 1), a2 + hstepA, voffA);
            PG8_WAIT_V(8); PG8_WAIT_L(0); PG8_BAR; PG8_MMA(0, 0, At, B0); PG8_MMA(0, 1, At, B1); PG8_BAR; PG8_SCHED;
            PG8_LDA(At, 1, 1); PG8_STAGE(PG8_SB(1, 0), b3, voffB); PG8_STAGE(PG8_SB(1, 1), b3 + hstepB, voffB); PG8_STAGE(PG8_SA(1, 0), a3, voffA);
            PG8_WAIT_V(8); PG8_WAIT_L(0); PG8_BAR; PG8_MMA(1, 0, At, B0); PG8_MMA(1, 1, At, B1); PG8_BAR; PG8_SCHED;
            } else {
            PG8_LDB(B0, 0, 0); PG8_SCHED; PG8_LDA(At, 0, 0); PG8_STAGE(PG8_SA(1, 1), a1 + hstepA, voffA);
            PG8_WAIT_L(8); PG8_BAR; PG8_WAIT_L(0); PG8_MMA(0, 0, At, B0); PG8_BAR; PG8_SCHED;
            PG8_LDB(B1, 0, 1); PG8_STAGE(PG8_SB(0, 0), b2, voffB);
            PG8_BAR; PG8_WAIT_L(0); PG8_MMA(0, 1, At, B1); PG8_BAR;
            PG8_LDA(At, 0, 1); PG8_STAGE(PG8_SA(0, 0), a2, voffA);
            PG8_BAR; PG8_WAIT_L(0); PG8_MMA(1, 0, At, B0); PG8_BAR; PG8_SCHED;
            PG8_STAGE(PG8_SB(0, 1), b2 + hstepB, voffB);
            PG8_WAIT_V(6); PG8_BAR; PG8_MMA(1, 1, At, B1); PG8_BAR;
            PG8_LDB(B0, 1, 0); PG8_SCHED; PG8_LDA(At, 1, 0); PG8_STAGE(PG8_SA(0, 1), a2 + hstepA, voffA);
            PG8_WAIT_L(8); PG8_BAR; PG8_WAIT_L(0); PG8_MMA(0, 0, At, B0); PG8_BAR; PG8_SCHED;
            PG8_LDB(B1, 1, 1); PG8_STAGE(PG8_SB(1, 0), b3, voffB);
            PG8_BAR; PG8_WAIT_L(0); PG8_MMA(0, 1, At, B1); PG8_BAR;
            PG8_LDA(At, 1, 1); PG8_STAGE(PG8_SA(1, 0), a3, voffA);
            PG8_BAR; PG8_WAIT_L(0); PG8_MMA(1, 0, At, B0); PG8_BAR; PG8_SCHED;
            PG8_STAGE(PG8_SB(1, 1), b3 + hstepB, voffB);
            PG8_WAIT_V(6); PG8_BAR; PG8_MMA(1, 1, At, B1); PG8_BAR;
            }
        }
        if constexpr (ALIGN_EPI) { if (wr == 0) PG8_BAR; }
        if constexpr (!Epi::AFTER_DRAIN) { E(acc, cur, wr, wc, fr, fq); S.done(cur); }
        if (!has_next) break;
#pragma unroll
        for (int a = 0; a < 2; ++a)
#pragma unroll
            for (int b = 0; b < 2; ++b)
#pragma unroll
                for (int m = 0; m < 4; ++m)
#pragma unroll
                    for (int n = 0; n < 2; ++n) acc[a][b][m][n] = (f32x4){0.f, 0.f, 0.f, 0.f};
        cur = nxt; cA = nA; cB = nB; ++ui;
        if constexpr (ALIGN_EPI) { if (wr == 1) PG8_BAR; }
    }
    PG8_WAIT_V(0);
    if constexpr (!ALIGN_EPI) { if (wr == 0) PG8_BAR; }
    PG8_BAR;
    if constexpr (Epi::AFTER_DRAIN) { E.fused(acc, cur, wr, wc, fr, fq, lds, wid, lane); S.done(cur); }
#undef PG8_SA
#undef PG8_SB
#undef PG8_STAGE
#undef PG8_LDA
#undef PG8_LDB
#undef PG8_MMA
#undef PG8_WAIT_V
#undef PG8_WAIT_L
#undef PG8_BAR
#undef PG8_SCHED
}
}

namespace pg8 {
struct EpiResidM {
    static constexpr bool PERM = false, AFTER_DRAIN = false;
    float* xlat; float* xctx; const float* slat; const float* sctx; const float* mod; int which; float* slab; int ntk_;
    __device__ __forceinline__ void operator()(const f32x4 (&acc)[2][2][4][2], const Unit& u, int wr, int wc, int fr, int fq) const {
        const int modrow = u.pm < ML / 256 ? (u.pm * 256) / SEQ : BATCH;
        const float* gp = mod + ((size_t)modrow * 6 + which) * D_MODEL;
        const int col0 = u.pn * BM + wc * 32 + 4 * fq;
        f32x4 gv[2][2], res[2][2][4][2];
        if (u.nt) {
            const int sl = u.kb / (BK * 2) / ((((ntk_ / 4) + 1) & ~1));
#pragma unroll
            for (int ai = 0; ai < 2; ++ai)
#pragma unroll
                for (int m = 0; m < 4; ++m) { const int r = u.pm * BM + ai * HALF + wr * 64 + m * 16 + fr - ML; float* sr = slab + ((size_t)sl * MC + r) * D_MODEL + col0;
#pragma unroll
                    for (int bj = 0; bj < 2; ++bj)
#pragma unroll
                        for (int n = 0; n < 2; ++n) *(f32x4*)(sr + bj * HALF + n * 16) = acc[ai][bj][m][n]; }
            return; }
#pragma unroll
        for (int bj = 0; bj < 2; ++bj)
#pragma unroll
            for (int n = 0; n < 2; ++n) gv[bj][n] = *(const f32x4*)(gp + col0 + bj * HALF + n * 16);
#pragma unroll
        for (int ai = 0; ai < 2; ++ai)
#pragma unroll
            for (int m = 0; m < 4; ++m) { const int r = u.pm * BM + ai * HALF + wr * 64 + m * 16 + fr;
                const float* xs = (r < ML ? slat + (size_t)r * D_MODEL : sctx + (size_t)(r - ML) * D_MODEL) + col0;
#pragma unroll
                for (int bj = 0; bj < 2; ++bj)
#pragma unroll
                    for (int n = 0; n < 2; ++n) res[ai][bj][m][n] = *(const f32x4*)(xs + bj * HALF + n * 16) + gv[bj][n] * acc[ai][bj][m][n]; }
        asm volatile("" ::: "memory");
#pragma unroll
        for (int ai = 0; ai < 2; ++ai)
#pragma unroll
            for (int m = 0; m < 4; ++m) { const int r = u.pm * BM + ai * HALF + wr * 64 + m * 16 + fr;
                float* xr = (r < ML ? xlat + (size_t)r * D_MODEL : xctx + (size_t)(r - ML) * D_MODEL) + col0;
#pragma unroll
                for (int bj = 0; bj < 2; ++bj)
#pragma unroll
                    for (int n = 0; n < 2; ++n) st_wt((f32x4*)(xr + bj * HALF + n * 16), res[ai][bj][m][n]); }
    }
};
__device__ __forceinline__ void unpack8(const u32x4 v, float* o) {
#pragma unroll
    for (int e = 0; e < 4; ++e) { o[2 * e] = __uint_as_float(v[e] << 16); o[2 * e + 1] = __uint_as_float(v[e] & 0xffff0000u); } }
struct EpiUpM {
    static constexpr bool PERM = true, AFTER_DRAIN = false;
    const bf16_t* GT; bf16_t* ACT; const float* cw; const float* cb;
    __device__ __forceinline__ void ldbatch(int b, const Unit& u, int wr, int wc, int fr, int fq, u32x4& gm, u32x4& gl, u32x4& gh) const {
        const int bj = b >> 3, ai = (b >> 2) & 1, m = b & 3, c = u.pn * BM + bj * HALF + wc * 32 + 8 * fq;
        const int r = u.pm * BM + ai * HALF + wr * 64 + m * 16 + fr;
        const int t = r < ML ? r % SEQ : (r - ML) % CTX_LEN, T = r < ML ? SEQ : CTX_LEN; const bf16_t* gp = GT + (size_t)r * D_FF + c;
        gm = *(const u32x4*)gp; gl = (u32x4){0u, 0u, 0u, 0u}; gh = (u32x4){0u, 0u, 0u, 0u};
        if (t > 0) gl = *(const u32x4*)(gp - D_FF);
        if (t < T - 1) gh = *(const u32x4*)(gp + D_FF);
    }
    __device__ __forceinline__ void operator()(const f32x4 (&acc)[2][2][4][2], const Unit& u, int wr, int wc, int fr, int fq) const {
        u32x4 gmA, glA, ghA, gmB, glB, ghB;
        ldbatch(0, u, wr, wc, fr, fq, gmA, glA, ghA);
#pragma unroll
        for (int bj = 0; bj < 2; ++bj) { const int c = u.pn * BM + bj * HALF + wc * 32 + 8 * fq;
            f32x4 w0[2], w1[2], w2[2], bb[2];
#pragma unroll
            for (int q = 0; q < 2; ++q) { w0[q] = *(const f32x4*)(cw + c + 4 * q); w1[q] = *(const f32x4*)(cw + D_FF + c + 4 * q); w2[q] = *(const f32x4*)(cw + 2 * D_FF + c + 4 * q); bb[q] = *(const f32x4*)(cb + c + 4 * q); }
#pragma unroll
            for (int i = 0; i < 8; ++i) { const int b = bj * 8 + i, ai = i >> 2, m = i & 3;
                u32x4& gm = (b & 1) ? gmB : gmA; u32x4& gl = (b & 1) ? glB : glA; u32x4& gh = (b & 1) ? ghB : ghA;
                if (b + 1 < 16) { if (b & 1) ldbatch(b + 1, u, wr, wc, fr, fq, gmA, glA, ghA); else ldbatch(b + 1, u, wr, wc, fr, fq, gmB, glB, ghB); }
                float g[8], x[8];
                unpack8(gm, x);
#pragma unroll
                for (int e = 0; e < 8; ++e) g[e] = bb[e >> 2][e & 3] + w1[e >> 2][e & 3] * x[e];
                unpack8(gl, x);
#pragma unroll
                for (int e = 0; e < 8; ++e) g[e] += w0[e >> 2][e & 3] * x[e];
                unpack8(gh, x);
#pragma unroll
                for (int e = 0; e < 8; ++e) g[e] += w2[e >> 2][e & 3] * x[e];
                const f32x4 v0 = acc[ai][bj][m][0], v1 = acc[ai][bj][m][1]; float o[8];
#pragma unroll
                for (int e = 0; e < 4; ++e) { o[e] = g[e] / (1.f + __expf(-g[e])) * v0[e]; o[4 + e] = g[4 + e] / (1.f + __expf(-g[4 + e])) * v1[e]; }
                u32x4 w; w.x = cvt_pk_bf16(o[0], o[1]); w.y = cvt_pk_bf16(o[2], o[3]); w.z = cvt_pk_bf16(o[4], o[5]); w.w = cvt_pk_bf16(o[6], o[7]);
                const int r = u.pm * BM + ai * HALF + wr * 64 + m * 16 + fr; *(u32x4*)(ACT + (size_t)r * D_FF + c) = w; } }
    }
};
struct EpiGluM {
    static constexpr bool PERM = false, AFTER_DRAIN = false;
    bf16_t* YM; const float* bg;
    __device__ __forceinline__ void operator()(const f32x4 (&acc)[2][2][4][2], const Unit& u, int wr, int wc, int fr, int fq) const {
#pragma unroll
        for (int n = 0; n < 2; ++n) { const int oc = u.pn * HALF + wc * 32 + 16 * n + 4 * fq;
            const f32x4 ba = *(const f32x4*)(bg + oc), bgt = *(const f32x4*)(bg + 256 + oc);
#pragma unroll
            for (int ai = 0; ai < 2; ++ai)
#pragma unroll
                for (int m = 0; m < 4; ++m) { const int r = u.pm * BM + ai * HALF + wr * 64 + m * 16 + fr;
                    const f32x4 a = acc[ai][0][m][n] + ba, g = acc[ai][1][m][n] + bgt; float o[4];
#pragma unroll
                    for (int e = 0; e < 4; ++e) o[e] = a[e] / (1.f + __expf(-g[e]));
                    typedef unsigned u32x2 __attribute__((ext_vector_type(2))); u32x2 w; w.x = cvt_pk_bf16(o[0], o[1]); w.y = cvt_pk_bf16(o[2], o[3]);
                    *(u32x2*)(YM + (size_t)r * D_MIX + 768 + oc) = w; } }
    }
};
struct EpiInProj {
    static constexpr bool PERM = true, AFTER_DRAIN = false;
    bf16_t* P; bf16_t* S5A; float* DTRAW;
    __device__ __forceinline__ void operator()(const f32x4 (&acc)[2][2][4][2], const Unit& u, int wr, int wc, int fr, int fq) const {
        const int row0 = u.pm * BM + wr * 64 + fr;
        if (u.pn == 9) { if (wc == 0 && fq == 0) {
#pragma unroll
                for (int ai = 0; ai < 2; ++ai)
#pragma unroll
                    for (int m = 0; m < 4; ++m) { float* d = DTRAW + (size_t)(row0 + ai * HALF + m * 16) * 8; *(f32x4*)d = acc[ai][0][m][0]; *(f32x4*)(d + 4) = acc[ai][0][m][1]; } }
            return; }
#pragma unroll
        for (int ai = 0; ai < 2; ++ai)
#pragma unroll
            for (int m = 0; m < 4; ++m) { const int r = row0 + ai * HALF + m * 16;
#pragma unroll
                for (int bj = 0; bj < 2; ++bj) { const f32x4 v0 = acc[ai][bj][m][0], v1 = acc[ai][bj][m][1];
                    u32x4 w; w.x = cvt_pk_bf16(v0[0], v0[1]); w.y = cvt_pk_bf16(v0[2], v0[3]); w.z = cvt_pk_bf16(v1[0], v1[1]); w.w = cvt_pk_bf16(v1[2], v1[3]);
                    const int cl = bj * HALF + wc * 32 + 8 * fq;
                    if (u.pn < 8) *(u32x4*)(P + (size_t)r * PLD + u.pn * BM + cl) = w;
                    else *(u32x4*)(S5A + ((size_t)(cl >> 4) * S5R + (r >> 4)) * 512 + (r & 15) * 16 + (cl & 15)) = w; } }
    }
};
struct BatchedOrder {
    int G, c;
    __device__ void init(int G_, int c_) { G = G_; c = c_; }
    __device__ bool next(int i, Unit& u) const { const int idx = i * G + (c + 16 * (S5R / 256)) % G;   if (idx >= 16 * (S5R / 256)) return false; u.pm = idx; u.pn = idx / (S5R / 256); return true; }
    __device__ __forceinline__ void a_ready(const Unit&) const {}
    __device__ __forceinline__ void done(const Unit&) const {}
};
constexpr int EX_OFF = MISC_OFF_ + 4096;
struct EpiGateUpM {
    static constexpr bool PERM = false, AFTER_DRAIN = false;
    bf16_t* ACT; const float* cw; const float* cb; float* EG; float* EU;
    __device__ __forceinline__ void operator()(const f32x4 (&acc)[2][2][4][2], const Unit& u, int wr, int wc, int fr_, int fq_) const {
        int fr = fr_, fq = fq_; asm volatile("" : "+v"(fr), "+v"(fq));
        extern __shared__ __attribute__((aligned(16))) unsigned char l_ex_[];
        PG8_LAS float* EXF = (PG8_LAS float*)((PG8_LAS unsigned char*)l_ex_ + EX_OFF); PG8_LAS float* EXL = EXF + 4 * 128;
        const int cl = wc * 32 + 4 * fq, lane = fq * 16 + fr, srcp = (lane & 48) | ((fr + 15) & 15), srcn = (lane & 48) | ((fr + 1) & 15);
#pragma unroll
        for (int ai = 0; ai < 2; ++ai) { const int blk = 2 * ai + wr;
#pragma unroll
            for (int n = 0; n < 2; ++n) {
                if (fr == 0) *(PG8_LAS f32x4*)(EXF + blk * 128 + cl + 16 * n) = acc[ai][0][0][n];
                if (fr == 15) *(PG8_LAS f32x4*)(EXL + blk * 128 + cl + 16 * n) = acc[ai][0][3][n]; } }
        asm volatile("s_waitcnt lgkmcnt(0)" ::: "memory"); __builtin_amdgcn_s_barrier(); asm volatile("" ::: "memory");
        const int c0 = u.pn * HALF + cl;
#pragma unroll
        for (int n = 0; n < 2; ++n) { const int c = c0 + 16 * n;
            const f32x4 w0 = *(const f32x4*)(cw + c), w1 = *(const f32x4*)(cw + D_FF + c), w2 = *(const f32x4*)(cw + 2 * D_FF + c), bb = *(const f32x4*)(cb + c);
#pragma unroll
            for (int ai = 0; ai < 2; ++ai) { const int blk = 2 * ai + wr;
                f32x4 eprev = (f32x4){0.f, 0.f, 0.f, 0.f}, enext = eprev;
                if (blk > 0) eprev = *(const PG8_LAS f32x4*)(EXL + (blk - 1) * 128 + cl + 16 * n);
                if (blk < 3) enext = *(const PG8_LAS f32x4*)(EXF + (blk + 1) * 128 + cl + 16 * n);
#pragma unroll
                for (int m = 0; m < 4; ++m) { const f32x4 g = acc[ai][0][m][n], up = acc[ai][1][m][n];
                    const f32x4 gm1 = acc[ai][0][m > 0 ? m - 1 : 0][n], gp1 = acc[ai][0][m < 3 ? m + 1 : 3][n]; f32x4 pv, nx;
#pragma unroll
                    for (int e = 0; e < 4; ++e) { pv[e] = __shfl(fr == 15 ? gm1[e] : g[e], srcp, 64); nx[e] = __shfl(fr == 0 ? gp1[e] : g[e], srcn, 64); }
                    if (fr == 0 && m == 0) pv = eprev;
                    if (fr == 15 && m == 3) nx = enext;
                    const f32x4 gc = bb + w0 * pv + w1 * g + w2 * nx; float o[4];
#pragma unroll
                    for (int e = 0; e < 4; ++e) o[e] = gc[e] * __builtin_amdgcn_rcpf(1.f + __expf(-gc[e])) * up[e];
                    typedef unsigned u32x2 __attribute__((ext_vector_type(2))); u32x2 w; w.x = cvt_pk_bf16(o[0], o[1]); w.y = cvt_pk_bf16(o[2], o[3]);
                    const int rl = ai * HALF + wr * 64 + m * 16 + fr;
                    *(u32x2*)(ACT + (size_t)(u.pm * BM + rl) * D_FF + c) = w;
                    if (rl < 2) { *(f32x4*)(EG + ((size_t)u.pm * 4 + rl) * D_FF + c) = g; if (rl == 0) *(f32x4*)(EU + ((size_t)u.pm * 2) * D_FF + c) = up; }
                    if (rl >= 254) { *(f32x4*)(EG + ((size_t)u.pm * 4 + rl - 252) * D_FF + c) = g; if (rl == 255) *(f32x4*)(EU + ((size_t)u.pm * 2 + 1) * D_FF + c) = up; } } } }
    }
};
struct TailSplitOrder {
    StaticOrder so; int G, c, ntk, nlat;
    __device__ void init(int K, int G_, int c_) { so.init(ML, D_MODEL, G_, c_); G = G_; c = c_; ntk = K / BK; nlat = (ML / BM) * (D_MODEL / BM); }
    __device__ bool next(int i, Unit& u) const {
        const int nl = c < nlat ? (nlat - c + G - 1) / G : 0;
        if (i < nl) { so.next(i, u); u.kb = 0; u.nt = 0; return true; }
        constexpr int NS = 4; const int j = (i - nl) * G + c; if (j >= 8 * NS) return false;
        const int tile = j / NS, sl = j % NS, per = ((ntk / NS) + 1) & ~1, k0 = sl * per;
        u.pm = ML / BM + tile / (D_MODEL / BM); u.pn = tile % (D_MODEL / BM); u.kb = k0 * BK * 2; u.nt = (sl == NS - 1) ? ntk - k0 : per; return true;
    }
    __device__ __forceinline__ void a_ready(const Unit&) const {}
    __device__ __forceinline__ void done(const Unit&) const {}
};
struct EpiS5E {
    static constexpr bool PERM = false, AFTER_DRAIN = false; float* E;
    __device__ __forceinline__ void operator()(const f32x4 (&acc)[2][2][4][2], const Unit& u, int wr, int wc, int fr, int fq) const {
        const int g = u.pn, sc0 = (u.pm - g * (S5R / 256)) * BM + wr * 64 + fr, col0 = wc * 32 + 4 * fq;
#pragma unroll
        for (int ai = 0; ai < 2; ++ai)
#pragma unroll
            for (int m = 0; m < 4; ++m) { const int sc = sc0 + ai * HALF + m * 16; if (sc < NSC) { float* e = E + ((size_t)g * NSC + sc) * 256 + col0;
#pragma unroll
                    for (int bj = 0; bj < 2; ++bj)
#pragma unroll
                        for (int n = 0; n < 2; ++n) *(f32x4*)(e + bj * HALF + n * 16) = acc[ai][bj][m][n]; } }
    }
};
struct EpiS5Y {
    static constexpr bool PERM = false, AFTER_DRAIN = false; bf16_t* P; int nsc;
    __device__ __forceinline__ void operator()(const f32x4 (&acc)[2][2][4][2], const Unit& u, int wr, int wc, int fr, int fq) const {
        const int g = u.pn, sc0 = (u.pm - g * (S5R / 256)) * BM + wr * 64 + fr, col0 = wc * 32 + 4 * fq;
        typedef unsigned u32x2 __attribute__((ext_vector_type(2)));
#pragma unroll
        for (int ai = 0; ai < 2; ++ai)
#pragma unroll
            for (int m = 0; m < 4; ++m) { const int sc = sc0 + ai * HALF + m * 16; if (sc < nsc) {
#pragma unroll
                    for (int bj = 0; bj < 2; ++bj)
#pragma unroll
                        for (int n = 0; n < 2; ++n) { const int ik = col0 + bj * HALF + n * 16; const f32x4 v = acc[ai][bj][m][n]; float o[4];
#pragma unroll
                            for (int e = 0; e < 4; ++e) { const float x = v[e], t = 0.7978845608028654f * (x + 0.044715f * x * x * x); o[e] = x / (1.f + __expf(-2.f * t)); }
                            u32x2 w; w.x = cvt_pk_bf16(o[0], o[1]); w.y = cvt_pk_bf16(o[2], o[3]);
                            *(u32x2*)(P + (size_t)(sc * 16 + (ik >> 4)) * PLD + YS5_OFF + g * 16 + (ik & 15)) = w; } } }
    }
};
}

__device__ __forceinline__ unsigned f2bf(float f) { unsigned u = __builtin_bit_cast(unsigned, f); return (u + 0x7fffu + ((u >> 16) & 1u)) >> 16; }
__device__ __forceinline__ unsigned pk2(float lo, float hi) { return f2bf(lo) | (f2bf(hi) << 16); }
typedef unsigned v4u __attribute__((ext_vector_type(4)));
__device__ __forceinline__ void transpose_item(const float* W, int ldw, int nblk, act_t* WT, int K, LAS float* scr, int item, int lane) {
    const int kb = item / nblk, nb = item % nblk, k0 = 64 * kb, n0 = 32 * nb;
#pragma unroll
    for (int i = 0; i < 32; ++i) { const int kk = 2 * i + (lane >> 5); scr[kk * 33 + (lane & 31)] = W[(size_t)(k0 + kk) * ldw + n0 + (lane & 31)]; }
    asm volatile("s_waitcnt lgkmcnt(0)" ::: "memory");
    const int c = lane & 7;
#pragma unroll
    for (int j = 0; j < 4; ++j) { const int n = (lane >> 3) + 8 * j; const LAS float* sp = scr + (8 * c) * 33 + n;
        v4u o; o.x = pk2(sp[0 * 33], sp[1 * 33]); o.y = pk2(sp[2 * 33], sp[3 * 33]); o.z = pk2(sp[4 * 33], sp[5 * 33]); o.w = pk2(sp[6 * 33], sp[7 * 33]);
        *(v4u*)(WT + (size_t)(n0 + n) * K + k0 + 8 * c) = o; }
    asm volatile("s_waitcnt lgkmcnt(0)" ::: "memory");
}
__device__ __forceinline__ void st_wprep(const Prm& p, int L, LAS unsigned char* lds, int g0, int gs, int part) {
    const int tl_ = TID_();
    const int lane = tl_ & 63, wave = __builtin_amdgcn_readfirstlane(tl_ >> 6);
    LAS float* scr = (LAS float*)(lds + wave * 16384);
    int gw = BIDX_() * (NTHREADS_ / 64) + wave, NGW = GDIM_() * (NTHREADS_ / 64);
    constexpr int I_IN1 = (D_MODEL / 64) * (1024 / 32), I_IN3 = (D_MODEL / 64) * (256 / 32), I_IN = 2 * I_IN1 + I_IN3, I_OUT = (D_MIX / 64) * (D_MODEL / 32), I_G = (D_MODEL / 64) * (D_FF / 32), I_D = (D_FF / 64) * (D_MODEL / 32);
    constexpr int NIT = I_IN + I_OUT + 2 * I_G + I_D;
    if (part == 1 && GDIM_() == 256) { const int bx = BIDX_();
        if (bx < 128) { gw = bx * 8 + wave; NGW = NIT; } else { gw = 1024 + (bx - 128) * 8 + wave; NGW = 1024; } }
    const int it0 = part ? I_IN + gw : gw, it1 = part ? NIT : I_IN;
    for (int it = it0; it < it1; it += NGW) { int r = it;
        if (r < I_IN) { const float* W = p.in[I_WIN] + (size_t)L * D_MODEL * D_IN; act_t* WT = WSP(act_t, WS_WIN);
            if (r < I_IN1) transpose_item(W, D_IN, 1024 / 32, WT, D_MODEL, scr, r, lane);
            else if (r < 2 * I_IN1) transpose_item(W + 1032, D_IN, 1024 / 32, WT + (size_t)1024 * D_MODEL, D_MODEL, scr, r - I_IN1, lane);
            else transpose_item(W + 2056, D_IN, 256 / 32, WT + (size_t)2048 * D_MODEL, D_MODEL, scr, r - 2 * I_IN1, lane);
            continue; } r -= I_IN;
        if (r < I_OUT) { transpose_item(p.in[I_WOUT] + (size_t)L * D_MIX * D_MODEL, D_MODEL, D_MODEL / 32, WSP(act_t, WS_WOUT), D_MIX, scr, r, lane); continue; } r -= I_OUT;
        if (r < 2 * I_G) { const bool isup = r >= I_G; const int rr = isup ? r - I_G : r, n0 = 32 * (rr % (D_FF / 32)), drow = (n0 >> 7) * 256 + (n0 & 127) + (isup ? 128 : 0);
            transpose_item(p.in[isup ? I_WUP : I_WGATE] + (size_t)L * D_MODEL * D_FF, D_FF, D_FF / 32, WSP(act_t, WS_WG) + (ptrdiff_t)(drow - n0) * D_MODEL, D_MODEL, scr, rr, lane); continue; } r -= 2 * I_G;
        transpose_item(p.in[I_WDOWN] + (size_t)L * D_FF * D_MODEL, D_MODEL, D_MODEL / 32, WSP(act_t, WS_WD), D_FF, scr, r, lane); }
    if (part) return;
    { const float* W = p.in[I_WIN] + (size_t)L * D_MODEL * D_IN; act_t* WT = WSP(act_t, WS_WIN);
      for (int i = g0; i < (int)((NIN - 2304) * D_MODEL); i += gs) { const int n = 2304 + (int)(i / D_MODEL), k = (int)(i % D_MODEL); stf(WT + (size_t)n * D_MODEL + k, n < 2312 ? W[(size_t)k * D_IN + 1024 + (n - 2304)] : 0.f); } }
    { const float* W = p.in[I_WGLU] + (size_t)L * 256 * 512; act_t* WT = WSP(act_t, WS_WGLU);
      for (int i = g0; i < (int)(512L * 256); i += gs) { const int j = (int)(i / 256), k = (int)(i % 256); const int pn = j >> 8, half = (j >> 7) & 1, o = j & 127; stf(WT + i, W[(size_t)k * 512 + half * 256 + 128 * pn + o]); } }
}
#include <hip/hip_bf16.h>
#include <cmath>
namespace attn_body {
using bf16=__hip_bfloat16;
using bf16x8=__attribute__((ext_vector_type(8)))short;
using s16x4=__attribute__((ext_vector_type(4)))short;
using f32x16=__attribute__((ext_vector_type(16)))float;
using u32x4=__attribute__((ext_vector_type(4)))unsigned;
constexpr int D=64,QKVP=PLD,OP=D_MIX;
constexpr int NW=8,QBLK=32,QB=QBLK*NW,KVBLK=64;
__device__ __forceinline__ int crow(int r,int hi){return (r&3)+8*(r>>2)+4*hi;}
#define SBAR() __builtin_amdgcn_sched_barrier(0)
__device__ __forceinline__ void wmask(f32x16&p0,f32x16&p1,int kbase,int qpos,int hi){
  const float NEG=-INFINITY; const int d0=kbase+4*hi-qpos;
  #pragma unroll
  for(int r=0;r<16;++r){const int dd=d0+(r&3)+8*(r>>2); if(dd<-128||dd>128)p0[r]=NEG; if(dd+32<-128||dd+32>128)p1[r]=NEG;}
}
constexpr int NSLOT=3, SLOTB=8192;
constexpr int LDS_K=0, LDS_V=NSLOT*SLOTB, LDS_WS=2*NSLOT*SLOTB, LDS_OST=LDS_WS+NW*64*4, LDS_BYTES=LDS_OST+NW*4096;
constexpr float C2=0.125f*1.4426950408889634f;
__device__ __forceinline__ void glds16(const void*gsrc,unsigned lds_dst){unsigned keep;
  asm volatile("s_mov_b32 %0, m0\n\ts_mov_b32 m0, %2\n\ts_nop 0\n\tglobal_load_lds_dwordx4 %1, off\n\ts_mov_b32 m0, %0":"=&s"(keep):"v"(gsrc),"s"(lds_dst):"memory");}
__device__ __forceinline__ float max3f(float a,float b,float c){float r;asm("v_max3_f32 %0, %1, %2, %3":"=v"(r):"v"(a),"v"(b),"v"(c));return r;}
__device__ __forceinline__ float max2f(float a,float b){float r;asm("v_max_f32_e32 %0, %1, %2":"=v"(r):"v"(a),"v"(b));return r;}
__device__ __forceinline__ float fadd_s(float a,float b){float r;asm("v_add_f32_e32 %0, %1, %2":"=v"(r):"v"(a),"v"(b));return r;}
__device__ __forceinline__ float fsub_s(float a,float b){float r;asm("v_sub_f32_e32 %0, %1, %2":"=v"(r):"v"(a),"v"(b));return r;}
typedef float f32x2_t __attribute__((ext_vector_type(2))); typedef __bf16 bf16x2_t __attribute__((ext_vector_type(2)));
__device__ __forceinline__ unsigned cvtpk_s(float lo,float hi){f32x2_t v={lo,hi};bf16x2_t b=__builtin_convertvector(v,bf16x2_t);return __builtin_bit_cast(unsigned,b);}
#define WAIT_BAR(N) asm volatile("s_waitcnt vmcnt(" #N ") lgkmcnt(0)\n\ts_barrier":::"memory")

__device__ __forceinline__ void qkt(f32x16&p0,f32x16&p1,const char*Kslot,const bf16x8*qr,const f32x16&negm,int r32,int hi){
  const char*kb=Kslot+hi*1024+r32*16;
  #pragma unroll
  for(int d0=0;d0<4;++d0){
    const bf16x8 b0=*reinterpret_cast<const bf16x8*>(kb+d0*2048);
    const bf16x8 b1=*reinterpret_cast<const bf16x8*>(kb+d0*2048+512);
    if(d0==0){p0=__builtin_amdgcn_mfma_f32_32x32x16_bf16(b0,qr[0],negm,0,0,0);p1=__builtin_amdgcn_mfma_f32_32x32x16_bf16(b1,qr[0],negm,0,0,0);}
    else{p0=__builtin_amdgcn_mfma_f32_32x32x16_bf16(b0,qr[d0],p0,0,0,0);p1=__builtin_amdgcn_mfma_f32_32x32x16_bf16(b1,qr[d0],p1,0,0,0);}}
}
typedef __attribute__((address_space(3))) const char* lds_cptr;
typedef short v4i16_t __attribute__((ext_vector_type(4)));
__device__ __forceinline__ void kload8(bf16x8*kf,lds_cptr kp){
  kf[0]=*(const __attribute__((address_space(3))) bf16x8*)(kp);      kf[1]=*(const __attribute__((address_space(3))) bf16x8*)(kp+512);
  kf[2]=*(const __attribute__((address_space(3))) bf16x8*)(kp+2048); kf[3]=*(const __attribute__((address_space(3))) bf16x8*)(kp+2560);
  kf[4]=*(const __attribute__((address_space(3))) bf16x8*)(kp+4096); kf[5]=*(const __attribute__((address_space(3))) bf16x8*)(kp+4608);
  kf[6]=*(const __attribute__((address_space(3))) bf16x8*)(kp+6144); kf[7]=*(const __attribute__((address_space(3))) bf16x8*)(kp+6656);
}
__device__ __forceinline__ void kload2(bf16x8*kf,lds_cptr kp,int j){ kf[2*j]=*(const __attribute__((address_space(3))) bf16x8*)(kp+j*2048); kf[2*j+1]=*(const __attribute__((address_space(3))) bf16x8*)(kp+j*2048+512); }
__device__ __forceinline__ s16x4 vtr(lds_cptr p){ return __builtin_bit_cast(s16x4,__builtin_amdgcn_ds_read_tr16_b64_v4i16((__attribute__((address_space(3))) v4i16_t*)p)); }
__device__ __forceinline__ float rowmax(const f32x16&p0,const f32x16&p1){
  float a=max3f(p0[0],p0[1],p1[0]),b=max3f(p0[2],p0[3],p1[1]);a=max3f(a,p1[2],p1[3]);
  #pragma unroll
  for(int r=4;r<16;r+=4){a=max3f(a,p0[r],p0[r+1]);b=max3f(b,p0[r+2],p0[r+3]);a=max3f(a,p1[r],p1[r+1]);b=max3f(b,p1[r+2],p1[r+3]);}
  const float m=max2f(a,b);
  auto rr=__builtin_amdgcn_permlane32_swap(__float_as_uint(m),__float_as_uint(m),false,false);
  return max2f(__uint_as_float(rr[0]),__uint_as_float(rr[1]));
}
__device__ __forceinline__ void pv(f32x16*o,int vb,bf16x8 pa0,bf16x8 pa1,bf16x8 pa2,bf16x8 pa3){
  #pragma unroll
  for(int d0=0;d0<2;++d0){s16x4 lo[4],hi[4];
    #pragma unroll
    for(int ks=0;ks<4;++ks){
      asm volatile("ds_read_b64_tr_b16 %0,%1 offset:%c2":"=&v"(lo[ks]):"v"(vb),"i"(d0*4096+ks*1024):"memory");
      asm volatile("ds_read_b64_tr_b16 %0,%1 offset:%c2":"=&v"(hi[ks]):"v"(vb),"i"(d0*4096+ks*1024+512):"memory");}
    asm volatile("s_waitcnt lgkmcnt(0)":::"memory");SBAR();
    #define PK(k) (bf16x8){lo[k][0],lo[k][1],lo[k][2],lo[k][3],hi[k][0],hi[k][1],hi[k][2],hi[k][3]}
    o[d0]=__builtin_amdgcn_mfma_f32_32x32x16_bf16(pa0,PK(0),o[d0],0,0,0);
    o[d0]=__builtin_amdgcn_mfma_f32_32x32x16_bf16(pa1,PK(1),o[d0],0,0,0);
    o[d0]=__builtin_amdgcn_mfma_f32_32x32x16_bf16(pa2,PK(2),o[d0],0,0,0);
    o[d0]=__builtin_amdgcn_mfma_f32_32x32x16_bf16(pa3,PK(3),o[d0],0,0,0);
    #undef PK
  }
}

#ifndef ATTN_STORE16
#define ATTN_STORE16(p,v) (*(u32x4*)(p)=(v))
#endif
template<int THRL,bool WIN> __device__ __forceinline__ void attn_unit(const bf16*Pm,int qrow0,int qoff,int koff,int voff,int ctx0,int lat0,int NT,int qpos0,int kpos0,float sinkl2,bf16*Ob,char*shm){
  const int tid=TID_(),lane=tid&63,r32=lane&31,hi=lane>>5; const int wid=__builtin_amdgcn_readfirstlane(tid>>6);
  const bf16*Qw=Pm+(long)(qrow0+wid*QBLK)*QKVP+qoff;
  const unsigned lds0=(unsigned)(uintptr_t)shm;
  float*wsf=(float*)(shm+LDS_WS)+wid*64;
  const bf16*ksrc=Pm+(long)lane*QKVP+koff+wid*8;
  const bf16*vsrc=Pm+(long)(16*(wid&3)+(lane>>2))*QKVP+voff+(wid>>2)*32+(lane&3)*8;
  #define KROW(t) ((t)<4?ctx0+64*(t):lat0+64*((t)-4))
  const unsigned kdst=lds0+LDS_K+wid*1024, vdst=lds0+LDS_V+wid*1024;
  #define DMA_K(t,slot) glds16(ksrc+(long)KROW(t)*QKVP,(unsigned)__builtin_amdgcn_readfirstlane(kdst+(slot)))
  #define DMA_V(t,slot) glds16(vsrc+(long)KROW(t)*QKVP,(unsigned)__builtin_amdgcn_readfirstlane(vdst+(slot)))
  const int vb0=(int)(lds0+LDS_V)+((lane>>4)&1)*32+(lane&3)*8+(4*hi+((lane&15)>>2))*64;
  const char*Kbase=shm+LDS_K; bf16x8 kf[8];
  const lds_cptr shm3=(lds_cptr)shm; const lds_cptr kp0=shm3+LDS_K+hi*1024+r32*16; const lds_cptr vp0=shm3+LDS_V+((lane>>4)&1)*32+(lane&3)*8+(4*hi+((lane&15)>>2))*64;
  DMA_K(0,0);DMA_V(0,0);DMA_K(1,SLOTB);
  bf16x8 qr[4];
  #pragma unroll
  for(int d0=0;d0<4;++d0)qr[d0]=*reinterpret_cast<const bf16x8*>(&Qw[(long)r32*QKVP+d0*16+hi*8]);
  float mhat=0.f,l_reg=0.f;f32x16 o[2];o[0]=f32x16{};o[1]=f32x16{};f32x16 negm=f32x16{};asm volatile("":"+v"(negm));
  const int qpos=qpos0+wid*QBLK+r32;
  #define CMASK(P0,P1,t) do{ if(WIN){ if((t)>=4) wmask(P0,P1,kpos0+64*((t)-4),qpos,hi); } }while(0)
  bool resc=false;
  #define START(P0,P1) do{ const float rm=rowmax(P0,P1); resc=false; \
    { const float dl=rm; mhat=fadd_s(mhat,dl); \
      _Pragma("unroll") for(int r=0;r<16;++r){P0[r]=fsub_s(P0[r],dl);P1[r]=fsub_s(P1[r],dl);} \
      _Pragma("unroll") for(int r=0;r<16;++r)negm[r]=-mhat; asm volatile("":"+v"(negm)); } \
    _Pragma("unroll") for(int r=0;r<16;++r)P0[r]=__builtin_amdgcn_exp2f(P0[r]); }while(0)
  #define RESC() do{ if(resc){ asm volatile("s_waitcnt lgkmcnt(0)":::"memory"); \
      _Pragma("unroll") for(int d_=0;d_<2;++d_) _Pragma("unroll") for(int r=0;r<16;++r)o[d_][r]*=wsf[crow(r,hi)]; } }while(0)
  f32x16 pA0,pA1,pB0,pB1;
  int sl_prev=0,sl_cur=0,sl_next=SLOTB;
  #define ROT() do{sl_prev=sl_cur;sl_cur=sl_next;sl_next=(sl_next==(NSLOT-1)*SLOTB)?0:sl_next+SLOTB;}while(0)
  DMA_K(2,2*SLOTB);
  WAIT_BAR(3);
  qkt(pA0,pA1,Kbase,qr,negm,r32,hi);asm volatile("s_nop 15\n\ts_nop 7":"+v"(pA0),"+v"(pA1));CMASK(pA0,pA1,0);
  START(pA0,pA1);
  _Pragma("unroll") for(int r=0;r<16;++r)pA1[r]=__builtin_amdgcn_exp2f(pA1[r]);
  WAIT_BAR(0);
  DMA_K(3,0);DMA_V(1,SLOTB);
  ROT();
  kload8(kf,kp0+sl_cur);
  WAIT_BAR(2);
  s16x4 vlo[8],vhi[8]; u32x4 pw0,pw1,pw2,pw3;
  #define PKW(P,B) cvtpk_s(P[B],P[B+1])
  #define PAF(k) __builtin_bit_cast(bf16x8,pw##k)
  #define VFR(i) (bf16x8){vlo[i][0],vlo[i][1],vlo[i][2],vlo[i][3],vhi[i][0],vhi[i][1],vhi[i][2],vhi[i][3]}
  #define PIN(x) asm volatile("":"+v"(x))
  #define MX3(a,b,c) __builtin_fmaxf(__builtin_fmaxf((a),(b)),(c))
  #define GAPA(MF,A0,A1,A2,A3,W0,W1,PW) do{ MF; sacc+=A0; sacc+=A1; sacc+=A2; sacc+=A3; PIN(sacc); W0; W1; PIN(PW); SBAR(); }while(0)
  #define EX(v) __builtin_amdgcn_exp2f(v)
  #define GAPB(MF,X,B) do{ MF; X[B]=EX(X[B]); X[B+1]=EX(X[B+1]); X[B+2]=EX(X[B+2]); X[B+3]=EX(X[B+3]); PIN(X); SBAR(); }while(0)
  #define VRD(i) do{ vlo[i]=vtr(vp_+(((i)>>2)*4096+((i)&3)*1024)); vhi[i]=vtr(vp_+(((i)>>2)*4096+((i)&3)*1024+512)); }while(0)
  #define KRD(G,j) do{ if(G){ kload2(kf,kp0+sl_next,j); SBAR(); } }while(0)
  #define STEP(C0,C1,P0,P1,t,GK,GV,GL) do{ SBAR(); \
    const lds_cptr vp_=vp0+sl_prev; \
    VRD(0); SBAR(); float sacc=(P0[0]+P0[1]); \
    GAPA(C0=__builtin_amdgcn_mfma_f32_32x32x16_bf16(kf[0],qr[0],negm,0,0,0), P0[2],P0[3],P0[4],P0[5],     pw0[0]=PKW(P0,0), pw0[1]=PKW(P0,2), pw0); \
    VRD(4); SBAR(); GAPA(C1=__builtin_amdgcn_mfma_f32_32x32x16_bf16(kf[1],qr[0],negm,0,0,0), P0[6],P0[7],P0[8],P0[9],     pw0[2]=PKW(P0,4), pw0[3]=PKW(P0,6), pw0); \
    VRD(1); SBAR(); GAPA(C0=__builtin_amdgcn_mfma_f32_32x32x16_bf16(kf[2],qr[1],C0,0,0,0),   P0[10],P0[11],P0[12],P0[13], pw1[0]=PKW(P0,8), pw1[1]=PKW(P0,10), pw1); \
    VRD(5); SBAR(); GAPA(C1=__builtin_amdgcn_mfma_f32_32x32x16_bf16(kf[3],qr[1],C1,0,0,0),   P0[14],P0[15],P1[0],P1[1],   pw1[2]=PKW(P0,12),pw1[3]=PKW(P0,14), pw1); \
    VRD(2); SBAR(); GAPA(C0=__builtin_amdgcn_mfma_f32_32x32x16_bf16(kf[4],qr[2],C0,0,0,0),   P1[2],P1[3],P1[4],P1[5],     pw2[0]=PKW(P1,0), pw2[1]=PKW(P1,2), pw2); \
    VRD(6); SBAR(); GAPA(C1=__builtin_amdgcn_mfma_f32_32x32x16_bf16(kf[5],qr[2],C1,0,0,0),   P1[6],P1[7],P1[8],P1[9],     pw2[2]=PKW(P1,4), pw2[3]=PKW(P1,6), pw2); \
    VRD(3); SBAR(); GAPA(C0=__builtin_amdgcn_mfma_f32_32x32x16_bf16(kf[6],qr[3],C0,0,0,0),   P1[10],P1[11],P1[12],P1[13], pw3[0]=PKW(P1,8), pw3[1]=PKW(P1,10), pw3); \
    VRD(7); SBAR(); GAPA(C1=__builtin_amdgcn_mfma_f32_32x32x16_bf16(kf[7],qr[3],C1,0,0,0),   P1[14],P1[15],0.f,0.f,       pw3[2]=PKW(P1,12),pw3[3]=PKW(P1,14), pw3); \
    l_reg+=sacc; \
    if(GK){DMA_K((t)+3,sl_cur);} if(GV){DMA_V((t)+1,sl_next);} \
    CMASK(C0,C1,t); \
    { float a=MX3(C0[0],C0[1],C1[0]),b=MX3(C0[2],C0[3],C1[1]); a=MX3(a,C1[2],C1[3]); \
      _Pragma("unroll") for(int r=4;r<16;r+=4){a=MX3(a,C0[r],C0[r+1]);b=MX3(b,C0[r+2],C0[r+3]);a=MX3(a,C1[r],C1[r+1]);b=MX3(b,C1[r+2],C1[r+3]);} \
      float rm=__builtin_fmaxf(a,b); { auto rr=__builtin_amdgcn_permlane32_swap(__float_as_uint(rm),__float_as_uint(rm),false,false); rm=__builtin_fmaxf(__uint_as_float(rr[0]),__uint_as_float(rr[1])); } \
      resc=false; \
      if(__builtin_expect(__any(rm>(float)THRL),0)){ const float dl=__builtin_fmaxf(rm,0.f); mhat+=dl; \
        _Pragma("unroll") for(int r=0;r<16;++r){C0[r]-=dl;C1[r]-=dl;} \
        _Pragma("unroll") for(int r=0;r<16;++r)negm[r]=-mhat; asm volatile("":"+v"(negm)); \
        const float f=__builtin_amdgcn_exp2f(-dl); l_reg*=f; if(hi==0)wsf[r32]=f; resc=true; } } \
    SBAR(); \
    GAPB(o[0]=__builtin_amdgcn_mfma_f32_32x32x16_bf16(PAF(0),VFR(0),o[0],0,0,0), C0,0); \
    GAPB(o[1]=__builtin_amdgcn_mfma_f32_32x32x16_bf16(PAF(0),VFR(4),o[1],0,0,0), C0,4); \
    KRD(GL,0); GAPB(o[0]=__builtin_amdgcn_mfma_f32_32x32x16_bf16(PAF(1),VFR(1),o[0],0,0,0), C0,8); \
    KRD(GL,1); GAPB(o[1]=__builtin_amdgcn_mfma_f32_32x32x16_bf16(PAF(1),VFR(5),o[1],0,0,0), C0,12); \
    KRD(GL,2); GAPB(o[0]=__builtin_amdgcn_mfma_f32_32x32x16_bf16(PAF(2),VFR(2),o[0],0,0,0), C1,0); \
    KRD(GL,3); GAPB(o[1]=__builtin_amdgcn_mfma_f32_32x32x16_bf16(PAF(2),VFR(6),o[1],0,0,0), C1,4); \
    GAPB(o[0]=__builtin_amdgcn_mfma_f32_32x32x16_bf16(PAF(3),VFR(3),o[0],0,0,0), C1,8); \
    GAPB(o[1]=__builtin_amdgcn_mfma_f32_32x32x16_bf16(PAF(3),VFR(7),o[1],0,0,0), C1,12); \
    }while(0)
  int t=1;
  for(;t+5<NT;t+=2){
    STEP(pB0,pB1,pA0,pA1,t,true,true,true);     WAIT_BAR(2); RESC(); ROT();
    STEP(pA0,pA1,pB0,pB1,t+1,true,true,true);   WAIT_BAR(2); RESC(); ROT();
  }
  #define ENDW(tt) do{ if((tt)+3<NT){WAIT_BAR(2);} else if((tt)+2<NT){WAIT_BAR(1);} else {WAIT_BAR(0);} }while(0)
  for(;t+1<NT;t+=2){
    STEP(pB0,pB1,pA0,pA1,t,(t+3<NT),(t+1<NT),(t+1<NT));       ENDW(t);   RESC(); ROT();
    STEP(pA0,pA1,pB0,pB1,t+1,(t+4<NT),(t+2<NT),(t+2<NT));     ENDW(t+1); RESC(); ROT();
  }
  STEP(pB0,pB1,pA0,pA1,NT-1,false,false,false); RESC();
  { float sacc=pB0[0]+pB0[1]; _Pragma("unroll") for(int r=2;r<16;++r)sacc+=pB0[r]; _Pragma("unroll") for(int r=0;r<16;++r)sacc+=pB1[r]; l_reg+=sacc;
    pw0=(u32x4){PKW(pB0,0),PKW(pB0,2),PKW(pB0,4),PKW(pB0,6)};pw1=(u32x4){PKW(pB0,8),PKW(pB0,10),PKW(pB0,12),PKW(pB0,14)};pw2=(u32x4){PKW(pB1,0),PKW(pB1,2),PKW(pB1,4),PKW(pB1,6)};pw3=(u32x4){PKW(pB1,8),PKW(pB1,10),PKW(pB1,12),PKW(pB1,14)};
    SBAR(); pv(o,vb0+sl_cur,PAF(0),PAF(1),PAF(2),PAF(3)); }
  #undef PKW
  #undef PAF
  #undef VFR
  #undef PIN
  #undef MX3
  #undef GAPA
  #undef GAPB
  #undef EX
  #undef VRD
  #undef KRD
  #undef STEP
  #undef ENDW
  {auto rr=__builtin_amdgcn_permlane32_swap(__float_as_uint(l_reg),__float_as_uint(l_reg),false,false);l_reg=__uint_as_float(rr[0])+__uint_as_float(rr[1]);}
  if(WIN)l_reg+=__builtin_amdgcn_exp2f(sinkl2-mhat);
  if(hi==0)wsf[32+r32]=l_reg;asm volatile("s_waitcnt lgkmcnt(0)":::"memory");
  float rli[16];
  #pragma unroll
  for(int r=0;r<16;++r)rli[r]=__builtin_amdgcn_rcpf(wsf[32+crow(r,hi)]);
  bf16*Ow=Ob+(long)(wid*QBLK)*OP;
  { bf16*stg=(bf16*)(shm+LDS_OST)+wid*2048;
    #pragma unroll
    for(int r=0;r<16;++r){const int orow=crow(r,hi);
      #pragma unroll
      for(int d0=0;d0<2;++d0)stg[orow*64+d0*32+r32]=__float2bfloat16(o[d0][r]*rli[r]);}
    asm volatile("s_waitcnt lgkmcnt(0)":::"memory");
    #pragma unroll
    for(int i=0;i<4;++i){const int row=i*8+(lane>>3),ch=lane&7; const u32x4 v=*(const u32x4*)(stg+row*64+ch*8); ATTN_STORE16(Ow+(long)row*OP+ch*8,v);} }
  asm volatile("s_waitcnt lgkmcnt(0)\n\ts_barrier":::"memory");
  #undef DMA_K
  #undef DMA_V
  #undef KROW
  #undef CMASK
  #undef START
  #undef RESC
  #undef ROT
}
constexpr int ATTN_LDS_BYTES=LDS_BYTES;
#undef SBAR
#undef WAIT_BAR
}

__device__ __forceinline__ void st_attn_mfma(const Prm& p, int L, int mode, char* shm) {
    using namespace attn_body;
    const bf16* Pm = (const bf16*)(p.ws + WS_P); bf16* YM = (bf16*)(p.ws + WS_YMIX);
    const int G = GDIM_(), bx = BIDX_(); const int vcu = (G % 8 == 0) ? (bx % 8) * (G / 8) + bx / 8 : bx;
    const int cu0 = G >= MT / 128 + 16 ? MT / 128 : 0, nmain = 512;
    int u0 = vcu, u1 = nmain, us = G; if (mode) { if (bx < cu0 || bx >= cu0 + 16) return; u0 = nmain + (bx - cu0); u1 = nmain + 16; us = 16; }
    for (int u = u0; u < u1; u += us) {
        int isw, b, hq, qrow0, ctx0, lat0, NT, qpos0 = 0, kpos0 = 0, orow0;
        if (u < 512) { const int v = u & 255, qb = v & 31; isw = u >> 8; b = v >> 7; hq = (v >> 5) & 3; qrow0 = b * SEQ + qb * 256; orow0 = qrow0; ctx0 = ML + b * CTX_LEN;
            if (!isw) { lat0 = b * SEQ; NT = 4 + SEQ / 64; }
            else { const int lt0 = 4 * qb - 2 < 0 ? 0 : 4 * qb - 2, lt1 = 4 * qb + 6 > SEQ / 64 ? SEQ / 64 : 4 * qb + 6; lat0 = b * SEQ + 64 * lt0; NT = 4 + lt1 - lt0; qpos0 = qb * 256; kpos0 = 64 * lt0; } }
        else { const int v = u - 512; isw = v >> 3; b = (v >> 2) & 1; hq = v & 3; qrow0 = ML + b * CTX_LEN; orow0 = qrow0; ctx0 = qrow0; lat0 = 0; NT = 4; }
        const int kv = hq >> 1;
        bf16* Ob = YM + (size_t)orow0 * D_MIX + (isw ? 512 : 256) + hq * 64;
        if (isw) attn_unit<8, true>(Pm, qrow0, WAQ + hq * 64, WAK + kv * 64, WAV + kv * 64, ctx0, lat0, NT, qpos0, kpos0, p.in[I_SINK][L * 4 + hq] * 1.4426950408889634f, Ob, shm);
        else attn_unit<8, false>(Pm, qrow0, GAQ + hq * 64, GAK + kv * 64, GAV + kv * 64, ctx0, lat0, NT, 0, 0, 0.f, Ob, shm);
    }
}

typedef float f32x4_t __attribute__((ext_vector_type(4)));
typedef unsigned u32x2_t __attribute__((ext_vector_type(2)));
__device__ __forceinline__ float wave_sum_(float v) {
#pragma unroll
    for (int o = 1; o < 64; o <<= 1) v += __shfl_xor(v, o);
    return v;
}
__device__ __forceinline__ int wave_id_() { const int t = TID_(); return BIDX_() * (NTHREADS_ / 64) + __builtin_amdgcn_readfirstlane(t >> 6); }
__device__ __forceinline__ int lane_id_() { unsigned m_ = ~0u; asm volatile("" : "+s"(m_)); return (int)__builtin_amdgcn_mbcnt_hi(m_, __builtin_amdgcn_mbcnt_lo(m_, 0u)); }
__device__ __forceinline__ const float* xsrc_(const Prm& p, int r, bool from_input) { return from_input ? (r < ML ? p.in[I_X] + (size_t)r * D_MODEL : p.in[I_CTX] + (size_t)(r - ML) * D_MODEL) : xrow(p, r); }
#define JX_(j) (128 * ((j) >> 1) + ((j) & 1))
__device__ __forceinline__ void st_norm_fused(const Prm& p, int L, int which, int nrows, const float* pend) {
    const int lane = lane_id_(), NGW = GDIM_() * (NTHREADS_ / 64); act_t* xn = WSP(act_t, WS_XN);
    const float* gw = p.in[which ? I_GFFN : I_GMIX] + (size_t)L * D_MODEL;
    for (int r = wave_id_(); r < nrows; r += NGW) {
        const f32x4_t* xr = (const f32x4_t*)xsrc_(p, r, L == 0 && which == 0) + 2 * lane; const int modrow = r < ML ? r / SEQ : BATCH;
        const f32x4_t* sh = (const f32x4_t*)modp(p, L, modrow, which ? 3 : 0) + 2 * lane; const f32x4_t* sc = (const f32x4_t*)modp(p, L, modrow, which ? 4 : 1) + 2 * lane; const f32x4_t* gp = (const f32x4_t*)gw + 2 * lane;
        f32x4_t v[D_MODEL / 256]; float ss = 0.f;
#pragma unroll
        for (int j = 0; j < D_MODEL / 256; ++j) v[j] = xr[JX_(j)];
        if (pend && r >= ML) { const f32x4_t* sl = (const f32x4_t*)(WSP(float, WS_SLAB) + (size_t)(r - ML) * D_MODEL) + 2 * lane; const f32x4_t* pg = (const f32x4_t*)pend + 2 * lane; f32x4_t* xw = (f32x4_t*)xrow(p, r) + 2 * lane;
#pragma unroll
            for (int j = 0; j < D_MODEL / 256; ++j) { const f32x4_t t = (sl[JX_(j)] + sl[JX_(j) + (size_t)MC * D_MODEL / 4]) + (sl[JX_(j) + (size_t)2 * MC * D_MODEL / 4] + sl[JX_(j) + (size_t)3 * MC * D_MODEL / 4]); v[j] = v[j] + pg[JX_(j)] * t; xw[JX_(j)] = v[j]; } }
#pragma unroll
        for (int j = 0; j < D_MODEL / 256; ++j) ss += (v[j].x * v[j].x + v[j].y * v[j].y) + (v[j].z * v[j].z + v[j].w * v[j].w);
        const float rs = 1.0f / sqrtf(wave_sum_(ss) * (1.0f / D_MODEL) + NORM_EPS);
        pg8::u32x4* o16 = (pg8::u32x4*)(xn + (size_t)r * D_MODEL) + lane;
#pragma unroll
        for (int jj = 0; jj < D_MODEL / 512; ++jj) { pg8::u32x4 w;
#pragma unroll
            for (int h = 0; h < 2; ++h) { const int j = 2 * jj + h; const f32x4_t g4 = gp[JX_(j)], s4 = sc[JX_(j)], h4 = sh[JX_(j)]; const f32x4_t y = v[j] * rs * g4 * (s4 + 1.0f) + h4; w[2 * h] = pk2(y.x, y.y); w[2 * h + 1] = pk2(y.z, y.w); }
            pg8::st_wt(o16 + 64 * jj, w); }
    }
}
#undef JX_
__device__ __forceinline__ void st_final_fused(const Prm& p) {
    const int lane = lane_id_(), NGW = GDIM_() * (NTHREADS_ / 64); const f32x4_t* gp = (const f32x4_t*)p.in[I_GFIN] + lane;
    for (int r = wave_id_(); r < ML; r += NGW) { f32x4_t* xr = (f32x4_t*)(p.out + (size_t)r * D_MODEL) + lane; f32x4_t v[D_MODEL / 256]; float ss = 0.f;
#pragma unroll
        for (int j = 0; j < D_MODEL / 256; ++j) { v[j] = xr[64 * j]; ss += (v[j].x * v[j].x + v[j].y * v[j].y) + (v[j].z * v[j].z + v[j].w * v[j].w); }
        const float rs = 1.0f / sqrtf(wave_sum_(ss) * (1.0f / D_MODEL) + NORM_EPS);
#pragma unroll
        for (int j = 0; j < D_MODEL / 256; ++j) xr[64 * j] = v[j] * rs * gp[64 * j]; }
}
__device__ __forceinline__ void unpack4_(const u32x2_t v, float* o) { o[0] = __uint_as_float(v.x << 16); o[1] = __uint_as_float(v.x & 0xffff0000u); o[2] = __uint_as_float(v.y << 16); o[3] = __uint_as_float(v.y & 0xffff0000u); }
__device__ __forceinline__ void st_ssd_out_w(const Prm& p, int L, int nrows) {
    const int lane = lane_id_(), NGW = GDIM_() * (NTHREADS_ / 64); const act_t* P = WSP(act_t, WS_P); act_t* ym = WSP(act_t, WS_YMIX);
    const f32x4_t g4 = *((const f32x4_t*)(p.in[I_SNG] + L * 256) + lane);
    for (int r = wave_id_(); r < nrows; r += NGW) { float y[4], z[4];
        unpack4_(*((const u32x2_t*)(P + (size_t)r * PLD + YSSD_OFF) + lane), y); unpack4_(*((const u32x2_t*)(P + (size_t)r * PLD + Z_OFF) + lane), z);
        float v[4], ss = 0.f;
#pragma unroll
        for (int e = 0; e < 4; ++e) { v[e] = y[e] * z[e] / (1.f + __expf(-z[e])); ss += v[e] * v[e]; }
        const float rn = 1.0f / sqrtf(wave_sum_(ss) * (1.f / 256.f) + NORM_EPS);
        u32x2_t w; w.x = pk2(v[0] * rn * g4.x, v[1] * rn * g4.y); w.y = pk2(v[2] * rn * g4.z, v[3] * rn * g4.w);
        *((u32x2_t*)(ym + (size_t)r * D_MIX) + lane) = w; }
}
__device__ __forceinline__ void st_ssd_cs_w(const Prm& p, int L) {
    const int lane = lane_id_(), NGW = GDIM_() * (NTHREADS_ / 64); const act_t* P = WSP(act_t, WS_P); float* DT = WSP(float, WS_DT); float* CS = WSP(float, WS_CS);
    for (int it = wave_id_(); it < NCH * 8; it += NGW) { const int dh = it & 7, c = it >> 3, d = dh >> 2;
        const float a = -expf(p.in[I_SALOG][L * 8 + dh]), bias = p.in[I_SDTB][L * 8 + dh];
        const size_t r0 = (size_t)c * 128 + lane, r1 = r0 + 64;
        const float* dtr = WSP(float, WS_DTRAW); const float dt0 = softplusf_(dtr[r0 * 8 + dh] + bias), dt1 = softplusf_(dtr[r1 * 8 + dh] + bias);
        float s0 = dt0 * a, s1 = dt1 * a; const float a0 = s0, a1 = s1;
#pragma unroll
        for (int o = 1; o < 64; o <<= 1) { const float t0 = __shfl_up(s0, o), t1 = __shfl_up(s1, o); if (lane >= o) { s0 += t0; s1 += t1; } }
        const float tot0 = __shfl(s0, 63); s1 += tot0; const float tot = __shfl(s1, 63);
        DT[r0 * 8 + dh] = dt0; DT[r1 * 8 + dh] = dt1;
        CS[r0 * 8 + dh] = d ? tot - s0 + a0 : s0; CS[r1 * 8 + dh] = d ? tot - s1 + a1 : s1; }
}
__device__ __forceinline__ void st_s5tabB_v(const Prm& p, int layer, int g0, int gs) {
    typedef float f32x2_t __attribute__((ext_vector_type(2)));
    const float* lamp = WSP(float, WS_LAMP) + (size_t)layer * 2 * 16 * 64 * 17 * 2; const float* bbar = WSP(float, WS_BBAR) + (size_t)layer * 2 * 16 * 64 * 16 * 2; const float* kt = WSP(float, WS_KT) + (size_t)layer * 2 * 16 * 16 * 256;
    act_t* BY = WSP(act_t, WS_S5BY); act_t* BE = WSP(act_t, WS_S5BE);
    constexpr int NBY = 16 * 256 * 512 / 8, NBE = 16 * 256 * 256 / 8;
    for (int it = g0; it < NBY + NBE; it += gs) { float v[8]; act_t* dst;
        if (it < NBY) { const int idx = it * 8, q = idx & 511, ik = (idx >> 9) & 255, g = idx >> 17, i = ik >> 4, k = ik & 15; dst = BY + idx;
            if (q < 256) { const int j = q >> 4, kp0 = q & 15;
                if (j != i) { const float* s0 = kt + ((j < i ? g * 16 + (i - j) : (16 + g) * 16 + (j - i)) * 16 + k) * 16 + kp0; const f32x4_t a = *(const f32x4_t*)s0, b = *(const f32x4_t*)(s0 + 4);
#pragma unroll
                    for (int e = 0; e < 4; ++e) { v[e] = a[e]; v[4 + e] = b[e]; } }
                else { const float* s0 = kt + ((g * 16) * 16 + k) * 16 + kp0; const float* s1 = kt + (((16 + g) * 16) * 16 + k) * 16 + kp0; const float dsk = p.in[I_S5D][layer * 256 + g * 16 + k];
                    const f32x4_t a0 = *(const f32x4_t*)s0, b0 = *(const f32x4_t*)(s0 + 4), a1 = *(const f32x4_t*)s1, b1 = *(const f32x4_t*)(s1 + 4);
#pragma unroll
                    for (int e = 0; e < 4; ++e) { v[e] = a0[e] + a1[e] + (k == kp0 + e ? dsk : 0.f); v[4 + e] = b0[e] + b1[e] + (k == kp0 + 4 + e ? dsk : 0.f); } } }
            else { const int dd = (q - 256) >> 7, n0 = ((q - 256) & 127) >> 1, pw = dd ? 16 - i : i + 1; const int dg = (layer * 2 + dd) * 16 + g, dgn = (dd * 16 + g) * 64 + n0;
                const f32x4_t cr = *(const f32x4_t*)(p.in[I_CRE] + (dg * 16 + k) * 64 + n0), ci = *(const f32x4_t*)(p.in[I_CIM] + (dg * 16 + k) * 64 + n0);
#pragma unroll
                for (int m = 0; m < 4; ++m) { const f32x2_t l = *(const f32x2_t*)(lamp + ((dgn + m) * 17 + pw) * 2); v[2 * m] = cr[m] * l.x - ci[m] * l.y; v[2 * m + 1] = -(cr[m] * l.y + ci[m] * l.x); } } }
        else { const int idx = (it - NBY) * 8, q = idx & 255, rr = (idx >> 8) & 255, g = idx >> 16, dd = rr >> 7, n = (rr & 127) >> 1, c = rr & 1, j = q >> 4, kp0 = q & 15, pw = dd ? j : 15 - j; dst = BE + idx;
            const int dgn = (dd * 16 + g) * 64 + n; const f32x2_t l = *(const f32x2_t*)(lamp + (dgn * 17 + pw) * 2); const float* bs = bbar + (dgn * 16 + kp0) * 2;
#pragma unroll
            for (int h = 0; h < 4; ++h) { const f32x4_t bb = *(const f32x4_t*)(bs + 4 * h);
                v[2 * h] = c ? (l.x * bb[1] + l.y * bb[0]) : (l.x * bb[0] - l.y * bb[1]); v[2 * h + 1] = c ? (l.x * bb[3] + l.y * bb[2]) : (l.x * bb[2] - l.y * bb[3]); } }
        v4u o; o.x = pk2(v[0], v[1]); o.y = pk2(v[2], v[3]); o.z = pk2(v[4], v[5]); o.w = pk2(v[6], v[7]); *(v4u*)dst = o; }
}
__device__ __forceinline__ void st_s5tab2_lds(const Prm& p, LAS unsigned char* lds) {
    typedef float f32x2_t __attribute__((ext_vector_type(2)));
    const float* lamp = WSP(float, WS_LAMP); const float* bbar = WSP(float, WS_BBAR); float* kt = WSP(float, WS_KT); const int tid = TID_();
    LAS float* CR = (LAS float*)lds; LAS float* CI = CR + 1024; LAS f32x2_t* LM = (LAS f32x2_t*)(CI + 1024); LAS f32x2_t* BB = LM + 256;
    for (int u = BIDX_(); u < DEPTH * 2 * 16 * 4; u += GDIM_()) { const int ldg = u >> 2, tq = u & 3;
#pragma unroll
        for (int i = 0; i < 2; ++i) { const int q = tid + 512 * i; CR[q] = p.in[I_CRE][ldg * 1024 + q]; CI[q] = p.in[I_CIM][ldg * 1024 + q]; BB[q] = *(const f32x2_t*)(bbar + (size_t)(ldg * 1024 + q) * 2); }
        if (tid < 256) { const int n = tid >> 2, tl = tid & 3; LM[tid] = *(const f32x2_t*)(lamp + (size_t)((ldg * 64 + n) * 17 + 4 * tq + tl) * 2); }
        __syncthreads();
#pragma unroll
        for (int i = 0; i < 2; ++i) { const int o = tid + 512 * i, tl = o >> 8, k = (o >> 4) & 15, kp = o & 15; float acc = 0.f;
#pragma unroll 8
            for (int n = 0; n < 64; ++n) { const float cr = CR[k * 64 + n], ci = CI[k * 64 + n]; const f32x2_t lm = LM[n * 4 + tl], bb = BB[n * 16 + kp];
                const float tr = lm.x * bb.x - lm.y * bb.y, ti = lm.x * bb.y + lm.y * bb.x; acc += cr * tr - ci * ti; }
            kt[(size_t)(ldg * 16 + 4 * tq + tl) * 256 + k * 16 + kp] = acc; }
        __syncthreads(); }
}
__device__ __forceinline__ void st_mod_atomic(const Prm& p, LAS unsigned char* lds) {
    const int tid = TID_(), lane = tid & 63, wave = __builtin_amdgcn_readfirstlane(tid >> 6); LAS float* sl = (LAS float*)lds;
    LAS f32x4_t* red = (LAS f32x4_t*)(lds + 16384);
    for (int i = tid; i < (BATCH + 1) * D_MODEL; i += NTHREADS_) { const float cv = i < BATCH * D_MODEL ? p.in[I_C][i] : p.in[I_CCTX][i - BATCH * D_MODEL]; sl[i] = cv / (1.f + __expf(-cv)); }
    __syncthreads();
    float* mod = WSP(float, WS_MOD); constexpr int NJ4 = 6 * D_MODEL / 4, KC = 32, NJB = NJ4 / 64, NKG = D_MODEL / (8 * KC); static_assert(NJ4 % 64 == 0 && D_MODEL % (8 * KC) == 0 && BATCH == 2, "modulation units");
    for (int u = BIDX_(); u < DEPTH * NJB * NKG; u += GDIM_()) { const int l = u / (NJB * NKG), jb = u % NJB, kg = (u / NJB) % NKG, j4 = jb * 64 + lane, k0 = (kg * 8 + wave) * KC;
        const f32x4_t* w = (const f32x4_t*)(p.in[I_WMOD] + (size_t)l * D_MODEL * 6 * D_MODEL) + j4; f32x4_t acc[BATCH + 1];
#pragma unroll
        for (int m = 0; m <= BATCH; ++m) acc[m] = (f32x4_t){0.f, 0.f, 0.f, 0.f};
#pragma unroll
        for (int k = 0; k < KC; ++k) { const f32x4_t wv = w[(size_t)(k0 + k) * NJ4];
#pragma unroll
            for (int m = 0; m <= BATCH; ++m) acc[m] += sl[m * D_MODEL + k0 + k] * wv; }
        if (kg == 0 && wave == 0) { const f32x4_t bv = *((const f32x4_t*)(p.in[I_BMOD] + (size_t)l * 6 * D_MODEL) + j4);
#pragma unroll
            for (int m = 0; m <= BATCH; ++m) acc[m] += bv; }
#pragma unroll
        for (int m = 0; m <= BATCH; ++m) red[(wave * (BATCH + 1) + m) * 64 + lane] = acc[m];
        __syncthreads();
        if (tid < (BATCH + 1) * 64) { const int m = tid >> 6; f32x4_t sum = red[m * 64 + lane];
#pragma unroll
            for (int wv = 1; wv < 8; ++wv) sum += red[(wv * (BATCH + 1) + m) * 64 + lane];
            float* o = mod + ((size_t)(l * (BATCH + 1) + m) * 6 * D_MODEL) + 4 * j4;
#pragma unroll
            for (int e = 0; e < 4; ++e) (void)__hip_atomic_fetch_add(o + e, sum[e], __ATOMIC_RELAXED, __HIP_MEMORY_SCOPE_AGENT); }
        __syncthreads(); }
}
__device__ __forceinline__ void st_ssd_carry_b(const Prm& p, int g0, int gs) {
    float* sst = WSP(float, WS_SST); const float* CS = WSP(float, WS_CS);
    constexpr int NJ = (CTX_LEN + SEQ) / 128, BL = 11; static_assert(NJ % BL == 0, "carry block");
    for (int i = g0; i < BATCH * 2 * 4 * 64 * 128; i += gs) { const int e = i % 8192, h = (i / 8192) % 4, d = (i / 32768) % 2, b = i / 65536, dh = d * 4 + h; float hst = 0.f;
#pragma clang loop unroll(disable)
        for (int j0 = 0; j0 < NJ; j0 += BL) { float tmp[BL], dec[BL]; int so[BL];
#pragma unroll
            for (int u = 0; u < BL; ++u) { const int c = ssd_chunk_of(b, d, j0 + u); so[u] = ((c * 2 + d) * 4 + h) * 8192 + e; tmp[u] = sst[so[u]]; dec[u] = CS[(c * 128 + (d ? 0 : 127)) * 8 + dh]; }
#pragma unroll
            for (int u = 0; u < BL; ++u) { sst[so[u]] = hst; hst = hst * __expf(dec[u]) + tmp[u]; } } }
}
__device__ __forceinline__ void st_s5_carry_b(const Prm& p, int L, LAS unsigned char* lds) {
    typedef float f32x2_t __attribute__((ext_vector_type(2)));
    const int tid = TID_();
    const float* lamp = WSP(float, WS_LAMP) + (size_t)L * 2 * 16 * 64 * 17 * 2; const float* E = WSP(float, WS_S5E); act_t* A = WSP(act_t, WS_S5A);
    constexpr int NJ = (CTX_LEN + SEQ) / 16, NSEG = 16, SL = NJ / NSEG, BL = 11, NPW = NTHREADS_ / NSEG; static_assert(NJ % NSEG == 0 && SL % BL == 0 && 64 % NPW == 0, "carry segments");
    LAS f32x2_t* T = (LAS f32x2_t*)lds;
    const int nl = tid % NPW, seg = tid / NPW;
    for (int u = BIDX_(); u < BATCH * 2 * 16 * (64 / NPW); u += GDIM_()) { const int nh = u % (64 / NPW), g = (u / (64 / NPW)) & 15, d = (u / (64 / NPW) >> 4) & 1, b = u / (64 / NPW) >> 5, n = nh * NPW + nl; const int dgn = (d * 16 + g) * 64 + n;
        const float lr = lamp[(dgn * 17 + 16) * 2], li = lamp[(dgn * 17 + 16) * 2 + 1];
        const float* Eb = E + (size_t)g * NSC * 256 + d * 128 + 2 * n; act_t* Ab = A + (size_t)g * S5R * 512 + 256 + d * 128 + 2 * n;
        float hr = 0.f, hi = 0.f;
#pragma clang loop unroll(disable)
        for (int j0 = seg * SL; j0 < (seg + 1) * SL; j0 += BL) { f32x2_t t[BL];
#pragma unroll
            for (int q = 0; q < BL; ++q) t[q] = *(const f32x2_t*)(Eb + s5_sc_of(b, d, j0 + q) * 256);
#pragma unroll
            for (int q = 0; q < BL; ++q) { const float nr = lr * hr - li * hi + t[q].x, ni = lr * hi + li * hr + t[q].y; hr = nr; hi = ni; } }
        T[seg * NPW + nl] = (f32x2_t){hr, hi};
        float pr = 1.f, pi = 0.f;
        for (int q = 0; q < SL; ++q) { const float nr = pr * lr - pi * li, ni = pr * li + pi * lr; pr = nr; pi = ni; }
        __syncthreads();
        hr = 0.f; hi = 0.f;
        for (int sg = 0; sg < seg; ++sg) { const f32x2_t tt = T[sg * NPW + nl]; const float nr = pr * hr - pi * hi + tt.x, ni = pr * hi + pi * hr + tt.y; hr = nr; hi = ni; }
#pragma clang loop unroll(disable)
        for (int j0 = seg * SL; j0 < (seg + 1) * SL; j0 += BL) { f32x2_t t[BL]; int scs[BL];
#pragma unroll
            for (int q = 0; q < BL; ++q) { scs[q] = s5_sc_of(b, d, j0 + q); t[q] = *(const f32x2_t*)(Eb + scs[q] * 256); }
#pragma unroll
            for (int q = 0; q < BL; ++q) { *(unsigned*)(Ab + scs[q] * 512) = pk2(hr, hi); const float nr = lr * hr - li * hi + t[q].x, ni = lr * hi + li * hr + t[q].y; hr = nr; hi = ni; } }
        __syncthreads(); }
}

namespace ssdm {
typedef short bf16x8 __attribute__((ext_vector_type(8)));
typedef float f32x4 __attribute__((ext_vector_type(4)));
typedef unsigned u32x4 __attribute__((ext_vector_type(4)));
typedef unsigned u32x2 __attribute__((ext_vector_type(2)));
constexpr int RS = 136;
constexpr int L_CM = 0, L_BM = 128 * RS * 2, L_X = 2 * 128 * RS * 2, L_H = L_X + 64 * RS * 2, L_F = L_H + 64 * RS * 2, L_H2 = L_F + 2 * 4 * 128 * 4, L_END = L_H2 + 64 * RS * 2;
static_assert(L_END <= 131072, "SSD LDS map");
#define SSD_MFMA(a, b, c) __builtin_amdgcn_mfma_f32_16x16x32_bf16(a, b, c, 0, 0, 0)
__device__ __forceinline__ bf16x8 frag(const LAS unsigned short* base, int row, int k0, int quad) { return *(const LAS bf16x8*)(base + row * RS + k0 + 8 * quad); }
__device__ __forceinline__ unsigned cvtpk_(float lo, float hi) { typedef float f2_ __attribute__((ext_vector_type(2))); typedef __bf16 b2_ __attribute__((ext_vector_type(2))); f2_ v = {lo, hi}; return __builtin_bit_cast(unsigned, __builtin_convertvector(v, b2_)); }
__device__ __forceinline__ void lds_fence() { asm volatile("s_waitcnt lgkmcnt(0)" ::: "memory"); }
__device__ __forceinline__ void stage_dtcs(const Prm& p, LAS float* F, size_t r0, int g, int tid) {
    const int combo = tid >> 7, l = tid & 127, dh = (combo >> 1) * 4 + 2 * g + (combo & 1);
    F[tid] = WSP(float, WS_DT)[(r0 + l) * 8 + dh]; F[512 + tid] = WSP(float, WS_CS)[(r0 + l) * 8 + dh];
}
__device__ __forceinline__ void ssd_states_unit(const Prm& p, LAS unsigned char* lds, int c, int g, int tid) {
    const int lane = tid & 63, wave = __builtin_amdgcn_readfirstlane(tid >> 6), quad = lane >> 4, l15 = lane & 15;
    const act_t* xbc = WSP(act_t, WS_XBC); float* sst = WSP(float, WS_SST); const int r0 = c * 128;
    LAS unsigned short* BT = (LAS unsigned short*)(lds + L_BM); LAS unsigned short* XT0 = (LAS unsigned short*)(lds + L_X); LAS unsigned short* XT1 = (LAS unsigned short*)(lds + L_H); LAS float* F = (LAS float*)(lds + L_F);
#pragma unroll
    for (int i = 0; i < 4; ++i) { const int q = tid + 512 * i, l = q >> 4, n0 = (q & 15) * 8; const u32x4 v = *(const u32x4*)(xbc + (r0 + l) * 768 + 256 + g * 128 + n0);
#pragma unroll
        for (int e = 0; e < 4; ++e) { BT[(n0 + 2 * e) * RS + l] = (unsigned short)(v[e] & 0xffffu); BT[(n0 + 2 * e + 1) * RS + l] = (unsigned short)(v[e] >> 16); } }
#pragma unroll
    for (int hh = 0; hh < 2; ++hh) { LAS unsigned short* XT = hh ? XT1 : XT0;
#pragma unroll
        for (int i = 0; i < 2; ++i) { const int q = tid + 512 * i, l = q >> 3, p0 = (q & 7) * 8; const u32x4 v = *(const u32x4*)(xbc + (r0 + l) * 768 + (2 * g + hh) * 64 + p0);
#pragma unroll
            for (int e = 0; e < 4; ++e) { XT[(p0 + 2 * e) * RS + l] = (unsigned short)(v[e] & 0xffffu); XT[(p0 + 2 * e + 1) * RS + l] = (unsigned short)(v[e] >> 16); } } }
    { const int combo = tid >> 7, l = tid & 127, d = combo >> 1, dh = d * 4 + 2 * g + (combo & 1); const float* DTg = WSP(float, WS_DT); const float* CSg = WSP(float, WS_CS);
      F[tid] = DTg[(r0 + l) * 8 + dh] * __expf(CSg[(r0 + (d ? 0 : 127)) * 8 + dh] - CSg[(r0 + l) * 8 + dh]); }
    __syncthreads();
    const int rt = wave & 3, cb0 = 4 * (wave >> 2);
#pragma clang loop unroll(disable)
    for (int combo = 0; combo < 4; ++combo) { const int d = combo >> 1, h = 2 * g + (combo & 1); const LAS unsigned short* XT = (combo & 1) ? XT1 : XT0; f32x4 acc[4];
#pragma unroll
        for (int j = 0; j < 4; ++j) acc[j] = (f32x4){0.f, 0.f, 0.f, 0.f};
#pragma unroll
        for (int ks = 0; ks < 4; ++ks) { const bf16x8 ar = frag(XT, 16 * rt + l15, 32 * ks, quad);
            const f32x4 w0 = *(const LAS f32x4*)(F + combo * 128 + 32 * ks + 8 * quad), w1 = *(const LAS f32x4*)(F + combo * 128 + 32 * ks + 8 * quad + 4);
            const u32x4 au = __builtin_bit_cast(u32x4, ar); u32x4 sc;
            sc[0] = cvtpk_(__uint_as_float(au[0] << 16) * w0[0], __uint_as_float(au[0] & 0xffff0000u) * w0[1]); sc[1] = cvtpk_(__uint_as_float(au[1] << 16) * w0[2], __uint_as_float(au[1] & 0xffff0000u) * w0[3]);
            sc[2] = cvtpk_(__uint_as_float(au[2] << 16) * w1[0], __uint_as_float(au[2] & 0xffff0000u) * w1[1]); sc[3] = cvtpk_(__uint_as_float(au[3] << 16) * w1[2], __uint_as_float(au[3] & 0xffff0000u) * w1[3]);
            const bf16x8 a = __builtin_bit_cast(bf16x8, sc);
#pragma unroll
            for (int j = 0; j < 4; ++j) acc[j] = SSD_MFMA(a, frag(BT, 16 * (cb0 + j) + l15, 32 * ks, quad), acc[j]); }
        float* o = sst + ((c * 2 + d) * 4 + h) * 8192;
#pragma unroll
        for (int j = 0; j < 4; ++j)
#pragma unroll
            for (int e = 0; e < 4; ++e) o[(16 * rt + 4 * quad + e) * 128 + 16 * (cb0 + j) + l15] = acc[j][e]; }
    __syncthreads();
}
__device__ __forceinline__ void ssd_y_unit(const Prm& p, int L, LAS unsigned char* lds, int c, int g, int tid) {
    const int lane = tid & 63, wave = __builtin_amdgcn_readfirstlane(tid >> 6), quad = lane >> 4, l15 = lane & 15;
    const act_t* xbc = WSP(act_t, WS_XBC); const float* sst = WSP(float, WS_SST); act_t* P = WSP(act_t, WS_P); const int r0 = c * 128;
    LAS unsigned short* CM = (LAS unsigned short*)(lds + L_CM); LAS unsigned short* BM = (LAS unsigned short*)(lds + L_BM); LAS unsigned short* XT = (LAS unsigned short*)(lds + L_X); LAS unsigned short* HN = (LAS unsigned short*)(lds + L_H); LAS float* F = (LAS float*)(lds + L_F);
    const int lrow = 16 * wave + l15, wks = wave >> 1;
#pragma unroll
    for (int i = 0; i < 4; ++i) { const int q = tid + 512 * i, l = q >> 4, n0 = (q & 15) * 8;
        *(LAS u32x4*)(CM + l * RS + n0) = *(const u32x4*)(xbc + (r0 + l) * 768 + 512 + g * 128 + n0); *(LAS u32x4*)(BM + l * RS + n0) = *(const u32x4*)(xbc + (r0 + l) * 768 + 256 + g * 128 + n0); }
    stage_dtcs(p, F, r0, g, tid);
    u32x4 xr[2][2]; u32x2 xsk[2][4]; f32x4 ph[2][4];
#pragma unroll
    for (int hh = 0; hh < 2; ++hh) {
#pragma unroll
        for (int i = 0; i < 2; ++i) { const int q = tid + 512 * i; xr[hh][i] = *(const u32x4*)(xbc + (r0 + (q >> 3)) * 768 + (2 * g + hh) * 64 + (q & 7) * 8); }
#pragma unroll
        for (int j = 0; j < 4; ++j) xsk[hh][j] = *(const u32x2*)(xbc + (r0 + lrow) * 768 + (2 * g + hh) * 64 + 16 * j + 4 * quad); }
#define SSD_LOADH2(hh_) do { _Pragma("unroll") for (int d_ = 0; d_ < 2; ++d_) { const float* hin_ = sst + ((c * 2 + d_) * 4 + 2 * g + (hh_)) * 8192; \
        _Pragma("unroll") for (int i = 0; i < 4; ++i) { const int q = tid + 512 * i; ph[d_][i] = *(const f32x4*)(hin_ + (q >> 5) * 128 + (q & 31) * 4); } } } while (0)
    SSD_LOADH2(0);
    __syncthreads();
    f32x4 cb[8]; bf16x8 bc[4];
#pragma unroll
    for (int j = 0; j < 8; ++j) cb[j] = (f32x4){0.f, 0.f, 0.f, 0.f};
#pragma unroll
    for (int ks = 0; ks < 4; ++ks) { bc[ks] = frag(CM, lrow, 32 * ks, quad);
#pragma unroll
        for (int j = 0; j < 8; ++j) cb[j] = SSD_MFMA(frag(BM, 16 * j + l15, 32 * ks, quad), bc[ks], cb[j]); }
    __syncthreads();
    LAS unsigned short* HN1 = (LAS unsigned short*)(lds + L_H2);
#pragma unroll
    for (int hh = 0; hh < 2; ++hh) { const int h = 2 * g + hh;
        const LAS float* dt0 = F + hh * 128; const LAS float* cs0 = F + 512 + hh * 128; const LAS float* dt1 = F + (2 + hh) * 128; const LAS float* cs1 = F + 512 + (2 + hh) * 128;
#pragma unroll
        for (int i = 0; i < 2; ++i) { const int q = tid + 512 * i, l = q >> 3, p0 = (q & 7) * 8; const u32x4 v = xr[hh][i];
#pragma unroll
            for (int e = 0; e < 4; ++e) { XT[(p0 + 2 * e) * RS + l] = (unsigned short)(v[e] & 0xffffu); XT[(p0 + 2 * e + 1) * RS + l] = (unsigned short)(v[e] >> 16); } }
#pragma unroll
        for (int i = 0; i < 4; ++i) { const int q = tid + 512 * i, pp = q >> 5, n0 = (q & 31) * 4; u32x2 w0, w1; w0.x = cvtpk_(ph[0][i][0], ph[0][i][1]); w0.y = cvtpk_(ph[0][i][2], ph[0][i][3]); w1.x = cvtpk_(ph[1][i][0], ph[1][i][1]); w1.y = cvtpk_(ph[1][i][2], ph[1][i][3]);
            *(LAS u32x2*)(HN + pp * RS + n0) = w0; *(LAS u32x2*)(HN1 + pp * RS + n0) = w1; }
        if (hh == 0) SSD_LOADH2(1);
        const float c0l = cs0[lrow], c1l = cs1[lrow];
#pragma unroll
        for (int j = 0; j < 8; ++j) { float m4[4]; const int s0i = 16 * j + 4 * quad;
            if (j < wave) { const f32x4 cs4 = *(const LAS f32x4*)(cs0 + s0i), dt4 = *(const LAS f32x4*)(dt0 + s0i);
#pragma unroll
                for (int e = 0; e < 4; ++e) m4[e] = cb[j][e] * dt4[e] * __expf(fminf(c0l - cs4[e], 0.f)); }
            else if (j > wave) { const f32x4 cs4 = *(const LAS f32x4*)(cs1 + s0i), dt4 = *(const LAS f32x4*)(dt1 + s0i);
#pragma unroll
                for (int e = 0; e < 4; ++e) m4[e] = cb[j][e] * dt4[e] * __expf(fminf(c1l - cs4[e], 0.f)); }
            else { const f32x4 ca4 = *(const LAS f32x4*)(cs0 + s0i), da4 = *(const LAS f32x4*)(dt0 + s0i), cb4 = *(const LAS f32x4*)(cs1 + s0i), db4 = *(const LAS f32x4*)(dt1 + s0i);
#pragma unroll
                for (int e = 0; e < 4; ++e) { const int sidx = s0i + e; const float t0 = sidx <= lrow ? da4[e] * __expf(fminf(c0l - ca4[e], 0.f)) : 0.f, t1 = sidx >= lrow ? db4[e] * __expf(fminf(c1l - cb4[e], 0.f)) : 0.f; m4[e] = cb[j][e] * (t0 + t1); } }
            u32x2 w; w.x = cvtpk_(m4[0], m4[1]); w.y = cvtpk_(m4[2], m4[3]); *(LAS u32x2*)(BM + lrow * RS + s0i) = w; }
        __syncthreads();
        f32x4 dg[4], o0[4], o1[4];
#pragma unroll
        for (int j = 0; j < 4; ++j) { dg[j] = (f32x4){0.f, 0.f, 0.f, 0.f}; o0[j] = dg[j]; o1[j] = dg[j]; }
#pragma unroll
        for (int ks = 0; ks < 4; ++ks) { const bf16x8 bm_ = frag(BM, lrow, 32 * ks, quad);
#pragma unroll
            for (int j = 0; j < 4; ++j) { dg[j] = SSD_MFMA(frag(XT, 16 * j + l15, 32 * ks, quad), bm_, dg[j]); o0[j] = SSD_MFMA(frag(HN, 16 * j + l15, 32 * ks, quad), bc[ks], o0[j]); o1[j] = SSD_MFMA(frag(HN1, 16 * j + l15, 32 * ks, quad), bc[ks], o1[j]); } }
        const float sc0 = __expf(c0l), sc1 = __expf(c1l), dsk = p.in[I_SD][L * 4 + h];
        __syncthreads();
#pragma unroll
        for (int j = 0; j < 4; ++j) { const int r = r0 + lrow; const int hp = h * 64 + 16 * j + 4 * quad; float xv[4]; const u32x2 xr_ = xsk[hh][j]; const f32x4 yv = dg[j] + sc0 * o0[j] + sc1 * o1[j];
            xv[0] = __uint_as_float(xr_.x << 16); xv[1] = __uint_as_float(xr_.x & 0xffff0000u); xv[2] = __uint_as_float(xr_.y << 16); xv[3] = __uint_as_float(xr_.y & 0xffff0000u);
            u32x2 w; w.x = cvtpk_(yv[0] + dsk * xv[0], yv[1] + dsk * xv[1]); w.y = cvtpk_(yv[2] + dsk * xv[2], yv[3] + dsk * xv[3]);
            *(u32x2*)(P + r * PLD + YSSD_OFF + hp) = w; } }
#undef SSD_LOADH2
}
__device__ __forceinline__ void ssd_y_chunk(const Prm& p, int L, LAS unsigned char* lds, int c, int tid) {
#pragma clang loop unroll(disable)
    for (int g_ = 0; g_ < 2; ++g_) { int g = g_, t2 = tid; asm volatile("" : "+s"(g), "+v"(t2)); ssd_y_unit(p, L, lds, c, g, t2); }
    const int lane = tid & 63, wave = __builtin_amdgcn_readfirstlane(tid >> 6), quad = lane >> 4, l15 = lane & 15; const int r = c * 128 + 16 * wave + l15;
    const act_t* P = WSP(act_t, WS_P); act_t* ym = WSP(act_t, WS_YMIX); const float* ng = p.in[I_SNG] + L * 256; float ss = 0.f;
    u32x2 zq[4][4], yq[4][4];
#pragma unroll
    for (int h = 0; h < 4; ++h)
#pragma unroll
        for (int j = 0; j < 4; ++j) { const int hp = h * 64 + 16 * j + 4 * quad; zq[h][j] = *(const u32x2*)(P + r * PLD + Z_OFF + hp); if (h < 2) yq[h][j] = *(const u32x2*)(P + r * PLD + YSSD_OFF + hp); }
    asm volatile("s_waitcnt vmcnt(0)" ::: "memory");
#pragma unroll
    for (int h = 2; h < 4; ++h)
#pragma unroll
        for (int j = 0; j < 4; ++j) yq[h][j] = *(const u32x2*)(P + r * PLD + YSSD_OFF + h * 64 + 16 * j + 4 * quad);
#pragma unroll
    for (int h = 0; h < 4; ++h)
#pragma unroll
        for (int j = 0; j < 4; ++j) { const u32x2 zr = zq[h][j], yr = yq[h][j]; float z[4], y[4];
            z[0] = __uint_as_float(zr.x << 16); z[1] = __uint_as_float(zr.x & 0xffff0000u); z[2] = __uint_as_float(zr.y << 16); z[3] = __uint_as_float(zr.y & 0xffff0000u);
            y[0] = __uint_as_float(yr.x << 16); y[1] = __uint_as_float(yr.x & 0xffff0000u); y[2] = __uint_as_float(yr.y << 16); y[3] = __uint_as_float(yr.y & 0xffff0000u);
#pragma unroll
            for (int e = 0; e < 4; ++e) { const float v = y[e] * z[e] * __builtin_amdgcn_rcpf(1.f + __expf(-z[e])); ss += v * v; } }
    ss += __shfl_xor(ss, 16); ss += __shfl_xor(ss, 32);
    const float rn = 1.0f / sqrtf(ss * (1.f / 256.f) + NORM_EPS);
#pragma unroll
    for (int h = 0; h < 4; ++h)
#pragma unroll
        for (int j = 0; j < 4; ++j) { const int hp = h * 64 + 16 * j + 4 * quad; const f32x4 g4 = *(const f32x4*)(ng + hp); const u32x2 zr = zq[h][j], yr = yq[h][j]; float z[4], y[4], o[4];
            z[0] = __uint_as_float(zr.x << 16); z[1] = __uint_as_float(zr.x & 0xffff0000u); z[2] = __uint_as_float(zr.y << 16); z[3] = __uint_as_float(zr.y & 0xffff0000u);
            y[0] = __uint_as_float(yr.x << 16); y[1] = __uint_as_float(yr.x & 0xffff0000u); y[2] = __uint_as_float(yr.y << 16); y[3] = __uint_as_float(yr.y & 0xffff0000u);
#pragma unroll
            for (int e = 0; e < 4; ++e) o[e] = y[e] * z[e] * __builtin_amdgcn_rcpf(1.f + __expf(-z[e])) * rn * g4[e];
            u32x2 w; w.x = pk2(o[0], o[1]); w.y = pk2(o[2], o[3]); *(u32x2*)(ym + r * D_MIX + hp) = w; }
}
#undef SSD_MFMA
}
__device__ __forceinline__ void st_ssd_states_m(const Prm& p, LAS unsigned char* lds) {
    const int t = TID_(); const int G = GDIM_(), bx = BIDX_();
    const int nps = G >= 160 ? G - 16 * (S5R / 256) : G;
    if (bx < nps) for (int u = bx; u < NCH * 2; u += nps) ssdm::ssd_states_unit(p, lds, u >> 1, u & 1, TID_());
}
__device__ __forceinline__ void st_ssd_y_m(const Prm& p, int L, int nrows, LAS unsigned char* lds) {
    const int t = TID_(); const int G = GDIM_(), bx = BIDX_();
    (void)t; for (int u = bx; u < nrows / 128; u += G) ssdm::ssd_y_chunk(p, L, lds, u, TID_());
}

typedef unsigned u32x4v_t __attribute__((ext_vector_type(4)));
__device__ __forceinline__ void unpack8_(const u32x4v_t v, float* o) {
#pragma unroll
    for (int e = 0; e < 4; ++e) { o[2 * e] = __uint_as_float(v[e] << 16); o[2 * e + 1] = __uint_as_float(v[e] & 0xffff0000u); } }
__device__ __forceinline__ u32x4v_t pack8_(const float* o) { u32x4v_t w; w.x = pk2(o[0], o[1]); w.y = pk2(o[2], o[3]); w.z = pk2(o[4], o[5]); w.w = pk2(o[6], o[7]); return w; }
__device__ __forceinline__ void st_ssd_conv_v(const Prm& p, int L) {
    const int tid = TID_(), cg = tid % 96, rs_ = tid / 96; if (rs_ >= 5) return;
    const act_t* P = WSP(act_t, WS_P); act_t* xbc = WSP(act_t, WS_XBC); const int c = cg * 8;
    const float* cw = p.in[I_SCW] + (size_t)L * 3 * SSD_XBC; const float* cb = p.in[I_SCB] + (size_t)L * SSD_XBC;
    float w0[8], w1[8], w2[8], bb[8];
#pragma unroll
    for (int e = 0; e < 8; ++e) { w0[e] = cw[c + e]; w1[e] = cw[SSD_XBC + c + e]; w2[e] = cw[2 * SSD_XBC + c + e]; bb[e] = cb[c + e]; }
    const int stride = GDIM_() * 5;
    for (int r0 = BIDX_() * 5 + rs_; r0 < MT; r0 += 4 * stride) { u32x4v_t vm[4], vl[4], vh[4];
#pragma unroll
        for (int u = 0; u < 4; ++u) { const int r = r0 + u * stride; vm[u] = (u32x4v_t){0u, 0u, 0u, 0u}; vl[u] = vm[u]; vh[u] = vm[u];
            if (r < MT) { const int t = r < ML ? r % SEQ : (r - ML) % CTX_LEN, T = r < ML ? SEQ : CTX_LEN; const act_t* src = P + (size_t)r * PLD + XBC_OFF + c;
                vm[u] = *(const u32x4v_t*)src; if (t > 0) vl[u] = *(const u32x4v_t*)(src - PLD); if (t < T - 1) vh[u] = *(const u32x4v_t*)(src + PLD); } }
#pragma unroll
        for (int u = 0; u < 4; ++u) { const int r = r0 + u * stride; if (r < MT) { float x[8], v[8];
                unpack8_(vm[u], x);
#pragma unroll
                for (int e = 0; e < 8; ++e) v[e] = bb[e] + w1[e] * x[e];
                unpack8_(vl[u], x);
#pragma unroll
                for (int e = 0; e < 8; ++e) v[e] += w0[e] * x[e];
                unpack8_(vh[u], x);
#pragma unroll
                for (int e = 0; e < 8; ++e) v[e] += w2[e] * x[e];
#pragma unroll
                for (int e = 0; e < 8; ++e) v[e] = v[e] * __builtin_amdgcn_rcpf(1.f + __expf(-v[e]));
                pg8::st_wt((pg8::u32x4*)(xbc + (size_t)r * SSD_XBC + c), pack8_(v)); } } }
}
__device__ __forceinline__ void st_qk_prep_v(const Prm& p, int L, int g0, int gs) {
    act_t* P = WSP(act_t, WS_P); const float* rc = WSP(float, WS_ROPE); const float* rs = rc + (size_t)SEQ * 32;
    for (int i = g0; i < MT * 12; i += gs) { const int r = i / 12, s = i % 12; const bool isctx = r >= ML; const int t = r % SEQ;
        int off; const float* gn = nullptr; float scale = 1.f;
        if (s < 4) { off = GAQ + s * 64; gn = p.in[I_GAQN] + L * 64; scale = QSCALE; }
        else if (s < 6) { off = GAK + (s - 4) * 64; gn = p.in[I_GAKN] + L * 64; }
        else if (s < 10) { off = WAQ + (s - 6) * 64; scale = QSCALE; }
        else { off = WAK + (s - 10) * 64; if (isctx) continue; }
        act_t* v = P + (size_t)r * PLD + off; float x[64];
#pragma unroll
        for (int c = 0; c < 8; ++c) unpack8_(*(const u32x4v_t*)(v + 8 * c), x + 8 * c);
        float rn = scale;
        if (gn) { float ssq = 0.f;
#pragma unroll
            for (int e = 0; e < 64; ++e) ssq += x[e] * x[e];
            rn = scale / sqrtf(ssq * (1.f / 64.f) + NORM_EPS);
#pragma unroll
            for (int e = 0; e < 64; ++e) x[e] *= gn[e]; }
        if (!isctx) {
#pragma unroll
            for (int e4 = 0; e4 < 8; ++e4) { const f32x4_t c4 = *((const f32x4_t*)(rc + (size_t)t * 32) + e4), s4 = *((const f32x4_t*)(rs + (size_t)t * 32) + e4);
#pragma unroll
                for (int q = 0; q < 4; ++q) { const int e = 4 * e4 + q; const float x1 = x[e], x2 = x[e + 32]; x[e] = x1 * c4[q] - x2 * s4[q]; x[e + 32] = x2 * c4[q] + x1 * s4[q]; } } }
#pragma unroll
        for (int e = 0; e < 64; ++e) x[e] *= rn;
#pragma unroll
        for (int c = 0; c < 8; ++c) *(u32x4v_t*)(v + 8 * c) = pack8_(x + 8 * c); }
}

__device__ __forceinline__ void st_ffn_fixup(const Prm& p, int L, int g0, int gs) {
    const float* EG = WSP(float, WS_EG); const float* EU = WSP(float, WS_EU); act_t* ACT = WSP(act_t, WS_ACT);
    const float* cw = p.in[I_FCW] + (size_t)L * 3 * D_FF; const float* cb = p.in[I_FCB] + (size_t)L * D_FF;
    constexpr int NB = ML / 256 - 1;
    for (int i = g0; i < NB * D_FF; i += gs) { const int pm = i / D_FF, c = i % D_FF; if (((pm + 1) * 256) % SEQ == 0) continue;
        const float gA = EG[((size_t)pm * 4 + 2) * D_FF + c], gB = EG[((size_t)pm * 4 + 3) * D_FF + c], gC = EG[((size_t)(pm + 1) * 4 + 0) * D_FF + c], gD = EG[((size_t)(pm + 1) * 4 + 1) * D_FF + c];
        const float uB = EU[((size_t)pm * 2 + 1) * D_FF + c], uC = EU[((size_t)(pm + 1) * 2) * D_FF + c];
        const float w0 = cw[c], w1 = cw[D_FF + c], w2 = cw[2 * D_FF + c], b = cb[c];
        const float x0 = b + w0 * gA + w1 * gB + w2 * gC, x1 = b + w0 * gB + w1 * gC + w2 * gD;
        const size_t R = (size_t)(pm + 1) * 256 - 1;
        stf(ACT + R * D_FF + c, x0 / (1.f + __expf(-x0)) * uB); stf(ACT + (R + 1) * D_FF + c, x1 / (1.f + __expf(-x1)) * uC); }
}

__device__ __forceinline__ void sub_barrier(unsigned* cnt, unsigned np, bool arrive) {
    asm volatile("s_waitcnt vmcnt(0)" ::: "memory");
    __syncthreads();
    if (TID_() == 0) {
        if (arrive) { __builtin_amdgcn_fence(__ATOMIC_RELEASE, "agent"); asm volatile("s_waitcnt vmcnt(0)" ::: "memory");
            (void)__hip_atomic_fetch_add(cnt, 1u, __ATOMIC_RELAXED, __HIP_MEMORY_SCOPE_AGENT); }
        unsigned sp = 0; while (__hip_atomic_load(cnt, __ATOMIC_RELAXED, __HIP_MEMORY_SCOPE_AGENT) < np) { __builtin_amdgcn_s_sleep(2); if (++sp > (1u << 22)) break; }
        __builtin_amdgcn_fence(__ATOMIC_ACQUIRE, "agent"); asm volatile("s_waitcnt vmcnt(0)" ::: "memory");
    }
    __syncthreads();
}
#endif

HD void run_step(const Prm& p, int st, int L, int g0_, int gs_) {
#ifdef CPU_TEST
    const int g0 = g0_, gs = gs_;
#else
    extern __shared__ __attribute__((aligned(16))) unsigned char lds_dyn_[];
    LAS unsigned char* const ldsb = (LAS unsigned char*)lds_dyn_;
    const int tidl_ = TID_();
    const int g0 = BIDX_() * NTHREADS_ + tidl_, gs = GDIM_() * NTHREADS_;
#endif
    const int nrows = (L < DEPTH - 1) ? MT : ML;
#ifndef CPU_TEST
    using namespace pg8;
    const float* modL = (const float*)(p.ws + WS_MOD) + (size_t)L * (BATCH + 1) * 6 * D_MODEL;
    const int G = GDIM_(), bid = BIDX_();
#endif
    switch (st) {
#ifdef CPU_TEST
    case S_MOD: st_mod(p, g0, gs); break;
#else
    case S_MOD: st_mod_atomic(p, ldsb); break;
#endif
#ifdef CPU_TEST
    case S_INIT: st_init(p, g0, gs); break;
#else
    case S_INIT: st_rope_tab(p, g0, gs); { float* xc = WSP(float, WS_XC); for (int i = g0; i < MC * D_MODEL; i += gs) xc[i] = p.in[I_CTX][i]; } break;
#endif
    case S_TAB1: st_s5tab1(p, g0, gs); break;
#ifdef CPU_TEST
    case S_TAB2: st_s5tab2(p, g0, gs); break;
#else
    case S_TAB2: st_s5tab2_lds(p, ldsb); break;
#endif
#ifdef CPU_TEST
    case S_ROWSS: st_rowss(p, MT, g0, gs); break;
    case S_NORM_MIX: st_normmod(p, L, 0, MT, g0, gs); break;
    case S_NORM_FFN: st_normmod(p, L, 1, nrows, g0, gs); break;
    case S_ROWSS_FIN: st_rowss(p, ML, g0, gs); break;
    case S_FINAL: st_final(p, g0, gs); break;
    case S_CS: st_ssd_cs(p, L, g0, gs); break;
    case S_SSD_CARRY: st_ssd_carry(p, g0, gs); break;
    case S_S5_CARRY: st_s5_carry(p, L, g0, gs); break;
    case S_SSD_OUT: st_ssd_out(p, L, nrows, g0, gs); break;
#else
    case S_NORM_MIX: st_norm_fused(p, L, 0, MT, L > 0 ? modp(p, L - 1, BATCH, 5) : nullptr); break;
    case S_NORM_FFN: st_norm_fused(p, L, 1, nrows, nrows > ML ? modp(p, L, BATCH, 2) : nullptr); break;
    case S_FINAL: st_final_fused(p); break;
    case S_CS: st_ssd_cs_w(p, L); break;
    case S_SSD_CARRY: st_ssd_carry_b(p, g0, gs); break;
    case S_S5_CARRY: st_s5_carry_b(p, L, ldsb); break;
    case S_SSD_OUT: st_ssd_out_w(p, L, nrows); break;
#endif
#ifdef CPU_TEST
    case S_TABB: st_s5tabB(p, L, g0, gs); break;
#else
    case S_TABB: { const int nfull = (MT / 256) * (NIN / 256) - 2 * GDIM_();
        const int b_ = BIDX_(), G_ = GDIM_(); if (nfull > 0 && nfull < G_) { if (b_ >= nfull) st_s5tabB_v(p, L, (b_ - nfull) * NTHREADS_ + TID_(), (G_ - nfull) * NTHREADS_); } else st_s5tabB_v(p, L, g0, gs); } break;
#endif
#ifdef CPU_TEST
    case S_ATTN: st_attn(p, L, nrows, g0, gs); break;
#else
    case S_ATTN: st_attn_mfma(p, L, 0, (char*)lds_dyn_); break;
    case S_ATTNC: if (L < DEPTH - 1) st_attn_mfma(p, L, 1, (char*)lds_dyn_); break;
#endif
#ifdef CPU_TEST
    case S_WPREP: case S_WPREP2: case S_ATTNC: break;
    case S_CONV: st_ssd_conv(p, L, g0, gs); break;
    case S_QK: st_qk_prep(p, L, g0, gs); break;
    case S_STATE: st_ssd_state(p, g0, gs); break;
    case S_CB: st_ssd_cb(p, g0, gs); break;
    case S_SSD_Y: st_ssd_y(p, L, nrows, g0, gs); break;
    case S_S5E: st_s5_E_naive(p, g0, gs); break;
    case S_S5_Y: st_s5_Y_naive(p, nrows, g0, gs); break;
    case S_GEMM_IN: { EpiStoreIn e{&p}; naive_gemm(WSP(act_t, WS_XN), D_MODEL, p.in[I_WIN] + (size_t)L * D_MODEL * D_IN, D_IN, MT, D_IN, D_MODEL, e, g0, gs); } break;
    case S_GLU: st_glu(p, L, nrows, g0, gs); break;
    case S_GEMM_OUT: { EpiResid e{&p, L, 2}; naive_gemm(WSP(act_t, WS_YMIX), D_MIX, p.in[I_WOUT] + (size_t)L * D_MIX * D_MODEL, D_MODEL, nrows, D_MODEL, D_MIX, e, g0, gs); } break;
    case S_GEMM_GATE: { EpiStore e{WSP(act_t, WS_GT), D_FF}; naive_gemm(WSP(act_t, WS_XN), D_MODEL, p.in[I_WGATE] + (size_t)L * D_MODEL * D_FF, D_FF, nrows, D_FF, D_MODEL, e, g0, gs); } break;
    case S_GEMM_UP: { EpiUp e{&p, L}; naive_gemm(WSP(act_t, WS_XN), D_MODEL, p.in[I_WUP] + (size_t)L * D_MODEL * D_FF, D_FF, nrows, D_FF, D_MODEL, e, g0, gs); } break;
    case S_GEMM_DOWN: { EpiResid e{&p, L, 5}; naive_gemm(WSP(act_t, WS_ACT), D_FF, p.in[I_WDOWN] + (size_t)L * D_FF * D_MODEL, D_MODEL, nrows, D_MODEL, D_FF, e, g0, gs); } break;
#else
    case S_WPREP: st_wprep(p, L, ldsb, g0, gs, 0); break;
    case S_WPREP2: st_wprep(p, L, ldsb, g0, gs, 1); break;
    case S_CONV: st_ssd_conv_v(p, L); break;
    case S_QK: st_qk_prep_v(p, L, g0, gs); break;
    case S_STATE: st_ssd_states_m(p, ldsb); break;
    case S_SSD_Y: st_ssd_y_m(p, L, nrows, ldsb); break;
    case S_GEMM_IN: { Gemm g{WSP(act_t, WS_XN), WSP(act_t, WS_WIN), MT, NIN, D_MODEL, D_MODEL}; StaticOrder S; S.init(MT, NIN, G, bid);
        EpiInProj E{WSP(act_t, WS_P), WSP(act_t, WS_S5A), WSP(float, WS_DTRAW)}; gemm_phase<EpiInProj, StaticOrder, true, true>(ldsb, g, S, E); } break;
    case S_S5E: { int k5 = 256; asm volatile("" : "+s"(k5)); Gemm g{WSP(act_t, WS_S5A), WSP(act_t, WS_S5BE), 16 * S5R, 16 * 256, k5, 512}; BatchedOrder S; S.init(G, bid);
        EpiS5E E{WSP(float, WS_S5E)}; gemm_phase<EpiS5E, BatchedOrder, true, true>(ldsb, g, S, E); } break;
    case S_S5_Y: { Gemm g{WSP(act_t, WS_S5A), WSP(act_t, WS_S5BY), 16 * S5R, 16 * 256, 512, 512}; BatchedOrder S; S.init(G, bid);
        EpiS5Y E{WSP(act_t, WS_P), nrows / 16}; gemm_phase<EpiS5Y, BatchedOrder, true, true>(ldsb, g, S, E); } break;
    case S_SUBGLU: { constexpr int NP = 16 * (S5R / 256); const int nssd = nrows / 128, pi = bid - nssd; if (pi >= 0 && G - nssd >= NP) {
            sub_barrier((unsigned*)(p.ws + WS_CTL) + 1024 + 64 * L, NP, bid >= G - NP);
            int kglu = 256; asm volatile("" : "+s"(kglu)); Gemm g{WSP(act_t, WS_P) + YS5_OFF, WSP(act_t, WS_WGLU), nrows, 512, kglu, PLD}; StaticOrder S; S.init(nrows, 512, G - nssd, pi);
            EpiGluM E{WSP(act_t, WS_YMIX), p.in[I_BGLU] + L * 512}; gemm_phase<EpiGluM, StaticOrder, true, true>(ldsb, g, S, E); } } break;
    case S_GLU: { int kglu = 256; asm volatile("" : "+s"(kglu)); Gemm g{WSP(act_t, WS_P) + YS5_OFF, WSP(act_t, WS_WGLU), nrows, 512, kglu, PLD}; StaticOrder S; S.init(nrows, 512, G, bid);
        EpiGluM E{WSP(act_t, WS_YMIX), p.in[I_BGLU] + L * 512}; gemm_phase<EpiGluM, StaticOrder, true, true>(ldsb, g, S, E); } break;
    case S_GEMM_OUT: { Gemm g{WSP(act_t, WS_YMIX), WSP(act_t, WS_WOUT), nrows, D_MODEL, D_MIX, D_MIX};
        EpiResidM E{p.out, WSP(float, WS_XC), L == 0 ? p.in[I_X] : p.out, WSP(float, WS_XC), modL, 2, WSP(float, WS_SLAB), D_MIX / 64};
        if (nrows > ML) { TailSplitOrder S; S.init(D_MIX, G, bid); gemm_phase<EpiResidM, TailSplitOrder, true, true>(ldsb, g, S, E); }
        else { StaticOrder S; S.init(nrows, D_MODEL, G, bid); gemm_phase<EpiResidM, StaticOrder, true, true>(ldsb, g, S, E); } } break;
    case S_GEMM_GU: { Gemm g{WSP(act_t, WS_XN), WSP(act_t, WS_WG), nrows, 2 * D_FF, D_MODEL, D_MODEL}; StaticOrder S; S.init(nrows, 2 * D_FF, G, bid);
        EpiGateUpM E{WSP(act_t, WS_ACT), p.in[I_FCW] + (size_t)L * 3 * D_FF, p.in[I_FCB] + (size_t)L * D_FF, WSP(float, WS_EG), WSP(float, WS_EU)}; gemm_phase<EpiGateUpM, StaticOrder, true, true>(ldsb, g, S, E); } break;
    case S_FIXUP: st_ffn_fixup(p, L, g0, gs); break;
    case S_GEMM_GATE: { Gemm g{WSP(act_t, WS_XN), WSP(act_t, WS_WG), nrows, D_FF, D_MODEL, D_MODEL}; StaticOrder S; S.init(nrows, D_FF, G, bid);
        EpiBf16<0> E{WSP(act_t, WS_GT), D_FF, nullptr, 0, 0, 1.f}; gemm_phase<EpiBf16<0>, StaticOrder, true, true>(ldsb, g, S, E); } break;
    case S_GEMM_UP: { Gemm g{WSP(act_t, WS_XN), WSP(act_t, WS_WU), nrows, D_FF, D_MODEL, D_MODEL}; StaticOrder S; S.init(nrows, D_FF, G, bid);
        EpiUpM E{WSP(act_t, WS_GT), WSP(act_t, WS_ACT), p.in[I_FCW] + (size_t)L * 3 * D_FF, p.in[I_FCB] + (size_t)L * D_FF}; gemm_phase<EpiUpM, StaticOrder, true, true>(ldsb, g, S, E); } break;
    case S_GEMM_DOWN: { Gemm g{WSP(act_t, WS_ACT), WSP(act_t, WS_WD), nrows, D_MODEL, D_FF, D_FF};
        EpiResidM E{p.out, WSP(float, WS_XC), p.out, WSP(float, WS_XC), modL, 5, WSP(float, WS_SLAB), D_FF / 64};
        if (nrows > ML) { TailSplitOrder S; S.init(D_FF, G, bid); gemm_phase<EpiResidM, TailSplitOrder, true, true>(ldsb, g, S, E); }
        else { StaticOrder S; S.init(nrows, D_MODEL, G, bid); gemm_phase<EpiResidM, StaticOrder, true, true>(ldsb, g, S, E); } } break;
#endif
    default: break;
    }
}

#ifndef CPU_TEST
#define XB_TMO      128
#define XB_XCNT(j)  (256  + 64 * (j))
#define XB_XSUB(j)  (1280 + 64 * (j))
#define XB_XGEN(j)  (2304 + 64 * (j))
#define XB_TOP      3328
#define XB_TOPGEN   3392
#define XCD_BAR_WORDS 3456
#define XB_SPIN_CAP (1u << 22)
__device__ __forceinline__ unsigned xb_ld(unsigned* p)              { return __hip_atomic_load(p, __ATOMIC_RELAXED, __HIP_MEMORY_SCOPE_AGENT); }
__device__ __forceinline__ unsigned xb_add(unsigned* p, unsigned v) { return __hip_atomic_fetch_add(p, v, __ATOMIC_RELAXED, __HIP_MEMORY_SCOPE_AGENT); }
__device__ __forceinline__ unsigned xb_xcc_id() { return (unsigned)__builtin_amdgcn_s_getreg((3 << 11) | 20) & 0xFu; }
#define XB_SPIN(cond, bar) do { unsigned _sp = 0; while (cond) { __builtin_amdgcn_s_sleep(1); \
    if ((++_sp & 255u) == 0u) { if (xb_ld(&(bar)[XB_TMO])) break; if (_sp > XB_SPIN_CAP) { atomicAdd(&(bar)[XB_TMO], 1u); break; } } } } while (0)
struct XcdBarrier { unsigned* bar; unsigned x; volatile LAS unsigned* st; };
__device__ __forceinline__ XcdBarrier xcd_barrier_post(unsigned* bar, volatile LAS unsigned* st) {
    XcdBarrier b; b.bar = bar; b.x = xb_xcc_id(); b.st = st;
    if (TID_() == 0) (void)xb_add(&bar[XB_XCNT(b.x)], 1u);
    return b;
}
__device__ __forceinline__ void xcd_barrier_complete(unsigned* bar, unsigned x, unsigned& nloc, unsigned& nx) {
    const unsigned G = gridDim.x * gridDim.y * gridDim.z;
    unsigned sum, cnt, mine, sp = 0u;
    for (;;) {
        sum = 0u; cnt = 0u; mine = 0u;
#pragma unroll
        for (unsigned j = 0; j < 16; ++j) { const unsigned c = xb_ld(&bar[XB_XCNT(j)]); sum += c; cnt += (c > 0u) ? 1u : 0u; mine = (j == x) ? c : mine; }
        if (sum == G) break;
        __builtin_amdgcn_s_sleep(1);
        if ((++sp & 255u) == 0u) { if (xb_ld(&bar[XB_TMO])) break; if (sp > XB_SPIN_CAP) { atomicAdd(&bar[XB_TMO], 1u); break; } }
    }
    nloc = mine > 0u ? mine : 1u; nx = cnt > 0u ? cnt : 1u;
}
__device__ __forceinline__ void xcd_barrier(const XcdBarrier& b) {
    asm volatile("s_waitcnt vmcnt(0)" ::: "memory");
    __syncthreads();
    if (TID_() == 0) {
        unsigned* bar = b.bar;
        __builtin_amdgcn_s_waitcnt(0);
        unsigned nloc = b.st[0], nx = b.st[1];
        if (nloc == 0u) { xcd_barrier_complete(bar, b.x, nloc, nx); b.st[0] = nloc; b.st[1] = nx; }
        const unsigned old = xb_add(&bar[XB_XSUB(b.x)], 1u);
        const unsigned gen = old / nloc;
        if (old + 1u == (gen + 1u) * nloc) {
            __builtin_amdgcn_fence(__ATOMIC_RELEASE, "agent");
            asm volatile("s_waitcnt vmcnt(0)" ::: "memory");
            const unsigned og = xb_add(&bar[XB_TOP], 1u);
            const unsigned tg = og / nx;
            if (og + 1u == (tg + 1u) * nx) xb_add(&bar[XB_TOPGEN], 1u);
            else XB_SPIN(xb_ld(&bar[XB_TOPGEN]) == tg, bar);
            __builtin_amdgcn_fence(__ATOMIC_ACQUIRE, "agent");
            xb_add(&bar[XB_XGEN(b.x)], 1u);
            asm volatile("s_waitcnt vmcnt(0)" ::: "memory");
        } else {
            XB_SPIN(xb_ld(&bar[XB_XGEN(b.x)]) == gen, bar);
            __builtin_amdgcn_fence(__ATOMIC_ACQUIRE, "agent");
            asm volatile("s_waitcnt vmcnt(0)" ::: "memory");
        }
    }
    __syncthreads();
}

constexpr int LDS_BYTES = 147456;
constexpr int MISC_OFF = MISC_OFF_;
constexpr int CW_BAR = 4096;
__global__ void __launch_bounds__(NTHREADS_, 2) mk_fwd(Prm p) {
    extern __shared__ __attribute__((aligned(16))) unsigned char lds[];
    { volatile LAS unsigned* MISC = (volatile LAS unsigned*)((LAS unsigned char*)lds + MISC_OFF);
      for (int u = threadIdx.x; u < (LDS_BYTES - MISC_OFF) / 4; u += NTHREADS_) MISC[u] = 0u;
      __syncthreads();
      if ((threadIdx.x & 63) == 0) MISC[WTAB_ + HWSLOT_()] = threadIdx.x >> 6;
      __syncthreads();
      const XcdBarrier b0 = xcd_barrier_post((unsigned*)(p.ws + WS_CTL) + CW_BAR, MISC + 8);
      if (TID_() == 0) MISC[10] = b0.x;
      __syncthreads(); }
#define KARG() const __attribute__((address_space(4))) Prm* pp_ = (const __attribute__((address_space(4))) Prm*)__builtin_amdgcn_kernarg_segment_ptr(); asm volatile("" : "+s"(pp_))
#define RUN(st, L) do { KARG(); run_step(*(const Prm*)pp_, st, L, 0, 0); __syncthreads(); } while (0)
#define SYNC() do { asm volatile("s_waitcnt vmcnt(0)" ::: "memory");     \
        KARG(); volatile LAS unsigned* MISC = (volatile LAS unsigned*)((LAS unsigned char*)lds + MISC_OFF); XcdBarrier b_; b_.bar = (unsigned*)(((const Prm*)pp_)->ws + WS_CTL) + CW_BAR; b_.x = MISC[10]; b_.st = MISC + 8; xcd_barrier(b_); } while (0)
    RUN(S_MOD, 0); RUN(S_INIT, 0); RUN(S_TAB1, 0); RUN(S_WPREP, 0); SYNC();
#define LAYER(L) do { \
        if (L > 0) RUN(S_WPREP, L); else RUN(S_TAB2, 0); \
        RUN(S_NORM_MIX, L); SYNC(); RUN(S_GEMM_IN, L); RUN(S_TABB, L); SYNC(); \
        RUN(S_CONV, L); RUN(S_CS, L); RUN(S_QK, L); SYNC(); \
        RUN(S_STATE, L); RUN(S_S5E, L); RUN(S_ATTN, L); SYNC(); \
        RUN(S_SSD_CARRY, L); RUN(S_S5_CARRY, L); RUN(S_WPREP2, L); SYNC(); \
        RUN(S_SSD_Y, L); RUN(S_S5_Y, L); RUN(S_ATTNC, L); RUN(S_SUBGLU, L); SYNC(); \
        RUN(S_GEMM_OUT, L); SYNC(); RUN(S_NORM_FFN, L); SYNC(); \
        RUN(S_GEMM_GU, L); SYNC(); RUN(S_FIXUP, L); SYNC(); RUN(S_GEMM_DOWN, L); SYNC(); } while (0)
    LAYER(0); LAYER(1);
    static_assert(DEPTH == 2, "layer program written out for two layers");
#undef LAYER
    RUN(S_FINAL, 0);
#undef RUN
#undef SYNC
#undef KARG
}
extern "C" void kernel_launch(void* const* d_in, const int* in_sizes, int n_in, void* d_out, int out_size, void* d_ws, size_t ws_size, hipStream_t stream) {
    if (n_in != 35 || out_size != ML * D_MODEL || ws_size < WS_TOTAL) { fprintf(stderr, "kernel_launch: unexpected shapes (n_in %d out %d ws %zu need %zu)\n", n_in, out_size, ws_size, (size_t)WS_TOTAL); return; }
    Prm p{};
    for (int i = 0; i < 35; ++i) p.in[i] = (const float*)d_in[i];
    p.out = (float*)d_out; p.ws = (unsigned char*)d_ws;
    static int grid = 0;
    if (grid == 0) {
        int dev = 0, cus = 0;
        if (hipGetDevice(&dev) != hipSuccess || hipDeviceGetAttribute(&cus, hipDeviceAttributeMultiprocessorCount, dev) != hipSuccess) { fprintf(stderr, "kernel_launch: device query failed\n"); grid = -1; return; }
        if (hipFuncSetAttribute((const void*)mk_fwd, hipFuncAttributeMaxDynamicSharedMemorySize, LDS_BYTES) != hipSuccess) { fprintf(stderr, "kernel_launch: hipFuncSetAttribute failed\n"); grid = -1; return; }
        int per_cu = 0;
        if (hipOccupancyMaxActiveBlocksPerMultiprocessor(&per_cu, (const void*)mk_fwd, NTHREADS_, LDS_BYTES) != hipSuccess || per_cu < 1) fprintf(stderr, "kernel_launch: note: occupancy query reports %d blocks per CU\n", per_cu);
        (void)hipGetLastError();
        grid = cus;
    }
    if (grid < 0) return;
    if (hipMemsetAsync((char*)d_ws + WS_CTL, 0, CTL_BYTES, stream) != hipSuccess) { fprintf(stderr, "kernel_launch: memset failed\n"); return; }
    hipLaunchKernelGGL(mk_fwd, dim3(grid), dim3(NTHREADS_), LDS_BYTES, stream, p);
}
#endif
```

```cpp
#ifndef CPU_TEST
#include <hip/hip_runtime.h>
#include <cstdio>
#include <cstdint>
#define HD __device__ __forceinline__
#define HDM __device__ __forceinline__
#else
#include <cmath>
#include <cstdio>
#include <cstdint>
#include <cstring>
#define HD static inline
#define HDM inline
#endif

#ifndef D_MODEL
#define D_MODEL 1024
#endif
#ifndef SEQ
#define SEQ 8192
#endif
#ifndef CTX_LEN
#define CTX_LEN 256
#endif
#ifndef D_FF
#define D_FF 2816
#endif
#define BATCH 2
#define DEPTH 2
#define GRID_W 64
#define HEAD_DIM 64
#define NORM_EPS 1e-6f
#define D_SSD 256
#define SSD_XBC 768
#define D_S5 256
#define D_MIX 1024
#define D_IN 2312
constexpr int NTHREADS_ = 512;
constexpr int ML = BATCH * SEQ, MC = BATCH * CTX_LEN, MT = ML + MC;
constexpr int NCH = MT / 128;
constexpr int NSC = MT / 16;
constexpr int PLD = 2048;
constexpr int NIN = 2560;
constexpr int S5R = 1280;
constexpr int Z_OFF = 0, XBC_OFF = 256, GAQ = 1024, GAK = 1280, GAV = 1408, WAQ = 1536, WAK = 1792, WAV = 1920;
constexpr int YSSD_OFF = 256, YS5_OFF = 512;

#ifdef CPU_TEST
typedef float act_t;
HD float ldf(const act_t* p) { return *p; }
HD void stf(act_t* p, float v) { *p = v; }
#else
typedef unsigned short act_t;
HD float ldf(const act_t* p) { return __uint_as_float(((unsigned)*p) << 16); }
HD void stf(act_t* p, float v) { unsigned u = __float_as_uint(v); u = (u + 0x7fffu + ((u >> 16) & 1u)) >> 16; *p = (act_t)u; }
#endif

constexpr size_t al256(size_t x) { return (x + 255) & ~(size_t)255; }
constexpr size_t WS_CTL = 0, CTL_BYTES = 1u << 20;
constexpr size_t WS_MOD = WS_CTL + 65536;
static_assert(65536 + (size_t)DEPTH * (BATCH + 1) * 6 * D_MODEL * 4 <= CTL_BYTES, "mod table inside the zeroed region");
constexpr size_t WS_ROPE = WS_CTL + CTL_BYTES;
constexpr size_t WS_LAMP = WS_ROPE + al256((size_t)SEQ * 64 * 4);
constexpr size_t WS_BBAR = WS_LAMP + al256((size_t)DEPTH * 2 * 16 * 64 * 17 * 2 * 4);
constexpr size_t WS_KT = WS_BBAR + al256((size_t)DEPTH * 2 * 16 * 64 * 16 * 2 * 4);
constexpr size_t WS_XC = WS_KT + al256((size_t)DEPTH * 2 * 16 * 16 * 256 * 4);
constexpr size_t WS_SS = WS_XC + al256((size_t)MC * D_MODEL * 4);
constexpr size_t WS_DT = WS_SS + al256((size_t)MT * 4);
constexpr size_t WS_CS = WS_DT + al256((size_t)MT * 8 * 4);
constexpr size_t WS_DTRAW = WS_CS + al256((size_t)MT * 8 * 4);
constexpr size_t WS_S5BY = WS_DTRAW + al256((size_t)MT * 8 * 4);
constexpr size_t WS_S5BE = WS_S5BY + al256((size_t)16 * 256 * 512 * sizeof(act_t));
constexpr size_t WS_ARENA = WS_S5BE + al256((size_t)16 * 256 * 256 * sizeof(act_t));
constexpr size_t WS_XN = WS_ARENA;
constexpr size_t WS_YMIX = WS_XN;
constexpr size_t WS_P = WS_XN + al256((size_t)MT * (D_MODEL > D_MIX ? D_MODEL : D_MIX) * sizeof(act_t));
constexpr size_t WS_XBC = WS_P + al256((size_t)MT * PLD * sizeof(act_t));
constexpr size_t WS_SST = WS_XBC + al256((size_t)MT * 768 * sizeof(act_t));
constexpr size_t WS_CB = WS_SST + al256((size_t)NCH * 2 * 4 * 64 * 128 * 4);
constexpr size_t WS_SLAB = WS_CB;
constexpr size_t WS_S5E = WS_CB + al256((size_t)NCH * 2 * 128 * 128 * 4);
constexpr size_t WS_S5A = WS_S5E + al256((size_t)16 * NSC * 256 * 4);
constexpr size_t WS_MIX_END = WS_S5A + al256((size_t)16 * S5R * 512 * sizeof(act_t));
constexpr size_t WS_GT = WS_P;
constexpr size_t WS_EG = WS_GT;
constexpr size_t WS_EU = WS_EG + al256((size_t)(MT / 256) * 4 * D_FF * 4);
constexpr size_t WS_ACT = WS_GT + al256((size_t)MT * D_FF * sizeof(act_t));
constexpr size_t WS_FFN_END = WS_ACT + al256((size_t)MT * D_FF * sizeof(act_t));
constexpr size_t WS_END = WS_MIX_END > WS_FFN_END ? WS_MIX_END : WS_FFN_END;
constexpr size_t WS_WIN = WS_END;
constexpr size_t WS_WOUT = WS_WIN + al256((size_t)NIN * D_MODEL * 2);
constexpr size_t WS_WG = WS_WOUT + al256((size_t)D_MODEL * D_MIX * 2);
constexpr size_t WS_WU = WS_WG + al256((size_t)D_FF * D_MODEL * 2);
constexpr size_t WS_WD = WS_WU + al256((size_t)D_FF * D_MODEL * 2);
constexpr size_t WS_WGLU = WS_WD + al256((size_t)D_MODEL * D_FF * 2);
constexpr size_t WS_TOTAL = WS_WGLU + al256((size_t)512 * 256 * 2);
#ifndef CPU_TEST
static_assert(WS_TOTAL <= ((size_t)256 << 20), "workspace map exceeds 256 MiB");
static_assert(WS_WU == WS_WG + (size_t)D_FF * D_MODEL * 2, "gate | up weight copies are one contiguous [2*D_FF][D] matrix");
#endif

struct Prm { const float* in[35]; float* out; unsigned char* ws; };
enum { I_X = 0, I_C, I_CTX, I_CCTX, I_WMOD, I_BMOD, I_GMIX, I_WIN, I_SCW, I_SCB, I_SALOG, I_SDTB, I_SD, I_SNG, I_GAQN, I_GAKN, I_SINK,
       I_LRE, I_LIM, I_LSTEP, I_BRE, I_BIM, I_CRE, I_CIM, I_S5D, I_WGLU, I_BGLU, I_WOUT, I_GFFN, I_WGATE, I_WUP, I_FCW, I_FCB, I_WDOWN, I_GFIN };

HD float sigmoidf_(float x) { return 1.f / (1.f + expf(-x)); }
HD float siluf_(float x) { return x * sigmoidf_(x); }
HD float softplusf_(float x) { return x > 20.f ? x : log1pf(expf(x)); }
HD float geluf_(float x) { return 0.5f * x * (1.f + tanhf(0.7978845608028654f * (x + 0.044715f * x * x * x))); }
struct RowInfo { int isctx, b, t, T, modrow; };
HD RowInfo rowinfo(int r) { RowInfo q; if (r < ML) { q.isctx = 0; q.b = r / SEQ; q.t = r % SEQ; q.T = SEQ; q.modrow = q.b; } else { const int rr = r - ML; q.isctx = 1; q.b = rr / CTX_LEN; q.t = rr % CTX_LEN; q.T = CTX_LEN; q.modrow = BATCH; } return q; }
HD float* xrow(const Prm& p, int r) { return r < ML ? p.out + (size_t)r * D_MODEL : (float*)(p.ws + WS_XC) + (size_t)(r - ML) * D_MODEL; }
HD const float* modp(const Prm& p, int layer, int modrow, int which) { return (const float*)(p.ws + WS_MOD) + ((size_t)(layer * (BATCH + 1) + modrow) * 6 + which) * D_MODEL; }
#define WSP(T, off) ((T*)(p.ws + (off)))
#ifdef CPU_TEST
#define QSCALE 0.125f
#else
#define QSCALE (0.125f * 1.4426950408889634f)
#endif

HD void st_mod(const Prm& p, int g0, int gs) {
    float* mod = WSP(float, WS_MOD);
    for (int i = g0; i < (int)(DEPTH * (BATCH + 1) * 6 * D_MODEL); i += gs) {
        const int j = (int)(i % (6 * D_MODEL)); const int m = (int)((i / (6 * D_MODEL)) % (BATCH + 1)); const int l = (int)(i / (6 * D_MODEL * (BATCH + 1)));
        const float* cv = m < BATCH ? p.in[I_C] + (size_t)m * D_MODEL : p.in[I_CCTX];
        const float* w = p.in[I_WMOD] + (size_t)l * D_MODEL * 6 * D_MODEL + j;
        float acc = 0.f;
        for (int k = 0; k < D_MODEL; ++k) acc += siluf_(cv[k]) * w[(size_t)k * 6 * D_MODEL];
        mod[i] = acc + p.in[I_BMOD][(size_t)l * 6 * D_MODEL + j];
    }
}
HD void st_init(const Prm& p, int g0, int gs) {
    for (int i = g0; i < (int)(ML * D_MODEL); i += gs) p.out[i] = p.in[I_X][i];
    float* xc = WSP(float, WS_XC);
    for (int i = g0; i < (int)(MC * D_MODEL); i += gs) xc[i] = p.in[I_CTX][i];
    float* rc = WSP(float, WS_ROPE); float* rs = rc + (size_t)SEQ * 32;
    for (int i = g0; i < (int)(SEQ * 32); i += gs) {
        const int t = (int)(i / 32), f = (int)(i % 32); const int pos = f < 16 ? t / GRID_W : t % GRID_W; const int fi = f & 15;
        const double inv = exp(-(double)fi * 0.5756462732485115); const double ang = (double)pos * inv;
        rc[i] = (float)cos(ang); rs[i] = (float)sin(ang);
    }
}
HD void st_rope_tab(const Prm& p, int g0, int gs) {
    float* rc = WSP(float, WS_ROPE); float* rs = rc + (size_t)SEQ * 32;
    for (int i = g0; i < (int)(SEQ * 32); i += gs) {
        const int t = (int)(i / 32), f = (int)(i % 32); const int pos = f < 16 ? t / GRID_W : t % GRID_W; const int fi = f & 15;
        const double inv = exp(-(double)fi * 0.5756462732485115); const double ang = (double)pos * inv;
        rc[i] = (float)cos(ang); rs[i] = (float)sin(ang);
    }
}
HD void st_s5tab1(const Prm& p, int g0, int gs) {
    float* lamp = WSP(float, WS_LAMP); float* bbar = WSP(float, WS_BBAR);
    for (int idx = g0; idx < (int)(DEPTH * 2 * 16 * 64 * 17); idx += gs) { const int i = idx / 17, tau = idx % 17, ldg = i / 64;
        const double lre = fmin((double)p.in[I_LRE][i], -1e-4), lim = (double)p.in[I_LIM][i], step = exp((double)p.in[I_LSTEP][ldg]);
        const double mag = exp(lre * step * tau), ang = lim * step * tau;
        lamp[(size_t)idx * 2 + 0] = (float)(mag * cos(ang)); lamp[(size_t)idx * 2 + 1] = (float)(mag * sin(ang)); }
    for (int i = gs - 1 - g0; i < (int)(DEPTH * 2 * 16 * 64); i += gs) { const int ldg = i / 64;
        const double lre = fmin((double)p.in[I_LRE][i], -1e-4), lim = (double)p.in[I_LIM][i], step = exp((double)p.in[I_LSTEP][ldg]);
        const double mag = exp(lre * step), ang = lim * step;
        const double nr = mag * cos(ang) - 1.0, ni = mag * sin(ang);
        const double den = lre * lre + lim * lim;
        const double fr = (nr * lre + ni * lim) / den, fi = (ni * lre - nr * lim) / den;
#pragma unroll
        for (int k = 0; k < 16; ++k) { const double br = p.in[I_BRE][i * 16 + k], bi = p.in[I_BIM][i * 16 + k];
            bbar[((size_t)i * 16 + k) * 2 + 0] = (float)(fr * br - fi * bi); bbar[((size_t)i * 16 + k) * 2 + 1] = (float)(fr * bi + fi * br); } }
}
HD void st_s5tab2(const Prm& p, int g0, int gs) {
    const float* lamp = WSP(float, WS_LAMP); const float* bbar = WSP(float, WS_BBAR); float* kt = WSP(float, WS_KT);
    for (int i = g0; i < (int)(DEPTH * 2 * 16 * 16 * 256); i += gs) {
        const int kp = (int)(i % 16), k = (int)((i / 16) % 16), tau = (int)((i / 256) % 16); const int ldg = i / 4096;
        float acc = 0.f;
        for (int n = 0; n < 64; ++n) {
            const float cr = p.in[I_CRE][(ldg * 16 + k) * 64 + n], ci = p.in[I_CIM][(ldg * 16 + k) * 64 + n];
            const float lr = lamp[((ldg * 64 + n) * 17 + tau) * 2], li = lamp[((ldg * 64 + n) * 17 + tau) * 2 + 1];
            const float br = bbar[((ldg * 64 + n) * 16 + kp) * 2], bi = bbar[((ldg * 64 + n) * 16 + kp) * 2 + 1];
            const float tr = lr * br - li * bi, ti = lr * bi + li * br;
            acc += cr * tr - ci * ti;
        }
        kt[i] = acc;
    }
}

HD void st_rowss(const Prm& p, int nrows, int g0, int gs) {
    float* ss = WSP(float, WS_SS);
    for (int r = g0; r < nrows; r += gs) { const float* x = xrow(p, (int)r); float s = 0.f; for (int k = 0; k < D_MODEL; ++k) s += x[k] * x[k]; ss[r] = s; }
}
HD void st_normmod(const Prm& p, int layer, int which  , int nrows, int g0, int gs) {
    const float* ss = WSP(float, WS_SS); act_t* xn = WSP(act_t, WS_XN);
    const float* gw = p.in[which ? I_GFFN : I_GMIX] + (size_t)layer * D_MODEL;
    for (int i = g0; i < (int)(nrows * D_MODEL); i += gs) {
        const int r = (int)(i / D_MODEL), k = (int)(i % D_MODEL); const RowInfo q = rowinfo(r);
        const float rs = 1.0f / sqrtf(ss[r] * (1.0f / D_MODEL) + NORM_EPS);
        const float sh = modp(p, layer, q.modrow, which ? 3 : 0)[k], sc = modp(p, layer, q.modrow, which ? 4 : 1)[k];
        stf(xn + i, xrow(p, r)[k] * rs * gw[k] * (1.f + sc) + sh);
    }
}
HD void st_final(const Prm& p, int g0, int gs) {
    const float* ss = WSP(float, WS_SS);
    for (int i = g0; i < (int)(ML * D_MODEL); i += gs) { const int r = (int)(i / D_MODEL), k = (int)(i % D_MODEL);
        p.out[i] = p.out[i] * (1.0f / sqrtf(ss[r] * (1.0f / D_MODEL) + NORM_EPS)) * p.in[I_GFIN][k]; }
}

template <class Epi> HD void naive_gemm(const act_t* A, int lda, const float* W, int ldw, int M, int N, int K, const Epi& epi, int g0, int gs) {
    const long n4 = N / 4, total = (long)(M / 4) * n4;
    for (long i = g0; i < total; i += gs) {
        const int r0 = (int)(i / n4) * 4, c0 = (int)(i % n4) * 4;
        float acc[4][4];
#pragma unroll
        for (int a = 0; a < 4; ++a)
#pragma unroll
            for (int b = 0; b < 4; ++b) acc[a][b] = 0.f;
        for (int k = 0; k < K; ++k) {
            float av[4], wv[4];
#pragma unroll
            for (int a = 0; a < 4; ++a) av[a] = ldf(A + (size_t)(r0 + a) * lda + k);
#pragma unroll
            for (int b = 0; b < 4; ++b) wv[b] = W[(size_t)k * ldw + c0 + b];
#pragma unroll
            for (int a = 0; a < 4; ++a)
#pragma unroll
                for (int b = 0; b < 4; ++b) acc[a][b] += av[a] * wv[b];
        }
#pragma unroll
        for (int a = 0; a < 4; ++a)
#pragma unroll
            for (int b = 0; b < 4; ++b) epi(r0 + a, c0 + b, acc[a][b]);
    }
}
HD void in_store(const Prm& p, int r, int c, float v) {
    if (c < 1024) stf((act_t*)(p.ws + WS_P) + (size_t)r * PLD + c, v);
    else if (c < 1032) ((float*)(p.ws + WS_DTRAW))[(size_t)r * 8 + (c - 1024)] = v;
    else if (c < 2056) stf((act_t*)(p.ws + WS_P) + (size_t)r * PLD + (c - 8), v);
    else { const int g = (c - 2056) >> 4, k = (c - 2056) & 15; stf((act_t*)(p.ws + WS_S5A) + ((size_t)g * S5R + (r >> 4)) * 512 + (r & 15) * 16 + k, v); }
}
struct EpiStoreIn { const Prm* p; HDM void operator()(int r, int c, float v) const { in_store(*p, r, c, v); } };
struct EpiStore { act_t* O; int ldo; HDM void operator()(int r, int c, float v) const { stf(O + (size_t)r * ldo + c, v); } };
struct EpiResid { const Prm* p; int layer, which; HDM void operator()(int r, int c, float v) const { const RowInfo q = rowinfo(r); xrow(*p, r)[c] += modp(*p, layer, q.modrow, which)[c] * v; } };
struct EpiUp { const Prm* p; int layer; HDM void operator()(int r, int c, float v) const {
    const RowInfo q = rowinfo(r); const act_t* gt = (const act_t*)(p->ws + WS_GT); const float* cw = p->in[I_FCW] + (size_t)layer * 3 * D_FF; const float* cb = p->in[I_FCB] + (size_t)layer * D_FF;
    float g = cb[c] + cw[D_FF + c] * ldf(gt + (size_t)r * D_FF + c);
    if (q.t > 0) g += cw[c] * ldf(gt + (size_t)(r - 1) * D_FF + c);
    if (q.t < q.T - 1) g += cw[2 * D_FF + c] * ldf(gt + (size_t)(r + 1) * D_FF + c);
    stf((act_t*)(p->ws + WS_ACT) + (size_t)r * D_FF + c, siluf_(g) * v); } };

HD void st_ssd_conv(const Prm& p, int layer, int g0, int gs) {
    const act_t* P = WSP(act_t, WS_P); act_t* xbc = WSP(act_t, WS_XBC);
    const float* cw = p.in[I_SCW] + (size_t)layer * 3 * SSD_XBC; const float* cb = p.in[I_SCB] + (size_t)layer * SSD_XBC;
    for (int i = g0; i < (int)(MT * SSD_XBC); i += gs) {
        const int r = (int)(i / SSD_XBC), c = (int)(i % SSD_XBC); const RowInfo q = rowinfo(r);
        float v = cb[c] + cw[SSD_XBC + c] * ldf(P + (size_t)r * PLD + XBC_OFF + c);
        if (q.t > 0) v += cw[c] * ldf(P + (size_t)(r - 1) * PLD + XBC_OFF + c);
        if (q.t < q.T - 1) v += cw[2 * SSD_XBC + c] * ldf(P + (size_t)(r + 1) * PLD + XBC_OFF + c);
        stf(xbc + i, siluf_(v));
    }
}
HD void st_ssd_cs(const Prm& p, int layer, int g0, int gs) {
    const act_t* P = WSP(act_t, WS_P); float* DT = WSP(float, WS_DT); float* CS = WSP(float, WS_CS);
    for (int i = g0; i < (int)(NCH * 8); i += gs) {
        const int dh = (int)(i % 8), c = (int)(i / 8), d = dh >> 2;
        const float a = -expf(p.in[I_SALOG][layer * 8 + dh]), bias = p.in[I_SDTB][layer * 8 + dh];
        float run = 0.f;
        for (int j = 0; j < 128; ++j) { const int l = d ? 127 - j : j; const size_t r = (size_t)c * 128 + l;
            const float dt = softplusf_(WSP(float, WS_DTRAW)[r * 8 + dh] + bias); run += dt * a; DT[r * 8 + dh] = dt; CS[r * 8 + dh] = run; }
    }
}
HD void st_qk_prep(const Prm& p, int layer, int g0, int gs) {
    act_t* P = WSP(act_t, WS_P); const float* rc = WSP(float, WS_ROPE); const float* rs = rc + (size_t)SEQ * 32;
    for (int i = g0; i < (int)(MT * 12); i += gs) {
        const int r = (int)(i / 12), s = (int)(i % 12); const RowInfo q = rowinfo(r);
        int off; const float* gn = nullptr; float scale = 1.f;
        if (s < 4) { off = GAQ + s * 64; gn = p.in[I_GAQN] + layer * 64; scale = QSCALE; }
        else if (s < 6) { off = GAK + (s - 4) * 64; gn = p.in[I_GAKN] + layer * 64; }
        else if (s < 10) { off = WAQ + (s - 6) * 64; scale = QSCALE; }
        else off = WAK + (s - 10) * 64;
        act_t* v = P + (size_t)r * PLD + off;
        float rn = 1.f;
        if (gn) { float ssq = 0.f; for (int e = 0; e < 64; ++e) { const float x = ldf(v + e); ssq += x * x; } rn = 1.0f / sqrtf(ssq * (1.f / 64.f) + NORM_EPS); }
        for (int e = 0; e < 32; ++e) {
            float x1 = ldf(v + e) * rn, x2 = ldf(v + e + 32) * rn;
            if (gn) { x1 *= gn[e]; x2 *= gn[e + 32]; }
            float o1 = x1, o2 = x2;
            if (!q.isctx) { const float c = rc[(size_t)q.t * 32 + e], sn = rs[(size_t)q.t * 32 + e]; o1 = x1 * c - x2 * sn; o2 = x2 * c + x1 * sn; }
            stf(v + e, o1 * scale); stf(v + e + 32, o2 * scale);
        }
    }
}

HD void st_ssd_state(const Prm& p, int g0, int gs) {
    const act_t* xbc = WSP(act_t, WS_XBC); const float* DT = WSP(float, WS_DT); const float* CS = WSP(float, WS_CS); float* sst = WSP(float, WS_SST);
    for (int i = g0; i < (int)(NCH * 2 * 4 * 64 * 128); i += gs) {
        const int n = (int)(i % 128), pp = (int)((i / 128) % 64), h = (int)((i / 8192) % 4), d = (int)((i / 32768) % 2), c = (int)(i / 65536);
        const int dh = d * 4 + h, g = h >> 1; const size_t r0 = (size_t)c * 128;
        const float aend = CS[(r0 + (d ? 0 : 127)) * 8 + dh];
        float acc = 0.f;
        for (int l = 0; l < 128; ++l) { const size_t r = r0 + l;
            acc += ldf(xbc + r * 768 + 256 + g * 128 + n) * ldf(xbc + r * 768 + h * 64 + pp) * DT[r * 8 + dh] * expf(aend - CS[r * 8 + dh]); }
        sst[i] = acc;
    }
}
HD void st_ssd_cb(const Prm& p, int g0, int gs) {
    const act_t* xbc = WSP(act_t, WS_XBC); float* cb = WSP(float, WS_CB);
    for (int i = g0; i < (int)(NCH * 2 * 128 * 128); i += gs) {
        const int s = (int)(i % 128), l = (int)((i / 128) % 128), g = (int)((i / 16384) % 2), c = (int)(i / 32768); const size_t r0 = (size_t)c * 128;
        float acc = 0.f;
        for (int n = 0; n < 128; ++n) acc += ldf(xbc + (r0 + l) * 768 + 512 + g * 128 + n) * ldf(xbc + (r0 + s) * 768 + 256 + g * 128 + n);
        cb[i] = acc;
    }
}
HD int ssd_chunk_of(int b, int d, int j) {
    constexpr int CC = CTX_LEN / 128, LC = SEQ / 128;
    if (j < CC) return ML / 128 + b * CC + (d ? CC - 1 - j : j);
    const int jj = j - CC; return b * LC + (d ? LC - 1 - jj : jj);
}
HD void st_ssd_carry(const Prm& p, int g0, int gs) {
    float* sst = WSP(float, WS_SST); const float* CS = WSP(float, WS_CS);
    for (int i = g0; i < (int)(BATCH * 2 * 4 * 64 * 128); i += gs) {
        const int e = (int)(i % 8192), h = (int)((i / 8192) % 4), d = (int)((i / 32768) % 2), b = (int)(i / 65536); const int dh = d * 4 + h;
        float hst = 0.f;
        for (int j = 0; j < (CTX_LEN + SEQ) / 128; ++j) { const int c = ssd_chunk_of(b, d, j);
            const float dec = expf(CS[((size_t)c * 128 + (d ? 0 : 127)) * 8 + dh]); float* sp = sst + ((size_t)(c * 2 + d) * 4 + h) * 8192 + e;
            const float tmp = *sp; *sp = hst; hst = hst * dec + tmp; }
    }
}
HD void st_ssd_y(const Prm& p, int layer, int nrows, int g0, int gs) {
    const act_t* xbc = WSP(act_t, WS_XBC); const float* DT = WSP(float, WS_DT); const float* CS = WSP(float, WS_CS); const float* sst = WSP(float, WS_SST); const float* cb = WSP(float, WS_CB);
    act_t* P = WSP(act_t, WS_P);
    for (int i = g0; i < (int)(nrows * 256); i += gs) {
        const int r = (int)(i / 256), hp = (int)(i % 256), h = hp >> 6, pp = hp & 63, g = h >> 1; const int c = r >> 7, l = r & 127; const size_t r0 = (size_t)c * 128;
        float y = p.in[I_SD][layer * 4 + h] * ldf(xbc + (size_t)r * 768 + hp);
        for (int d = 0; d < 2; ++d) { const int dh = d * 4 + h; const float csl = CS[(size_t)r * 8 + dh];
            const int s0 = d ? l : 0, s1 = d ? 127 : l; float acc = 0.f;
            for (int s = s0; s <= s1; ++s) { const size_t rs_ = r0 + s;
                acc += cb[((size_t)(c * 2 + g) * 128 + l) * 128 + s] * expf(csl - CS[rs_ * 8 + dh]) * ldf(xbc + rs_ * 768 + hp) * DT[rs_ * 8 + dh]; }
            float off = 0.f; const float* hin = sst + ((size_t)(c * 2 + d) * 4 + h) * 8192 + (size_t)pp * 128;
            for (int n = 0; n < 128; ++n) off += ldf(xbc + (size_t)r * 768 + 512 + g * 128 + n) * hin[n];
            y += acc + off * expf(csl); }
        stf(P + (size_t)r * PLD + YSSD_OFF + hp, y);
    }
}
HD void st_ssd_out(const Prm& p, int layer, int nrows, int g0, int gs) {
    const act_t* P = WSP(act_t, WS_P); act_t* ym = WSP(act_t, WS_YMIX); const float* ng = p.in[I_SNG] + layer * 256;
    for (int r = g0; r < nrows; r += gs) { float ssq = 0.f;
        for (int c = 0; c < 256; ++c) { const float v = ldf(P + (size_t)r * PLD + YSSD_OFF + c) * siluf_(ldf(P + (size_t)r * PLD + Z_OFF + c)); ssq += v * v; }
        const float rn = 1.0f / sqrtf(ssq * (1.f / 256.f) + NORM_EPS);
        for (int c = 0; c < 256; ++c) { const float v = ldf(P + (size_t)r * PLD + YSSD_OFF + c) * siluf_(ldf(P + (size_t)r * PLD + Z_OFF + c)); stf(ym + (size_t)r * D_MIX + c, v * rn * ng[c]); } }
}

HD void st_s5tabB(const Prm& p, int layer, int g0, int gs) {
    const float* lamp = WSP(float, WS_LAMP) + (size_t)layer * 2 * 16 * 64 * 17 * 2; const float* bbar = WSP(float, WS_BBAR) + (size_t)layer * 2 * 16 * 64 * 16 * 2; const float* kt = WSP(float, WS_KT) + (size_t)layer * 2 * 16 * 16 * 256;
    act_t* BY = WSP(act_t, WS_S5BY); act_t* BE = WSP(act_t, WS_S5BE);
    for (int idx = g0; idx < 16 * 256 * 512; idx += gs) { const int q = idx & 511, ik = (idx >> 9) & 255, g = idx >> 17, i = ik >> 4, k = ik & 15; float v;
        if (q < 256) { const int j = q >> 4, kp = q & 15;
            if (j < i) v = kt[(((size_t)(0 * 16 + g) * 16 + (i - j)) * 16 + k) * 16 + kp];
            else if (j > i) v = kt[(((size_t)(1 * 16 + g) * 16 + (j - i)) * 16 + k) * 16 + kp];
            else v = kt[(((size_t)(0 * 16 + g) * 16) * 16 + k) * 16 + kp] + kt[(((size_t)(1 * 16 + g) * 16) * 16 + k) * 16 + kp] + (k == kp ? p.in[I_S5D][layer * 256 + g * 16 + k] : 0.f); }
        else { const int dd = (q - 256) >> 7, n = ((q - 256) & 127) >> 1, c = q & 1, pw = dd ? 16 - i : i + 1; const size_t dg = (size_t)(layer * 2 + dd) * 16 + g, dgn = (size_t)(dd * 16 + g) * 64 + n;
            const float cr = p.in[I_CRE][(dg * 16 + k) * 64 + n], ci = p.in[I_CIM][(dg * 16 + k) * 64 + n], lr = lamp[(dgn * 17 + pw) * 2], li = lamp[(dgn * 17 + pw) * 2 + 1];
            v = c ? -(cr * li + ci * lr) : (cr * lr - ci * li); }
        stf(BY + idx, v); }
    for (int idx = g0; idx < 16 * 256 * 256; idx += gs) { const int q = idx & 255, rr = (idx >> 8) & 255, g = idx >> 16, dd = rr >> 7, n = (rr & 127) >> 1, c = rr & 1, j = q >> 4, kp = q & 15, pw = dd ? j : 15 - j;
        const size_t dgn = (size_t)(dd * 16 + g) * 64 + n; const float lr = lamp[(dgn * 17 + pw) * 2], li = lamp[(dgn * 17 + pw) * 2 + 1], br = bbar[(dgn * 16 + kp) * 2], bi = bbar[(dgn * 16 + kp) * 2 + 1];
        stf(BE + idx, c ? (lr * bi + li * br) : (lr * br - li * bi)); }
}
HD void st_s5_E_naive(const Prm& p, int g0, int gs) {
    const act_t* A = WSP(act_t, WS_S5A); const act_t* BE = WSP(act_t, WS_S5BE); float* E = WSP(float, WS_S5E);
    for (int idx = g0; idx < 16 * NSC * 256; idx += gs) { const int rr = idx & 255, sc = (idx >> 8) % NSC, g = (idx >> 8) / NSC; float acc = 0.f;
        for (int q = 0; q < 256; ++q) acc += ldf(A + ((size_t)g * S5R + sc) * 512 + q) * ldf(BE + ((size_t)g * 256 + rr) * 256 + q);
        E[idx] = acc; }
}
HD int s5_sc_of(int b, int d, int j) {
    constexpr int CC = CTX_LEN / 16, LC = SEQ / 16;
    if (j < CC) return ML / 16 + b * CC + (d ? CC - 1 - j : j);
    const int jj = j - CC; return b * LC + (d ? LC - 1 - jj : jj);
}
HD void st_s5_carry(const Prm& p, int layer, int g0, int gs) {
    const float* lamp = WSP(float, WS_LAMP) + (size_t)layer * 2 * 16 * 64 * 17 * 2; const float* E = WSP(float, WS_S5E); act_t* A = WSP(act_t, WS_S5A);
    for (int i = g0; i < BATCH * 2 * 16 * 64; i += gs) {
        const int n = i & 63, g = (i >> 6) & 15, d = (i >> 10) & 1, b = i >> 11; const size_t dgn = (size_t)(d * 16 + g) * 64 + n;
        const float lr = lamp[(dgn * 17 + 16) * 2], li = lamp[(dgn * 17 + 16) * 2 + 1];
        float hr = 0.f, hi = 0.f;
        for (int j = 0; j < (CTX_LEN + SEQ) / 16; ++j) { const int sc = s5_sc_of(b, d, j); const float* e = E + ((size_t)g * NSC + sc) * 256 + d * 128 + 2 * n; act_t* a = A + ((size_t)g * S5R + sc) * 512 + 256 + d * 128 + 2 * n;
            const float tr = e[0], ti = e[1]; stf(a, hr); stf(a + 1, hi); const float nr = lr * hr - li * hi + tr, ni = lr * hi + li * hr + ti; hr = nr; hi = ni; }
    }
}
HD void s5y_store(const Prm& p, int g, int sc, int ik, float v) { const int r = sc * 16 + (ik >> 4); stf((act_t*)(p.ws + WS_P) + (size_t)r * PLD + YS5_OFF + g * 16 + (ik & 15), geluf_(v)); }
HD void st_s5_Y_naive(const Prm& p, int nrows, int g0, int gs) {
    const act_t* A = WSP(act_t, WS_S5A); const act_t* BY = WSP(act_t, WS_S5BY);
    for (int idx = g0; idx < 16 * (nrows / 16) * 256; idx += gs) { const int ik = idx & 255, sc = (idx >> 8) % (nrows / 16), g = (idx >> 8) / (nrows / 16); float acc = 0.f;
        for (int q = 0; q < 512; ++q) acc += ldf(A + ((size_t)g * S5R + sc) * 512 + q) * ldf(BY + ((size_t)g * 256 + ik) * 512 + q);
        s5y_store(p, g, sc, ik, acc); }
}
HD void st_glu(const Prm& p, int layer, int nrows, int g0, int gs) {
    const act_t* P = WSP(act_t, WS_P); act_t* ym = WSP(act_t, WS_YMIX); const float* w = p.in[I_WGLU] + (size_t)layer * 256 * 512; const float* bg = p.in[I_BGLU] + layer * 512;
    for (int i = g0; i < (int)(nrows * 256); i += gs) { const int r = (int)(i / 256), n = (int)(i % 256); float a = bg[n], g = bg[256 + n];
        for (int k = 0; k < 256; ++k) { const float y = ldf(P + (size_t)r * PLD + YS5_OFF + k); a += y * w[(size_t)k * 512 + n]; g += y * w[(size_t)k * 512 + 256 + n]; }
        stf(ym + (size_t)r * D_MIX + 768 + n, a * sigmoidf_(g)); }
}

struct AttnAcc { float m, l; float o[32]; };
#ifdef CPU_TEST
HD void ld8(const act_t* p, float* o) { for (int e = 0; e < 8; ++e) o[e] = p[e]; }
#else
typedef unsigned u32x4_t __attribute__((ext_vector_type(4)));
HD void ld8(const act_t* p, float* o) { const u32x4_t v = *(const u32x4_t*)p;
#pragma unroll
    for (int e = 0; e < 4; ++e) { o[2 * e] = __uint_as_float(v[e] << 16); o[2 * e + 1] = __uint_as_float(v[e] & 0xffff0000u); } }
#endif
HD void attn_seg(AttnAcc& A, const act_t* q, const act_t* P, int row0, int cnt, int koff, int voff) {
#pragma clang loop unroll(disable)
    for (int j = 0; j < cnt; ++j) { const act_t* kr = P + (size_t)(row0 + j) * PLD;
        float s = 0.f;
#pragma clang loop unroll(disable)
        for (int c = 0; c < 8; ++c) { float qv[8], kv[8]; ld8(q + c * 8, qv); ld8(kr + koff + c * 8, kv);
#pragma unroll
            for (int e = 0; e < 8; ++e) s += qv[e] * kv[e]; }
        if (s > A.m) { const float f = expf(A.m - s); A.l *= f;
#pragma unroll
            for (int e = 0; e < 32; ++e) A.o[e] *= f;
            A.m = s; }
        const float pexp = expf(s - A.m); A.l += pexp;
#pragma unroll
        for (int c = 0; c < 4; ++c) { float vv[8]; ld8(kr + voff + c * 8, vv);
#pragma unroll
            for (int e = 0; e < 8; ++e) A.o[c * 8 + e] += pexp * vv[e]; } }
}
HD void st_attn(const Prm& p, int layer, int nrows, int g0, int gs) {
    const act_t* P = WSP(act_t, WS_P); act_t* ym = WSP(act_t, WS_YMIX);
    for (int i = g0; i < (int)(nrows * 16); i += gs) {
        const int r = (int)(i / 16), s = (int)((i % 16) >> 1), half = (int)(i & 1); const RowInfo qi = rowinfo(r); const int isw = s >= 4, hq = s & 3, kv = hq >> 1;
        const int qoff = (isw ? WAQ : GAQ) + hq * 64, koff = (isw ? WAK : GAK) + kv * 64, voff = (isw ? WAV : GAV) + kv * 64 + half * 32;
        const act_t* q = P + (size_t)r * PLD + qoff;
        AttnAcc A; A.m = -1e30f; A.l = 0.f;
#pragma unroll
        for (int e = 0; e < 32; ++e) A.o[e] = 0.f;
        attn_seg(A, q, P, ML + qi.b * CTX_LEN, CTX_LEN, koff, voff);
        if (!qi.isctx) {
            if (!isw) attn_seg(A, q, P, qi.b * SEQ, SEQ, koff, voff);
            else { const int t0 = qi.t - 128 < 0 ? 0 : qi.t - 128, t1 = qi.t + 128 > SEQ - 1 ? SEQ - 1 : qi.t + 128; attn_seg(A, q, P, qi.b * SEQ + t0, t1 - t0 + 1, koff, voff); }
        }
        if (isw) { const float sk = p.in[I_SINK][layer * 4 + hq]; if (sk > A.m) { const float f = expf(A.m - sk); A.l *= f;
#pragma unroll
                for (int e = 0; e < 32; ++e) A.o[e] *= f;
                A.m = sk; }
            A.l += expf(sk - A.m); }
        const float inv = 1.f / A.l;
#pragma unroll
        for (int e = 0; e < 32; ++e) stf(ym + (size_t)r * D_MIX + 256 + s * 64 + half * 32 + e, A.o[e] * inv);
    }
}

enum { S_SYNC = 0, S_MOD, S_INIT, S_TAB1, S_TAB2, S_ROWSS, S_NORM_MIX, S_GEMM_IN, S_CONV, S_CS, S_QK, S_STATE, S_CB, S_S5E, S_ATTN, S_SSD_CARRY, S_S5_CARRY,
       S_SSD_Y, S_S5_Y, S_SSD_OUT, S_GLU, S_GEMM_OUT, S_NORM_FFN, S_GEMM_GATE, S_GEMM_UP, S_GEMM_DOWN, S_ROWSS_FIN, S_FINAL, S_WPREP, S_MODR, S_TABB, S_GEMM_GU, S_FIXUP, S_SUBGLU, S_WPREP2, S_ATTNC };
struct Step { int st, layer; };
#define LAYER_STEPS(L) {S_WPREP, L}, {S_TABB, L}, {S_ROWSS, L}, {S_SYNC, 0}, {S_NORM_MIX, L}, {S_SYNC, 0}, {S_GEMM_IN, L}, {S_SYNC, 0}, {S_CONV, L}, {S_CS, L}, {S_QK, L}, {S_SYNC, 0}, \
    {S_STATE, L}, {S_CB, L}, {S_S5E, L}, {S_ATTN, L}, {S_SYNC, 0}, {S_SSD_CARRY, L}, {S_S5_CARRY, L}, {S_SYNC, 0}, {S_SSD_Y, L}, {S_S5_Y, L}, {S_SYNC, 0}, \
    {S_SSD_OUT, L}, {S_GLU, L}, {S_SYNC, 0}, {S_GEMM_OUT, L}, {S_SYNC, 0}, {S_ROWSS, L}, {S_SYNC, 0}, {S_NORM_FFN, L}, {S_SYNC, 0}, {S_GEMM_GATE, L}, {S_SYNC, 0}, \
    {S_GEMM_UP, L}, {S_SYNC, 0}, {S_GEMM_DOWN, L}, {S_SYNC, 0}
#ifdef CPU_TEST
static const Step PROG[] = {
#else
__constant__ Step PROG_D[] = {
#endif
    {S_MOD, 0}, {S_INIT, 0}, {S_TAB1, 0}, {S_SYNC, 0}, {S_TAB2, 0}, {S_SYNC, 0}, LAYER_STEPS(0), LAYER_STEPS(1), {S_ROWSS_FIN, 0}, {S_SYNC, 0}, {S_FINAL, 0} };
#ifndef CPU_TEST
static const Step PROG[] = { {S_MOD, 0}, {S_INIT, 0}, {S_TAB1, 0}, {S_SYNC, 0}, {S_TAB2, 0}, {S_SYNC, 0}, LAYER_STEPS(0), LAYER_STEPS(1), {S_ROWSS_FIN, 0}, {S_SYNC, 0}, {S_FINAL, 0} };
#endif
constexpr int NPROG = 6 + 2 * 38 + 3;

#ifndef CPU_TEST
#define LAS __attribute__((address_space(3)))
__device__ __forceinline__ int BIDX_() { int v = blockIdx.x; asm volatile("" : "+s"(v)); return v; }
__device__ __forceinline__ int GDIM_() { int v = gridDim.x; asm volatile("" : "+s"(v)); return v; }
constexpr int MISC_OFF_ = 131072, WTAB_ = 32;
__device__ __forceinline__ int HWSLOT_() { return (int)(__builtin_amdgcn_s_getreg((5 << 11) | 4) & 0x3f); }
__device__ __forceinline__ int TID_() { extern __shared__ __attribute__((aligned(16))) unsigned char l_dyn_[];
    const int w = __builtin_amdgcn_readfirstlane(((volatile LAS int*)((LAS unsigned char*)l_dyn_ + MISC_OFF_))[WTAB_ + HWSLOT_()]);
    unsigned m_ = ~0u; asm volatile("" : "+s"(m_));
    return w * 64 + (int)__builtin_amdgcn_mbcnt_hi(m_, __builtin_amdgcn_mbcnt_lo(m_, 0u)); }
namespace pg8 {
#define PG8_LAS __attribute__((address_space(3)))
typedef unsigned short bf16_t;
typedef short bf16x8 __attribute__((ext_vector_type(8)));
typedef float f32x4 __attribute__((ext_vector_type(4)));
typedef unsigned u32x4 __attribute__((ext_vector_type(4)));
constexpr int BM = 256, BK = 64, HALF = 128, HTB = HALF * BK * 2  , STAGE_BYTES = 8 * HTB, NXCD = 8, WGM = 8;

__host__ __device__ __forceinline__ int lds_byte(int r, int c) { const int st = (r >> 4) * 2 + (c >> 5), rr = r & 15, cc = c & 31, ob = rr * 64 + cc * 2; return st * 1024 + (ob ^ (((ob >> 9) & 1) << 5)); }
__host__ __device__ __forceinline__ void stage_rc(int b, int& R, int& C) { const int st = b / 1024, sb = b % 1024, swz = sb ^ (((sb >> 9) & 1) << 5); R = (st >> 1) * 16 + swz / 64; C = (st & 1) * 32 + (swz % 64) / 2; }
__host__ __device__ __forceinline__ int perm32(int rho) { const int n = rho >> 4, i = rho & 15; return 8 * (i >> 2) + 4 * n + (i & 3); }

struct Unit { int pm, pn, kb = 0, nt = 0; };
struct Gemm { const bf16_t* A; const bf16_t* Bt; int M, N, K, lda; };

struct StaticOrder {
    int nM, nN, nwg, G, c;
    __host__ __device__ void init(int M, int N, int G_, int c_) { nM = M / BM; nN = N / BM; nwg = nM * nN; G = G_; c = c_; }
    __host__ __device__ bool next(int i, Unit& u) const {
        const long L = (long)i * G + c; if (L >= nwg) return false;
        int wgid = (int)L; { const int q = nwg / NXCD, r = nwg % NXCD, xcd = wgid % NXCD, off = wgid / NXCD; wgid = (xcd < r ? xcd * (q + 1) : r * (q + 1) + (xcd - r) * q) + off; }
        const int nig = WGM * nN, gid = wgid / nig, fm = gid * WGM, gsz = (nM - fm) < WGM ? (nM - fm) : WGM;
        u.pm = fm + ((wgid % nig) % gsz); u.pn = (wgid % nig) / gsz; return true;
    }
    __device__ __forceinline__ void a_ready(const Unit&) const {}
    __device__ __forceinline__ void done(const Unit&) const {}
};

__device__ __forceinline__ unsigned cvt_pk_bf16(float lo, float hi) { unsigned r; asm volatile("v_cvt_pk_bf16_f32 %0, %1, %2" : "=v"(r) : "v"(lo), "v"(hi)); return r; }
typedef float f32x2 __attribute__((ext_vector_type(2)));
__device__ __forceinline__ void st_wt(f32x4* p, f32x4 v) { asm volatile("global_store_dwordx4 %0, %1, off sc1\n\ts_nop 1" :: "v"(p), "v"(v) : "memory"); }
__device__ __forceinline__ void st_wt(u32x4* p, u32x4 v) { asm volatile("global_store_dwordx4 %0, %1, off sc1\n\ts_nop 1" :: "v"(p), "v"(v) : "memory"); }
typedef unsigned u32x2w __attribute__((ext_vector_type(2)));
__device__ __forceinline__ void st_wt(u32x2w* p, u32x2w v) { asm volatile("global_store_dwordx2 %0, %1, off sc1" :: "v"(p), "v"(v) : "memory"); }
__device__ __forceinline__ f32x2 gelu_pk(f32x2 v) {
    const f32x2 av = __builtin_elementwise_abs(v), d = av * 0.2316418882f + 1.0f;
    f32x2 t; t.x = __builtin_amdgcn_rcpf(d.x); t.y = __builtin_amdgcn_rcpf(d.y);
    f32x2 q = t * 0.5307027145f + (-0.7265760135f); q = q * t + 0.7107068705f; q = q * t + (-0.142248368f); q = q * t + 0.127414796f; q = q * t;
    const f32x2 s = (v * v) * (-0.72134752044f);
    f32x2 e; e.x = __builtin_amdgcn_exp2f(s.x); e.y = __builtin_amdgcn_exp2f(s.y);
    const f32x2 m = v * (q * e), r = v - m;
    f32x2 o; o.x = v.x < 0.f ? m.x : r.x; o.y = v.y < 0.f ? m.y : r.y; return o;
}

template <int ACT  > struct EpiBf16 {
    static constexpr bool PERM = true, AFTER_DRAIN = false; static_assert(ACT == 0 || ACT == 1, "EpiBf16: ACT is 0 (none) or 1 (gelu_pk)");
    bf16_t* O; int ldc; const float* bias; int split_cols; size_t split_stride; float scale0;
    __device__ __forceinline__ void operator()(const f32x4 (&acc)[2][2][4][2], const Unit& u, int wr, int wc, int fr, int fq) const {
        const int row0 = u.pm * BM + wr * 64 + fr; int colt = u.pn * BM; bf16_t* base = O;
        float sc = 1.f; if (split_cols) { const int t = colt / split_cols; base += (size_t)t * split_stride; colt -= t * split_cols; if (t == 0) sc = scale0; }
        const int col0 = colt + wc * 32 + 8 * fq, bcol0 = u.pn * BM + wc * 32 + 8 * fq;
        f32x4 bv[2][2];
#pragma unroll
        for (int bj = 0; bj < 2; ++bj)
#pragma unroll
            for (int n = 0; n < 2; ++n) bv[bj][n] = bias ? *(const f32x4*)(bias + bcol0 + bj * HALF + 4 * n) : (f32x4){0.f, 0.f, 0.f, 0.f};
#pragma unroll
        for (int ai = 0; ai < 2; ++ai)
#pragma unroll
            for (int m = 0; m < 4; ++m) { bf16_t* rowp = base + (size_t)(row0 + ai * HALF + m * 16) * ldc + col0;
#pragma unroll
                for (int bj = 0; bj < 2; ++bj) { f32x4 v0 = acc[ai][bj][m][0] + bv[bj][0], v1 = acc[ai][bj][m][1] + bv[bj][1];
                    if (ACT == 1) { f32x2 a = gelu_pk((f32x2){v0[0], v0[1]}), b = gelu_pk((f32x2){v0[2], v0[3]}), c = gelu_pk((f32x2){v1[0], v1[1]}), d = gelu_pk((f32x2){v1[2], v1[3]});
                        v0 = (f32x4){a.x, a.y, b.x, b.y}; v1 = (f32x4){c.x, c.y, d.x, d.y}; }
                    v0 = v0 * sc; v1 = v1 * sc; u32x4 w; w.x = cvt_pk_bf16(v0[0], v0[1]); w.y = cvt_pk_bf16(v0[2], v0[3]); w.z = cvt_pk_bf16(v1[0], v1[1]); w.w = cvt_pk_bf16(v1[2], v1[3]);
                    *(u32x4*)(rowp + bj * HALF) = w; } }
    }
};
template <class Epi, class Sched, bool ALIGN_EPI = false, bool SP2 = false>
__device__ __forceinline__ void gemm_phase(PG8_LAS unsigned char* lds, const Gemm g, const Sched& S, const Epi& E) {
    const int tid = TID_(),
        wid = __builtin_amdgcn_readfirstlane(tid >> 6), lane = tid & 63, wr = wid >> 2, wc = wid & 3, fr = lane & 15, fq = lane >> 4;
    const int K = g.K, nt = K / BK;
    unsigned voffA[2], voffB[2];
#pragma unroll
    for (int i = 0; i < 2; ++i) { int R, C; stage_rc(tid * 16 + i * 8192, R, C); const int Rb = Epi::PERM ? ((R & ~31) + perm32(R & 31)) : R;
        voffA[i] = (unsigned)(R * g.lda + C) * 2u; voffB[i] = (unsigned)(Rb * K + C) * 2u; }
    const size_t kstep = (size_t)(BK * 2);
    const size_t hstepA = (size_t)HALF * g.lda * 2, hstepB = (size_t)HALF * K * 2;
    const size_t tstepA = 2 * hstepA, tstepB = 2 * hstepB;
    const unsigned ldsw = (unsigned)wid * 1024u;
    const int aoff = lds_byte(wr * 64 + fr, fq * 8), boff = lds_byte(wc * 32 + fr, fq * 8);
#define PG8_SA(b, h) (((b) * 2 + (h)) * HTB)
#define PG8_SB(b, h) ((4 + (b) * 2 + (h)) * HTB)
#define PG8_STAGE(bufoff, gbase, voff) do { _Pragma("unroll") for (int _i = 0; _i < 2; ++_i) \
        __builtin_amdgcn_global_load_lds((const unsigned*)((const char*)(gbase) + (voff)[_i]), (PG8_LAS unsigned*)(lds + (bufoff) + ldsw + _i * 8192), 16, 0, 0); } while (0)
#define PG8_LDA(dst, b, h) do { _Pragma("unroll") for (int m = 0; m < 4; ++m) _Pragma("unroll") for (int k = 0; k < 2; ++k) dst[m][k] = *(const PG8_LAS bf16x8*)(lds + PG8_SA(b, h) + aoff + m * 2048 + k * 1024); } while (0)
#define PG8_LDB(dst, b, h) do { _Pragma("unroll") for (int n = 0; n < 2; ++n) _Pragma("unroll") for (int k = 0; k < 2; ++k) dst[n][k] = *(const PG8_LAS bf16x8*)(lds + PG8_SB(b, h) + boff + n * 2048 + k * 1024); } while (0)
#define PG8_MMA(ai, bj, At, Bt) do { __builtin_amdgcn_s_setprio(1); _Pragma("unroll") for (int m = 0; m < 4; ++m) _Pragma("unroll") for (int n = 0; n < 2; ++n) _Pragma("unroll") for (int k = 0; k < 2; ++k) \
        acc[ai][bj][m][n] = __builtin_amdgcn_mfma_f32_16x16x32_bf16(Bt[n][k], At[m][k], acc[ai][bj][m][n], 0, 0, 0); __builtin_amdgcn_s_setprio(0); } while (0)
#define PG8_WAIT_V(n) asm volatile("s_waitcnt vmcnt(" #n ")" ::: "memory")
#define PG8_WAIT_L(n) asm volatile("s_waitcnt lgkmcnt(" #n ")" ::: "memory")
#define PG8_BAR __builtin_amdgcn_s_barrier()
#define PG8_SCHED __builtin_amdgcn_sched_barrier(0)
    Unit cur, nxt; int ui = 0;
    if (!S.next(0, cur)) return;
    f32x4 acc[2][2][4][2];
#pragma unroll
    for (int a = 0; a < 2; ++a)
#pragma unroll
        for (int b = 0; b < 2; ++b)
#pragma unroll
            for (int m = 0; m < 4; ++m)
#pragma unroll
                for (int n = 0; n < 2; ++n) acc[a][b][m][n] = (f32x4){0.f, 0.f, 0.f, 0.f};
    bf16x8 At[4][2], B0[2][2], B1[2][2];
    const char* cA = (const char*)g.A + (size_t)cur.pm * tstepA + cur.kb; const char* cB = (const char*)g.Bt + (size_t)cur.pn * tstepB + cur.kb;
    S.a_ready(cur);
    if constexpr (SP2) {
        PG8_STAGE(PG8_SB(0, 0), cB, voffB); PG8_STAGE(PG8_SB(0, 1), cB + hstepB, voffB); PG8_STAGE(PG8_SA(0, 0), cA, voffA); PG8_STAGE(PG8_SA(0, 1), cA + hstepA, voffA);
        if (wr == 1) PG8_BAR;
        PG8_WAIT_V(2); PG8_BAR;
        PG8_STAGE(PG8_SB(1, 0), cB + kstep, voffB); PG8_STAGE(PG8_SA(1, 0), cA + kstep, voffA); PG8_STAGE(PG8_SB(1, 1), cB + hstepB + kstep, voffB);
        PG8_WAIT_V(6); PG8_BAR;
    } else {
        PG8_STAGE(PG8_SB(0, 0), cB, voffB); PG8_STAGE(PG8_SA(0, 0), cA, voffA); PG8_STAGE(PG8_SB(0, 1), cB + hstepB, voffB); PG8_STAGE(PG8_SA(0, 1), cA + hstepA, voffA);
        if (wr == 1) PG8_BAR;
        PG8_WAIT_V(4); PG8_BAR;
        PG8_STAGE(PG8_SB(1, 0), cB + kstep, voffB); PG8_STAGE(PG8_SA(1, 0), cA + kstep, voffA); PG8_STAGE(PG8_SB(1, 1), cB + hstepB + kstep, voffB);
        PG8_WAIT_V(6); PG8_BAR;
    }
    for (;;) {
        const bool has_next = S.next(ui + 1, nxt);
        const char* nA = has_next ? (const char*)g.A + (size_t)nxt.pm * tstepA + nxt.kb : cA; const char* nB = has_next ? (const char*)g.Bt + (size_t)nxt.pn * tstepB + nxt.kb : cB;
        const int unt = cur.nt ? cur.nt : nt;
        for (int t = 0; t < unt; t += 2) {
            const bool last = (t == unt - 2);
            const char* a1 = cA + (size_t)(t + 1) * kstep;
            const char* a2 = last ? nA : cA + (size_t)(t + 2) * kstep; const char* b2 = last ? nB : cB + (size_t)(t + 2) * kstep;
            const char* a3 = a2 + kstep; const char* b3 = b2 + kstep;
            if (last && has_next) S.a_ready(nxt);
            if constexpr (SP2) {
            PG8_LDB(B0, 0, 0); PG8_LDB(B1, 0, 1); PG8_SCHED; PG8_LDA(At, 0, 0); PG8_STAGE(PG8_SA(1, 1), a1 + hstepA, voffA);
            PG8_WAIT_V(8); PG8_WAIT_L(0); PG8_BAR; PG8_MMA(0, 0, At, B0); PG8_MMA(0, 1, At, B1); PG8_BAR; PG8_SCHED;
            PG8_LDA(At, 0, 1); PG8_STAGE(PG8_SB(0, 0), b2, voffB); PG8_STAGE(PG8_SB(0, 1), b2 + hstepB, voffB); PG8_STAGE(PG8_SA(0, 0), a2, voffA);
            PG8_WAIT_V(8); PG8_WAIT_L(0); PG8_BAR; PG8_MMA(1, 0, At, B0); PG8_MMA(1, 1, At, B1); PG8_BAR; PG8_SCHED;
            PG8_LDB(B0, 1, 0); PG8_LDB(B1, 1, 1); PG8_SCHED; PG8_LDA(At, 1, 0); PG8_STAGE(PG8_SA(0, 1), a2 + hstepA, voffA);
            PG8_WAIT_V(8); PG8_WAIT_L(0); PG8_BAR; PG8_MMA(0, 0, At, B0); PG8_MMA(0, 1, At, B1); PG8_BAR; PG8_SCHED;
            PG8_LDA(At, 1, 1); PG8_STAGE(PG8_SB(1, 0), b3, voffB); PG8_STAGE(PG8_SB(1, 1), b3 + hstepB, voffB); PG8_STAGE(PG8_SA(1, 0), a3, voffA);
            PG8_WAIT_V(8); PG8_WAIT_L(0); PG8_BAR; PG8_MMA(1, 0, At, B0); PG8_MMA(1, 1, At, B1); PG8_BAR; PG8_SCHED;
            } else {
            PG8_LDB(B0, 0, 0); PG8_SCHED; PG8_LDA(At, 0, 0); PG8_STAGE(PG8_SA(1, 1), a1 + hstepA, voffA);
            PG8_WAIT_L(8); PG8_BAR; PG8_WAIT_L(0); PG8_MMA(0, 0, At, B0); PG8_BAR; PG8_SCHED;
            PG8_LDB(B1, 0, 1); PG8_STAGE(PG8_SB(0, 0), b2, voffB);
            PG8_BAR; PG8_WAIT_L(0); PG8_MMA(0, 1, At, B1); PG8_BAR;
            PG8_LDA(At, 0, 1); PG8_STAGE(PG8_SA(0, 0), a2, voffA);
            PG8_BAR; PG8_WAIT_L(0); PG8_MMA(1, 0, At, B0); PG8_BAR; PG8_SCHED;
            PG8_STAGE(PG8_SB(0, 1), b2 + hstepB, voffB);
            PG8_WAIT_V(6); PG8_BAR; PG8_MMA(1, 1, At, B1); PG8_BAR;
            PG8_LDB(B0, 1, 0); PG8_SCHED; PG8_LDA(At, 1, 0); PG8_STAGE(PG8_SA(0, 1), a2 + hstepA, voffA);
            PG8_WAIT_L(8); PG8_BAR; PG8_WAIT_L(0); PG8_MMA(0, 0, At, B0); PG8_BAR; PG8_SCHED;
            PG8_LDB(B1, 1, 1); PG8_STAGE(PG8_SB(1, 0), b3, voffB);
            PG8_BAR; PG8_WAIT_L(0); PG8_MMA(0, 1, At, B1); PG8_BAR;
            PG8_LDA(At, 1, 1); PG8_STAGE(PG8_SA(1, 0), a3, voffA);
            PG8_BAR; PG8_WAIT_L(0); PG8_MMA(1, 0, At, B0); PG8_BAR; PG8_SCHED;
            PG8_STAGE(PG8_SB(1, 1), b3 + hstepB, voffB);
            PG8_WAIT_V(6); PG8_BAR; PG8_MMA(1, 1, At, B1); PG8_BAR;
            }
        }
        if constexpr (ALIGN_EPI) { if (wr == 0) PG8_BAR; }
        if constexpr (!Epi::AFTER_DRAIN) { E(acc, cur, wr, wc, fr, fq); S.done(cur); }
        if (!has_next) break;
#pragma unroll
        for (int a = 0; a < 2; ++a)
#pragma unroll
            for (int b = 0; b < 2; ++b)
#pragma unroll
                for (int m = 0; m < 4; ++m)
#pragma unroll
                    for (int n = 0; n < 2; ++n) acc[a][b][m][n] = (f32x4){0.f, 0.f, 0.f, 0.f};
        cur = nxt; cA = nA; cB = nB; ++ui;
        if constexpr (ALIGN_EPI) { if (wr == 1) PG8_BAR; }
    }
    PG8_WAIT_V(0);
    if constexpr (!ALIGN_EPI) { if (wr == 0) PG8_BAR; }
    PG8_BAR;
    if constexpr (Epi::AFTER_DRAIN) { E.fused(acc, cur, wr, wc, fr, fq, lds, wid, lane); S.done(cur); }
#undef PG8_SA
#undef PG8_SB
#undef PG8_STAGE
#undef PG8_LDA
#undef PG8_LDB
#undef PG8_MMA
#undef PG8_WAIT_V
#undef PG8_WAIT_L
#undef PG8_BAR
#undef PG8_SCHED
}
}

namespace pg8 {
struct EpiResidM {
    static constexpr bool PERM = false, AFTER_DRAIN = false;
    float* xlat; float* xctx; const float* slat; const float* sctx; const float* mod; int which; float* slab; int ntk_;
    __device__ __forceinline__ void operator()(const f32x4 (&acc)[2][2][4][2], const Unit& u, int wr, int wc, int fr, int fq) const {
        const int modrow = u.pm < ML / 256 ? (u.pm * 256) / SEQ : BATCH;
        const float* gp = mod + ((size_t)modrow * 6 + which) * D_MODEL;
        const int col0 = u.pn * BM + wc * 32 + 4 * fq;
        f32x4 gv[2][2], res[2][2][4][2];
        if (u.nt) {
            const int sl = u.kb / (BK * 2) / ((((ntk_ / 4) + 1) & ~1));
#pragma unroll
            for (int ai = 0; ai < 2; ++ai)
#pragma unroll
                for (int m = 0; m < 4; ++m) { const int r = u.pm * BM + ai * HALF + wr * 64 + m * 16 + fr - ML; float* sr = slab + ((size_t)sl * MC + r) * D_MODEL + col0;
#pragma unroll
                    for (int bj = 0; bj < 2; ++bj)
#pragma unroll
                        for (int n = 0; n < 2; ++n) *(f32x4*)(sr + bj * HALF + n * 16) = acc[ai][bj][m][n]; }
            return; }
#pragma unroll
        for (int bj = 0; bj < 2; ++bj)
#pragma unroll
            for (int n = 0; n < 2; ++n) gv[bj][n] = *(const f32x4*)(gp + col0 + bj * HALF + n * 16);
#pragma unroll
        for (int ai = 0; ai < 2; ++ai)
#pragma unroll
            for (int m = 0; m < 4; ++m) { const int r = u.pm * BM + ai * HALF + wr * 64 + m * 16 + fr;
                const float* xs = (r < ML ? slat + (size_t)r * D_MODEL : sctx + (size_t)(r - ML) * D_MODEL) + col0;
#pragma unroll
                for (int bj = 0; bj < 2; ++bj)
#pragma unroll
                    for (int n = 0; n < 2; ++n) res[ai][bj][m][n] = *(const f32x4*)(xs + bj * HALF + n * 16) + gv[bj][n] * acc[ai][bj][m][n]; }
        asm volatile("" ::: "memory");
#pragma unroll
        for (int ai = 0; ai < 2; ++ai)
#pragma unroll
            for (int m = 0; m < 4; ++m) { const int r = u.pm * BM + ai * HALF + wr * 64 + m * 16 + fr;
                float* xr = (r < ML ? xlat + (size_t)r * D_MODEL : xctx + (size_t)(r - ML) * D_MODEL) + col0;
#pragma unroll
                for (int bj = 0; bj < 2; ++bj)
#pragma unroll
                    for (int n = 0; n < 2; ++n) st_wt((f32x4*)(xr + bj * HALF + n * 16), res[ai][bj][m][n]); }
    }
};
__device__ __forceinline__ void unpack8(const u32x4 v, float* o) {
#pragma unroll
    for (int e = 0; e < 4; ++e) { o[2 * e] = __uint_as_float(v[e] << 16); o[2 * e + 1] = __uint_as_float(v[e] & 0xffff0000u); } }
struct EpiUpM {
    static constexpr bool PERM = true, AFTER_DRAIN = false;
    const bf16_t* GT; bf16_t* ACT; const float* cw; const float* cb;
    __device__ __forceinline__ void ldbatch(int b, const Unit& u, int wr, int wc, int fr, int fq, u32x4& gm, u32x4& gl, u32x4& gh) const {
        const int bj = b >> 3, ai = (b >> 2) & 1, m = b & 3, c = u.pn * BM + bj * HALF + wc * 32 + 8 * fq;
        const int r = u.pm * BM + ai * HALF + wr * 64 + m * 16 + fr;
        const int t = r < ML ? r % SEQ : (r - ML) % CTX_LEN, T = r < ML ? SEQ : CTX_LEN; const bf16_t* gp = GT + (size_t)r * D_FF + c;
        gm = *(const u32x4*)gp; gl = (u32x4){0u, 0u, 0u, 0u}; gh = (u32x4){0u, 0u, 0u, 0u};
        if (t > 0) gl = *(const u32x4*)(gp - D_FF);
        if (t < T - 1) gh = *(const u32x4*)(gp + D_FF);
    }
    __device__ __forceinline__ void operator()(const f32x4 (&acc)[2][2][4][2], const Unit& u, int wr, int wc, int fr, int fq) const {
        u32x4 gmA, glA, ghA, gmB, glB, ghB;
        ldbatch(0, u, wr, wc, fr, fq, gmA, glA, ghA);
#pragma unroll
        for (int bj = 0; bj < 2; ++bj) { const int c = u.pn * BM + bj * HALF + wc * 32 + 8 * fq;
            f32x4 w0[2], w1[2], w2[2], bb[2];
#pragma unroll
            for (int q = 0; q < 2; ++q) { w0[q] = *(const f32x4*)(cw + c + 4 * q); w1[q] = *(const f32x4*)(cw + D_FF + c + 4 * q); w2[q] = *(const f32x4*)(cw + 2 * D_FF + c + 4 * q); bb[q] = *(const f32x4*)(cb + c + 4 * q); }
#pragma unroll
            for (int i = 0; i < 8; ++i) { const int b = bj * 8 + i, ai = i >> 2, m = i & 3;
                u32x4& gm = (b & 1) ? gmB : gmA; u32x4& gl = (b & 1) ? glB : glA; u32x4& gh = (b & 1) ? ghB : ghA;
                if (b + 1 < 16) { if (b & 1) ldbatch(b + 1, u, wr, wc, fr, fq, gmA, glA, ghA); else ldbatch(b + 1, u, wr, wc, fr, fq, gmB, glB, ghB); }
                float g[8], x[8];
                unpack8(gm, x);
#pragma unroll
                for (int e = 0; e < 8; ++e) g[e] = bb[e >> 2][e & 3] + w1[e >> 2][e & 3] * x[e];
                unpack8(gl, x);
#pragma unroll
                for (int e = 0; e < 8; ++e) g[e] += w0[e >> 2][e & 3] * x[e];
                unpack8(gh, x);
#pragma unroll
                for (int e = 0; e < 8; ++e) g[e] += w2[e >> 2][e & 3] * x[e];
                const f32x4 v0 = acc[ai][bj][m][0], v1 = acc[ai][bj][m][1]; float o[8];
#pragma unroll
                for (int e = 0; e < 4; ++e) { o[e] = g[e] / (1.f + __expf(-g[e])) * v0[e]; o[4 + e] = g[4 + e] / (1.f + __expf(-g[4 + e])) * v1[e]; }
                u32x4 w; w.x = cvt_pk_bf16(o[0], o[1]); w.y = cvt_pk_bf16(o[2], o[3]); w.z = cvt_pk_bf16(o[4], o[5]); w.w = cvt_pk_bf16(o[6], o[7]);
                const int r = u.pm * BM + ai * HALF + wr * 64 + m * 16 + fr; *(u32x4*)(ACT + (size_t)r * D_FF + c) = w; } }
    }
};
struct EpiGluM {
    static constexpr bool PERM = false, AFTER_DRAIN = false;
    bf16_t* YM; const float* bg;
    __device__ __forceinline__ void operator()(const f32x4 (&acc)[2][2][4][2], const Unit& u, int wr, int wc, int fr, int fq) const {
#pragma unroll
        for (int n = 0; n < 2; ++n) { const int oc = u.pn * HALF + wc * 32 + 16 * n + 4 * fq;
            const f32x4 ba = *(const f32x4*)(bg + oc), bgt = *(const f32x4*)(bg + 256 + oc);
#pragma unroll
            for (int ai = 0; ai < 2; ++ai)
#pragma unroll
                for (int m = 0; m < 4; ++m) { const int r = u.pm * BM + ai * HALF + wr * 64 + m * 16 + fr;
                    const f32x4 a = acc[ai][0][m][n] + ba, g = acc[ai][1][m][n] + bgt; float o[4];
#pragma unroll
                    for (int e = 0; e < 4; ++e) o[e] = a[e] / (1.f + __expf(-g[e]));
                    typedef unsigned u32x2 __attribute__((ext_vector_type(2))); u32x2 w; w.x = cvt_pk_bf16(o[0], o[1]); w.y = cvt_pk_bf16(o[2], o[3]);
                    *(u32x2*)(YM + (size_t)r * D_MIX + 768 + oc) = w; } }
    }
};
struct EpiInProj {
    static constexpr bool PERM = true, AFTER_DRAIN = false;
    bf16_t* P; bf16_t* S5A; float* DTRAW;
    __device__ __forceinline__ void operator()(const f32x4 (&acc)[2][2][4][2], const Unit& u, int wr, int wc, int fr, int fq) const {
        const int row0 = u.pm * BM + wr * 64 + fr;
        if (u.pn == 9) { if (wc == 0 && fq == 0) {
#pragma unroll
                for (int ai = 0; ai < 2; ++ai)
#pragma unroll
                    for (int m = 0; m < 4; ++m) { float* d = DTRAW + (size_t)(row0 + ai * HALF + m * 16) * 8; *(f32x4*)d = acc[ai][0][m][0]; *(f32x4*)(d + 4) = acc[ai][0][m][1]; } }
            return; }
#pragma unroll
        for (int ai = 0; ai < 2; ++ai)
#pragma unroll
            for (int m = 0; m < 4; ++m) { const int r = row0 + ai * HALF + m * 16;
#pragma unroll
                for (int bj = 0; bj < 2; ++bj) { const f32x4 v0 = acc[ai][bj][m][0], v1 = acc[ai][bj][m][1];
                    u32x4 w; w.x = cvt_pk_bf16(v0[0], v0[1]); w.y = cvt_pk_bf16(v0[2], v0[3]); w.z = cvt_pk_bf16(v1[0], v1[1]); w.w = cvt_pk_bf16(v1[2], v1[3]);
                    const int cl = bj * HALF + wc * 32 + 8 * fq;
                    if (u.pn < 8) *(u32x4*)(P + (size_t)r * PLD + u.pn * BM + cl) = w;
                    else *(u32x4*)(S5A + ((size_t)(cl >> 4) * S5R + (r >> 4)) * 512 + (r & 15) * 16 + (cl & 15)) = w; } }
    }
};
struct BatchedOrder {
    int G, c;
    __device__ void init(int G_, int c_) { G = G_; c = c_; }
    __device__ bool next(int i, Unit& u) const { const int idx = i * G + (c + 16 * (S5R / 256)) % G;   if (idx >= 16 * (S5R / 256)) return false; u.pm = idx; u.pn = idx / (S5R / 256); return true; }
    __device__ __forceinline__ void a_ready(const Unit&) const {}
    __device__ __forceinline__ void done(const Unit&) const {}
};
constexpr int EX_OFF = MISC_OFF_ + 4096;
struct EpiGateUpM {
    static constexpr bool PERM = false, AFTER_DRAIN = false;
    bf16_t* ACT; const float* cw; const float* cb; float* EG; float* EU;
    __device__ __forceinline__ void operator()(const f32x4 (&acc)[2][2][4][2], const Unit& u, int wr, int wc, int fr_, int fq_) const {
        int fr = fr_, fq = fq_; asm volatile("" : "+v"(fr), "+v"(fq));
        extern __shared__ __attribute__((aligned(16))) unsigned char l_ex_[];
        PG8_LAS float* EXF = (PG8_LAS float*)((PG8_LAS unsigned char*)l_ex_ + EX_OFF); PG8_LAS float* EXL = EXF + 4 * 128;
        const int cl = wc * 32 + 4 * fq, lane = fq * 16 + fr, srcp = (lane & 48) | ((fr + 15) & 15), srcn = (lane & 48) | ((fr + 1) & 15);
#pragma unroll
        for (int ai = 0; ai < 2; ++ai) { const int blk = 2 * ai + wr;
#pragma unroll
            for (int n = 0; n < 2; ++n) {
                if (fr == 0) *(PG8_LAS f32x4*)(EXF + blk * 128 + cl + 16 * n) = acc[ai][0][0][n];
                if (fr == 15) *(PG8_LAS f32x4*)(EXL + blk * 128 + cl + 16 * n) = acc[ai][0][3][n]; } }
        asm volatile("s_waitcnt lgkmcnt(0)" ::: "memory"); __builtin_amdgcn_s_barrier(); asm volatile("" ::: "memory");
        const int c0 = u.pn * HALF + cl;
#pragma unroll
        for (int n = 0; n < 2; ++n) { const int c = c0 + 16 * n;
            const f32x4 w0 = *(const f32x4*)(cw + c), w1 = *(const f32x4*)(cw + D_FF + c), w2 = *(const f32x4*)(cw + 2 * D_FF + c), bb = *(const f32x4*)(cb + c);
#pragma unroll
            for (int ai = 0; ai < 2; ++ai) { const int blk = 2 * ai + wr;
                f32x4 eprev = (f32x4){0.f, 0.f, 0.f, 0.f}, enext = eprev;
                if (blk > 0) eprev = *(const PG8_LAS f32x4*)(EXL + (blk - 1) * 128 + cl + 16 * n);
                if (blk < 3) enext = *(const PG8_LAS f32x4*)(EXF + (blk + 1) * 128 + cl + 16 * n);
#pragma unroll
                for (int m = 0; m < 4; ++m) { const f32x4 g = acc[ai][0][m][n], up = acc[ai][1][m][n];
                    const f32x4 gm1 = acc[ai][0][m > 0 ? m - 1 : 0][n], gp1 = acc[ai][0][m < 3 ? m + 1 : 3][n]; f32x4 pv, nx;
#pragma unroll
                    for (int e = 0; e < 4; ++e) { pv[e] = __shfl(fr == 15 ? gm1[e] : g[e], srcp, 64); nx[e] = __shfl(fr == 0 ? gp1[e] : g[e], srcn, 64); }
                    if (fr == 0 && m == 0) pv = eprev;
                    if (fr == 15 && m == 3) nx = enext;
                    const f32x4 gc = bb + w0 * pv + w1 * g + w2 * nx; float o[4];
#pragma unroll
                    for (int e = 0; e < 4; ++e) o[e] = gc[e] * __builtin_amdgcn_rcpf(1.f + __expf(-gc[e])) * up[e];
                    typedef unsigned u32x2 __attribute__((ext_vector_type(2))); u32x2 w; w.x = cvt_pk_bf16(o[0], o[1]); w.y = cvt_pk_bf16(o[2], o[3]);
                    const int rl = ai * HALF + wr * 64 + m * 16 + fr;
                    *(u32x2*)(ACT + (size_t)(u.pm * BM + rl) * D_FF + c) = w;
                    if (rl < 2) { *(f32x4*)(EG + ((size_t)u.pm * 4 + rl) * D_FF + c) = g; if (rl == 0) *(f32x4*)(EU + ((size_t)u.pm * 2) * D_FF + c) = up; }
                    if (rl >= 254) { *(f32x4*)(EG + ((size_t)u.pm * 4 + rl - 252) * D_FF + c) = g; if (rl == 255) *(f32x4*)(EU + ((size_t)u.pm * 2 + 1) * D_FF + c) = up; } } } }
    }
};
struct TailSplitOrder {
    StaticOrder so; int G, c, ntk, nlat;
    __device__ void init(int K, int G_, int c_) { so.init(ML, D_MODEL, G_, c_); G = G_; c = c_; ntk = K / BK; nlat = (ML / BM) * (D_MODEL / BM); }
    __device__ bool next(int i, Unit& u) const {
        const int nl = c < nlat ? (nlat - c + G - 1) / G : 0;
        if (i < nl) { so.next(i, u); u.kb = 0; u.nt = 0; return true; }
        constexpr int NS = 4; const int j = (i - nl) * G + c; if (j >= 8 * NS) return false;
        const int tile = j / NS, sl = j % NS, per = ((ntk / NS) + 1) & ~1, k0 = sl * per;
        u.pm = ML / BM + tile / (D_MODEL / BM); u.pn = tile % (D_MODEL / BM); u.kb = k0 * BK * 2; u.nt = (sl == NS - 1) ? ntk - k0 : per; return true;
    }
    __device__ __forceinline__ void a_ready(const Unit&) const {}
    __device__ __forceinline__ void done(const Unit&) const {}
};
struct EpiS5E {
    static constexpr bool PERM = false, AFTER_DRAIN = false; float* E;
    __device__ __forceinline__ void operator()(const f32x4 (&acc)[2][2][4][2], const Unit& u, int wr, int wc, int fr, int fq) const {
        const int g = u.pn, sc0 = (u.pm - g * (S5R / 256)) * BM + wr * 64 + fr, col0 = wc * 32 + 4 * fq;
#pragma unroll
        for (int ai = 0; ai < 2; ++ai)
#pragma unroll
            for (int m = 0; m < 4; ++m) { const int sc = sc0 + ai * HALF + m * 16; if (sc < NSC) { float* e = E + ((size_t)g * NSC + sc) * 256 + col0;
#pragma unroll
                    for (int bj = 0; bj < 2; ++bj)
#pragma unroll
                        for (int n = 0; n < 2; ++n) *(f32x4*)(e + bj * HALF + n * 16) = acc[ai][bj][m][n]; } }
    }
};
struct EpiS5Y {
    static constexpr bool PERM = false, AFTER_DRAIN = false; bf16_t* P; int nsc;
    __device__ __forceinline__ void operator()(const f32x4 (&acc)[2][2][4][2], const Unit& u, int wr, int wc, int fr, int fq) const {
        const int g = u.pn, sc0 = (u.pm - g * (S5R / 256)) * BM + wr * 64 + fr, col0 = wc * 32 + 4 * fq;
        typedef unsigned u32x2 __attribute__((ext_vector_type(2)));
#pragma unroll
        for (int ai = 0; ai < 2; ++ai)
#pragma unroll
            for (int m = 0; m < 4; ++m) { const int sc = sc0 + ai * HALF + m * 16; if (sc < nsc) {
#pragma unroll
                    for (int bj = 0; bj < 2; ++bj)
#pragma unroll
                        for (int n = 0; n < 2; ++n) { const int ik = col0 + bj * HALF + n * 16; const f32x4 v = acc[ai][bj][m][n]; float o[4];
#pragma unroll
                            for (int e = 0; e < 4; ++e) { const float x = v[e], t = 0.7978845608028654f * (x + 0.044715f * x * x * x); o[e] = x / (1.f + __expf(-2.f * t)); }
                            u32x2 w; w.x = cvt_pk_bf16(o[0], o[1]); w.y = cvt_pk_bf16(o[2], o[3]);
                            *(u32x2*)(P + (size_t)(sc * 16 + (ik >> 4)) * PLD + YS5_OFF + g * 16 + (ik & 15)) = w; } } }
    }
};
}

__device__ __forceinline__ unsigned f2bf(float f) { unsigned u = __builtin_bit_cast(unsigned, f); return (u + 0x7fffu + ((u >> 16) & 1u)) >> 16; }
__device__ __forceinline__ unsigned pk2(float lo, float hi) { return f2bf(lo) | (f2bf(hi) << 16); }
typedef unsigned v4u __attribute__((ext_vector_type(4)));
__device__ __forceinline__ void transpose_item(const float* W, int ldw, int nblk, act_t* WT, int K, LAS float* scr, int item, int lane) {
    const int kb = item / nblk, nb = item % nblk, k0 = 64 * kb, n0 = 32 * nb;
#pragma unroll
    for (int i = 0; i < 32; ++i) { const int kk = 2 * i + (lane >> 5); scr[kk * 33 + (lane & 31)] = W[(size_t)(k0 + kk) * ldw + n0 + (lane & 31)]; }
    asm volatile("s_waitcnt lgkmcnt(0)" ::: "memory");
    const int c = lane & 7;
#pragma unroll
    for (int j = 0; j < 4; ++j) { const int n = (lane >> 3) + 8 * j; const LAS float* sp = scr + (8 * c) * 33 + n;
        v4u o; o.x = pk2(sp[0 * 33], sp[1 * 33]); o.y = pk2(sp[2 * 33], sp[3 * 33]); o.z = pk2(sp[4 * 33], sp[5 * 33]); o.w = pk2(sp[6 * 33], sp[7 * 33]);
        pg8::st_wt((pg8::u32x4*)(WT + (size_t)(n0 + n) * K + k0 + 8 * c), o); }
    asm volatile("s_waitcnt lgkmcnt(0)" ::: "memory");
}
__device__ __forceinline__ void st_wprep(const Prm& p, int L, LAS unsigned char* lds, int g0, int gs, int part) {
    const int tl_ = TID_();
    const int lane = tl_ & 63, wave = __builtin_amdgcn_readfirstlane(tl_ >> 6);
    LAS float* scr = (LAS float*)(lds + wave * 16384);
    int gw = BIDX_() * (NTHREADS_ / 64) + wave, NGW = GDIM_() * (NTHREADS_ / 64);
    constexpr int I_IN1 = (D_MODEL / 64) * (1024 / 32), I_IN3 = (D_MODEL / 64) * (256 / 32), I_IN = 2 * I_IN1 + I_IN3, I_OUT = (D_MIX / 64) * (D_MODEL / 32), I_G = (D_MODEL / 64) * (D_FF / 32), I_D = (D_FF / 64) * (D_MODEL / 32);
    constexpr int NIT = I_IN + I_OUT + 2 * I_G + I_D;
    if (part == 1 && GDIM_() == 256) { const int bx = BIDX_();
        if (bx < 128) { gw = bx * 8 + wave; NGW = NIT; } else { gw = 1024 + (bx - 128) * 8 + wave; NGW = 1024; } }
    const int it0 = part ? I_IN + gw : gw, it1 = part ? NIT : I_IN;
    for (int it = it0; it < it1; it += NGW) { int r = it;
        if (r < I_IN) { const float* W = p.in[I_WIN] + (size_t)L * D_MODEL * D_IN; act_t* WT = WSP(act_t, WS_WIN);
            if (r < I_IN1) transpose_item(W, D_IN, 1024 / 32, WT, D_MODEL, scr, r, lane);
            else if (r < 2 * I_IN1) transpose_item(W + 1032, D_IN, 1024 / 32, WT + (size_t)1024 * D_MODEL, D_MODEL, scr, r - I_IN1, lane);
            else transpose_item(W + 2056, D_IN, 256 / 32, WT + (size_t)2048 * D_MODEL, D_MODEL, scr, r - 2 * I_IN1, lane);
            continue; } r -= I_IN;
        if (r < I_OUT) { transpose_item(p.in[I_WOUT] + (size_t)L * D_MIX * D_MODEL, D_MODEL, D_MODEL / 32, WSP(act_t, WS_WOUT), D_MIX, scr, r, lane); continue; } r -= I_OUT;
        if (r < 2 * I_G) { const bool isup = r >= I_G; const int rr = isup ? r - I_G : r, n0 = 32 * (rr % (D_FF / 32)), drow = (n0 >> 7) * 256 + (n0 & 127) + (isup ? 128 : 0);
            transpose_item(p.in[isup ? I_WUP : I_WGATE] + (size_t)L * D_MODEL * D_FF, D_FF, D_FF / 32, WSP(act_t, WS_WG) + (ptrdiff_t)(drow - n0) * D_MODEL, D_MODEL, scr, rr, lane); continue; } r -= 2 * I_G;
        transpose_item(p.in[I_WDOWN] + (size_t)L * D_FF * D_MODEL, D_MODEL, D_MODEL / 32, WSP(act_t, WS_WD), D_FF, scr, r, lane); }
    if (part) return;
    { const float* W = p.in[I_WIN] + (size_t)L * D_MODEL * D_IN; act_t* WT = WSP(act_t, WS_WIN);
      for (int i = g0; i < (int)((NIN - 2304) * D_MODEL); i += gs) { const int n = 2304 + (int)(i / D_MODEL), k = (int)(i % D_MODEL); stf(WT + (size_t)n * D_MODEL + k, n < 2312 ? W[(size_t)k * D_IN + 1024 + (n - 2304)] : 0.f); } }
    { const float* W = p.in[I_WGLU] + (size_t)L * 256 * 512; act_t* WT = WSP(act_t, WS_WGLU);
      for (int i = g0; i < (int)(512L * 256); i += gs) { const int j = (int)(i / 256), k = (int)(i % 256); const int pn = j >> 8, half = (j >> 7) & 1, o = j & 127; stf(WT + i, W[(size_t)k * 512 + half * 256 + 128 * pn + o]); } }
}
#include <hip/hip_bf16.h>
#include <cmath>
namespace attn_body {
using bf16=__hip_bfloat16;
using bf16x8=__attribute__((ext_vector_type(8)))short;
using s16x4=__attribute__((ext_vector_type(4)))short;
using f32x16=__attribute__((ext_vector_type(16)))float;
using u32x4=__attribute__((ext_vector_type(4)))unsigned;
constexpr int D=64,QKVP=PLD,OP=D_MIX;
constexpr int NW=8,QBLK=32,QB=QBLK*NW,KVBLK=64;
__device__ __forceinline__ int crow(int r,int hi){return (r&3)+8*(r>>2)+4*hi;}
#define SBAR() __builtin_amdgcn_sched_barrier(0)
__device__ __forceinline__ void wmask(f32x16&p0,f32x16&p1,int kbase,int qpos,int hi){
  const float NEG=-INFINITY; const int d0=kbase+4*hi-qpos;
  #pragma unroll
  for(int r=0;r<16;++r){const int dd=d0+(r&3)+8*(r>>2); if(dd<-128||dd>128)p0[r]=NEG; if(dd+32<-128||dd+32>128)p1[r]=NEG;}
}
constexpr int NSLOT=3, SLOTB=8192;
constexpr int LDS_K=0, LDS_V=NSLOT*SLOTB, LDS_WS=2*NSLOT*SLOTB, LDS_OST=LDS_WS+NW*64*4, LDS_BYTES=LDS_OST+NW*4096;
constexpr float C2=0.125f*1.4426950408889634f;
__device__ __forceinline__ void glds16(const void*gsrc,unsigned lds_dst){unsigned keep;
  asm volatile("s_mov_b32 %0, m0\n\ts_mov_b32 m0, %2\n\ts_nop 0\n\tglobal_load_lds_dwordx4 %1, off\n\ts_mov_b32 m0, %0":"=&s"(keep):"v"(gsrc),"s"(lds_dst):"memory");}
__device__ __forceinline__ float max3f(float a,float b,float c){float r;asm("v_max3_f32 %0, %1, %2, %3":"=v"(r):"v"(a),"v"(b),"v"(c));return r;}
__device__ __forceinline__ float max2f(float a,float b){float r;asm("v_max_f32_e32 %0, %1, %2":"=v"(r):"v"(a),"v"(b));return r;}
__device__ __forceinline__ float fadd_s(float a,float b){float r;asm("v_add_f32_e32 %0, %1, %2":"=v"(r):"v"(a),"v"(b));return r;}
__device__ __forceinline__ float fsub_s(float a,float b){float r;asm("v_sub_f32_e32 %0, %1, %2":"=v"(r):"v"(a),"v"(b));return r;}
typedef float f32x2_t __attribute__((ext_vector_type(2))); typedef __bf16 bf16x2_t __attribute__((ext_vector_type(2)));
__device__ __forceinline__ unsigned cvtpk_s(float lo,float hi){f32x2_t v={lo,hi};bf16x2_t b=__builtin_convertvector(v,bf16x2_t);return __builtin_bit_cast(unsigned,b);}
#define WAIT_BAR(N) asm volatile("s_waitcnt vmcnt(" #N ") lgkmcnt(0)\n\ts_barrier":::"memory")

__device__ __forceinline__ void qkt(f32x16&p0,f32x16&p1,const char*Kslot,const bf16x8*qr,const f32x16&negm,int r32,int hi){
  const char*kb=Kslot+hi*1024+r32*16;
  #pragma unroll
  for(int d0=0;d0<4;++d0){
    const bf16x8 b0=*reinterpret_cast<const bf16x8*>(kb+d0*2048);
    const bf16x8 b1=*reinterpret_cast<const bf16x8*>(kb+d0*2048+512);
    if(d0==0){p0=__builtin_amdgcn_mfma_f32_32x32x16_bf16(b0,qr[0],negm,0,0,0);p1=__builtin_amdgcn_mfma_f32_32x32x16_bf16(b1,qr[0],negm,0,0,0);}
    else{p0=__builtin_amdgcn_mfma_f32_32x32x16_bf16(b0,qr[d0],p0,0,0,0);p1=__builtin_amdgcn_mfma_f32_32x32x16_bf16(b1,qr[d0],p1,0,0,0);}}
}
typedef __attribute__((address_space(3))) const char* lds_cptr;
typedef short v4i16_t __attribute__((ext_vector_type(4)));
__device__ __forceinline__ void kload8(bf16x8*kf,lds_cptr kp){
  kf[0]=*(const __attribute__((address_space(3))) bf16x8*)(kp);      kf[1]=*(const __attribute__((address_space(3))) bf16x8*)(kp+512);
  kf[2]=*(const __attribute__((address_space(3))) bf16x8*)(kp+2048); kf[3]=*(const __attribute__((address_space(3))) bf16x8*)(kp+2560);
  kf[4]=*(const __attribute__((address_space(3))) bf16x8*)(kp+4096); kf[5]=*(const __attribute__((address_space(3))) bf16x8*)(kp+4608);
  kf[6]=*(const __attribute__((address_space(3))) bf16x8*)(kp+6144); kf[7]=*(const __attribute__((address_space(3))) bf16x8*)(kp+6656);
}
__device__ __forceinline__ void kload2(bf16x8*kf,lds_cptr kp,int j){ kf[2*j]=*(const __attribute__((address_space(3))) bf16x8*)(kp+j*2048); kf[2*j+1]=*(const __attribute__((address_space(3))) bf16x8*)(kp+j*2048+512); }
__device__ __forceinline__ s16x4 vtr(lds_cptr p){ return __builtin_bit_cast(s16x4,__builtin_amdgcn_ds_read_tr16_b64_v4i16((__attribute__((address_space(3))) v4i16_t*)p)); }
__device__ __forceinline__ float rowmax(const f32x16&p0,const f32x16&p1){
  float a=max3f(p0[0],p0[1],p1[0]),b=max3f(p0[2],p0[3],p1[1]);a=max3f(a,p1[2],p1[3]);
  #pragma unroll
  for(int r=4;r<16;r+=4){a=max3f(a,p0[r],p0[r+1]);b=max3f(b,p0[r+2],p0[r+3]);a=max3f(a,p1[r],p1[r+1]);b=max3f(b,p1[r+2],p1[r+3]);}
  const float m=max2f(a,b);
  auto rr=__builtin_amdgcn_permlane32_swap(__float_as_uint(m),__float_as_uint(m),false,false);
  return max2f(__uint_as_float(rr[0]),__uint_as_float(rr[1]));
}
__device__ __forceinline__ void pv(f32x16*o,int vb,bf16x8 pa0,bf16x8 pa1,bf16x8 pa2,bf16x8 pa3){
  #pragma unroll
  for(int d0=0;d0<2;++d0){s16x4 lo[4],hi[4];
    #pragma unroll
    for(int ks=0;ks<4;++ks){
      asm volatile("ds_read_b64_tr_b16 %0,%1 offset:%c2":"=&v"(lo[ks]):"v"(vb),"i"(d0*4096+ks*1024):"memory");
      asm volatile("ds_read_b64_tr_b16 %0,%1 offset:%c2":"=&v"(hi[ks]):"v"(vb),"i"(d0*4096+ks*1024+512):"memory");}
    asm volatile("s_waitcnt lgkmcnt(0)":::"memory");SBAR();
    #define PK(k) (bf16x8){lo[k][0],lo[k][1],lo[k][2],lo[k][3],hi[k][0],hi[k][1],hi[k][2],hi[k][3]}
    o[d0]=__builtin_amdgcn_mfma_f32_32x32x16_bf16(pa0,PK(0),o[d0],0,0,0);
    o[d0]=__builtin_amdgcn_mfma_f32_32x32x16_bf16(pa1,PK(1),o[d0],0,0,0);
    o[d0]=__builtin_amdgcn_mfma_f32_32x32x16_bf16(pa2,PK(2),o[d0],0,0,0);
    o[d0]=__builtin_amdgcn_mfma_f32_32x32x16_bf16(pa3,PK(3),o[d0],0,0,0);
    #undef PK
  }
}

#ifndef ATTN_STORE16
#define ATTN_STORE16(p,v) (*(u32x4*)(p)=(v))
#endif
template<int THRL,bool WIN> __device__ __forceinline__ void attn_unit(const bf16*Pm,int qrow0,int qoff,int koff,int voff,int ctx0,int lat0,int NT,int qpos0,int kpos0,float sinkl2,bf16*Ob,char*shm){
  const int tid=TID_(),lane=tid&63,r32=lane&31,hi=lane>>5; const int wid=__builtin_amdgcn_readfirstlane(tid>>6);
  const bf16*Qw=Pm+(long)(qrow0+wid*QBLK)*QKVP+qoff;
  const unsigned lds0=(unsigned)(uintptr_t)shm;
  float*wsf=(float*)(shm+LDS_WS)+wid*64;
  const bf16*ksrc=Pm+(long)lane*QKVP+koff+wid*8;
  const bf16*vsrc=Pm+(long)(16*(wid&3)+(lane>>2))*QKVP+voff+(wid>>2)*32+(lane&3)*8;
  #define KROW(t) ((t)<4?ctx0+64*(t):lat0+64*((t)-4))
  const unsigned kdst=lds0+LDS_K+wid*1024, vdst=lds0+LDS_V+wid*1024;
  #define DMA_K(t,slot) glds16(ksrc+(long)KROW(t)*QKVP,(unsigned)__builtin_amdgcn_readfirstlane(kdst+(slot)))
  #define DMA_V(t,slot) glds16(vsrc+(long)KROW(t)*QKVP,(unsigned)__builtin_amdgcn_readfirstlane(vdst+(slot)))
  const int vb0=(int)(lds0+LDS_V)+((lane>>4)&1)*32+(lane&3)*8+(4*hi+((lane&15)>>2))*64;
  const char*Kbase=shm+LDS_K; bf16x8 kf[8];
  const lds_cptr shm3=(lds_cptr)shm; const lds_cptr kp0=shm3+LDS_K+hi*1024+r32*16; const lds_cptr vp0=shm3+LDS_V+((lane>>4)&1)*32+(lane&3)*8+(4*hi+((lane&15)>>2))*64;
  DMA_K(0,0);DMA_V(0,0);DMA_K(1,SLOTB);
  bf16x8 qr[4];
  #pragma unroll
  for(int d0=0;d0<4;++d0)qr[d0]=*reinterpret_cast<const bf16x8*>(&Qw[(long)r32*QKVP+d0*16+hi*8]);
  float mhat=0.f,l_reg=0.f;f32x16 o[2];o[0]=f32x16{};o[1]=f32x16{};f32x16 negm=f32x16{};asm volatile("":"+v"(negm));
  const int qpos=qpos0+wid*QBLK+r32;
  #define CMASK(P0,P1,t) do{ if(WIN){ if((t)>=4) wmask(P0,P1,kpos0+64*((t)-4),qpos,hi); } }while(0)
  bool resc=false;
  #define START(P0,P1) do{ const float rm=rowmax(P0,P1); resc=false; \
    { const float dl=rm; mhat=fadd_s(mhat,dl); \
      _Pragma("unroll") for(int r=0;r<16;++r){P0[r]=fsub_s(P0[r],dl);P1[r]=fsub_s(P1[r],dl);} \
      _Pragma("unroll") for(int r=0;r<16;++r)negm[r]=-mhat; asm volatile("":"+v"(negm)); } \
    _Pragma("unroll") for(int r=0;r<16;++r)P0[r]=__builtin_amdgcn_exp2f(P0[r]); }while(0)
  #define RESC() do{ if(resc){ asm volatile("s_waitcnt lgkmcnt(0)":::"memory"); \
      _Pragma("unroll") for(int d_=0;d_<2;++d_) _Pragma("unroll") for(int r=0;r<16;++r)o[d_][r]*=wsf[crow(r,hi)]; } }while(0)
  f32x16 pA0,pA1,pB0,pB1;
  int sl_prev=0,sl_cur=0,sl_next=SLOTB;
  #define ROT() do{sl_prev=sl_cur;sl_cur=sl_next;sl_next=(sl_next==(NSLOT-1)*SLOTB)?0:sl_next+SLOTB;}while(0)
  DMA_K(2,2*SLOTB);
  WAIT_BAR(3);
  qkt(pA0,pA1,Kbase,qr,negm,r32,hi);asm volatile("s_nop 15\n\ts_nop 7":"+v"(pA0),"+v"(pA1));CMASK(pA0,pA1,0);
  START(pA0,pA1);
  _Pragma("unroll") for(int r=0;r<16;++r)pA1[r]=__builtin_amdgcn_exp2f(pA1[r]);
  WAIT_BAR(0);
  DMA_K(3,0);DMA_V(1,SLOTB);
  ROT();
  kload8(kf,kp0+sl_cur);
  WAIT_BAR(2);
  s16x4 vlo[8],vhi[8]; u32x4 pw0,pw1,pw2,pw3;
  #define PKW(P,B) cvtpk_s(P[B],P[B+1])
  #define PAF(k) __builtin_bit_cast(bf16x8,pw##k)
  #define VFR(i) (bf16x8){vlo[i][0],vlo[i][1],vlo[i][2],vlo[i][3],vhi[i][0],vhi[i][1],vhi[i][2],vhi[i][3]}
  #define PIN(x) asm volatile("":"+v"(x))
  #define MX3(a,b,c) __builtin_fmaxf(__builtin_fmaxf((a),(b)),(c))
  #define GAPA(MF,A0,A1,A2,A3,W0,W1,PW) do{ MF; sacc+=A0; sacc+=A1; sacc+=A2; sacc+=A3; PIN(sacc); W0; W1; PIN(PW); SBAR(); }while(0)
  #define EX(v) __builtin_amdgcn_exp2f(v)
  #define GAPB(MF,X,B) do{ MF; X[B]=EX(X[B]); X[B+1]=EX(X[B+1]); X[B+2]=EX(X[B+2]); X[B+3]=EX(X[B+3]); PIN(X); SBAR(); }while(0)
  #define VRD(i) do{ vlo[i]=vtr(vp_+(((i)>>2)*4096+((i)&3)*1024)); vhi[i]=vtr(vp_+(((i)>>2)*4096+((i)&3)*1024+512)); }while(0)
  #define KRD(G,j) do{ if(G){ kload2(kf,kp0+sl_next,j); SBAR(); } }while(0)
  #define STEP(C0,C1,P0,P1,t,GK,GV,GL) do{ SBAR(); \
    const lds_cptr vp_=vp0+sl_prev; \
    VRD(0); SBAR(); float sacc=(P0[0]+P0[1]); \
    GAPA(C0=__builtin_amdgcn_mfma_f32_32x32x16_bf16(kf[0],qr[0],negm,0,0,0), P0[2],P0[3],P0[4],P0[5],     pw0[0]=PKW(P0,0), pw0[1]=PKW(P0,2), pw0); \
    VRD(4); SBAR(); GAPA(C1=__builtin_amdgcn_mfma_f32_32x32x16_bf16(kf[1],qr[0],negm,0,0,0), P0[6],P0[7],P0[8],P0[9],     pw0[2]=PKW(P0,4), pw0[3]=PKW(P0,6), pw0); \
    VRD(1); SBAR(); GAPA(C0=__builtin_amdgcn_mfma_f32_32x32x16_bf16(kf[2],qr[1],C0,0,0,0),   P0[10],P0[11],P0[12],P0[13], pw1[0]=PKW(P0,8), pw1[1]=PKW(P0,10), pw1); \
    VRD(5); SBAR(); GAPA(C1=__builtin_amdgcn_mfma_f32_32x32x16_bf16(kf[3],qr[1],C1,0,0,0),   P0[14],P0[15],P1[0],P1[1],   pw1[2]=PKW(P0,12),pw1[3]=PKW(P0,14), pw1); \
    VRD(2); SBAR(); GAPA(C0=__builtin_amdgcn_mfma_f32_32x32x16_bf16(kf[4],qr[2],C0,0,0,0),   P1[2],P1[3],P1[4],P1[5],     pw2[0]=PKW(P1,0), pw2[1]=PKW(P1,2), pw2); \
    VRD(6); SBAR(); GAPA(C1=__builtin_amdgcn_mfma_f32_32x32x16_bf16(kf[5],qr[2],C1,0,0,0),   P1[6],P1[7],P1[8],P1[9],     pw2[2]=PKW(P1,4), pw2[3]=PKW(P1,6), pw2); \
    VRD(3); SBAR(); GAPA(C0=__builtin_amdgcn_mfma_f32_32x32x16_bf16(kf[6],qr[3],C0,0,0,0),   P1[10],P1[11],P1[12],P1[13], pw3[0]=PKW(P1,8), pw3[1]=PKW(P1,10), pw3); \
    VRD(7); SBAR(); GAPA(C1=__builtin_amdgcn_mfma_f32_32x32x16_bf16(kf[7],qr[3],C1,0,0,0),   P1[14],P1[15],0.f,0.f,       pw3[2]=PKW(P1,12),pw3[3]=PKW(P1,14), pw3); \
    l_reg+=sacc; \
    if(GK){DMA_K((t)+3,sl_cur);} if(GV){DMA_V((t)+1,sl_next);} \
    CMASK(C0,C1,t); \
    { float a=MX3(C0[0],C0[1],C1[0]),b=MX3(C0[2],C0[3],C1[1]); a=MX3(a,C1[2],C1[3]); \
      _Pragma("unroll") for(int r=4;r<16;r+=4){a=MX3(a,C0[r],C0[r+1]);b=MX3(b,C0[r+2],C0[r+3]);a=MX3(a,C1[r],C1[r+1]);b=MX3(b,C1[r+2],C1[r+3]);} \
      float rm=__builtin_fmaxf(a,b); { auto rr=__builtin_amdgcn_permlane32_swap(__float_as_uint(rm),__float_as_uint(rm),false,false); rm=__builtin_fmaxf(__uint_as_float(rr[0]),__uint_as_float(rr[1])); } \
      resc=false; \
      if(__builtin_expect(__any(rm>(float)THRL),0)){ const float dl=__builtin_fmaxf(rm,0.f); mhat+=dl; \
        _Pragma("unroll") for(int r=0;r<16;++r){C0[r]-=dl;C1[r]-=dl;} \
        _Pragma("unroll") for(int r=0;r<16;++r)negm[r]=-mhat; asm volatile("":"+v"(negm)); \
        const float f=__builtin_amdgcn_exp2f(-dl); l_reg*=f; if(hi==0)wsf[r32]=f; resc=true; } } \
    SBAR(); \
    GAPB(o[0]=__builtin_amdgcn_mfma_f32_32x32x16_bf16(PAF(0),VFR(0),o[0],0,0,0), C0,0); \
    GAPB(o[1]=__builtin_amdgcn_mfma_f32_32x32x16_bf16(PAF(0),VFR(4),o[1],0,0,0), C0,4); \
    KRD(GL,0); GAPB(o[0]=__builtin_amdgcn_mfma_f32_32x32x16_bf16(PAF(1),VFR(1),o[0],0,0,0), C0,8); \
    KRD(GL,1); GAPB(o[1]=__builtin_amdgcn_mfma_f32_32x32x16_bf16(PAF(1),VFR(5),o[1],0,0,0), C0,12); \
    KRD(GL,2); GAPB(o[0]=__builtin_amdgcn_mfma_f32_32x32x16_bf16(PAF(2),VFR(2),o[0],0,0,0), C1,0); \
    KRD(GL,3); GAPB(o[1]=__builtin_amdgcn_mfma_f32_32x32x16_bf16(PAF(2),VFR(6),o[1],0,0,0), C1,4); \
    GAPB(o[0]=__builtin_amdgcn_mfma_f32_32x32x16_bf16(PAF(3),VFR(3),o[0],0,0,0), C1,8); \
    GAPB(o[1]=__builtin_amdgcn_mfma_f32_32x32x16_bf16(PAF(3),VFR(7),o[1],0,0,0), C1,12); \
    }while(0)
  int t=1;
  for(;t+5<NT;t+=2){
    STEP(pB0,pB1,pA0,pA1,t,true,true,true);     WAIT_BAR(2); RESC(); ROT();
    STEP(pA0,pA1,pB0,pB1,t+1,true,true,true);   WAIT_BAR(2); RESC(); ROT();
  }
  #define ENDW(tt) do{ if((tt)+3<NT){WAIT_BAR(2);} else if((tt)+2<NT){WAIT_BAR(1);} else {WAIT_BAR(0);} }while(0)
  for(;t+1<NT;t+=2){
    STEP(pB0,pB1,pA0,pA1,t,(t+3<NT),(t+1<NT),(t+1<NT));       ENDW(t);   RESC(); ROT();
    STEP(pA0,pA1,pB0,pB1,t+1,(t+4<NT),(t+2<NT),(t+2<NT));     ENDW(t+1); RESC(); ROT();
  }
  STEP(pB0,pB1,pA0,pA1,NT-1,false,false,false); RESC();
  { float sacc=pB0[0]+pB0[1]; _Pragma("unroll") for(int r=2;r<16;++r)sacc+=pB0[r]; _Pragma("unroll") for(int r=0;r<16;++r)sacc+=pB1[r]; l_reg+=sacc;
    pw0=(u32x4){PKW(pB0,0),PKW(pB0,2),PKW(pB0,4),PKW(pB0,6)};pw1=(u32x4){PKW(pB0,8),PKW(pB0,10),PKW(pB0,12),PKW(pB0,14)};pw2=(u32x4){PKW(pB1,0),PKW(pB1,2),PKW(pB1,4),PKW(pB1,6)};pw3=(u32x4){PKW(pB1,8),PKW(pB1,10),PKW(pB1,12),PKW(pB1,14)};
    SBAR(); pv(o,vb0+sl_cur,PAF(0),PAF(1),PAF(2),PAF(3)); }
  #undef PKW
  #undef PAF
  #undef VFR
  #undef PIN
  #undef MX3
  #undef GAPA
  #undef GAPB
  #undef EX
  #undef VRD
  #undef KRD
  #undef STEP
  #undef ENDW
  {auto rr=__builtin_amdgcn_permlane32_swap(__float_as_uint(l_reg),__float_as_uint(l_reg),false,false);l_reg=__uint_as_float(rr[0])+__uint_as_float(rr[1]);}
  if(WIN)l_reg+=__builtin_amdgcn_exp2f(sinkl2-mhat);
  if(hi==0)wsf[32+r32]=l_reg;asm volatile("s_waitcnt lgkmcnt(0)":::"memory");
  float rli[16];
  #pragma unroll
  for(int r=0;r<16;++r)rli[r]=__builtin_amdgcn_rcpf(wsf[32+crow(r,hi)]);
  bf16*Ow=Ob+(long)(wid*QBLK)*OP;
  { bf16*stg=(bf16*)(shm+LDS_OST)+wid*2048;
    #pragma unroll
    for(int r=0;r<16;++r){const int orow=crow(r,hi);
      #pragma unroll
      for(int d0=0;d0<2;++d0)stg[orow*64+d0*32+r32]=__float2bfloat16(o[d0][r]*rli[r]);}
    asm volatile("s_waitcnt lgkmcnt(0)":::"memory");
    #pragma unroll
    for(int i=0;i<4;++i){const int row=i*8+(lane>>3),ch=lane&7; const u32x4 v=*(const u32x4*)(stg+row*64+ch*8); ATTN_STORE16(Ow+(long)row*OP+ch*8,v);} }
  asm volatile("s_waitcnt lgkmcnt(0)\n\ts_barrier":::"memory");
  #undef DMA_K
  #undef DMA_V
  #undef KROW
  #undef CMASK
  #undef START
  #undef RESC
  #undef ROT
}
constexpr int ATTN_LDS_BYTES=LDS_BYTES;
#undef SBAR
#undef WAIT_BAR
}

__device__ __forceinline__ void st_attn_mfma(const Prm& p, int L, int mode, char* shm) {
    using namespace attn_body;
    const bf16* Pm = (const bf16*)(p.ws + WS_P); bf16* YM = (bf16*)(p.ws + WS_YMIX);
    const int G = GDIM_(), bx = BIDX_(); const int vcu = (G % 8 == 0) ? (bx % 8) * (G / 8) + bx / 8 : bx;
    const int cu0 = G >= MT / 128 + 16 ? MT / 128 : 0, nmain = 512;
    int u0 = vcu, u1 = nmain, us = G; if (mode) { if (bx < cu0 || bx >= cu0 + 16) return; u0 = nmain + (bx - cu0); u1 = nmain + 16; us = 16; }
    for (int u = u0; u < u1; u += us) {
        int isw, b, hq, qrow0, ctx0, lat0, NT, qpos0 = 0, kpos0 = 0, orow0;
        if (u < 512) { const int v = u & 255, qb = v & 31; isw = u >> 8; b = v >> 7; hq = (v >> 5) & 3; qrow0 = b * SEQ + qb * 256; orow0 = qrow0; ctx0 = ML + b * CTX_LEN;
            if (!isw) { lat0 = b * SEQ; NT = 4 + SEQ / 64; }
            else { const int lt0 = 4 * qb - 2 < 0 ? 0 : 4 * qb - 2, lt1 = 4 * qb + 6 > SEQ / 64 ? SEQ / 64 : 4 * qb + 6; lat0 = b * SEQ + 64 * lt0; NT = 4 + lt1 - lt0; qpos0 = qb * 256; kpos0 = 64 * lt0; } }
        else { const int v = u - 512; isw = v >> 3; b = (v >> 2) & 1; hq = v & 3; qrow0 = ML + b * CTX_LEN; orow0 = qrow0; ctx0 = qrow0; lat0 = 0; NT = 4; }
        const int kv = hq >> 1;
        bf16* Ob = YM + (size_t)orow0 * D_MIX + (isw ? 512 : 256) + hq * 64;
        if (isw) attn_unit<8, true>(Pm, qrow0, WAQ + hq * 64, WAK + kv * 64, WAV + kv * 64, ctx0, lat0, NT, qpos0, kpos0, p.in[I_SINK][L * 4 + hq] * 1.4426950408889634f, Ob, shm);
        else attn_unit<8, false>(Pm, qrow0, GAQ + hq * 64, GAK + kv * 64, GAV + kv * 64, ctx0, lat0, NT, 0, 0, 0.f, Ob, shm);
    }
}

typedef float f32x4_t __attribute__((ext_vector_type(4)));
typedef unsigned u32x2_t __attribute__((ext_vector_type(2)));
__device__ __forceinline__ float wave_sum_(float v) {
#pragma unroll
    for (int o = 1; o < 64; o <<= 1) v += __shfl_xor(v, o);
    return v;
}
__device__ __forceinline__ int wave_id_() { const int t = TID_(); return BIDX_() * (NTHREADS_ / 64) + __builtin_amdgcn_readfirstlane(t >> 6); }
__device__ __forceinline__ int lane_id_() { unsigned m_ = ~0u; asm volatile("" : "+s"(m_)); return (int)__builtin_amdgcn_mbcnt_hi(m_, __builtin_amdgcn_mbcnt_lo(m_, 0u)); }
__device__ __forceinline__ const float* xsrc_(const Prm& p, int r, bool from_input) { return from_input ? (r < ML ? p.in[I_X] + (size_t)r * D_MODEL : p.in[I_CTX] + (size_t)(r - ML) * D_MODEL) : xrow(p, r); }
#define JX_(j) (128 * ((j) >> 1) + ((j) & 1))
__device__ __forceinline__ void st_norm_fused(const Prm& p, int L, int which, int nrows, const float* pend) {
    const int lane = lane_id_(), NGW = GDIM_() * (NTHREADS_ / 64); act_t* xn = WSP(act_t, WS_XN);
    const float* gw = p.in[which ? I_GFFN : I_GMIX] + (size_t)L * D_MODEL;
    for (int r = wave_id_(); r < nrows; r += NGW) {
        const f32x4_t* xr = (const f32x4_t*)xsrc_(p, r, L == 0 && which == 0) + 2 * lane; const int modrow = r < ML ? r / SEQ : BATCH;
        const f32x4_t* sh = (const f32x4_t*)modp(p, L, modrow, which ? 3 : 0) + 2 * lane; const f32x4_t* sc = (const f32x4_t*)modp(p, L, modrow, which ? 4 : 1) + 2 * lane; const f32x4_t* gp = (const f32x4_t*)gw + 2 * lane;
        f32x4_t v[D_MODEL / 256]; float ss = 0.f;
#pragma unroll
        for (int j = 0; j < D_MODEL / 256; ++j) v[j] = xr[JX_(j)];
        if (pend && r >= ML) { const f32x4_t* sl = (const f32x4_t*)(WSP(float, WS_SLAB) + (size_t)(r - ML) * D_MODEL) + 2 * lane; const f32x4_t* pg = (const f32x4_t*)pend + 2 * lane; f32x4_t* xw = (f32x4_t*)xrow(p, r) + 2 * lane;
#pragma unroll
            for (int j = 0; j < D_MODEL / 256; ++j) { const f32x4_t t = (sl[JX_(j)] + sl[JX_(j) + (size_t)MC * D_MODEL / 4]) + (sl[JX_(j) + (size_t)2 * MC * D_MODEL / 4] + sl[JX_(j) + (size_t)3 * MC * D_MODEL / 4]); v[j] = v[j] + pg[JX_(j)] * t; xw[JX_(j)] = v[j]; } }
#pragma unroll
        for (int j = 0; j < D_MODEL / 256; ++j) ss += (v[j].x * v[j].x + v[j].y * v[j].y) + (v[j].z * v[j].z + v[j].w * v[j].w);
        const float rs = 1.0f / sqrtf(wave_sum_(ss) * (1.0f / D_MODEL) + NORM_EPS);
        pg8::u32x4* o16 = (pg8::u32x4*)(xn + (size_t)r * D_MODEL) + lane;
#pragma unroll
        for (int jj = 0; jj < D_MODEL / 512; ++jj) { pg8::u32x4 w;
#pragma unroll
            for (int h = 0; h < 2; ++h) { const int j = 2 * jj + h; const f32x4_t g4 = gp[JX_(j)], s4 = sc[JX_(j)], h4 = sh[JX_(j)]; const f32x4_t y = v[j] * rs * g4 * (s4 + 1.0f) + h4; w[2 * h] = pk2(y.x, y.y); w[2 * h + 1] = pk2(y.z, y.w); }
            pg8::st_wt(o16 + 64 * jj, w); }
    }
}
#undef JX_
__device__ __forceinline__ void st_final_fused(const Prm& p) {
    const int lane = lane_id_(), NGW = GDIM_() * (NTHREADS_ / 64); const f32x4_t* gp = (const f32x4_t*)p.in[I_GFIN] + lane;
    for (int r = wave_id_(); r < ML; r += NGW) { f32x4_t* xr = (f32x4_t*)(p.out + (size_t)r * D_MODEL) + lane; f32x4_t v[D_MODEL / 256]; float ss = 0.f;
#pragma unroll
        for (int j = 0; j < D_MODEL / 256; ++j) { v[j] = xr[64 * j]; ss += (v[j].x * v[j].x + v[j].y * v[j].y) + (v[j].z * v[j].z + v[j].w * v[j].w); }
        const float rs = 1.0f / sqrtf(wave_sum_(ss) * (1.0f / D_MODEL) + NORM_EPS);
#pragma unroll
        for (int j = 0; j < D_MODEL / 256; ++j) xr[64 * j] = v[j] * rs * gp[64 * j]; }
}
__device__ __forceinline__ void unpack4_(const u32x2_t v, float* o) { o[0] = __uint_as_float(v.x << 16); o[1] = __uint_as_float(v.x & 0xffff0000u); o[2] = __uint_as_float(v.y << 16); o[3] = __uint_as_float(v.y & 0xffff0000u); }
__device__ __forceinline__ void st_ssd_out_w(const Prm& p, int L, int nrows) {
    const int lane = lane_id_(), NGW = GDIM_() * (NTHREADS_ / 64); const act_t* P = WSP(act_t, WS_P); act_t* ym = WSP(act_t, WS_YMIX);
    const f32x4_t g4 = *((const f32x4_t*)(p.in[I_SNG] + L * 256) + lane);
    for (int r = wave_id_(); r < nrows; r += NGW) { float y[4], z[4];
        unpack4_(*((const u32x2_t*)(P + (size_t)r * PLD + YSSD_OFF) + lane), y); unpack4_(*((const u32x2_t*)(P + (size_t)r * PLD + Z_OFF) + lane), z);
        float v[4], ss = 0.f;
#pragma unroll
        for (int e = 0; e < 4; ++e) { v[e] = y[e] * z[e] / (1.f + __expf(-z[e])); ss += v[e] * v[e]; }
        const float rn = 1.0f / sqrtf(wave_sum_(ss) * (1.f / 256.f) + NORM_EPS);
        u32x2_t w; w.x = pk2(v[0] * rn * g4.x, v[1] * rn * g4.y); w.y = pk2(v[2] * rn * g4.z, v[3] * rn * g4.w);
        *((u32x2_t*)(ym + (size_t)r * D_MIX) + lane) = w; }
}
__device__ __forceinline__ void st_ssd_cs_w(const Prm& p, int L) {
    const int lane = lane_id_(), NGW = GDIM_() * (NTHREADS_ / 64); const act_t* P = WSP(act_t, WS_P); float* DT = WSP(float, WS_DT); float* CS = WSP(float, WS_CS);
    for (int it = wave_id_(); it < NCH * 8; it += NGW) { const int dh = it & 7, c = it >> 3, d = dh >> 2;
        const float a = -expf(p.in[I_SALOG][L * 8 + dh]), bias = p.in[I_SDTB][L * 8 + dh];
        const size_t r0 = (size_t)c * 128 + lane, r1 = r0 + 64;
        const float* dtr = WSP(float, WS_DTRAW); const float dt0 = softplusf_(dtr[r0 * 8 + dh] + bias), dt1 = softplusf_(dtr[r1 * 8 + dh] + bias);
        float s0 = dt0 * a, s1 = dt1 * a; const float a0 = s0, a1 = s1;
#pragma unroll
        for (int o = 1; o < 64; o <<= 1) { const float t0 = __shfl_up(s0, o), t1 = __shfl_up(s1, o); if (lane >= o) { s0 += t0; s1 += t1; } }
        const float tot0 = __shfl(s0, 63); s1 += tot0; const float tot = __shfl(s1, 63);
        DT[r0 * 8 + dh] = dt0; DT[r1 * 8 + dh] = dt1;
        CS[r0 * 8 + dh] = d ? tot - s0 + a0 : s0; CS[r1 * 8 + dh] = d ? tot - s1 + a1 : s1; }
}
__device__ __forceinline__ void st_s5tabB_v(const Prm& p, int layer, int g0, int gs) {
    typedef float f32x2_t __attribute__((ext_vector_type(2)));
    const float* lamp = WSP(float, WS_LAMP) + (size_t)layer * 2 * 16 * 64 * 17 * 2; const float* bbar = WSP(float, WS_BBAR) + (size_t)layer * 2 * 16 * 64 * 16 * 2; const float* kt = WSP(float, WS_KT) + (size_t)layer * 2 * 16 * 16 * 256;
    act_t* BY = WSP(act_t, WS_S5BY); act_t* BE = WSP(act_t, WS_S5BE);
    constexpr int NBY = 16 * 256 * 512 / 8, NBE = 16 * 256 * 256 / 8;
    for (int it = g0; it < NBY + NBE; it += gs) { float v[8]; act_t* dst;
        if (it < NBY) { const int idx = it * 8, q = idx & 511, ik = (idx >> 9) & 255, g = idx >> 17, i = ik >> 4, k = ik & 15; dst = BY + idx;
            if (q < 256) { const int j = q >> 4, kp0 = q & 15;
                if (j != i) { const float* s0 = kt + ((j < i ? g * 16 + (i - j) : (16 + g) * 16 + (j - i)) * 16 + k) * 16 + kp0; const f32x4_t a = *(const f32x4_t*)s0, b = *(const f32x4_t*)(s0 + 4);
#pragma unroll
                    for (int e = 0; e < 4; ++e) { v[e] = a[e]; v[4 + e] = b[e]; } }
                else { const float* s0 = kt + ((g * 16) * 16 + k) * 16 + kp0; const float* s1 = kt + (((16 + g) * 16) * 16 + k) * 16 + kp0; const float dsk = p.in[I_S5D][layer * 256 + g * 16 + k];
                    const f32x4_t a0 = *(const f32x4_t*)s0, b0 = *(const f32x4_t*)(s0 + 4), a1 = *(const f32x4_t*)s1, b1 = *(const f32x4_t*)(s1 + 4);
#pragma unroll
                    for (int e = 0; e < 4; ++e) { v[e] = a0[e] + a1[e] + (k == kp0 + e ? dsk : 0.f); v[4 + e] = b0[e] + b1[e] + (k == kp0 + 4 + e ? dsk : 0.f); } } }
            else { const int dd = (q - 256) >> 7, n0 = ((q - 256) & 127) >> 1, pw = dd ? 16 - i : i + 1; const int dg = (layer * 2 + dd) * 16 + g, dgn = (dd * 16 + g) * 64 + n0;
                const f32x4_t cr = *(const f32x4_t*)(p.in[I_CRE] + (dg * 16 + k) * 64 + n0), ci = *(const f32x4_t*)(p.in[I_CIM] + (dg * 16 + k) * 64 + n0);
#pragma unroll
                for (int m = 0; m < 4; ++m) { const f32x2_t l = *(const f32x2_t*)(lamp + ((dgn + m) * 17 + pw) * 2); v[2 * m] = cr[m] * l.x - ci[m] * l.y; v[2 * m + 1] = -(cr[m] * l.y + ci[m] * l.x); } } }
        else { const int idx = (it - NBY) * 8, q = idx & 255, rr = (idx >> 8) & 255, g = idx >> 16, dd = rr >> 7, n = (rr & 127) >> 1, c = rr & 1, j = q >> 4, kp0 = q & 15, pw = dd ? j : 15 - j; dst = BE + idx;
            const int dgn = (dd * 16 + g) * 64 + n; const f32x2_t l = *(const f32x2_t*)(lamp + (dgn * 17 + pw) * 2); const float* bs = bbar + (dgn * 16 + kp0) * 2;
#pragma unroll
            for (int h = 0; h < 4; ++h) { const f32x4_t bb = *(const f32x4_t*)(bs + 4 * h);
                v[2 * h] = c ? (l.x * bb[1] + l.y * bb[0]) : (l.x * bb[0] - l.y * bb[1]); v[2 * h + 1] = c ? (l.x * bb[3] + l.y * bb[2]) : (l.x * bb[2] - l.y * bb[3]); } }
        v4u o; o.x = pk2(v[0], v[1]); o.y = pk2(v[2], v[3]); o.z = pk2(v[4], v[5]); o.w = pk2(v[6], v[7]); *(v4u*)dst = o; }
}
__device__ __forceinline__ void st_s5tab2_lds(const Prm& p, LAS unsigned char* lds) {
    typedef float f32x2_t __attribute__((ext_vector_type(2)));
    const float* lamp = WSP(float, WS_LAMP); const float* bbar = WSP(float, WS_BBAR); float* kt = WSP(float, WS_KT); const int tid = TID_();
    LAS float* CR = (LAS float*)lds; LAS float* CI = CR + 1024; LAS f32x2_t* LM = (LAS f32x2_t*)(CI + 1024); LAS f32x2_t* BB = LM + 256;
    for (int u = BIDX_(); u < DEPTH * 2 * 16 * 4; u += GDIM_()) { const int ldg = u >> 2, tq = u & 3;
#pragma unroll
        for (int i = 0; i < 2; ++i) { const int q = tid + 512 * i; CR[q] = p.in[I_CRE][ldg * 1024 + q]; CI[q] = p.in[I_CIM][ldg * 1024 + q]; BB[q] = *(const f32x2_t*)(bbar + (size_t)(ldg * 1024 + q) * 2); }
        if (tid < 256) { const int n = tid >> 2, tl = tid & 3; LM[tid] = *(const f32x2_t*)(lamp + (size_t)((ldg * 64 + n) * 17 + 4 * tq + tl) * 2); }
        __syncthreads();
#pragma unroll
        for (int i = 0; i < 2; ++i) { const int o = tid + 512 * i, tl = o >> 8, k = (o >> 4) & 15, kp = o & 15; float acc = 0.f;
#pragma unroll 8
            for (int n = 0; n < 64; ++n) { const float cr = CR[k * 64 + n], ci = CI[k * 64 + n]; const f32x2_t lm = LM[n * 4 + tl], bb = BB[n * 16 + kp];
                const float tr = lm.x * bb.x - lm.y * bb.y, ti = lm.x * bb.y + lm.y * bb.x; acc += cr * tr - ci * ti; }
            kt[(size_t)(ldg * 16 + 4 * tq + tl) * 256 + k * 16 + kp] = acc; }
        __syncthreads(); }
}
__device__ __forceinline__ void st_mod_atomic(const Prm& p, LAS unsigned char* lds) {
    const int tid = TID_(), lane = tid & 63, wave = __builtin_amdgcn_readfirstlane(tid >> 6); LAS float* sl = (LAS float*)lds;
    LAS f32x4_t* red = (LAS f32x4_t*)(lds + 16384);
    for (int i = tid; i < (BATCH + 1) * D_MODEL; i += NTHREADS_) { const float cv = i < BATCH * D_MODEL ? p.in[I_C][i] : p.in[I_CCTX][i - BATCH * D_MODEL]; sl[i] = cv / (1.f + __expf(-cv)); }
    __syncthreads();
    float* mod = WSP(float, WS_MOD); constexpr int NJ4 = 6 * D_MODEL / 4, KC = 32, NJB = NJ4 / 64, NKG = D_MODEL / (8 * KC); static_assert(NJ4 % 64 == 0 && D_MODEL % (8 * KC) == 0 && BATCH == 2, "modulation units");
    for (int u = BIDX_(); u < DEPTH * NJB * NKG; u += GDIM_()) { const int l = u / (NJB * NKG), jb = u % NJB, kg = (u / NJB) % NKG, j4 = jb * 64 + lane, k0 = (kg * 8 + wave) * KC;
        const f32x4_t* w = (const f32x4_t*)(p.in[I_WMOD] + (size_t)l * D_MODEL * 6 * D_MODEL) + j4; f32x4_t acc[BATCH + 1];
#pragma unroll
        for (int m = 0; m <= BATCH; ++m) acc[m] = (f32x4_t){0.f, 0.f, 0.f, 0.f};
#pragma unroll
        for (int k = 0; k < KC; ++k) { const f32x4_t wv = w[(size_t)(k0 + k) * NJ4];
#pragma unroll
            for (int m = 0; m <= BATCH; ++m) acc[m] += sl[m * D_MODEL + k0 + k] * wv; }
        if (kg == 0 && wave == 0) { const f32x4_t bv = *((const f32x4_t*)(p.in[I_BMOD] + (size_t)l * 6 * D_MODEL) + j4);
#pragma unroll
            for (int m = 0; m <= BATCH; ++m) acc[m] += bv; }
#pragma unroll
        for (int m = 0; m <= BATCH; ++m) red[(wave * (BATCH + 1) + m) * 64 + lane] = acc[m];
        __syncthreads();
        if (tid < (BATCH + 1) * 64) { const int m = tid >> 6; f32x4_t sum = red[m * 64 + lane];
#pragma unroll
            for (int wv = 1; wv < 8; ++wv) sum += red[(wv * (BATCH + 1) + m) * 64 + lane];
            float* o = mod + ((size_t)(l * (BATCH + 1) + m) * 6 * D_MODEL) + 4 * j4;
#pragma unroll
            for (int e = 0; e < 4; ++e) (void)__hip_atomic_fetch_add(o + e, sum[e], __ATOMIC_RELAXED, __HIP_MEMORY_SCOPE_AGENT); }
        __syncthreads(); }
}
__device__ __forceinline__ void st_ssd_carry_b(const Prm& p, int g0, int gs) {
    float* sst = WSP(float, WS_SST); const float* CS = WSP(float, WS_CS);
    constexpr int NJ = (CTX_LEN + SEQ) / 128, BL = 11; static_assert(NJ % BL == 0, "carry block");
    for (int i = g0; i < BATCH * 2 * 4 * 64 * 128; i += gs) { const int e = i % 8192, h = (i / 8192) % 4, d = (i / 32768) % 2, b = i / 65536, dh = d * 4 + h; float hst = 0.f;
#pragma clang loop unroll(disable)
        for (int j0 = 0; j0 < NJ; j0 += BL) { float tmp[BL], dec[BL]; int so[BL];
#pragma unroll
            for (int u = 0; u < BL; ++u) { const int c = ssd_chunk_of(b, d, j0 + u); so[u] = ((c * 2 + d) * 4 + h) * 8192 + e; tmp[u] = sst[so[u]]; dec[u] = CS[(c * 128 + (d ? 0 : 127)) * 8 + dh]; }
#pragma unroll
            for (int u = 0; u < BL; ++u) { sst[so[u]] = hst; hst = hst * __expf(dec[u]) + tmp[u]; } } }
}
__device__ __forceinline__ void st_s5_carry_b(const Prm& p, int L, LAS unsigned char* lds) {
    typedef float f32x2_t __attribute__((ext_vector_type(2)));
    const int tid = TID_();
    const float* lamp = WSP(float, WS_LAMP) + (size_t)L * 2 * 16 * 64 * 17 * 2; const float* E = WSP(float, WS_S5E); act_t* A = WSP(act_t, WS_S5A);
    constexpr int NJ = (CTX_LEN + SEQ) / 16, NSEG = 16, SL = NJ / NSEG, BL = 11, NPW = NTHREADS_ / NSEG; static_assert(NJ % NSEG == 0 && SL % BL == 0 && 64 % NPW == 0, "carry segments");
    LAS f32x2_t* T = (LAS f32x2_t*)lds;
    const int nl = tid % NPW, seg = tid / NPW;
    for (int u = BIDX_(); u < BATCH * 2 * 16 * (64 / NPW); u += GDIM_()) { const int nh = u % (64 / NPW), g = (u / (64 / NPW)) & 15, d = (u / (64 / NPW) >> 4) & 1, b = u / (64 / NPW) >> 5, n = nh * NPW + nl; const int dgn = (d * 16 + g) * 64 + n;
        const float lr = lamp[(dgn * 17 + 16) * 2], li = lamp[(dgn * 17 + 16) * 2 + 1];
        const float* Eb = E + (size_t)g * NSC * 256 + d * 128 + 2 * n; act_t* Ab = A + (size_t)g * S5R * 512 + 256 + d * 128 + 2 * n;
        float hr = 0.f, hi = 0.f;
#pragma clang loop unroll(disable)
        for (int j0 = seg * SL; j0 < (seg + 1) * SL; j0 += BL) { f32x2_t t[BL];
#pragma unroll
            for (int q = 0; q < BL; ++q) t[q] = *(const f32x2_t*)(Eb + s5_sc_of(b, d, j0 + q) * 256);
#pragma unroll
            for (int q = 0; q < BL; ++q) { const float nr = lr * hr - li * hi + t[q].x, ni = lr * hi + li * hr + t[q].y; hr = nr; hi = ni; } }
        T[seg * NPW + nl] = (f32x2_t){hr, hi};
        float pr = 1.f, pi = 0.f;
        for (int q = 0; q < SL; ++q) { const float nr = pr * lr - pi * li, ni = pr * li + pi * lr; pr = nr; pi = ni; }
        __syncthreads();
        hr = 0.f; hi = 0.f;
        for (int sg = 0; sg < seg; ++sg) { const f32x2_t tt = T[sg * NPW + nl]; const float nr = pr * hr - pi * hi + tt.x, ni = pr * hi + pi * hr + tt.y; hr = nr; hi = ni; }
#pragma clang loop unroll(disable)
        for (int j0 = seg * SL; j0 < (seg + 1) * SL; j0 += BL) { f32x2_t t[BL]; int scs[BL];
#pragma unroll
            for (int q = 0; q < BL; ++q) { scs[q] = s5_sc_of(b, d, j0 + q); t[q] = *(const f32x2_t*)(Eb + scs[q] * 256); }
#pragma unroll
            for (int q = 0; q < BL; ++q) { *(unsigned*)(Ab + scs[q] * 512) = pk2(hr, hi); const float nr = lr * hr - li * hi + t[q].x, ni = lr * hi + li * hr + t[q].y; hr = nr; hi = ni; } }
        __syncthreads(); }
}

namespace ssdm {
typedef short bf16x8 __attribute__((ext_vector_type(8)));
typedef float f32x4 __attribute__((ext_vector_type(4)));
typedef unsigned u32x4 __attribute__((ext_vector_type(4)));
typedef unsigned u32x2 __attribute__((ext_vector_type(2)));
constexpr int RS = 136;
constexpr int L_CM = 0, L_BM = 128 * RS * 2, L_X = 2 * 128 * RS * 2, L_H = L_X + 64 * RS * 2, L_F = L_H + 64 * RS * 2, L_H2 = L_F + 2 * 4 * 128 * 4, L_END = L_H2 + 64 * RS * 2;
static_assert(L_END <= 131072, "SSD LDS map");
#define SSD_MFMA(a, b, c) __builtin_amdgcn_mfma_f32_16x16x32_bf16(a, b, c, 0, 0, 0)
__device__ __forceinline__ bf16x8 frag(const LAS unsigned short* base, int row, int k0, int quad) { return *(const LAS bf16x8*)(base + row * RS + k0 + 8 * quad); }
__device__ __forceinline__ unsigned cvtpk_(float lo, float hi) { typedef float f2_ __attribute__((ext_vector_type(2))); typedef __bf16 b2_ __attribute__((ext_vector_type(2))); f2_ v = {lo, hi}; return __builtin_bit_cast(unsigned, __builtin_convertvector(v, b2_)); }
__device__ __forceinline__ void lds_fence() { asm volatile("s_waitcnt lgkmcnt(0)" ::: "memory"); }
__device__ __forceinline__ void stage_dtcs(const Prm& p, LAS float* F, size_t r0, int g, int tid) {
    const int combo = tid >> 7, l = tid & 127, dh = (combo >> 1) * 4 + 2 * g + (combo & 1);
    F[tid] = WSP(float, WS_DT)[(r0 + l) * 8 + dh]; F[512 + tid] = WSP(float, WS_CS)[(r0 + l) * 8 + dh];
}
__device__ __forceinline__ void ssd_states_unit(const Prm& p, LAS unsigned char* lds, int c, int g, int tid) {
    const int lane = tid & 63, wave = __builtin_amdgcn_readfirstlane(tid >> 6), quad = lane >> 4, l15 = lane & 15;
    const act_t* xbc = WSP(act_t, WS_XBC); float* sst = WSP(float, WS_SST); const int r0 = c * 128;
    LAS unsigned short* BT = (LAS unsigned short*)(lds + L_BM); LAS unsigned short* XT0 = (LAS unsigned short*)(lds + L_X); LAS unsigned short* XT1 = (LAS unsigned short*)(lds + L_H); LAS float* F = (LAS float*)(lds + L_F);
#pragma unroll
    for (int i = 0; i < 4; ++i) { const int q = tid + 512 * i, l = q >> 4, n0 = (q & 15) * 8; const u32x4 v = *(const u32x4*)(xbc + (r0 + l) * 768 + 256 + g * 128 + n0);
#pragma unroll
        for (int e = 0; e < 4; ++e) { BT[(n0 + 2 * e) * RS + l] = (unsigned short)(v[e] & 0xffffu); BT[(n0 + 2 * e + 1) * RS + l] = (unsigned short)(v[e] >> 16); } }
#pragma unroll
    for (int hh = 0; hh < 2; ++hh) { LAS unsigned short* XT = hh ? XT1 : XT0;
#pragma unroll
        for (int i = 0; i < 2; ++i) { const int q = tid + 512 * i, l = q >> 3, p0 = (q & 7) * 8; const u32x4 v = *(const u32x4*)(xbc + (r0 + l) * 768 + (2 * g + hh) * 64 + p0);
#pragma unroll
            for (int e = 0; e < 4; ++e) { XT[(p0 + 2 * e) * RS + l] = (unsigned short)(v[e] & 0xffffu); XT[(p0 + 2 * e + 1) * RS + l] = (unsigned short)(v[e] >> 16); } } }
    { const int combo = tid >> 7, l = tid & 127, d = combo >> 1, dh = d * 4 + 2 * g + (combo & 1); const float* DTg = WSP(float, WS_DT); const float* CSg = WSP(float, WS_CS);
      F[tid] = DTg[(r0 + l) * 8 + dh] * __expf(CSg[(r0 + (d ? 0 : 127)) * 8 + dh] - CSg[(r0 + l) * 8 + dh]); }
    __syncthreads();
    const int rt = wave & 3, cb0 = 4 * (wave >> 2);
#pragma clang loop unroll(disable)
    for (int combo = 0; combo < 4; ++combo) { const int d = combo >> 1, h = 2 * g + (combo & 1); const LAS unsigned short* XT = (combo & 1) ? XT1 : XT0; f32x4 acc[4];
#pragma unroll
        for (int j = 0; j < 4; ++j) acc[j] = (f32x4){0.f, 0.f, 0.f, 0.f};
#pragma unroll
        for (int ks = 0; ks < 4; ++ks) { const bf16x8 ar = frag(XT, 16 * rt + l15, 32 * ks, quad);
            const f32x4 w0 = *(const LAS f32x4*)(F + combo * 128 + 32 * ks + 8 * quad), w1 = *(const LAS f32x4*)(F + combo * 128 + 32 * ks + 8 * quad + 4);
            const u32x4 au = __builtin_bit_cast(u32x4, ar); u32x4 sc;
            sc[0] = cvtpk_(__uint_as_float(au[0] << 16) * w0[0], __uint_as_float(au[0] & 0xffff0000u) * w0[1]); sc[1] = cvtpk_(__uint_as_float(au[1] << 16) * w0[2], __uint_as_float(au[1] & 0xffff0000u) * w0[3]);
            sc[2] = cvtpk_(__uint_as_float(au[2] << 16) * w1[0], __uint_as_float(au[2] & 0xffff0000u) * w1[1]); sc[3] = cvtpk_(__uint_as_float(au[3] << 16) * w1[2], __uint_as_float(au[3] & 0xffff0000u) * w1[3]);
            const bf16x8 a = __builtin_bit_cast(bf16x8, sc);
#pragma unroll
            for (int j = 0; j < 4; ++j) acc[j] = SSD_MFMA(a, frag(BT, 16 * (cb0 + j) + l15, 32 * ks, quad), acc[j]); }
        float* o = sst + ((c * 2 + d) * 4 + h) * 8192;
#pragma unroll
        for (int j = 0; j < 4; ++j)
#pragma unroll
            for (int e = 0; e < 4; ++e) o[(16 * rt + 4 * quad + e) * 128 + 16 * (cb0 + j) + l15] = acc[j][e]; }
    __syncthreads();
}
__device__ __forceinline__ void ssd_y_unit(const Prm& p, int L, LAS unsigned char* lds, int c, int g, int tid) {
    const int lane = tid & 63, wave = __builtin_amdgcn_readfirstlane(tid >> 6), quad = lane >> 4, l15 = lane & 15;
    const act_t* xbc = WSP(act_t, WS_XBC); const float* sst = WSP(float, WS_SST); act_t* P = WSP(act_t, WS_P); const int r0 = c * 128;
    LAS unsigned short* CM = (LAS unsigned short*)(lds + L_CM); LAS unsigned short* BM = (LAS unsigned short*)(lds + L_BM); LAS unsigned short* XT = (LAS unsigned short*)(lds + L_X); LAS unsigned short* HN = (LAS unsigned short*)(lds + L_H); LAS float* F = (LAS float*)(lds + L_F);
    const int lrow = 16 * wave + l15, wks = wave >> 1;
#pragma unroll
    for (int i = 0; i < 4; ++i) { const int q = tid + 512 * i, l = q >> 4, n0 = (q & 15) * 8;
        *(LAS u32x4*)(CM + l * RS + n0) = *(const u32x4*)(xbc + (r0 + l) * 768 + 512 + g * 128 + n0); *(LAS u32x4*)(BM + l * RS + n0) = *(const u32x4*)(xbc + (r0 + l) * 768 + 256 + g * 128 + n0); }
    stage_dtcs(p, F, r0, g, tid);
    u32x4 xr[2][2]; u32x2 xsk[2][4]; f32x4 ph[2][4];
#pragma unroll
    for (int hh = 0; hh < 2; ++hh) {
#pragma unroll
        for (int i = 0; i < 2; ++i) { const int q = tid + 512 * i; xr[hh][i] = *(const u32x4*)(xbc + (r0 + (q >> 3)) * 768 + (2 * g + hh) * 64 + (q & 7) * 8); }
#pragma unroll
        for (int j = 0; j < 4; ++j) xsk[hh][j] = *(const u32x2*)(xbc + (r0 + lrow) * 768 + (2 * g + hh) * 64 + 16 * j + 4 * quad); }
#define SSD_LOADH2(hh_) do { _Pragma("unroll") for (int d_ = 0; d_ < 2; ++d_) { const float* hin_ = sst + ((c * 2 + d_) * 4 + 2 * g + (hh_)) * 8192; \
        _Pragma("unroll") for (int i = 0; i < 4; ++i) { const int q = tid + 512 * i; ph[d_][i] = *(const f32x4*)(hin_ + (q >> 5) * 128 + (q & 31) * 4); } } } while (0)
    SSD_LOADH2(0);
    __syncthreads();
    f32x4 cb[8]; bf16x8 bc[4];
#pragma unroll
    for (int j = 0; j < 8; ++j) cb[j] = (f32x4){0.f, 0.f, 0.f, 0.f};
#pragma unroll
    for (int ks = 0; ks < 4; ++ks) { bc[ks] = frag(CM, lrow, 32 * ks, quad);
#pragma unroll
        for (int j = 0; j < 8; ++j) cb[j] = SSD_MFMA(frag(BM, 16 * j + l15, 32 * ks, quad), bc[ks], cb[j]); }
    __syncthreads();
    LAS unsigned short* HN1 = (LAS unsigned short*)(lds + L_H2);
#pragma unroll
    for (int hh = 0; hh < 2; ++hh) { const int h = 2 * g + hh;
        const LAS float* dt0 = F + hh * 128; const LAS float* cs0 = F + 512 + hh * 128; const LAS float* dt1 = F + (2 + hh) * 128; const LAS float* cs1 = F + 512 + (2 + hh) * 128;
#pragma unroll
        for (int i = 0; i < 2; ++i) { const int q = tid + 512 * i, l = q >> 3, p0 = (q & 7) * 8; const u32x4 v = xr[hh][i];
#pragma unroll
            for (int e = 0; e < 4; ++e) { XT[(p0 + 2 * e) * RS + l] = (unsigned short)(v[e] & 0xffffu); XT[(p0 + 2 * e + 1) * RS + l] = (unsigned short)(v[e] >> 16); } }
#pragma unroll
        for (int i = 0; i < 4; ++i) { const int q = tid + 512 * i, pp = q >> 5, n0 = (q & 31) * 4; u32x2 w0, w1; w0.x = cvtpk_(ph[0][i][0], ph[0][i][1]); w0.y = cvtpk_(ph[0][i][2], ph[0][i][3]); w1.x = cvtpk_(ph[1][i][0], ph[1][i][1]); w1.y = cvtpk_(ph[1][i][2], ph[1][i][3]);
            *(LAS u32x2*)(HN + pp * RS + n0) = w0; *(LAS u32x2*)(HN1 + pp * RS + n0) = w1; }
        if (hh == 0) SSD_LOADH2(1);
        const float c0l = cs0[lrow], c1l = cs1[lrow];
#pragma unroll
        for (int j = 0; j < 8; ++j) { float m4[4]; const int s0i = 16 * j + 4 * quad;
            if (j < wave) { const f32x4 cs4 = *(const LAS f32x4*)(cs0 + s0i), dt4 = *(const LAS f32x4*)(dt0 + s0i);
#pragma unroll
                for (int e = 0; e < 4; ++e) m4[e] = cb[j][e] * dt4[e] * __expf(fminf(c0l - cs4[e], 0.f)); }
            else if (j > wave) { const f32x4 cs4 = *(const LAS f32x4*)(cs1 + s0i), dt4 = *(const LAS f32x4*)(dt1 + s0i);
#pragma unroll
                for (int e = 0; e < 4; ++e) m4[e] = cb[j][e] * dt4[e] * __expf(fminf(c1l - cs4[e], 0.f)); }
            else { const f32x4 ca4 = *(const LAS f32x4*)(cs0 + s0i), da4 = *(const LAS f32x4*)(dt0 + s0i), cb4 = *(const LAS f32x4*)(cs1 + s0i), db4 = *(const LAS f32x4*)(dt1 + s0i);
#pragma unroll
                for (int e = 0; e < 4; ++e) { const int sidx = s0i + e; const float t0 = sidx <= lrow ? da4[e] * __expf(fminf(c0l - ca4[e], 0.f)) : 0.f, t1 = sidx >= lrow ? db4[e] * __expf(fminf(c1l - cb4[e], 0.f)) : 0.f; m4[e] = cb[j][e] * (t0 + t1); } }
            u32x2 w; w.x = cvtpk_(m4[0], m4[1]); w.y = cvtpk_(m4[2], m4[3]); *(LAS u32x2*)(BM + lrow * RS + s0i) = w; }
        __syncthreads();
        f32x4 dg[4], o0[4], o1[4];
#pragma unroll
        for (int j = 0; j < 4; ++j) { dg[j] = (f32x4){0.f, 0.f, 0.f, 0.f}; o0[j] = dg[j]; o1[j] = dg[j]; }
#pragma unroll
        for (int ks = 0; ks < 4; ++ks) { const bf16x8 bm_ = frag(BM, lrow, 32 * ks, quad);
#pragma unroll
            for (int j = 0; j < 4; ++j) { dg[j] = SSD_MFMA(frag(XT, 16 * j + l15, 32 * ks, quad), bm_, dg[j]); o0[j] = SSD_MFMA(frag(HN, 16 * j + l15, 32 * ks, quad), bc[ks], o0[j]); o1[j] = SSD_MFMA(frag(HN1, 16 * j + l15, 32 * ks, quad), bc[ks], o1[j]); } }
        const float sc0 = __expf(c0l), sc1 = __expf(c1l), dsk = p.in[I_SD][L * 4 + h];
        __syncthreads();
#pragma unroll
        for (int j = 0; j < 4; ++j) { const int r = r0 + lrow; const int hp = h * 64 + 16 * j + 4 * quad; float xv[4]; const u32x2 xr_ = xsk[hh][j]; const f32x4 yv = dg[j] + sc0 * o0[j] + sc1 * o1[j];
            xv[0] = __uint_as_float(xr_.x << 16); xv[1] = __uint_as_float(xr_.x & 0xffff0000u); xv[2] = __uint_as_float(xr_.y << 16); xv[3] = __uint_as_float(xr_.y & 0xffff0000u);
            u32x2 w; w.x = cvtpk_(yv[0] + dsk * xv[0], yv[1] + dsk * xv[1]); w.y = cvtpk_(yv[2] + dsk * xv[2], yv[3] + dsk * xv[3]);
            *(u32x2*)(P + r * PLD + YSSD_OFF + hp) = w; } }
#undef SSD_LOADH2
}
__device__ __forceinline__ void ssd_y_chunk(const Prm& p, int L, LAS unsigned char* lds, int c, int tid) {
#pragma clang loop unroll(disable)
    for (int g_ = 0; g_ < 2; ++g_) { int g = g_, t2 = tid; asm volatile("" : "+s"(g), "+v"(t2)); ssd_y_unit(p, L, lds, c, g, t2); }
    const int lane = tid & 63, wave = __builtin_amdgcn_readfirstlane(tid >> 6), quad = lane >> 4, l15 = lane & 15; const int r = c * 128 + 16 * wave + l15;
    const act_t* P = WSP(act_t, WS_P); act_t* ym = WSP(act_t, WS_YMIX); const float* ng = p.in[I_SNG] + L * 256; float ss = 0.f;
    u32x2 zq[4][4], yq[4][4];
#pragma unroll
    for (int h = 0; h < 4; ++h)
#pragma unroll
        for (int j = 0; j < 4; ++j) { const int hp = h * 64 + 16 * j + 4 * quad; zq[h][j] = *(const u32x2*)(P + r * PLD + Z_OFF + hp); if (h < 2) yq[h][j] = *(const u32x2*)(P + r * PLD + YSSD_OFF + hp); }
    asm volatile("s_waitcnt vmcnt(0)" ::: "memory");
#pragma unroll
    for (int h = 2; h < 4; ++h)
#pragma unroll
        for (int j = 0; j < 4; ++j) yq[h][j] = *(const u32x2*)(P + r * PLD + YSSD_OFF + h * 64 + 16 * j + 4 * quad);
#pragma unroll
    for (int h = 0; h < 4; ++h)
#pragma unroll
        for (int j = 0; j < 4; ++j) { const u32x2 zr = zq[h][j], yr = yq[h][j]; float z[4], y[4];
            z[0] = __uint_as_float(zr.x << 16); z[1] = __uint_as_float(zr.x & 0xffff0000u); z[2] = __uint_as_float(zr.y << 16); z[3] = __uint_as_float(zr.y & 0xffff0000u);
            y[0] = __uint_as_float(yr.x << 16); y[1] = __uint_as_float(yr.x & 0xffff0000u); y[2] = __uint_as_float(yr.y << 16); y[3] = __uint_as_float(yr.y & 0xffff0000u);
#pragma unroll
            for (int e = 0; e < 4; ++e) { const float v = y[e] * z[e] * __builtin_amdgcn_rcpf(1.f + __expf(-z[e])); ss += v * v; } }
    ss += __shfl_xor(ss, 16); ss += __shfl_xor(ss, 32);
    const float rn = 1.0f / sqrtf(ss * (1.f / 256.f) + NORM_EPS);
#pragma unroll
    for (int h = 0; h < 4; ++h)
#pragma unroll
        for (int j = 0; j < 4; ++j) { const int hp = h * 64 + 16 * j + 4 * quad; const f32x4 g4 = *(const f32x4*)(ng + hp); const u32x2 zr = zq[h][j], yr = yq[h][j]; float z[4], y[4], o[4];
            z[0] = __uint_as_float(zr.x << 16); z[1] = __uint_as_float(zr.x & 0xffff0000u); z[2] = __uint_as_float(zr.y << 16); z[3] = __uint_as_float(zr.y & 0xffff0000u);
            y[0] = __uint_as_float(yr.x << 16); y[1] = __uint_as_float(yr.x & 0xffff0000u); y[2] = __uint_as_float(yr.y << 16); y[3] = __uint_as_float(yr.y & 0xffff0000u);
#pragma unroll
            for (int e = 0; e < 4; ++e) o[e] = y[e] * z[e] * __builtin_amdgcn_rcpf(1.f + __expf(-z[e])) * rn * g4[e];
            u32x2 w; w.x = pk2(o[0], o[1]); w.y = pk2(o[2], o[3]); *(u32x2*)(ym + r * D_MIX + hp) = w; }
}
#undef SSD_MFMA
}
__device__ __forceinline__ void st_ssd_states_m(const Prm& p, LAS unsigned char* lds) {
    const int t = TID_(); const int G = GDIM_(), bx = BIDX_();
    const int nps = G >= 160 ? G - 16 * (S5R / 256) : G;
    if (bx < nps) for (int u = bx; u < NCH * 2; u += nps) ssdm::ssd_states_unit(p, lds, u >> 1, u & 1, TID_());
}
__device__ __forceinline__ void st_ssd_y_m(const Prm& p, int L, int nrows, LAS unsigned char* lds) {
    const int t = TID_(); const int G = GDIM_(), bx = BIDX_();
    (void)t; for (int u = bx; u < nrows / 128; u += G) ssdm::ssd_y_chunk(p, L, lds, u, TID_());
}

typedef unsigned u32x4v_t __attribute__((ext_vector_type(4)));
__device__ __forceinline__ void unpack8_(const u32x4v_t v, float* o) {
#pragma unroll
    for (int e = 0; e < 4; ++e) { o[2 * e] = __uint_as_float(v[e] << 16); o[2 * e + 1] = __uint_as_float(v[e] & 0xffff0000u); } }
__device__ __forceinline__ u32x4v_t pack8_(const float* o) { u32x4v_t w; w.x = pk2(o[0], o[1]); w.y = pk2(o[2], o[3]); w.z = pk2(o[4], o[5]); w.w = pk2(o[6], o[7]); return w; }
__device__ __forceinline__ void st_ssd_conv_v(const Prm& p, int L) {
    const int tid = TID_(), cg = tid % 96, rs_ = tid / 96; if (rs_ >= 5) return;
    const act_t* P = WSP(act_t, WS_P); act_t* xbc = WSP(act_t, WS_XBC); const int c = cg * 8;
    const float* cw = p.in[I_SCW] + (size_t)L * 3 * SSD_XBC; const float* cb = p.in[I_SCB] + (size_t)L * SSD_XBC;
    float w0[8], w1[8], w2[8], bb[8];
#pragma unroll
    for (int e = 0; e < 8; ++e) { w0[e] = cw[c + e]; w1[e] = cw[SSD_XBC + c + e]; w2[e] = cw[2 * SSD_XBC + c + e]; bb[e] = cb[c + e]; }
    const int stride = GDIM_() * 5;
    for (int r0 = BIDX_() * 5 + rs_; r0 < MT; r0 += 4 * stride) { u32x4v_t vm[4], vl[4], vh[4];
#pragma unroll
        for (int u = 0; u < 4; ++u) { const int r = r0 + u * stride; vm[u] = (u32x4v_t){0u, 0u, 0u, 0u}; vl[u] = vm[u]; vh[u] = vm[u];
            if (r < MT) { const int t = r < ML ? r % SEQ : (r - ML) % CTX_LEN, T = r < ML ? SEQ : CTX_LEN; const act_t* src = P + (size_t)r * PLD + XBC_OFF + c;
                vm[u] = *(const u32x4v_t*)src; if (t > 0) vl[u] = *(const u32x4v_t*)(src - PLD); if (t < T - 1) vh[u] = *(const u32x4v_t*)(src + PLD); } }
#pragma unroll
        for (int u = 0; u < 4; ++u) { const int r = r0 + u * stride; if (r < MT) { float x[8], v[8];
                unpack8_(vm[u], x);
#pragma unroll
                for (int e = 0; e < 8; ++e) v[e] = bb[e] + w1[e] * x[e];
                unpack8_(vl[u], x);
#pragma unroll
                for (int e = 0; e < 8; ++e) v[e] += w0[e] * x[e];
                unpack8_(vh[u], x);
#pragma unroll
                for (int e = 0; e < 8; ++e) v[e] += w2[e] * x[e];
#pragma unroll
                for (int e = 0; e < 8; ++e) v[e] = v[e] * __builtin_amdgcn_rcpf(1.f + __expf(-v[e]));
                pg8::st_wt((pg8::u32x4*)(xbc + (size_t)r * SSD_XBC + c), pack8_(v)); } } }
}
__device__ __forceinline__ void st_qk_prep_v(const Prm& p, int L, int g0, int gs) {
    act_t* P = WSP(act_t, WS_P); const float* rc = WSP(float, WS_ROPE); const float* rs = rc + (size_t)SEQ * 32;
    for (int i = g0; i < MT * 12; i += gs) { const int r = i / 12, s = i % 12; const bool isctx = r >= ML; const int t = r % SEQ;
        int off; const float* gn = nullptr; float scale = 1.f;
        if (s < 4) { off = GAQ + s * 64; gn = p.in[I_GAQN] + L * 64; scale = QSCALE; }
        else if (s < 6) { off = GAK + (s - 4) * 64; gn = p.in[I_GAKN] + L * 64; }
        else if (s < 10) { off = WAQ + (s - 6) * 64; scale = QSCALE; }
        else { off = WAK + (s - 10) * 64; if (isctx) continue; }
        act_t* v = P + (size_t)r * PLD + off; float x[64];
#pragma unroll
        for (int c = 0; c < 8; ++c) unpack8_(*(const u32x4v_t*)(v + 8 * c), x + 8 * c);
        float rn = scale;
        if (gn) { float ssq = 0.f;
#pragma unroll
            for (int e = 0; e < 64; ++e) ssq += x[e] * x[e];
            rn = scale / sqrtf(ssq * (1.f / 64.f) + NORM_EPS);
#pragma unroll
            for (int e = 0; e < 64; ++e) x[e] *= gn[e]; }
        if (!isctx) {
#pragma unroll
            for (int e4 = 0; e4 < 8; ++e4) { const f32x4_t c4 = *((const f32x4_t*)(rc + (size_t)t * 32) + e4), s4 = *((const f32x4_t*)(rs + (size_t)t * 32) + e4);
#pragma unroll
                for (int q = 0; q < 4; ++q) { const int e = 4 * e4 + q; const float x1 = x[e], x2 = x[e + 32]; x[e] = x1 * c4[q] - x2 * s4[q]; x[e + 32] = x2 * c4[q] + x1 * s4[q]; } } }
#pragma unroll
        for (int e = 0; e < 64; ++e) x[e] *= rn;
#pragma unroll
        for (int c = 0; c < 8; ++c) *(u32x4v_t*)(v + 8 * c) = pack8_(x + 8 * c); }
}

__device__ __forceinline__ void st_ffn_fixup(const Prm& p, int L, int g0, int gs) {
    const float* EG = WSP(float, WS_EG); const float* EU = WSP(float, WS_EU); act_t* ACT = WSP(act_t, WS_ACT);
    const float* cw = p.in[I_FCW] + (size_t)L * 3 * D_FF; const float* cb = p.in[I_FCB] + (size_t)L * D_FF;
    constexpr int NB = ML / 256 - 1;
    for (int i = g0; i < NB * D_FF; i += gs) { const int pm = i / D_FF, c = i % D_FF; if (((pm + 1) * 256) % SEQ == 0) continue;
        const float gA = EG[((size_t)pm * 4 + 2) * D_FF + c], gB = EG[((size_t)pm * 4 + 3) * D_FF + c], gC = EG[((size_t)(pm + 1) * 4 + 0) * D_FF + c], gD = EG[((size_t)(pm + 1) * 4 + 1) * D_FF + c];
        const float uB = EU[((size_t)pm * 2 + 1) * D_FF + c], uC = EU[((size_t)(pm + 1) * 2) * D_FF + c];
        const float w0 = cw[c], w1 = cw[D_FF + c], w2 = cw[2 * D_FF + c], b = cb[c];
        const float x0 = b + w0 * gA + w1 * gB + w2 * gC, x1 = b + w0 * gB + w1 * gC + w2 * gD;
        const size_t R = (size_t)(pm + 1) * 256 - 1;
        stf(ACT + R * D_FF + c, x0 / (1.f + __expf(-x0)) * uB); stf(ACT + (R + 1) * D_FF + c, x1 / (1.f + __expf(-x1)) * uC); }
}

__device__ __forceinline__ void sub_barrier(unsigned* cnt, unsigned np, bool arrive) {
    asm volatile("s_waitcnt vmcnt(0)" ::: "memory");
    __syncthreads();
    if (TID_() == 0) {
        if (arrive) { __builtin_amdgcn_fence(__ATOMIC_RELEASE, "agent"); asm volatile("s_waitcnt vmcnt(0)" ::: "memory");
            (void)__hip_atomic_fetch_add(cnt, 1u, __ATOMIC_RELAXED, __HIP_MEMORY_SCOPE_AGENT); }
        unsigned sp = 0; while (__hip_atomic_load(cnt, __ATOMIC_RELAXED, __HIP_MEMORY_SCOPE_AGENT) < np) { __builtin_amdgcn_s_sleep(2); if (++sp > (1u << 22)) break; }
        __builtin_amdgcn_fence(__ATOMIC_ACQUIRE, "agent"); asm volatile("s_waitcnt vmcnt(0)" ::: "memory");
    }
    __syncthreads();
}
#endif

HD void run_step(const Prm& p, int st, int L, int g0_, int gs_) {
#ifdef CPU_TEST
    const int g0 = g0_, gs = gs_;
#else
    extern __shared__ __attribute__((aligned(16))) unsigned char lds_dyn_[];
    LAS unsigned char* const ldsb = (LAS unsigned char*)lds_dyn_;
    const int tidl_ = TID_();
    const int g0 = BIDX_() * NTHREADS_ + tidl_, gs = GDIM_() * NTHREADS_;
#endif
    const int nrows = (L < DEPTH - 1) ? MT : ML;
#ifndef CPU_TEST
    using namespace pg8;
    const float* modL = (const float*)(p.ws + WS_MOD) + (size_t)L * (BATCH + 1) * 6 * D_MODEL;
    const int G = GDIM_(), bid = BIDX_();
#endif
    switch (st) {
#ifdef CPU_TEST
    case S_MOD: st_mod(p, g0, gs); break;
#else
    case S_MOD: st_mod_atomic(p, ldsb); break;
#endif
#ifdef CPU_TEST
    case S_INIT: st_init(p, g0, gs); break;
#else
    case S_INIT: st_rope_tab(p, g0, gs); { float* xc = WSP(float, WS_XC); for (int i = g0; i < MC * D_MODEL; i += gs) xc[i] = p.in[I_CTX][i]; } break;
#endif
    case S_TAB1: st_s5tab1(p, g0, gs); break;
#ifdef CPU_TEST
    case S_TAB2: st_s5tab2(p, g0, gs); break;
#else
    case S_TAB2: st_s5tab2_lds(p, ldsb); break;
#endif
#ifdef CPU_TEST
    case S_ROWSS: st_rowss(p, MT, g0, gs); break;
    case S_NORM_MIX: st_normmod(p, L, 0, MT, g0, gs); break;
    case S_NORM_FFN: st_normmod(p, L, 1, nrows, g0, gs); break;
    case S_ROWSS_FIN: st_rowss(p, ML, g0, gs); break;
    case S_FINAL: st_final(p, g0, gs); break;
    case S_CS: st_ssd_cs(p, L, g0, gs); break;
    case S_SSD_CARRY: st_ssd_carry(p, g0, gs); break;
    case S_S5_CARRY: st_s5_carry(p, L, g0, gs); break;
    case S_SSD_OUT: st_ssd_out(p, L, nrows, g0, gs); break;
#else
    case S_NORM_MIX: st_norm_fused(p, L, 0, MT, L > 0 ? modp(p, L - 1, BATCH, 5) : nullptr); break;
    case S_NORM_FFN: st_norm_fused(p, L, 1, nrows, nrows > ML ? modp(p, L, BATCH, 2) : nullptr); break;
    case S_FINAL: st_final_fused(p); break;
    case S_CS: st_ssd_cs_w(p, L); break;
    case S_SSD_CARRY: st_ssd_carry_b(p, g0, gs); break;
    case S_S5_CARRY: st_s5_carry_b(p, L, ldsb); break;
    case S_SSD_OUT: st_ssd_out_w(p, L, nrows); break;
#endif
#ifdef CPU_TEST
    case S_TABB: st_s5tabB(p, L, g0, gs); break;
#else
    case S_TABB: { const int nfull = (MT / 256) * (NIN / 256) - 2 * GDIM_();
        const int b_ = BIDX_(), G_ = GDIM_(); if (nfull > 0 && nfull < G_) { if (b_ >= nfull) st_s5tabB_v(p, L, (b_ - nfull) * NTHREADS_ + TID_(), (G_ - nfull) * NTHREADS_); } else st_s5tabB_v(p, L, g0, gs); } break;
#endif
#ifdef CPU_TEST
    case S_ATTN: st_attn(p, L, nrows, g0, gs); break;
#else
    case S_ATTN: st_attn_mfma(p, L, 0, (char*)lds_dyn_); break;
    case S_ATTNC: if (L < DEPTH - 1) st_attn_mfma(p, L, 1, (char*)lds_dyn_); break;
#endif
#ifdef CPU_TEST
    case S_WPREP: case S_WPREP2: case S_ATTNC: break;
    case S_CONV: st_ssd_conv(p, L, g0, gs); break;
    case S_QK: st_qk_prep(p, L, g0, gs); break;
    case S_STATE: st_ssd_state(p, g0, gs); break;
    case S_CB: st_ssd_cb(p, g0, gs); break;
    case S_SSD_Y: st_ssd_y(p, L, nrows, g0, gs); break;
    case S_S5E: st_s5_E_naive(p, g0, gs); break;
    case S_S5_Y: st_s5_Y_naive(p, nrows, g0, gs); break;
    case S_GEMM_IN: { EpiStoreIn e{&p}; naive_gemm(WSP(act_t, WS_XN), D_MODEL, p.in[I_WIN] + (size_t)L * D_MODEL * D_IN, D_IN, MT, D_IN, D_MODEL, e, g0, gs); } break;
    case S_GLU: st_glu(p, L, nrows, g0, gs); break;
    case S_GEMM_OUT: { EpiResid e{&p, L, 2}; naive_gemm(WSP(act_t, WS_YMIX), D_MIX, p.in[I_WOUT] + (size_t)L * D_MIX * D_MODEL, D_MODEL, nrows, D_MODEL, D_MIX, e, g0, gs); } break;
    case S_GEMM_GATE: { EpiStore e{WSP(act_t, WS_GT), D_FF}; naive_gemm(WSP(act_t, WS_XN), D_MODEL, p.in[I_WGATE] + (size_t)L * D_MODEL * D_FF, D_FF, nrows, D_FF, D_MODEL, e, g0, gs); } break;
    case S_GEMM_UP: { EpiUp e{&p, L}; naive_gemm(WSP(act_t, WS_XN), D_MODEL, p.in[I_WUP] + (size_t)L * D_MODEL * D_FF, D_FF, nrows, D_FF, D_MODEL, e, g0, gs); } break;
    case S_GEMM_DOWN: { EpiResid e{&p, L, 5}; naive_gemm(WSP(act_t, WS_ACT), D_FF, p.in[I_WDOWN] + (size_t)L * D_FF * D_MODEL, D_MODEL, nrows, D_MODEL, D_FF, e, g0, gs); } break;
#else
    case S_WPREP: st_wprep(p, L, ldsb, g0, gs, 0); break;
    case S_WPREP2: st_wprep(p, L, ldsb, g0, gs, 1); break;
    case S_CONV: st_ssd_conv_v(p, L); break;
    case S_QK: st_qk_prep_v(p, L, g0, gs); break;
    case S_STATE: st_ssd_states_m(p, ldsb); break;
    case S_SSD_Y: st_ssd_y_m(p, L, nrows, ldsb); break;
    case S_GEMM_IN: { Gemm g{WSP(act_t, WS_XN), WSP(act_t, WS_WIN), MT, NIN, D_MODEL, D_MODEL}; StaticOrder S; S.init(MT, NIN, G, bid);
        EpiInProj E{WSP(act_t, WS_P), WSP(act_t, WS_S5A), WSP(float, WS_DTRAW)}; gemm_phase<EpiInProj, StaticOrder, true, true>(ldsb, g, S, E); } break;
    case S_S5E: { int k5 = 256; asm volatile("" : "+s"(k5)); Gemm g{WSP(act_t, WS_S5A), WSP(act_t, WS_S5BE), 16 * S5R, 16 * 256, k5, 512}; BatchedOrder S; S.init(G, bid);
        EpiS5E E{WSP(float, WS_S5E)}; gemm_phase<EpiS5E, BatchedOrder, true, true>(ldsb, g, S, E); } break;
    case S_S5_Y: { Gemm g{WSP(act_t, WS_S5A), WSP(act_t, WS_S5BY), 16 * S5R, 16 * 256, 512, 512}; BatchedOrder S; S.init(G, bid);
        EpiS5Y E{WSP(act_t, WS_P), nrows / 16}; gemm_phase<EpiS5Y, BatchedOrder, true, true>(ldsb, g, S, E); } break;
    case S_SUBGLU: { constexpr int NP = 16 * (S5R / 256); const int nssd = nrows / 128, pi = bid - nssd; if (pi >= 0 && G - nssd >= NP) {
            sub_barrier((unsigned*)(p.ws + WS_CTL) + 1024 + 64 * L, NP, bid >= G - NP);
            int kglu = 256; asm volatile("" : "+s"(kglu)); Gemm g{WSP(act_t, WS_P) + YS5_OFF, WSP(act_t, WS_WGLU), nrows, 512, kglu, PLD}; StaticOrder S; S.init(nrows, 512, G - nssd, pi);
            EpiGluM E{WSP(act_t, WS_YMIX), p.in[I_BGLU] + L * 512}; gemm_phase<EpiGluM, StaticOrder, true, true>(ldsb, g, S, E); } } break;
    case S_GLU: { int kglu = 256; asm volatile("" : "+s"(kglu)); Gemm g{WSP(act_t, WS_P) + YS5_OFF, WSP(act_t, WS_WGLU), nrows, 512, kglu, PLD}; StaticOrder S; S.init(nrows, 512, G, bid);
        EpiGluM E{WSP(act_t, WS_YMIX), p.in[I_BGLU] + L * 512}; gemm_phase<EpiGluM, StaticOrder, true, true>(ldsb, g, S, E); } break;
    case S_GEMM_OUT: { Gemm g{WSP(act_t, WS_YMIX), WSP(act_t, WS_WOUT), nrows, D_MODEL, D_MIX, D_MIX};
        EpiResidM E{p.out, WSP(float, WS_XC), L == 0 ? p.in[I_X] : p.out, WSP(float, WS_XC), modL, 2, WSP(float, WS_SLAB), D_MIX / 64};
        if (nrows > ML) { TailSplitOrder S; S.init(D_MIX, G, bid); gemm_phase<EpiResidM, TailSplitOrder, true, true>(ldsb, g, S, E); }
        else { StaticOrder S; S.init(nrows, D_MODEL, G, bid); gemm_phase<EpiResidM, StaticOrder, true, true>(ldsb, g, S, E); } } break;
    case S_GEMM_GU: { Gemm g{WSP(act_t, WS_XN), WSP(act_t, WS_WG), nrows, 2 * D_FF, D_MODEL, D_MODEL}; StaticOrder S; S.init(nrows, 2 * D_FF, G, bid);
        EpiGateUpM E{WSP(act_t, WS_ACT), p.in[I_FCW] + (size_t)L * 3 * D_FF, p.in[I_FCB] + (size_t)L * D_FF, WSP(float, WS_EG), WSP(float, WS_EU)}; gemm_phase<EpiGateUpM, StaticOrder, true, true>(ldsb, g, S, E); } break;
    case S_FIXUP: st_ffn_fixup(p, L, g0, gs); break;
    case S_GEMM_GATE: { Gemm g{WSP(act_t, WS_XN), WSP(act_t, WS_WG), nrows, D_FF, D_MODEL, D_MODEL}; StaticOrder S; S.init(nrows, D_FF, G, bid);
        EpiBf16<0> E{WSP(act_t, WS_GT), D_FF, nullptr, 0, 0, 1.f}; gemm_phase<EpiBf16<0>, StaticOrder, true, true>(ldsb, g, S, E); } break;
    case S_GEMM_UP: { Gemm g{WSP(act_t, WS_XN), WSP(act_t, WS_WU), nrows, D_FF, D_MODEL, D_MODEL}; StaticOrder S; S.init(nrows, D_FF, G, bid);
        EpiUpM E{WSP(act_t, WS_GT), WSP(act_t, WS_ACT), p.in[I_FCW] + (size_t)L * 3 * D_FF, p.in[I_FCB] + (size_t)L * D_FF}; gemm_phase<EpiUpM, StaticOrder, true, true>(ldsb, g, S, E); } break;
    case S_GEMM_DOWN: { Gemm g{WSP(act_t, WS_ACT), WSP(act_t, WS_WD), nrows, D_MODEL, D_FF, D_FF};
        EpiResidM E{p.out, WSP(float, WS_XC), p.out, WSP(float, WS_XC), modL, 5, WSP(float, WS_SLAB), D_FF / 64};
        if (nrows > ML) { TailSplitOrder S; S.init(D_FF, G, bid); gemm_phase<EpiResidM, TailSplitOrder, true, true>(ldsb, g, S, E); }
        else { StaticOrder S; S.init(nrows, D_MODEL, G, bid); gemm_phase<EpiResidM, StaticOrder, true, true>(ldsb, g, S, E); } } break;
#endif
    default: break;
    }
}

#ifndef CPU_TEST
#define XB_TMO      128
#define XB_XCNT(j)  (256  + 64 * (j))
#define XB_XSUB(j)  (1280 + 64 * (j))
#define XB_XGEN(j)  (2304 + 64 * (j))
#define XB_TOP      3328
#define XB_TOPGEN   3392
#define XCD_BAR_WORDS 3456
#define XB_SPIN_CAP (1u << 22)
__device__ __forceinline__ unsigned xb_ld(unsigned* p)              { return __hip_atomic_load(p, __ATOMIC_RELAXED, __HIP_MEMORY_SCOPE_AGENT); }
__device__ __forceinline__ unsigned xb_add(unsigned* p, unsigned v) { return __hip_atomic_fetch_add(p, v, __ATOMIC_RELAXED, __HIP_MEMORY_SCOPE_AGENT); }
__device__ __forceinline__ unsigned xb_xcc_id() { return (unsigned)__builtin_amdgcn_s_getreg((3 << 11) | 20) & 0xFu; }
#define XB_SPIN(cond, bar) do { unsigned _sp = 0; while (cond) { __builtin_amdgcn_s_sleep(1); \
    if ((++_sp & 255u) == 0u) { if (xb_ld(&(bar)[XB_TMO])) break; if (_sp > XB_SPIN_CAP) { atomicAdd(&(bar)[XB_TMO], 1u); break; } } } } while (0)
struct XcdBarrier { unsigned* bar; unsigned x; volatile LAS unsigned* st; };
__device__ __forceinline__ XcdBarrier xcd_barrier_post(unsigned* bar, volatile LAS unsigned* st) {
    XcdBarrier b; b.bar = bar; b.x = xb_xcc_id(); b.st = st;
    if (TID_() == 0) (void)xb_add(&bar[XB_XCNT(b.x)], 1u);
    return b;
}
__device__ __forceinline__ void xcd_barrier_complete(unsigned* bar, unsigned x, unsigned& nloc, unsigned& nx) {
    const unsigned G = gridDim.x * gridDim.y * gridDim.z;
    unsigned sum, cnt, mine, sp = 0u;
    for (;;) {
        sum = 0u; cnt = 0u; mine = 0u;
#pragma unroll
        for (unsigned j = 0; j < 16; ++j) { const unsigned c = xb_ld(&bar[XB_XCNT(j)]); sum += c; cnt += (c > 0u) ? 1u : 0u; mine = (j == x) ? c : mine; }
        if (sum == G) break;
        __builtin_amdgcn_s_sleep(1);
        if ((++sp & 255u) == 0u) { if (xb_ld(&bar[XB_TMO])) break; if (sp > XB_SPIN_CAP) { atomicAdd(&bar[XB_TMO], 1u); break; } }
    }
    nloc = mine > 0u ? mine : 1u; nx = cnt > 0u ? cnt : 1u;
}
__device__ __forceinline__ void xcd_barrier(const XcdBarrier& b) {
    asm volatile("s_waitcnt vmcnt(0)" ::: "memory");
    __syncthreads();
    if (TID_() == 0) {
        unsigned* bar = b.bar;
        __builtin_amdgcn_s_waitcnt(0);
        unsigned nloc = b.st[0], nx = b.st[1];
        if (nloc == 0u) { xcd_barrier_complete(bar, b.x, nloc, nx); b.st[0] = nloc; b.st[1] = nx; }
        const unsigned old = xb_add(&bar[XB_XSUB(b.x)], 1u);
        const unsigned gen = old / nloc;
        if (old + 1u == (gen + 1u) * nloc) {
            __builtin_amdgcn_fence(__ATOMIC_RELEASE, "agent");
            asm volatile("s_waitcnt vmcnt(0)" ::: "memory");
            const unsigned og = xb_add(&bar[XB_TOP], 1u);
            const unsigned tg = og / nx;
            if (og + 1u == (tg + 1u) * nx) xb_add(&bar[XB_TOPGEN], 1u);
            else XB_SPIN(xb_ld(&bar[XB_TOPGEN]) == tg, bar);
            __builtin_amdgcn_fence(__ATOMIC_ACQUIRE, "agent");
            xb_add(&bar[XB_XGEN(b.x)], 1u);
            asm volatile("s_waitcnt vmcnt(0)" ::: "memory");
        } else {
            XB_SPIN(xb_ld(&bar[XB_XGEN(b.x)]) == gen, bar);
            __builtin_amdgcn_fence(__ATOMIC_ACQUIRE, "agent");
            asm volatile("s_waitcnt vmcnt(0)" ::: "memory");
        }
    }
    __syncthreads();
}

constexpr int LDS_BYTES = 147456;
constexpr int MISC_OFF = MISC_OFF_;
constexpr int CW_BAR = 4096;
__global__ void __launch_bounds__(NTHREADS_, 2) mk_fwd(Prm p) {
    extern __shared__ __attribute__((aligned(16))) unsigned char lds[];
    { volatile LAS unsigned* MISC = (volatile LAS unsigned*)((LAS unsigned char*)lds + MISC_OFF);
      for (int u = threadIdx.x; u < (LDS_BYTES - MISC_OFF) / 4; u += NTHREADS_) MISC[u] = 0u;
      __syncthreads();
      if ((threadIdx.x & 63) == 0) MISC[WTAB_ + HWSLOT_()] = threadIdx.x >> 6;
      __syncthreads();
      const XcdBarrier b0 = xcd_barrier_post((unsigned*)(p.ws + WS_CTL) + CW_BAR, MISC + 8);
      if (TID_() == 0) MISC[10] = b0.x;
      __syncthreads(); }
#define KARG() const __attribute__((address_space(4))) Prm* pp_ = (const __attribute__((address_space(4))) Prm*)__builtin_amdgcn_kernarg_segment_ptr(); asm volatile("" : "+s"(pp_))
#define RUN(st, L) do { KARG(); run_step(*(const Prm*)pp_, st, L, 0, 0); __syncthreads(); } while (0)
#define SYNC() do { asm volatile("s_waitcnt vmcnt(0)" ::: "memory");     \
        KARG(); volatile LAS unsigned* MISC = (volatile LAS unsigned*)((LAS unsigned char*)lds + MISC_OFF); XcdBarrier b_; b_.bar = (unsigned*)(((const Prm*)pp_)->ws + WS_CTL) + CW_BAR; b_.x = MISC[10]; b_.st = MISC + 8; xcd_barrier(b_); } while (0)
    RUN(S_MOD, 0); RUN(S_INIT, 0); RUN(S_TAB1, 0); RUN(S_WPREP, 0); SYNC();
#define LAYER(L) do { \
        if (L > 0) RUN(S_WPREP, L); else RUN(S_TAB2, 0); \
        RUN(S_NORM_MIX, L); SYNC(); RUN(S_GEMM_IN, L); RUN(S_TABB, L); SYNC(); \
        RUN(S_CONV, L); RUN(S_CS, L); RUN(S_QK, L); SYNC(); \
        RUN(S_STATE, L); RUN(S_S5E, L); RUN(S_ATTN, L); SYNC(); \
        RUN(S_SSD_CARRY, L); RUN(S_S5_CARRY, L); RUN(S_WPREP2, L); SYNC(); \
        RUN(S_SSD_Y, L); RUN(S_S5_Y, L); RUN(S_ATTNC, L); RUN(S_SUBGLU, L); SYNC(); \
        RUN(S_GEMM_OUT, L); SYNC(); RUN(S_NORM_FFN, L); SYNC(); \
        RUN(S_GEMM_GU, L); SYNC(); RUN(S_FIXUP, L); SYNC(); RUN(S_GEMM_DOWN, L); SYNC(); } while (0)
    LAYER(0); LAYER(1);
    static_assert(DEPTH == 2, "layer program written out for two layers");
#undef LAYER
    RUN(S_FINAL, 0);
#undef RUN
#undef SYNC
#undef KARG
}
extern "C" void kernel_launch(void* const* d_in, const int* in_sizes, int n_in, void* d_out, int out_size, void* d_ws, size_t ws_size, hipStream_t stream) {
    if (n_in != 35 || out_size != ML * D_MODEL || ws_size < WS_TOTAL) { fprintf(stderr, "kernel_launch: unexpected shapes (n_in %d out %d ws %zu need %zu)\n", n_in, out_size, ws_size, (size_t)WS_TOTAL); return; }
    Prm p{};
    for (int i = 0; i < 35; ++i) p.in[i] = (const float*)d_in[i];
    p.out = (float*)d_out; p.ws = (unsigned char*)d_ws;
    static int grid = 0;
    if (grid == 0) {
        int dev = 0, cus = 0;
        if (hipGetDevice(&dev) != hipSuccess || hipDeviceGetAttribute(&cus, hipDeviceAttributeMultiprocessorCount, dev) != hipSuccess) { fprintf(stderr, "kernel_launch: device query failed\n"); grid = -1; return; }
        if (hipFuncSetAttribute((const void*)mk_fwd, hipFuncAttributeMaxDynamicSharedMemorySize, LDS_BYTES) != hipSuccess) { fprintf(stderr, "kernel_launch: hipFuncSetAttribute failed\n"); grid = -1; return; }
        int per_cu = 0;
        if (hipOccupancyMaxActiveBlocksPerMultiprocessor(&per_cu, (const void*)mk_fwd, NTHREADS_, LDS_BYTES) != hipSuccess || per_cu < 1) fprintf(stderr, "kernel_launch: note: occupancy query reports %d blocks per CU\n", per_cu);
        (void)hipGetLastError();
        grid = cus;
    }
    if (grid < 0) return;
    if (hipMemsetAsync((char*)d_ws + WS_CTL, 0, CTL_BYTES, stream) != hipSuccess) { fprintf(stderr, "kernel_launch: memset failed\n"); return; }
    hipLaunchKernelGGL(mk_fwd, dim3(grid), dim3(NTHREADS_), LDS_BYTES, stream, p);
}
#endif
```
